# Optimizing an MI355X kernel written in HIP

```python
import math, functools
import jax, jax.numpy as jnp
from jax import lax
import numpy as np

D_MODEL = 1024
BATCH = 4
SEQ = 4096
DEPTH = 1
DEC_BATCH = 32
DEC_SEQ = 4
PAST_LEN = 16384
PAGE_SIZE = 128

RW_HEAD = 64
RW_HEADS = (D_MODEL // 2) // RW_HEAD
RW_WIDTH = RW_HEADS * RW_HEAD
W_LORA = 64
A_LORA = 64
G_LORA = 128
RW_GN_EPS = 64e-5
RW_SHIFT = 3 * RW_WIDTH + W_LORA + A_LORA + G_LORA

NSA_HEAD = 64
NSA_HEADS = (D_MODEL // 2) // NSA_HEAD
NSA_KV = 2
NSA_HPG = NSA_HEADS // NSA_KV
NSA_WIDTH = NSA_HEADS * NSA_HEAD
NSA_KV_COLS = NSA_KV * NSA_HEAD
NSA_SCALE = NSA_HEAD ** -0.5
CMP_STRIDE = 16
CMP_LEN = 2 * CMP_STRIDE
CMP_HID = 128
SEL_BLOCK = 64
SEL_TOPK = 16
WINDOW = 512
Q_BLOCK = 128

D_FF = 2816
N_IN = RW_SHIFT + NSA_WIDTH + 6 * NSA_KV_COLS + 3 * NSA_HEADS + 2 * D_MODEL
ALPHA = (2 * DEPTH) ** 0.25
BETA = (8 * DEPTH) ** -0.25
LN_EPS = 1e-5
NEG_INF = -1e30
BIG = 1e9

kernel_name = 'hybrid_rwkv7_nsa_macaron_deepnorm_step'


def layer_norm(x, g, b):
    xf = x.astype(jnp.float32)
    mu = xf.mean(-1, keepdims=True)
    var = jnp.square(xf - mu).mean(-1, keepdims=True)
    return ((xf - mu) * lax.rsqrt(var + LN_EPS) * g + b).astype(x.dtype)


def swiglu(u, w_gate, w_up, w_down):
    return (jax.nn.silu(u @ w_gate) * (u @ w_up)) @ w_down


def masked_softmax(s, mask):
    s = jnp.where(mask, s, NEG_INF)
    e = jnp.where(mask, jnp.exp(s - s.max(axis=-1, keepdims=True)), 0.0)
    return e / jnp.maximum(e.sum(axis=-1, keepdims=True), 1e-30)


def rwkv7_time_mix(p, prev, s0, mu, w0, w2, a0, a2, g2, k_k, k_a, r_k, ln_w, ln_b):
    B, T, _ = p.shape
    f32 = jnp.float32
    p_prev = jnp.concatenate([prev[:, None].astype(p.dtype), p[:, :-1]], axis=1)
    xs = p + (p_prev - p) * mu
    r, k, v, wd, ad, gd = jnp.split(xs, [RW_WIDTH, 2 * RW_WIDTH, 3 * RW_WIDTH,
                                         3 * RW_WIDTH + W_LORA, 3 * RW_WIDTH + W_LORA + A_LORA], axis=-1)
    heads = lambda t: t.reshape(B, T, RW_HEADS, RW_HEAD).astype(f32)
    log_w = -jax.nn.softplus(-(w0 + jnp.tanh(wd) @ w2).astype(f32)) - 0.5
    decay = jnp.exp(-jnp.exp(log_w))
    a = jax.nn.sigmoid(a0 + ad @ a2)
    g = jax.nn.sigmoid(gd) @ g2
    kk = heads(k * k_k)
    kk = kk * lax.rsqrt(jnp.maximum(jnp.sum(kk * kk, -1, keepdims=True), 1e-24))
    k = k * (1 + (a - 1) * k_a)
    r_h, k_h, v_h, a_h, w_h = heads(r), heads(k), heads(v), heads(a), heads(decay)

    def step(S, inp):
        r_t, w_t, k_t, v_t, kk_t, a_t = inp
        sa = jnp.einsum('bhij,bhj->bhi', S, -kk_t)
        S = S * w_t[:, :, None, :] + sa[..., None] * (kk_t * a_t)[:, :, None, :] + v_t[..., None] * k_t[:, :, None, :]
        return S, jnp.einsum('bhij,bhj->bhi', S, r_t)

    seq_first = lambda t: jnp.swapaxes(t, 0, 1)
    s_final, y = lax.scan(step, s0.astype(f32), tuple(seq_first(t) for t in (r_h, w_h, k_h, v_h, kk, a_h)))
    y = seq_first(y)
    mean = y.mean(-1, keepdims=True)
    var = jnp.square(y - mean).mean(-1, keepdims=True)
    y = ((y - mean) * lax.rsqrt(var + RW_GN_EPS)).reshape(B, T, RW_WIDTH) * ln_w + ln_b
    bonus = (jnp.sum(r_h * k_h * r_k, -1, keepdims=True) * v_h).reshape(B, T, RW_WIDTH)
    out = ((y + bonus) * g).astype(p.dtype)
    return out, p[:, -1], s_final


def compress_blocks(x, pe, w1, w2):
    B, L = x.shape[:2]
    n_cmp = (L - CMP_LEN) // CMP_STRIDE + 1
    ch = x[:, :(n_cmp + 1) * CMP_STRIDE].reshape(B, n_cmp + 1, CMP_STRIDE, NSA_KV, NSA_HEAD)
    h_lo = jnp.einsum('bnjgd,jde->bnge', ch, w1[:CMP_STRIDE])
    h_hi = jnp.einsum('bnjgd,jde->bnge', ch, w1[CMP_STRIDE:])
    h = jax.nn.gelu(h_lo[:, :-1] + h_hi[:, 1:] + jnp.einsum('jd,jde->e', pe, w1))
    return jnp.einsum('bnge,ed->bngd', h, w2)


def to_blocks(x):
    B, L = x.shape[:2]
    n_sel = -(-L // SEL_BLOCK)
    x = jnp.pad(x, ((0, 0), (0, n_sel * SEL_BLOCK - L), (0, 0), (0, 0)))
    return x.reshape(B, n_sel, SEL_BLOCK, NSA_KV, NSA_HEAD).transpose(0, 3, 1, 2, 4)


def block_importance(p, n_sel):
    R = SEL_BLOCK // CMP_STRIDE
    n_cmp = p.shape[-1]
    pad = [(0, 0)] * (p.ndim - 1) + [(1, R * (n_sel + 1) - 1 - n_cmp)]
    pp = jnp.pad(p, pad).reshape(p.shape[:-1] + (n_sel + 1, R))
    return pp[..., :-1, :].sum(-1) + pp[..., 1:, 0]


def nsa_attend(q, gates, q_pos, kc, vc, ksb, vsb, kw, vw, w_pos):
    B, Qb = q.shape[:2]
    f32 = jnp.float32
    qg = q.reshape(B, Qb, NSA_KV, NSA_HPG, NSA_HEAD) * NSA_SCALE
    cmp_end = jnp.arange(kc.shape[1]) * CMP_STRIDE + (CMP_LEN - 1)
    s = jnp.einsum('bqghd,bngd->bghqn', qg, kc, preferred_element_type=f32)
    p_c = masked_softmax(s, cmp_end[None, :] <= q_pos[:, None])
    o_c = jnp.einsum('bghqn,bngd->bqghd', p_c.astype(vc.dtype), vc)
    n_sel = ksb.shape[2]
    score = block_importance(p_c.sum(axis=2), n_sel)
    cur = (q_pos // SEL_BLOCK)[:, None]
    j = jnp.arange(n_sel)[None, :]
    forced = (j == 0) | (j == cur) | (j == cur - 1)
    score = jnp.where(j <= cur, jnp.where(forced, BIG, score), -BIG)
    _, idx = lax.top_k(score, min(SEL_TOPK, n_sel))
    bi = jnp.arange(B)[:, None, None, None]
    gi = jnp.arange(NSA_KV)[None, :, None, None]
    n_keys = idx.shape[-1] * SEL_BLOCK
    kb = ksb[bi, gi, idx].reshape(B, NSA_KV, Qb, n_keys, NSA_HEAD)
    vb = vsb[bi, gi, idx].reshape(B, NSA_KV, Qb, n_keys, NSA_HEAD)
    k_pos = (idx[..., None] * SEL_BLOCK + jnp.arange(SEL_BLOCK)).reshape(B, NSA_KV, 1, Qb, n_keys)
    s = jnp.einsum('bqghd,bgqld->bghql', qg, kb, preferred_element_type=f32)
    p_s = masked_softmax(s, k_pos <= q_pos[:, None])
    o_s = jnp.einsum('bghql,bgqld->bqghd', p_s.astype(vb.dtype), vb)
    s = jnp.einsum('bqghd,blgd->bghql', qg, kw, preferred_element_type=f32)
    dist = q_pos[:, None] - w_pos[None, :]
    p_w = masked_softmax(s, (dist >= 0) & (dist < WINDOW) & (w_pos[None, :] >= 0))
    o_w = jnp.einsum('bghql,blgd->bqghd', p_w.astype(vw.dtype), vw)
    gt = gates.reshape(B, Qb, NSA_KV, NSA_HPG, 3)
    o = gt[..., 0:1] * o_c + gt[..., 1:2] * o_s + gt[..., 2:3] * o_w
    return o.reshape(B, Qb, NSA_WIDTH)


def nsa_prompt(q, gates, kvc, kvs, kvw, lp):
    B, T = q.shape[:2]
    kc = compress_blocks(kvc[:, :, 0], lp['phi_pe'][0], lp['phi_w1'][0], lp['phi_w2'][0])
    vc = compress_blocks(kvc[:, :, 1], lp['phi_pe'][1], lp['phi_w1'][1], lp['phi_w2'][1])
    ksb, vsb = to_blocks(kvs[:, :, 0]), to_blocks(kvs[:, :, 1])
    qb = min(Q_BLOCK, T)
    nb = T // qb
    kvw_pad = jnp.pad(kvw, ((0, 0), (WINDOW, 0), (0, 0), (0, 0), (0, 0)))

    def one_block(args):
        i, q_i, g_i = args
        t0 = i * qb
        kvw_i = lax.dynamic_slice_in_dim(kvw_pad, t0, WINDOW + qb, axis=1)
        return nsa_attend(q_i, g_i, t0 + jnp.arange(qb), kc, vc, ksb, vsb,
                          kvw_i[:, :, 0], kvw_i[:, :, 1], t0 - WINDOW + jnp.arange(WINDOW + qb))

    blocks = lambda t: jnp.swapaxes(t.reshape((B, nb, qb) + t.shape[2:]), 0, 1)
    out = lax.map(one_block, (jnp.arange(nb), blocks(q), blocks(gates)))
    y = jnp.swapaxes(out, 0, 1).reshape(B, T, NSA_WIDTH)
    return y, kvw[:, T - min(WINDOW, T):]


def nsa_sample(q, gates, kvc, kvs, kvw, lp, past_kvc, past_kvs, win_buf, past_len):
    B, T = q.shape[:2]
    kvc_all = jnp.concatenate([past_kvc.astype(kvc.dtype), kvc], axis=1)
    kvs_all = jnp.concatenate([past_kvs.astype(kvs.dtype), kvs], axis=1)
    kc = compress_blocks(kvc_all[:, :, 0], lp['phi_pe'][0], lp['phi_w1'][0], lp['phi_w2'][0])
    vc = compress_blocks(kvc_all[:, :, 1], lp['phi_pe'][1], lp['phi_w1'][1], lp['phi_w2'][1])
    ksb, vsb = to_blocks(kvs_all[:, :, 0]), to_blocks(kvs_all[:, :, 1])
    n_buf = win_buf.shape[1]
    win_all = jnp.concatenate([win_buf.astype(kvw.dtype), kvw], axis=1)
    w_pos = past_len - n_buf + jnp.arange(n_buf + T)
    y = nsa_attend(q, gates, past_len + jnp.arange(T), kc, vc, ksb, vsb,
                   win_all[:, :, 0], win_all[:, :, 1], w_pos)
    return y, win_all[:, T:]


def group_layer(x, c, lp, rw_prev, rw_wkv, nsa_fn):
    B, T, _ = x.shape
    mod = (jax.nn.silu(c) @ lp['w_ada'] + lp['b_ada']).reshape(B, 9, 1, D_MODEL)
    u = x * (1 + mod[:, 1]) + mod[:, 0]
    f = swiglu(u, lp['ffn_w_gate'][0], lp['ffn_w_up'][0], lp['ffn_w_down'][0])
    x = layer_norm(ALPHA * x + 0.5 * (1 + mod[:, 2]) * f, lp['ln_g'][0], lp['ln_b'][0])
    u = x * (1 + mod[:, 4]) + mod[:, 3]
    proj = u @ lp['w_in'] + lp['b_in']
    c1 = RW_SHIFT
    c2 = c1 + NSA_WIDTH
    c3 = c2 + 6 * NSA_KV_COLS
    c4 = c3 + 3 * NSA_HEADS
    p_rw, p_q, p_kv, p_gate, p_merge = jnp.split(proj, [c1, c2, c3, c4], axis=-1)
    y_a, new_prev, new_wkv = rwkv7_time_mix(p_rw, rw_prev, rw_wkv, lp['rw_mu'], lp['rw_w0'], lp['rw_w2'],
                                            lp['rw_a0'], lp['rw_a2'], lp['rw_g2'], lp['rw_k_k'],
                                            lp['rw_k_a'], lp['rw_r_k'], lp['rw_ln_w'], lp['rw_ln_b'])
    kv = p_kv.reshape(B, T, 3, 2, NSA_KV, NSA_HEAD)
    y_b, new_win = nsa_fn(p_q.reshape(B, T, NSA_HEADS, NSA_HEAD),
                          jax.nn.sigmoid(p_gate).reshape(B, T, NSA_HEADS, 3),
                          kv[:, :, 0], kv[:, :, 1], kv[:, :, 2], lp)
    g_a, g_b = jnp.split(jax.nn.sigmoid(p_merge), 2, axis=-1)
    m = (g_a * (y_a @ lp['w_out_a']) + g_b * (y_b @ lp['w_out_b'])) @ lp['w_o']
    x = layer_norm(ALPHA * x + (1 + mod[:, 5]) * m, lp['ln_g'][1], lp['ln_b'][1])
    u = x * (1 + mod[:, 7]) + mod[:, 6]
    f = swiglu(u, lp['ffn_w_gate'][1], lp['ffn_w_up'][1], lp['ffn_w_down'][1])
    x = layer_norm(ALPHA * x + 0.5 * (1 + mod[:, 8]) * f, lp['ln_g'][2], lp['ln_b'][2])
    return x, (kv[:, :, 0], kv[:, :, 1], new_win, new_wkv, new_prev)


def setup_inputs(seed: int = 0) -> dict:
    key = jax.random.key(seed)
    ks = jax.random.split(key, 40)
    nrm = lambda k, shape, scale: scale * jax.random.normal(k, shape, jnp.float32)
    L = DEPTH
    n_pages = PAST_LEN // PAGE_SIZE
    n_used = DEC_BATCH * n_pages
    n_phys = n_used + max(1, n_used // 4)
    win_buf = min(WINDOW, PAST_LEN)
    page_table = jax.random.permutation(ks[0], n_phys)[:n_used].reshape(DEC_BATCH, n_pages).astype(jnp.int32)
    return {
        'x_prompt': nrm(ks[1], (BATCH, SEQ, D_MODEL), 1.0),
        'x_sample': nrm(ks[2], (DEC_BATCH, DEC_SEQ, D_MODEL), 1.0),
        'c_prompt': nrm(ks[3], (BATCH, D_MODEL), 1.0),
        'c_sample': nrm(ks[4], (DEC_BATCH, D_MODEL), 1.0),
        'cache_kv_cmp': nrm(ks[5], (L, n_phys, PAGE_SIZE, 2, NSA_KV, NSA_HEAD), 1.0),
        'cache_kv_sel': nrm(ks[6], (L, n_phys, PAGE_SIZE, 2, NSA_KV, NSA_HEAD), 1.0),
        'state_kv_win': nrm(ks[7], (L, DEC_BATCH, win_buf, 2, NSA_KV, NSA_HEAD), 1.0),
        'state_wkv': nrm(ks[8], (L, DEC_BATCH, RW_HEADS, RW_HEAD, RW_HEAD), 0.3),
        'state_shift': nrm(ks[9], (L, DEC_BATCH, RW_SHIFT), 1.0),
        'page_table': page_table,
        'w_ada': nrm(ks[10], (L, D_MODEL, 9 * D_MODEL), 0.2 * D_MODEL ** -0.5),
        'b_ada': nrm(ks[11], (L, 9 * D_MODEL), 0.02),
        'ln_g': 1.0 + nrm(ks[12], (L, 3, D_MODEL), 0.05),
        'ln_b': nrm(ks[13], (L, 3, D_MODEL), 0.02),
        'ffn_w_gate': nrm(ks[14], (L, 2, D_MODEL, D_FF), D_MODEL ** -0.5),
        'ffn_w_up': nrm(ks[15], (L, 2, D_MODEL, D_FF), D_MODEL ** -0.5),
        'ffn_w_down': nrm(ks[16], (L, 2, D_FF, D_MODEL), BETA * D_FF ** -0.5),
        'w_in': nrm(ks[17], (L, D_MODEL, N_IN), D_MODEL ** -0.5),
        'b_in': nrm(ks[18], (L, N_IN), 0.02),
        'rw_mu': jax.random.uniform(ks[19], (L, RW_SHIFT), jnp.float32),
        'rw_w0': -1.0 + nrm(ks[20], (L, RW_WIDTH), 0.5),
        'rw_w2': nrm(ks[21], (L, W_LORA, RW_WIDTH), 0.5 * W_LORA ** -0.5),
        'rw_a0': nrm(ks[22], (L, RW_WIDTH), 0.5),
        'rw_a2': nrm(ks[23], (L, A_LORA, RW_WIDTH), 0.5 * A_LORA ** -0.5),
        'rw_g2': nrm(ks[24], (L, G_LORA, RW_WIDTH), G_LORA ** -0.5),
        'rw_k_k': 0.85 + nrm(ks[25], (L, RW_WIDTH), 0.05),
        'rw_k_a': 1.0 + nrm(ks[26], (L, RW_WIDTH), 0.05),
        'rw_r_k': nrm(ks[27], (L, RW_HEADS, RW_HEAD), 0.1),
        'rw_ln_w': 1.0 + nrm(ks[28], (L, RW_WIDTH), 0.05),
        'rw_ln_b': nrm(ks[29], (L, RW_WIDTH), 0.02),
        'nsa_phi_pe': nrm(ks[30], (L, 2, CMP_LEN, NSA_HEAD), 0.1),
        'nsa_phi_w1': nrm(ks[31], (L, 2, CMP_LEN, NSA_HEAD, CMP_HID), (CMP_LEN * NSA_HEAD) ** -0.5),
        'nsa_phi_w2': nrm(ks[32], (L, 2, CMP_HID, NSA_HEAD), CMP_HID ** -0.5),
        'w_out_a': nrm(ks[33], (L, RW_WIDTH, D_MODEL), BETA * RW_WIDTH ** -0.5),
        'w_out_b': nrm(ks[34], (L, NSA_WIDTH, D_MODEL), BETA * NSA_WIDTH ** -0.5),
        'w_o': nrm(ks[35], (L, D_MODEL, D_MODEL), BETA * D_MODEL ** -0.5),
    }


def reference(x_prompt, x_sample, c_prompt, c_sample, cache_kv_cmp, cache_kv_sel, state_kv_win,
              state_wkv, state_shift, page_table, w_ada, b_ada, ln_g, ln_b, ffn_w_gate, ffn_w_up,
              ffn_w_down, w_in, b_in, rw_mu, rw_w0, rw_w2, rw_a0, rw_a2, rw_g2, rw_k_k, rw_k_a,
              rw_r_k, rw_ln_w, rw_ln_b, nsa_phi_pe, nsa_phi_w1, nsa_phi_w2, w_out_a, w_out_b, w_o):
    bp = x_prompt.shape[0]
    bd = x_sample.shape[0]
    past_len = page_table.shape[1] * cache_kv_cmp.shape[2]
    y_prompt, y_sample = x_prompt, x_sample
    st_prompt, st_sample = [], []
    for l in range(DEPTH):
        lp = dict(w_ada=w_ada[l], b_ada=b_ada[l], ln_g=ln_g[l], ln_b=ln_b[l],
                  ffn_w_gate=ffn_w_gate[l], ffn_w_up=ffn_w_up[l], ffn_w_down=ffn_w_down[l],
                  w_in=w_in[l], b_in=b_in[l], rw_mu=rw_mu[l], rw_w0=rw_w0[l], rw_w2=rw_w2[l],
                  rw_a0=rw_a0[l], rw_a2=rw_a2[l], rw_g2=rw_g2[l], rw_k_k=rw_k_k[l], rw_k_a=rw_k_a[l],
                  rw_r_k=rw_r_k[l], rw_ln_w=rw_ln_w[l], rw_ln_b=rw_ln_b[l],
                  phi_pe=nsa_phi_pe[l], phi_w1=nsa_phi_w1[l], phi_w2=nsa_phi_w2[l],
                  w_out_a=w_out_a[l], w_out_b=w_out_b[l], w_o=w_o[l])
        y_prompt, st_p = group_layer(y_prompt, c_prompt, lp,
                                     jnp.zeros((bp, RW_SHIFT), x_prompt.dtype),
                                     jnp.zeros((bp, RW_HEADS, RW_HEAD, RW_HEAD), jnp.float32),
                                     nsa_prompt)
        past_kvc = cache_kv_cmp[l, page_table].reshape(bd, past_len, 2, NSA_KV, NSA_HEAD)
        past_kvs = cache_kv_sel[l, page_table].reshape(bd, past_len, 2, NSA_KV, NSA_HEAD)
        nsa_s = functools.partial(nsa_sample, past_kvc=past_kvc, past_kvs=past_kvs,
                                  win_buf=state_kv_win[l], past_len=past_len)
        y_sample, st_s = group_layer(y_sample, c_sample, lp, state_shift[l], state_wkv[l], nsa_s)
        st_prompt.append(st_p)
        st_sample.append(st_s)
    new_kv_cmp_prompt = jnp.stack([s[0] for s in st_prompt])
    new_kv_sel_prompt = jnp.stack([s[1] for s in st_prompt])
    new_kv_win_prompt = jnp.stack([s[2] for s in st_prompt])
    new_wkv_prompt = jnp.stack([s[3] for s in st_prompt])
    new_shift_prompt = jnp.stack([s[4] for s in st_prompt])
    new_kv_cmp_sample = jnp.stack([s[0] for s in st_sample])
    new_kv_sel_sample = jnp.stack([s[1] for s in st_sample])
    new_kv_win_sample = jnp.stack([s[2] for s in st_sample])
    new_wkv_sample = jnp.stack([s[3] for s in st_sample])
    new_shift_sample = jnp.stack([s[4] for s in st_sample])
    return (y_prompt, y_sample, new_kv_cmp_prompt, new_kv_sel_prompt, new_kv_win_prompt,
            new_wkv_prompt, new_shift_prompt, new_kv_cmp_sample, new_kv_sel_sample,
            new_kv_win_sample, new_wkv_sample, new_shift_sample)
```

```cpp
#include <hip/hip_runtime.h>
#include <cstdio>
#include <cstdint>
#define DI __device__ __forceinline__
constexpr int D = 1024, FF = 2816, T = 4096, NBP = 4, NBS = 32, ST = 4;
constexpr int MP = NBP * T;
constexpr int MS = NBS * ST;
constexpr int MR = MP + MS;
constexpr int MA = 16640;
constexpr int NIN = 5144, NINP = 5376;
constexpr int C_Q = 1792, C_KV = 2304, C_GATE = 3072, C_MERGE = 3096;
constexpr int RWW = 512;
constexpr int NCH_S = 1024, NCH_P = 256;
constexpr int NCMP_S = 1023, NCMP_P = 255;
constexpr int CROWS_S = NBS * NCH_S * 2;
constexpr int CROWS = CROWS_S + NBP * NCH_P * 2;
constexpr float ALPHA = 1.189207115002721f;
constexpr float LN_EPS = 1e-5f, GN_EPS = 64e-5f;
constexpr float LOG2E = 1.4426950408889634f;
constexpr float NEGF = -1e30f;
constexpr size_t O_Y = 0;
constexpr size_t O_KVC_P = 16908288, O_KVS_P = 21102592, O_KVW_P = 25296896, O_WKV_P = 25821184, O_SH_P = 25952256;
constexpr size_t O_KVC_S = 25959424, O_KVS_S = 25992192, O_KVW_S = 26024960, O_WKV_S = 30219264, O_SH_S = 31267840, O_END = 31325184;
DI int bb_of_row(int row) { return row < MP ? (row >> 12) : (row < MR ? 4 + ((row - MP) >> 2) : 35); }
namespace pg8 {
#define PG8_LAS __attribute__((address_space(3)))
typedef unsigned short bf16_t;
typedef short bf16x8 __attribute__((ext_vector_type(8)));
typedef float f32x4 __attribute__((ext_vector_type(4)));
typedef unsigned u32x4 __attribute__((ext_vector_type(4)));
constexpr int BM = 256, BK = 64, HALF = 128, HTB = HALF * BK * 2  , STAGE_BYTES = 8 * HTB, NXCD = 8, WGM = 8;

__host__ __device__ __forceinline__ int lds_byte(int r, int c) { const int st = (r >> 4) * 2 + (c >> 5), rr = r & 15, cc = c & 31, ob = rr * 64 + cc * 2; return st * 1024 + (ob ^ (((ob >> 9) & 1) << 5)); }
__host__ __device__ __forceinline__ void stage_rc(int b, int& R, int& C) { const int st = b / 1024, sb = b % 1024, swz = sb ^ (((sb >> 9) & 1) << 5); R = (st >> 1) * 16 + swz / 64; C = (st & 1) * 32 + (swz % 64) / 2; }
__host__ __device__ __forceinline__ int perm32(int rho) { const int n = rho >> 4, i = rho & 15; return 8 * (i >> 2) + 4 * n + (i & 3); }

struct Unit { int pm, pn; };
struct Gemm { const bf16_t* A; const bf16_t* Bt; int M, N, K; };

struct StaticOrder {
    int nM, nN, nwg, G, c;
    __host__ __device__ void init(int M, int N, int G_, int c_) { nM = M / BM; nN = N / BM; nwg = nM * nN; G = G_; c = c_; }
    __host__ __device__ bool next(int i, Unit& u) const {
        const long L = (long)i * G + c; if (L >= nwg) return false;
        int wgid = (int)L; { const int q = nwg / NXCD, r = nwg % NXCD, xcd = wgid % NXCD, off = wgid / NXCD; wgid = (xcd < r ? xcd * (q + 1) : r * (q + 1) + (xcd - r) * q) + off; }
        const int nig = WGM * nN, gid = wgid / nig, fm = gid * WGM, gsz = (nM - fm) < WGM ? (nM - fm) : WGM;
        u.pm = fm + ((wgid % nig) % gsz); u.pn = (wgid % nig) / gsz; return true;
    }
    __device__ __forceinline__ void a_ready(const Unit&) const {}
    __device__ __forceinline__ void done(const Unit&) const {}
};

struct PairOrder {
    int nm, nn, G, c;
    __device__ __forceinline__ bool next(int i, Unit& u) const {
        const int tile = (i >> 1) * G + c; if (tile >= nm * nn) return false;
        const int rep = i & 1; u.pm = tile / nn + rep * nm; u.pn = tile % nn + rep * nn; return true;
    }
    __device__ __forceinline__ void a_ready(const Unit&) const {}
    __device__ __forceinline__ void done(const Unit&) const {}
};
struct DiagOrder {
    int nm, nn, nrep, G, c;
    __device__ __forceinline__ bool next(int i, Unit& u) const {
        const int L = i * G + c; if (L >= nrep * nm * nn) return false;
        const int rep = L / (nm * nn), rem = L % (nm * nn); u.pm = rem / nn + rep * nm; u.pn = rem % nn + rep * nn; return true;
    }
    __device__ __forceinline__ void a_ready(const Unit&) const {}
    __device__ __forceinline__ void done(const Unit&) const {}
};

typedef float f32x2 __attribute__((ext_vector_type(2)));
typedef __bf16 bf16x2_t __attribute__((ext_vector_type(2)));
__device__ __forceinline__ unsigned cvt_pk_bf16(float lo, float hi) { f32x2 v = {lo, hi}; bf16x2_t b = __builtin_convertvector(v, bf16x2_t); return __builtin_bit_cast(unsigned, b); }
__device__ __forceinline__ float fast_sigmoid(float x) { return __builtin_amdgcn_rcpf(1.0f + __builtin_amdgcn_exp2f(-x * LOG2E)); }

struct EpiSwiglu {
    static constexpr bool PERM = true, AFTER_DRAIN = false;
    bf16_t* H;
    __device__ __forceinline__ void operator()(const f32x4 (&acc)[2][2][4][2], const Unit& u, int wr, int wc, int fr, int fq) const {
        const int row0 = u.pm * BM + wr * 64 + fr, hc0 = u.pn * HALF + wc * 32 + 8 * fq;
#pragma unroll
        for (int ai = 0; ai < 2; ++ai)
#pragma unroll
            for (int m = 0; m < 4; ++m) {
                bf16_t* rowp = H + (size_t)(row0 + ai * HALF + m * 16) * FF + hc0;
                float h[8];
#pragma unroll
                for (int n = 0; n < 2; ++n)
#pragma unroll
                    for (int e = 0; e < 4; ++e) { const float g = acc[ai][0][m][n][e], up = acc[ai][1][m][n][e]; h[4 * n + e] = g * fast_sigmoid(g) * up; }
                u32x4 w; w.x = cvt_pk_bf16(h[0], h[1]); w.y = cvt_pk_bf16(h[2], h[3]); w.z = cvt_pk_bf16(h[4], h[5]); w.w = cvt_pk_bf16(h[6], h[7]);
                *(u32x4*)rowp = w;
            }
    }
};
struct EpiResid {
    static constexpr bool PERM = false, AFTER_DRAIN = false;
    const float* xp; const float* xs; const float* mod; int slot; float coef; float* Z;
    __device__ __forceinline__ void operator()(const f32x4 (&acc)[2][2][4][2], const Unit& u, int wr, int wc, int fr, int fq) const {
        const int row0 = u.pm * BM + wr * 64 + fr, col0 = u.pn * BM + wc * 32 + 4 * fq;
#pragma unroll
        for (int ai = 0; ai < 2; ++ai)
#pragma unroll
            for (int m = 0; m < 4; ++m) {
                const int row = row0 + ai * HALF + m * 16; const bool valid = row < MR;
                const float* xr = row < MP ? xp + (size_t)row * D : xs + (size_t)(row - MP) * D;
                const float* mr = mod + (size_t)(bb_of_row(row) * 9 + slot) * D;
#pragma unroll
                for (int bj = 0; bj < 2; ++bj)
#pragma unroll
                    for (int n = 0; n < 2; ++n) { const int col = col0 + bj * HALF + n * 16;
                        const f32x4 xv = valid ? *(const f32x4*)(xr + col) : (f32x4){0.f, 0.f, 0.f, 0.f}; const f32x4 mv = *(const f32x4*)(mr + col);
                        *(f32x4*)(Z + (size_t)row * D + col) = ALPHA * xv + coef * (1.0f + mv) * acc[ai][bj][m][n]; }
            }
    }
};
struct EpiProj {
    static constexpr bool PERM = false, AFTER_DRAIN = false;
    const float* bias; float* P;
    __device__ __forceinline__ void operator()(const f32x4 (&acc)[2][2][4][2], const Unit& u, int wr, int wc, int fr, int fq) const {
        const int row0 = u.pm * BM + wr * 64 + fr, col0 = u.pn * BM + wc * 32 + 4 * fq;
        f32x4 bv[2][2];
#pragma unroll
        for (int bj = 0; bj < 2; ++bj)
#pragma unroll
            for (int n = 0; n < 2; ++n) { const int col = col0 + bj * HALF + n * 16; bv[bj][n] = col < NIN ? *(const f32x4*)(bias + col) : (f32x4){0.f, 0.f, 0.f, 0.f}; }
#pragma unroll
        for (int ai = 0; ai < 2; ++ai)
#pragma unroll
            for (int m = 0; m < 4; ++m) { float* rp = P + (size_t)(row0 + ai * HALF + m * 16) * NINP + col0;
#pragma unroll
                for (int bj = 0; bj < 2; ++bj)
#pragma unroll
                    for (int n = 0; n < 2; ++n) *(f32x4*)(rp + bj * HALF + n * 16) = acc[ai][bj][m][n] + bv[bj][n]; }
    }
};
struct EpiF32 {
    static constexpr bool PERM = false, AFTER_DRAIN = false;
    float* O; int ldc; int nm;
    __device__ __forceinline__ void operator()(const f32x4 (&acc)[2][2][4][2], const Unit& u, int wr, int wc, int fr, int fq) const {
        const int row0 = u.pm * BM + wr * 64 + fr, col0 = wc * 32 + 4 * fq;
#pragma unroll
        for (int ai = 0; ai < 2; ++ai)
#pragma unroll
            for (int m = 0; m < 4; ++m) { float* rp = O + (size_t)(row0 + ai * HALF + m * 16) * ldc + col0;
#pragma unroll
                for (int bj = 0; bj < 2; ++bj)
#pragma unroll
                    for (int n = 0; n < 2; ++n) *(f32x4*)(rp + bj * HALF + n * 16) = acc[ai][bj][m][n]; }
    }
};
struct EpiOutAB {
    static constexpr bool PERM = false, AFTER_DRAIN = false;
    const float* P; float* M1; bf16_t* MIN; int nm;
    __device__ __forceinline__ void operator()(const f32x4 (&acc)[2][2][4][2], const Unit& u, int wr, int wc, int fr, int fq) const {
        const int rep = u.pm >= nm ? 1 : 0;
        const int row0 = (u.pm - rep * nm) * BM + wr * 64 + fr, col0 = (u.pn - rep * 4) * BM + wc * 32 + 4 * fq;
#pragma unroll
        for (int ai = 0; ai < 2; ++ai)
#pragma unroll
            for (int m = 0; m < 4; ++m) { const int row = row0 + ai * HALF + m * 16;
#pragma unroll
                for (int bj = 0; bj < 2; ++bj)
#pragma unroll
                    for (int n = 0; n < 2; ++n) { const int col = col0 + bj * HALF + n * 16;
                        const f32x4 pm = *(const f32x4*)(P + (size_t)row * NINP + C_MERGE + rep * D + col);
                        f32x4 g; g[0] = fast_sigmoid(pm[0]); g[1] = fast_sigmoid(pm[1]); g[2] = fast_sigmoid(pm[2]); g[3] = fast_sigmoid(pm[3]);
                        const f32x4 v = g * acc[ai][bj][m][n];
                        if (rep == 0) *(f32x4*)(M1 + (size_t)row * D + col) = v;
                        else { const f32x4 s = *(const f32x4*)(M1 + (size_t)row * D + col) + v;
                               typedef unsigned u32x2v __attribute__((ext_vector_type(2))); u32x2v w; w.x = cvt_pk_bf16(s[0], s[1]); w.y = cvt_pk_bf16(s[2], s[3]);
                               *(u32x2v*)(MIN + (size_t)row * D + col) = w; } }
            }
    }
};
template <class Epi, class Sched, bool ALIGN_EPI = false, bool SP2 = false>
__device__ __forceinline__ void gemm_phase(PG8_LAS unsigned char* lds, const Gemm g, const Sched& S, const Epi& E) {
    const int tid = threadIdx.x, wid = __builtin_amdgcn_readfirstlane(tid >> 6), lane = tid & 63, wr = wid >> 2, wc = wid & 3, fr = lane & 15, fq = lane >> 4;
    const int K = g.K, nt = K / BK;
    unsigned voffA[2], voffB[2];
#pragma unroll
    for (int i = 0; i < 2; ++i) { int R, C; stage_rc(tid * 16 + i * 8192, R, C); const int Rb = Epi::PERM ? ((R & ~31) + perm32(R & 31)) : R;
        voffA[i] = (unsigned)(R * K + C) * 2u; voffB[i] = (unsigned)(Rb * K + C) * 2u; }
    const size_t kstep = (size_t)(BK * 2);
    const size_t hstep = (size_t)HALF * K * 2;
    const size_t tstep = 2 * hstep;
    const unsigned ldsw = (unsigned)wid * 1024u;
    const int aoff = lds_byte(wr * 64 + fr, fq * 8), boff = lds_byte(wc * 32 + fr, fq * 8);
#define PG8_SA(b, h) (((b) * 2 + (h)) * HTB)
#define PG8_SB(b, h) ((4 + (b) * 2 + (h)) * HTB)
#define PG8_STAGE(bufoff, gbase, voff) do { _Pragma("unroll") for (int _i = 0; _i < 2; ++_i) \
        __builtin_amdgcn_global_load_lds((const unsigned*)((const char*)(gbase) + (voff)[_i]), (PG8_LAS unsigned*)(lds + (bufoff) + ldsw + _i * 8192), 16, 0, 0); } while (0)
#define PG8_LDA(dst, b, h) do { _Pragma("unroll") for (int m = 0; m < 4; ++m) _Pragma("unroll") for (int k = 0; k < 2; ++k) dst[m][k] = *(const PG8_LAS bf16x8*)(lds + PG8_SA(b, h) + aoff + m * 2048 + k * 1024); } while (0)
#define PG8_LDB(dst, b, h) do { _Pragma("unroll") for (int n = 0; n < 2; ++n) _Pragma("unroll") for (int k = 0; k < 2; ++k) dst[n][k] = *(const PG8_LAS bf16x8*)(lds + PG8_SB(b, h) + boff + n * 2048 + k * 1024); } while (0)
#define PG8_MMA(ai, bj, At, Bt) do { __builtin_amdgcn_s_setprio(1); _Pragma("unroll") for (int m = 0; m < 4; ++m) _Pragma("unroll") for (int n = 0; n < 2; ++n) _Pragma("unroll") for (int k = 0; k < 2; ++k) \
        acc[ai][bj][m][n] = __builtin_amdgcn_mfma_f32_16x16x32_bf16(Bt[n][k], At[m][k], acc[ai][bj][m][n], 0, 0, 0); __builtin_amdgcn_s_setprio(0); } while (0)
#define PG8_WAIT_V(n) asm volatile("s_waitcnt vmcnt(" #n ")" ::: "memory")
#define PG8_WAIT_L(n) asm volatile("s_waitcnt lgkmcnt(" #n ")" ::: "memory")
#define PG8_BAR __builtin_amdgcn_s_barrier()
#define PG8_SCHED __builtin_amdgcn_sched_barrier(0)
    Unit cur, nxt; int ui = 0;
    if (!S.next(0, cur)) return;
    f32x4 acc[2][2][4][2];
#pragma unroll
    for (int a = 0; a < 2; ++a)
#pragma unroll
        for (int b = 0; b < 2; ++b)
#pragma unroll
            for (int m = 0; m < 4; ++m)
#pragma unroll
                for (int n = 0; n < 2; ++n) acc[a][b][m][n] = (f32x4){0.f, 0.f, 0.f, 0.f};
    bf16x8 At[4][2], B0[2][2], B1[2][2];
    const char* cA = (const char*)g.A + (size_t)cur.pm * tstep; const char* cB = (const char*)g.Bt + (size_t)cur.pn * tstep;
    S.a_ready(cur);
    if constexpr (SP2) {
        PG8_STAGE(PG8_SB(0, 0), cB, voffB); PG8_STAGE(PG8_SB(0, 1), cB + hstep, voffB); PG8_STAGE(PG8_SA(0, 0), cA, voffA); PG8_STAGE(PG8_SA(0, 1), cA + hstep, voffA);
        if (wr == 1) PG8_BAR;
        PG8_WAIT_V(2); PG8_BAR;
        PG8_STAGE(PG8_SB(1, 0), cB + kstep, voffB); PG8_STAGE(PG8_SA(1, 0), cA + kstep, voffA); PG8_STAGE(PG8_SB(1, 1), cB + hstep + kstep, voffB);
        PG8_WAIT_V(6); PG8_BAR;
    } else {
        PG8_STAGE(PG8_SB(0, 0), cB, voffB); PG8_STAGE(PG8_SA(0, 0), cA, voffA); PG8_STAGE(PG8_SB(0, 1), cB + hstep, voffB); PG8_STAGE(PG8_SA(0, 1), cA + hstep, voffA);
        if (wr == 1) PG8_BAR;
        PG8_WAIT_V(4); PG8_BAR;
        PG8_STAGE(PG8_SB(1, 0), cB + kstep, voffB); PG8_STAGE(PG8_SA(1, 0), cA + kstep, voffA); PG8_STAGE(PG8_SB(1, 1), cB + hstep + kstep, voffB);
        PG8_WAIT_V(6); PG8_BAR;
    }
    for (;;) {
        const bool has_next = S.next(ui + 1, nxt);
        const char* nA = has_next ? (const char*)g.A + (size_t)nxt.pm * tstep : cA; const char* nB = has_next ? (const char*)g.Bt + (size_t)nxt.pn * tstep : cB;
        for (int t = 0; t < nt; t += 2) {
            const bool last = (t == nt - 2);
            const char* a1 = cA + (size_t)(t + 1) * kstep;
            const char* a2 = last ? nA : cA + (size_t)(t + 2) * kstep; const char* b2 = last ? nB : cB + (size_t)(t + 2) * kstep;
            const char* a3 = a2 + kstep; const char* b3 = b2 + kstep;
            if (last && has_next) S.a_ready(nxt);
            if constexpr (SP2) {
            PG8_LDB(B0, 0, 0); PG8_LDB(B1, 0, 1); PG8_SCHED; PG8_LDA(At, 0, 0); PG8_STAGE(PG8_SA(1, 1), a1 + hstep, voffA);
            PG8_WAIT_V(8); PG8_WAIT_L(0); PG8_BAR; PG8_MMA(0, 0, At, B0); PG8_MMA(0, 1, At, B1); PG8_BAR; PG8_SCHED;
            PG8_LDA(At, 0, 1); PG8_STAGE(PG8_SB(0, 0), b2, voffB); PG8_STAGE(PG8_SB(0, 1), b2 + hstep, voffB); PG8_STAGE(PG8_SA(0, 0), a2, voffA);
            PG8_WAIT_V(8); PG8_WAIT_L(0); PG8_BAR; PG8_MMA(1, 0, At, B0); PG8_MMA(1, 1, At, B1); PG8_BAR; PG8_SCHED;
            PG8_LDB(B0, 1, 0); PG8_LDB(B1, 1, 1); PG8_SCHED; PG8_LDA(At, 1, 0); PG8_STAGE(PG8_SA(0, 1), a2 + hstep, voffA);
            PG8_WAIT_V(8); PG8_WAIT_L(0); PG8_BAR; PG8_MMA(0, 0, At, B0); PG8_MMA(0, 1, At, B1); PG8_BAR; PG8_SCHED;
            PG8_LDA(At, 1, 1); PG8_STAGE(PG8_SB(1, 0), b3, voffB); PG8_STAGE(PG8_SB(1, 1), b3 + hstep, voffB); PG8_STAGE(PG8_SA(1, 0), a3, voffA);
            PG8_WAIT_V(8); PG8_WAIT_L(0); PG8_BAR; PG8_MMA(1, 0, At, B0); PG8_MMA(1, 1, At, B1); PG8_BAR; PG8_SCHED;
            } else {
            PG8_LDB(B0, 0, 0); PG8_SCHED; PG8_LDA(At, 0, 0); PG8_STAGE(PG8_SA(1, 1), a1 + hstep, voffA);
            PG8_WAIT_L(8); PG8_BAR; PG8_WAIT_L(0); PG8_MMA(0, 0, At, B0); PG8_BAR; PG8_SCHED;
            PG8_LDB(B1, 0, 1); PG8_STAGE(PG8_SB(0, 0), b2, voffB);
            PG8_BAR; PG8_WAIT_L(0); PG8_MMA(0, 1, At, B1); PG8_BAR;
            PG8_LDA(At, 0, 1); PG8_STAGE(PG8_SA(0, 0), a2, voffA);
            PG8_BAR; PG8_WAIT_L(0); PG8_MMA(1, 0, At, B0); PG8_BAR; PG8_SCHED;
            PG8_STAGE(PG8_SB(0, 1), b2 + hstep, voffB);
            PG8_WAIT_V(6); PG8_BAR; PG8_MMA(1, 1, At, B1); PG8_BAR;
            PG8_LDB(B0, 1, 0); PG8_SCHED; PG8_LDA(At, 1, 0); PG8_STAGE(PG8_SA(0, 1), a2 + hstep, voffA);
            PG8_WAIT_L(8); PG8_BAR; PG8_WAIT_L(0); PG8_MMA(0, 0, At, B0); PG8_BAR; PG8_SCHED;
            PG8_LDB(B1, 1, 1); PG8_STAGE(PG8_SB(1, 0), b3, voffB);
            PG8_BAR; PG8_WAIT_L(0); PG8_MMA(0, 1, At, B1); PG8_BAR;
            PG8_LDA(At, 1, 1); PG8_STAGE(PG8_SA(1, 0), a3, voffA);
            PG8_BAR; PG8_WAIT_L(0); PG8_MMA(1, 0, At, B0); PG8_BAR; PG8_SCHED;
            PG8_STAGE(PG8_SB(1, 1), b3 + hstep, voffB);
            PG8_WAIT_V(6); PG8_BAR; PG8_MMA(1, 1, At, B1); PG8_BAR;
            }
        }
        if constexpr (ALIGN_EPI) { if (wr == 0) PG8_BAR; }
        if constexpr (!Epi::AFTER_DRAIN) { E(acc, cur, wr, wc, fr, fq); S.done(cur); }
        if (!has_next) break;
#pragma unroll
        for (int a = 0; a < 2; ++a)
#pragma unroll
            for (int b = 0; b < 2; ++b)
#pragma unroll
                for (int m = 0; m < 4; ++m)
#pragma unroll
                    for (int n = 0; n < 2; ++n) acc[a][b][m][n] = (f32x4){0.f, 0.f, 0.f, 0.f};
        cur = nxt; cA = nA; cB = nB; ++ui;
        if constexpr (ALIGN_EPI) { if (wr == 1) PG8_BAR; }
    }
    PG8_WAIT_V(0);
    if constexpr (!ALIGN_EPI) { if (wr == 0) PG8_BAR; }
    PG8_BAR;
    if constexpr (Epi::AFTER_DRAIN) { E.fused(acc, cur, wr, wc, fr, fq, lds, wid, lane); S.done(cur); }
#undef PG8_SA
#undef PG8_SB
#undef PG8_STAGE
#undef PG8_LDA
#undef PG8_LDB
#undef PG8_MMA
#undef PG8_WAIT_V
#undef PG8_WAIT_L
#undef PG8_BAR
#undef PG8_SCHED
}
}

constexpr size_t al256(size_t x) { return (x + 255) & ~(size_t)255; }
constexpr size_t WS_CTL = 0, CTL_ZERO_BYTES = 1u << 20;
constexpr int CW_BAR = 4096;
constexpr size_t WS_MOD  = CTL_ZERO_BYTES;
constexpr size_t WS_PET  = al256(WS_MOD + (size_t)36 * 9 * D * 4);
constexpr size_t WS_WGU  = al256(WS_PET + 2 * 128 * 4);
constexpr size_t WS_WDN  = al256(WS_WGU + (size_t)2 * 5632 * D * 2);
constexpr size_t WS_WIN  = al256(WS_WDN + (size_t)2 * D * FF * 2);
constexpr size_t WS_WOAB = al256(WS_WIN + (size_t)NINP * D * 2);
constexpr size_t WS_WO   = al256(WS_WOAB + (size_t)2048 * 512 * 2);
constexpr size_t WS_WC1  = al256(WS_WO + (size_t)D * D * 2);
constexpr size_t WS_U    = al256(WS_WC1 + (size_t)512 * 1024 * 2);
constexpr size_t WS_H    = al256(WS_U + (size_t)MA * D * 2);
constexpr size_t WS_Z    = al256(WS_H + (size_t)MA * FF * 2);
constexpr size_t WS_X1   = al256(WS_Z + (size_t)MA * D * 4);
constexpr size_t WS_X2   = al256(WS_X1 + (size_t)MA * D * 4);
constexpr size_t WS_M1   = al256(WS_X2 + (size_t)MA * D * 4);
constexpr size_t WS_MIN  = al256(WS_M1 + (size_t)MA * D * 4);
constexpr size_t WS_PROJ = al256(WS_MIN + (size_t)MA * D * 2);
constexpr size_t WS_RW   = al256(WS_PROJ + (size_t)MA * NINP * 4);
constexpr size_t RW_STRIDE = (size_t)MA * RWW;
constexpr size_t WS_G    = al256(WS_RW + 6 * RW_STRIDE * 4);
constexpr size_t WS_BON  = al256(WS_G + RW_STRIDE * 4);
constexpr size_t WS_YS   = al256(WS_BON + RW_STRIDE * 4);
constexpr size_t WS_AST  = al256(WS_YS + RW_STRIDE * 4);
constexpr size_t WS_KSEL = al256(WS_AST + (size_t)2 * MA * RWW * 2);
constexpr size_t KV_BYTES = (size_t)NBP * 2 * T * 64 * 2;
constexpr size_t WS_KWIN = WS_KSEL + KV_BYTES, WS_VTSEL = WS_KWIN + KV_BYTES, WS_VTWIN = WS_VTSEL + KV_BYTES;
constexpr size_t WS_KCP  = WS_VTWIN + KV_BYTES;
constexpr size_t WS_VCTP = WS_KCP + (size_t)NBP * 2 * 256 * 64 * 2;
constexpr size_t WS_KCS  = al256(WS_VCTP + (size_t)NBP * 2 * 256 * 64 * 2);
constexpr size_t KCS_STRIDE = (size_t)NBS * NCMP_S * 2 * 64;
constexpr size_t WS_ACMP = al256(WS_KCS + 2 * KCS_STRIDE * 4);
constexpr size_t WS_HC   = al256(WS_ACMP + (size_t)2 * CROWS * 1024 * 2);
constexpr size_t WS_END  = al256(WS_HC + (size_t)2 * CROWS * 256 * 4);

constexpr int NWAVES = 8;
constexpr int RING_OFF = 0, RING_BYTES = 131072;
constexpr int LDSCTL_OFF = RING_BYTES, MISC_OFF = LDSCTL_OFF + 320;
constexpr int LDS_BYTES = 147456;

#define GAS __attribute__((address_space(1)))
#define LAS __attribute__((address_space(3)))
typedef unsigned short bf16;
typedef unsigned v4u __attribute__((ext_vector_type(4)));
typedef unsigned v2u __attribute__((ext_vector_type(2)));
typedef float f32x4 __attribute__((ext_vector_type(4)));
typedef float f32x16 __attribute__((ext_vector_type(16)));
typedef short bf16x8 __attribute__((ext_vector_type(8)));
typedef short s16x4 __attribute__((ext_vector_type(4)));
typedef GAS unsigned gu32;
#define RLX_AGENT __ATOMIC_RELAXED, __HIP_MEMORY_SCOPE_AGENT
#define LDS_WAIT() asm volatile("s_waitcnt lgkmcnt(0)" ::: "memory")
#define VM_WAIT() asm volatile("s_waitcnt vmcnt(0)" ::: "memory")
DI unsigned f2bf(float f) { unsigned u = __builtin_bit_cast(unsigned, f); return (u + 0x7fffu + ((u >> 16) & 1u)) >> 16; }
DI unsigned pk2(float lo, float hi) { return pg8::cvt_pk_bf16(lo, hi); }
DI float sigmoidf_(float x) { return 1.0f / (1.0f + __expf(-x)); }
DI float wave_sum(float v) {
#pragma unroll
    for (int o = 1; o < 64; o <<= 1) v += __shfl_xor(v, o);
    return v;
}
DI float wave_max(float v) {
#pragma unroll
    for (int o = 1; o < 64; o <<= 1) v = fmaxf(v, __shfl_xor(v, o));
    return v;
}
template <int CTRL> DI float dpp_f(float x) { return __builtin_bit_cast(float, __builtin_amdgcn_update_dpp(0, __builtin_bit_cast(int, x), CTRL, 0xf, 0xf, false)); }
DI float row16_sum(float x) {
    x += dpp_f<0x128>(x); x += dpp_f<0x124>(x); x += dpp_f<0x122>(x); x += dpp_f<0x121>(x); return x;
}
DI float gelu_tanh(float x) { const float u = 0.7978845608028654f * (x + 0.044715f * x * x * x); const float e = __expf(2.0f * u); const float th = 1.0f - 2.0f / (e + 1.0f); return 0.5f * x * (1.0f + th); }
#define XB_TMO      128
#define XB_XCNT(j)  (256  + 64 * (j))
#define XB_XSUB(j)  (1280 + 64 * (j))
#define XB_XGEN(j)  (2304 + 64 * (j))
#define XB_TOP      3328
#define XB_TOPGEN   3392
#define XCD_BAR_WORDS 3456
#define XB_SPIN_CAP (1u << 18)

__device__ __forceinline__ unsigned xb_ld(unsigned* p)              { return __hip_atomic_load(p, __ATOMIC_RELAXED, __HIP_MEMORY_SCOPE_AGENT); }
__device__ __forceinline__ unsigned xb_add(unsigned* p, unsigned v) { return __hip_atomic_fetch_add(p, v, __ATOMIC_RELAXED, __HIP_MEMORY_SCOPE_AGENT); }
__device__ __forceinline__ unsigned xb_xcc_id() { return (unsigned)__builtin_amdgcn_s_getreg((3 << 11) | 20) & 0xFu; }
#define XB_SPIN(cond, bar) do { unsigned _sp = 0; while (cond) { __builtin_amdgcn_s_sleep(1); \
    if ((++_sp & 255u) == 0u) { if (xb_ld(&(bar)[XB_TMO])) break; if (_sp > XB_SPIN_CAP) { atomicAdd(&(bar)[XB_TMO], 1u); break; } } } } while (0)

struct XcdBarrier {
    unsigned* bar; unsigned x;
    volatile LAS unsigned* st;
};

__device__ __forceinline__ XcdBarrier xcd_barrier_post(unsigned* bar, volatile LAS unsigned* st) {
    XcdBarrier b; b.bar = bar; b.x = xb_xcc_id(); b.st = st;
    if (threadIdx.x == 0) (void)xb_add(&bar[XB_XCNT(b.x)], 1u);
    return b;
}
__device__ __forceinline__ void xcd_barrier_complete(unsigned* bar, unsigned x, unsigned& nloc, unsigned& nx) {
    const unsigned G = gridDim.x * gridDim.y * gridDim.z;
    unsigned sum, cnt, mine, sp = 0u;
    for (;;) {
        sum = 0u; cnt = 0u; mine = 0u;
#pragma unroll
        for (unsigned j = 0; j < 16; ++j) { const unsigned c = xb_ld(&bar[XB_XCNT(j)]); sum += c; cnt += (c > 0u) ? 1u : 0u; mine = (j == x) ? c : mine; }
        if (sum == G) break;
        __builtin_amdgcn_s_sleep(1);
        if ((++sp & 255u) == 0u) { if (xb_ld(&bar[XB_TMO])) break; if (sp > XB_SPIN_CAP) { atomicAdd(&bar[XB_TMO], 1u); break; } }
    }
    nloc = mine > 0u ? mine : 1u; nx = cnt > 0u ? cnt : 1u;
}

__device__ __forceinline__ void xcd_barrier(const XcdBarrier& b) {
    asm volatile("s_waitcnt vmcnt(0)" ::: "memory");
    __syncthreads();
    if (threadIdx.x == 0) {
        unsigned* bar = b.bar;
        __builtin_amdgcn_s_waitcnt(0);
        unsigned nloc = b.st[0], nx = b.st[1];
        if (nloc == 0u) { xcd_barrier_complete(bar, b.x, nloc, nx); b.st[0] = nloc; b.st[1] = nx; }
        const unsigned old = xb_add(&bar[XB_XSUB(b.x)], 1u);
        const unsigned gen = old / nloc;
        if (old + 1u == (gen + 1u) * nloc) {
            __builtin_amdgcn_fence(__ATOMIC_RELEASE, "agent");
            asm volatile("s_waitcnt vmcnt(0)" ::: "memory");
            const unsigned og = xb_add(&bar[XB_TOP], 1u);
            const unsigned tg = og / nx;
            if (og + 1u == (tg + 1u) * nx) xb_add(&bar[XB_TOPGEN], 1u);
            else XB_SPIN(xb_ld(&bar[XB_TOPGEN]) == tg, bar);
            __builtin_amdgcn_fence(__ATOMIC_ACQUIRE, "agent");
            xb_add(&bar[XB_XGEN(b.x)], 1u);
            asm volatile("s_waitcnt vmcnt(0)" ::: "memory");
        } else {
            XB_SPIN(xb_ld(&bar[XB_XGEN(b.x)]) == gen, bar);
            __builtin_amdgcn_fence(__ATOMIC_ACQUIRE, "agent");
            asm volatile("s_waitcnt vmcnt(0)" ::: "memory");
        }
    }
    __syncthreads();
}

enum { I_XP = 0, I_XS, I_CP, I_CS, I_CKC, I_CKS, I_SKW, I_SWKV, I_SSH, I_PT, I_WADA, I_BADA, I_LNG, I_LNB, I_WG, I_WU, I_WD, I_WIN, I_BIN, I_MU, I_W0, I_W2, I_A0, I_A2, I_G2,
       I_KK, I_KA, I_RK, I_LNW, I_LNBB, I_PE, I_PW1, I_PW2, I_WOA, I_WOB, I_WOO, N_IN };
struct Args { const float* in[N_IN]; float* out; unsigned char* ws; int ph_lo, ph_hi; };
#define WSF(off) ((float*)(a.ws + (off)))
#define WSB(off) ((bf16*)(a.ws + (off)))

DI void tr_item(const float* __restrict__ W, int ldw, int ncols, int k0, int n0, bf16* WT, int ldo, int dr0, LAS float* scr, int lane) {
#pragma unroll 8
    for (int i = 0; i < 32; ++i) { const int kk = 2 * i + (lane >> 5), col = n0 + (lane & 31); scr[kk * 33 + (lane & 31)] = col < ncols ? W[(size_t)(k0 + kk) * ldw + col] : 0.f; }
    LDS_WAIT(); asm volatile("" ::: "memory");
    const int c = lane & 7;
#pragma unroll
    for (int j = 0; j < 4; ++j) { const int n = (lane >> 3) + 8 * j; const LAS float* s = scr + (8 * c) * 33 + n;
        v4u o; o.x = pk2(s[0 * 33], s[1 * 33]); o.y = pk2(s[2 * 33], s[3 * 33]); o.z = pk2(s[4 * 33], s[5 * 33]); o.w = pk2(s[6 * 33], s[7 * 33]);
        *(v4u*)(WT + (size_t)(dr0 + n) * ldo + k0 + 8 * c) = o; }
    LDS_WAIT(); asm volatile("" ::: "memory");
}
DI void mod_gemv_item(const Args& a, LAS unsigned char* lds, int tid, int lane, int wave, int item) {
    LAS float* S = (LAS float*)lds;
    const float* wada = a.in[I_WADA];
    float acc[36];
#pragma unroll
    for (int i = 0; i < 36; ++i) acc[i] = 0.f;
    const int col = item * 64 + lane;
    for (int kh = 0; kh < 2; ++kh) {
        __syncthreads();
        for (int e = tid; e < 36 * 512; e += 512) { const int bbv = e >> 9, kk = e & 511;
            const float c = bbv < 4 ? a.in[I_CP][bbv * D + kh * 512 + kk] : a.in[I_CS][(bbv - 4) * D + kh * 512 + kk];
            S[kk * 36 + bbv] = c / (1.0f + __expf(-c)); }
        __syncthreads();
        for (int kk = wave * 64; kk < wave * 64 + 64; ++kk) {
            const float wv = wada[(size_t)(kh * 512 + kk) * 9216 + col];
            const LAS f32x4* sp = (const LAS f32x4*)(S + kk * 36);
#pragma unroll
            for (int q = 0; q < 9; ++q) { const f32x4 s = sp[q]; acc[4 * q] += s[0] * wv; acc[4 * q + 1] += s[1] * wv; acc[4 * q + 2] += s[2] * wv; acc[4 * q + 3] += s[3] * wv; }
        }
    }
    __syncthreads();
    LAS float* P = (LAS float*)lds;
#pragma unroll
    for (int i = 0; i < 36; ++i) P[(wave * 36 + i) * 64 + lane] = acc[i];
    __syncthreads();
    float* MOD = WSF(WS_MOD);
    for (int o = tid; o < 36 * 64; o += 512) { const int bbv = o >> 6, l = o & 63; float s = 0.f;
#pragma unroll
        for (int w = 0; w < 8; ++w) s += P[(w * 36 + bbv) * 64 + l];
        const int cc = item * 64 + l; MOD[(size_t)bbv * 9216 + cc] = s + a.in[I_BADA][cc]; }
    __syncthreads();
}
DI void pet_item(const Args& a, LAS unsigned char* lds, int tid, int lane, int wave, int item) {
    const int kv = item >> 1, e = (item & 1) * 64 + lane;
    const float* pe = a.in[I_PE] + kv * 2048; const float* w1 = a.in[I_PW1] + (size_t)kv * 2048 * 128;
    float acc = 0.f;
    for (int k = wave * 256; k < wave * 256 + 256; ++k) acc += pe[k] * w1[(size_t)k * 128 + e];
    LAS float* P = (LAS float*)lds;
    __syncthreads();
    P[wave * 64 + lane] = acc;
    __syncthreads();
    if (tid < 64) { float s = 0.f;
#pragma unroll
        for (int w = 0; w < 8; ++w) s += P[w * 64 + tid];
        WSF(WS_PET)[kv * 128 + (item & 1) * 64 + tid] = s; }
    __syncthreads();
}
DI void ph_prologue(const Args& a, LAS unsigned char* lds, int tid, int lane, int wave, int G, int bx) {
    for (int it = bx; it < 148; it += G) { if (it < 144) mod_gemv_item(a, lds, tid, lane, wave, it); else pet_item(a, lds, tid, lane, wave, it - 144); }
    __syncthreads();
    LAS float* scr = (LAS float*)(lds + wave * 16384);
    const int gw = wave * G + bx, NGW = G * NWAVES;
    constexpr int I_GU = 16 * 88, I_DN = 44 * 32, I_IN = 16 * 168, I_OAB = 8 * 32, I_O = 16 * 32, I_C1 = 16 * 4, I_CONV = NBS * NCH_S, I_WCP = 1016, I_ZERO = 128;
    constexpr int NITEMS = 4 * I_GU + 2 * I_DN + I_IN + 2 * I_OAB + I_O + 4 * I_C1 + I_CONV + I_WCP + I_ZERO;
    for (int it = gw; it < NITEMS; it += NGW) {
        int r = it;
        if (r < 4 * I_GU) { const int which = r / I_GU, l = which & 1, up = which >> 1; r %= I_GU; const int kb = r / 88, nb = r % 88, n0 = nb * 32;
            tr_item((up ? a.in[I_WU] : a.in[I_WG]) + (size_t)l * D * FF, FF, FF, kb * 64, n0, WSB(WS_WGU) + (size_t)l * 5632 * D, D, (n0 >> 7) * 256 + up * 128 + (n0 & 127), scr, lane); continue; } r -= 4 * I_GU;
        if (r < 2 * I_DN) { const int l = r / I_DN; r %= I_DN; const int kb = r / 32, nb = r % 32;
            tr_item(a.in[I_WD] + (size_t)l * FF * D, D, D, kb * 64, nb * 32, WSB(WS_WDN) + (size_t)l * D * FF, FF, nb * 32, scr, lane); continue; } r -= 2 * I_DN;
        if (r < I_IN) { const int kb = r / 168, nb = r % 168; tr_item(a.in[I_WIN], NIN, NIN, kb * 64, nb * 32, WSB(WS_WIN), D, nb * 32, scr, lane); continue; } r -= I_IN;
        if (r < 2 * I_OAB) { const int w = r / I_OAB; r %= I_OAB; const int kb = r / 32, nb = r % 32;
            tr_item(w ? a.in[I_WOB] : a.in[I_WOA], D, D, kb * 64, nb * 32, WSB(WS_WOAB), 512, w * 1024 + nb * 32, scr, lane); continue; } r -= 2 * I_OAB;
        if (r < I_O) { const int kb = r / 32, nb = r % 32; tr_item(a.in[I_WOO], D, D, kb * 64, nb * 32, WSB(WS_WO), D, nb * 32, scr, lane); continue; } r -= I_O;
        if (r < 4 * I_C1) { const int mat = r / I_C1; r %= I_C1; const int kb = r / 4, nb = r % 4;
            tr_item(a.in[I_PW1] + (size_t)mat * 1024 * 128, 128, 128, kb * 64, nb * 32, WSB(WS_WC1), 1024, mat * 128 + nb * 32, scr, lane); continue; } r -= 4 * I_C1;
        if (r < I_CONV) {
            const int b = r >> 10, c = r & 1023; const int page = ((const int*)a.in[I_PT])[b * 128 + (c >> 3)];
            const float* src = a.in[I_CKC] + ((size_t)page * 128 + (c & 7) * 16) * 256 + lane * 4;
            const int kv = lane >> 5, g = (lane >> 4) & 1, d = (lane & 15) * 4;
            bf16* dst = WSB(WS_ACMP) + ((size_t)kv * CROWS + (size_t)(b * NCH_S + c) * 2 + g) * 1024 + d;
#pragma unroll 4
            for (int j = 0; j < 16; ++j) { const f32x4 v = *(const f32x4*)(src + j * 256); v2u o; o.x = pk2(v[0], v[1]); o.y = pk2(v[2], v[3]); *(v2u*)(dst + j * 64) = o; }
            continue; } r -= I_CONV;
        if (r < I_WCP) {
#pragma unroll 4
            for (int i = 0; i < 16; ++i) { const int f = r * 1024 + i * 64 + lane; const int b = f / 32512, i4 = f % 32512;
                *(f32x4*)(a.out + O_KVW_S + (size_t)b * 131072 + (size_t)i4 * 4) = *(const f32x4*)(a.in[I_SKW] + (size_t)b * 131072 + 1024 + (size_t)i4 * 4); }
            continue; } r -= I_WCP;
        { v4u z = {0u, 0u, 0u, 0u}; unsigned char* p = a.ws + WS_KCP + (size_t)r * 4096 + lane * 64;
#pragma unroll
          for (int i = 0; i < 4; ++i) *(v4u*)(p + 16 * i) = z; }
    }
}
DI void ph_u1(const Args& a, int lane, int wave, int G, int bx) {
    const int gw = wave * G + bx, NGW = G * NWAVES; const float* MOD = WSF(WS_MOD); bf16* U = WSB(WS_U);
    for (int row = gw; row < MA; row += NGW) {
        const float* xr = row < MP ? a.in[I_XP] + (size_t)row * D : a.in[I_XS] + (size_t)(row - MP) * D;
        const float* ms = MOD + (size_t)(bb_of_row(row) * 9) * D;
#pragma unroll
        for (int j = 0; j < 4; ++j) { const int col = lane * 4 + 256 * j;
            f32x4 u = {0.f, 0.f, 0.f, 0.f};
            if (row < MR) { const f32x4 x = *(const f32x4*)(xr + col); u = x * (1.0f + *(const f32x4*)(ms + D + col)) + *(const f32x4*)(ms + col); }
            v2u o; o.x = pk2(u[0], u[1]); o.y = pk2(u[2], u[3]); *(v2u*)(U + (size_t)row * D + col) = o; }
    }
}
template <int WHICH> DI void ph_ln(const Args& a, int lane, int wave, int G, int bx) {
    const int gw = wave * G + bx, NGW = G * NWAVES; const float* MOD = WSF(WS_MOD); const float* Z = WSF(WS_Z); bf16* U = WSB(WS_U);
    float* XN = WHICH == 0 ? WSF(WS_X1) : (WHICH == 1 ? WSF(WS_X2) : a.out);
    const float* lg = a.in[I_LNG] + WHICH * D; const float* lb = a.in[I_LNB] + WHICH * D;
    for (int row = gw; row < MA; row += NGW) {
        if (WHICH == 2 && row >= MR) break;
        f32x4 v[4]; float s = 0.f;
#pragma unroll
        for (int j = 0; j < 4; ++j) { v[j] = *(const f32x4*)(Z + (size_t)row * D + lane * 4 + 256 * j); s += (v[j][0] + v[j][1]) + (v[j][2] + v[j][3]); }
        const float mean = wave_sum(s) * (1.0f / D); float s2 = 0.f;
#pragma unroll
        for (int j = 0; j < 4; ++j) { v[j] = v[j] - mean; s2 += (v[j][0] * v[j][0] + v[j][1] * v[j][1]) + (v[j][2] * v[j][2] + v[j][3] * v[j][3]); }
        const float rstd = 1.0f / sqrtf(wave_sum(s2) * (1.0f / D) + LN_EPS);
        const float* ms = MOD + (size_t)(bb_of_row(row) * 9 + 3 * WHICH + 3) * D;
#pragma unroll
        for (int j = 0; j < 4; ++j) { const int col = lane * 4 + 256 * j;
            const f32x4 x = v[j] * rstd * *(const f32x4*)(lg + col) + *(const f32x4*)(lb + col);
            *(f32x4*)(XN + (size_t)row * D + col) = x;
            if (WHICH < 2) { const f32x4 u = x * (1.0f + *(const f32x4*)(ms + D + col)) + *(const f32x4*)(ms + col);
                v2u o; o.x = pk2(u[0], u[1]); o.y = pk2(u[2], u[3]); *(v2u*)(U + (size_t)row * D + col) = o; } }
    }
}

DI float proj_prev(const Args& a, const float* PROJ, int row, int col) {
    if (row < MP) return (row & (T - 1)) ? PROJ[(size_t)(row - 1) * NINP + col] : 0.f;
    const int s = row - MP; return (s & 3) ? PROJ[(size_t)(row - 1) * NINP + col] : a.in[I_SSH][(size_t)(s >> 2) * C_Q + col];
}
DI void ph_dist_rwprep(const Args& a, LAS unsigned char* lds, int tid, int lane, int wave, int G, int bx) {
    const float* PROJ = WSF(WS_PROJ);
    LAS float* vt = (LAS float*)lds;
    LAS float* L = (LAS float*)(lds + 36864);
    for (int it = bx; it < MR / 32; it += G) {
        const int r0 = it * 32;
        __syncthreads();
        {
            const int rr = tid >> 4, seg = tid & 15, row = r0 + rr;
            const float* pr = PROJ + (size_t)row * NINP + C_KV;
            if (row < MP) {
                const int b = row >> 12, t = row & (T - 1);
#pragma unroll
                for (int i = 0; i < 12; ++i) { const int col = 4 * (seg + 16 * i), br = col >> 8, within = col & 255, kv = within >> 7, g = (within >> 6) & 1, d = within & 63;
                    const f32x4 v = *(const f32x4*)(pr + col); v2u pk; pk.x = pk2(v[0], v[1]); pk.y = pk2(v[2], v[3]);
                    if (br == 0) { *(f32x4*)(a.out + O_KVC_P + (size_t)row * 256 + within) = v;
                        *(v2u*)(WSB(WS_ACMP) + ((size_t)kv * CROWS + CROWS_S + (size_t)(b * NCH_P + (t >> 4)) * 2 + g) * 1024 + (t & 15) * 64 + d) = pk; }
                    else { if (br == 1) *(f32x4*)(a.out + O_KVS_P + (size_t)row * 256 + within) = v;
                           else if (t >= T - 512) *(f32x4*)(a.out + O_KVW_P + ((size_t)b * 512 + (t - (T - 512))) * 256 + within) = v;
                           if (kv == 0) *(v2u*)(WSB(br == 1 ? WS_KSEL : WS_KWIN) + ((size_t)(b * 2 + g) * T + t) * 64 + d) = pk;
                           else { LAS float* q = vt + ((br - 1) * 32 + rr) * 132 + g * 64 + d; q[0] = v[0]; q[1] = v[1]; q[2] = v[2]; q[3] = v[3]; } }
                }
                if (t == T - 1) { const float* ps = PROJ + (size_t)row * NINP;
#pragma unroll 4
                    for (int i = 0; i < 28; ++i) *(f32x4*)(a.out + O_SH_P + (size_t)b * C_Q + 4 * (seg + 16 * i)) = *(const f32x4*)(ps + 4 * (seg + 16 * i)); }
            } else {
                const int s = row - MP, b = s >> 2, tq = s & 3;
#pragma unroll
                for (int i = 0; i < 12; ++i) { const int col = 4 * (seg + 16 * i), br = col >> 8, within = col & 255;
                    const f32x4 v = *(const f32x4*)(pr + col);
                    if (br == 0) *(f32x4*)(a.out + O_KVC_S + (size_t)s * 256 + within) = v;
                    else if (br == 1) *(f32x4*)(a.out + O_KVS_S + (size_t)s * 256 + within) = v;
                    else *(f32x4*)(a.out + O_KVW_S + ((size_t)b * 512 + 508 + tq) * 256 + within) = v; }
                if (tq == 3) { const float* ps = PROJ + (size_t)row * NINP;
#pragma unroll 4
                    for (int i = 0; i < 28; ++i) *(f32x4*)(a.out + O_SH_S + (size_t)b * C_Q + 4 * (seg + 16 * i)) = *(const f32x4*)(ps + 4 * (seg + 16 * i)); }
            }
        }
#pragma unroll 4
        for (int i = 0; i < 16; ++i) { const int e = tid + 512 * i, tt = e >> 8, k = e & 255, row = r0 + tt, col = 1536 + k;
            const float p = PROJ[(size_t)row * NINP + col], pp = proj_prev(a, PROJ, row, col); const float xs = p + (pp - p) * a.in[I_MU][col];
            L[k * 36 + tt] = k < 64 ? tanhf(xs) : (k < 128 ? xs : sigmoidf_(xs)); }
        __syncthreads();
        if (r0 < MP) {
            const int gd = tid >> 2, tc = tid & 3, g = gd >> 6, d = gd & 63, b = r0 >> 12, t0 = r0 & (T - 1);
#pragma unroll
            for (int br = 0; br < 2; ++br) { const LAS float* q = vt + (br * 32 + tc * 8) * 132 + gd;
                v4u o; o.x = pk2(q[0], q[132]); o.y = pk2(q[2 * 132], q[3 * 132]); o.z = pk2(q[4 * 132], q[5 * 132]); o.w = pk2(q[6 * 132], q[7 * 132]);
                *(v4u*)(WSB(br == 0 ? WS_VTSEL : WS_VTWIN) + ((size_t)(b * 2 + g) * 64 + d) * T + t0 + tc * 8) = o; }
        }
        {
            const int c = tid;
            float aw[32], aa[32], ag[32];
#pragma unroll
            for (int i = 0; i < 32; ++i) { aw[i] = 0.f; aa[i] = 0.f; ag[i] = 0.f; }
            const float* w2 = a.in[I_W2] + c; const float* a2 = a.in[I_A2] + c; const float* g2 = a.in[I_G2] + c;
            for (int k = 0; k < 64; ++k) { const float w = w2[k * RWW], av = a2[k * RWW];
#pragma unroll
                for (int q = 0; q < 8; ++q) { const f32x4 s = *(const LAS f32x4*)(L + k * 36 + 4 * q), s2 = *(const LAS f32x4*)(L + (64 + k) * 36 + 4 * q);
#pragma unroll
                    for (int e = 0; e < 4; ++e) { aw[4 * q + e] += s[e] * w; aa[4 * q + e] += s2[e] * av; } } }
            for (int k = 0; k < 128; ++k) { const float w = g2[k * RWW];
#pragma unroll
                for (int q = 0; q < 8; ++q) { const f32x4 s = *(const LAS f32x4*)(L + (128 + k) * 36 + 4 * q);
#pragma unroll
                    for (int e = 0; e < 4; ++e) ag[4 * q + e] += s[e] * w; } }
            const float mu_r = a.in[I_MU][c], mu_k = a.in[I_MU][512 + c], mu_v = a.in[I_MU][1024 + c];
            const float w0 = a.in[I_W0][c], a0 = a.in[I_A0][c], kkc = a.in[I_KK][c], kac = a.in[I_KA][c], rkc = a.in[I_RK][c];
            float* RW = WSF(WS_RW);
#pragma unroll
            for (int tt = 0; tt < 32; ++tt) { const int row = r0 + tt; const float* pr = PROJ + (size_t)row * NINP;
                float pr_ = pr[c], pk_ = pr[512 + c], pv_ = pr[1024 + c];
                const float r = pr_ + (proj_prev(a, PROJ, row, c) - pr_) * mu_r, k = pk_ + (proj_prev(a, PROJ, row, 512 + c) - pk_) * mu_k, v = pv_ + (proj_prev(a, PROJ, row, 1024 + c) - pv_) * mu_v;
                const float z = -(w0 + aw[tt]);
                const float sp = fmaxf(z, 0.f) + log1pf(__expf(-fabsf(z)));
                const float decay = __expf(-__expf(-sp - 0.5f));
                const float av = sigmoidf_(a0 + aa[tt]);
                float kk = k * kkc; const float ss = wave_sum(kk * kk); kk *= rsqrtf(fmaxf(ss, 1e-24f));
                const float k2 = k * (1.0f + (av - 1.0f) * kac);
                const float rk = wave_sum(r * k2 * rkc);
                const size_t o = (size_t)row * RWW + c;
                RW[o] = r; RW[RW_STRIDE + o] = decay; RW[2 * RW_STRIDE + o] = k2; RW[3 * RW_STRIDE + o] = v; RW[4 * RW_STRIDE + o] = kk; RW[5 * RW_STRIDE + o] = kk * av;
                WSF(WS_G)[o] = ag[tt]; WSF(WS_BON)[o] = rk * v; }
        }
    }
}

struct StepD { f32x4 r, w, k, kk, b; float v; };
DI void scan_run(const float* RW, float* Y, int rowbase, int nsteps, int h, int i, int lane, const float* s_in, float* s_out) {
    const int j0 = (lane & 15) * 4; const size_t cofs = (size_t)h * 64 + j0, vofs = (size_t)h * 64 + i;
    f32x4 S = s_in ? *(const f32x4*)(s_in + i * 64 + j0) : (f32x4){0.f, 0.f, 0.f, 0.f};
#define SC_LD(sd, t) { const size_t o_ = (size_t)(rowbase + (t)) * RWW; sd.r = *(const f32x4*)(RW + o_ + cofs); sd.w = *(const f32x4*)(RW + RW_STRIDE + o_ + cofs); sd.k = *(const f32x4*)(RW + 2 * RW_STRIDE + o_ + cofs); \
        sd.v = RW[3 * RW_STRIDE + o_ + vofs]; sd.kk = *(const f32x4*)(RW + 4 * RW_STRIDE + o_ + cofs); sd.b = *(const f32x4*)(RW + 5 * RW_STRIDE + o_ + cofs); }
#define SC_DO(sd, t) { float d_ = (S[0] * sd.kk[0] + S[1] * sd.kk[1]) + (S[2] * sd.kk[2] + S[3] * sd.kk[3]); d_ = row16_sum(d_); const float sa_ = -d_; \
        S = S * sd.w + (sa_ * sd.b + sd.v * sd.k); float y_ = (S[0] * sd.r[0] + S[1] * sd.r[1]) + (S[2] * sd.r[2] + S[3] * sd.r[3]); y_ = row16_sum(y_); \
        if ((lane & 15) == 0) Y[(size_t)(rowbase + (t)) * RWW + vofs] = y_; }
    StepD c0, c1, c2, c3, n0, n1, n2, n3;
    SC_LD(c0, 0) SC_LD(c1, 1) SC_LD(c2, 2) SC_LD(c3, 3)
    for (int t = 0; t < nsteps; t += 4) {
        const int tn = (t + 4 < nsteps) ? t + 4 : t;
        SC_LD(n0, tn) SC_LD(n1, tn + 1) SC_LD(n2, tn + 2) SC_LD(n3, tn + 3)
        SC_DO(c0, t) SC_DO(c1, t + 1) SC_DO(c2, t + 2) SC_DO(c3, t + 3)
        c0 = n0; c1 = n1; c2 = n2; c3 = n3;
    }
#undef SC_LD
#undef SC_DO
    *(f32x4*)(s_out + i * 64 + j0) = S;
}
DI void cfinal_worker(const Args& a, int lane, int worker, int nworkers) {
    const int kv = worker & 1; const int NIT = (NBS * NCMP_S + NBP * NCMP_P) * 2;
    float w2c[128];
#pragma unroll
    for (int e = 0; e < 128; ++e) w2c[e] = a.in[I_PW2][(size_t)(kv * 128 + e) * 64 + lane];
    const float pe0 = WSF(WS_PET)[kv * 128 + lane], pe1 = WSF(WS_PET)[kv * 128 + 64 + lane];
    const float* HC = WSF(WS_HC) + (size_t)kv * CROWS * 256;
    for (int j = worker >> 1; j < NIT; j += nworkers >> 1) {
        const int g = j & 1; int q = j >> 1; int b, n, rowlo; const bool smp = q < NBS * NCMP_S;
        if (smp) { b = q / NCMP_S; n = q % NCMP_S; rowlo = (b * NCH_S + n) * 2 + g; } else { q -= NBS * NCMP_S; b = q / NCMP_P; n = q % NCMP_P; rowlo = CROWS_S + (b * NCH_P + n) * 2 + g; }
        const float* lo = HC + (size_t)rowlo * 256; const float* hi = lo + 2 * 256 + 128;
        const float h0 = gelu_tanh(lo[lane] + hi[lane] + pe0), h1 = gelu_tanh(lo[64 + lane] + hi[64 + lane] + pe1);
        float acc = 0.f;
#pragma unroll
        for (int e = 0; e < 64; ++e) acc += __builtin_bit_cast(float, __builtin_amdgcn_readlane(__builtin_bit_cast(int, h0), e)) * w2c[e];
#pragma unroll
        for (int e = 0; e < 64; ++e) acc += __builtin_bit_cast(float, __builtin_amdgcn_readlane(__builtin_bit_cast(int, h1), e)) * w2c[64 + e];
        if (smp) WSF(WS_KCS)[(size_t)kv * KCS_STRIDE + ((size_t)(b * NCMP_S + n) * 2 + g) * 64 + lane] = acc;
        else if (kv == 0) WSB(WS_KCP)[((size_t)(b * 2 + g) * 256 + n) * 64 + lane] = (bf16)f2bf(acc);
        else WSB(WS_VCTP)[((size_t)(b * 2 + g) * 64 + lane) * 256 + n] = (bf16)f2bf(acc);
    }
}
DI void ph_scan_cfinal(const Args& a, int lane, int wave, int G, int bx) {
    const float* RW = WSF(WS_RW); float* Y = WSF(WS_YS);
    if (wave < 2) {
        for (int pi = bx * 2 + wave; pi < 512; pi += 2 * G) { const int bh = pi >> 4, rg = pi & 15, b = bh >> 3, h = bh & 7, i = rg * 4 + (lane >> 4);
            scan_run(RW, Y, b * T, T, h, i, lane, nullptr, a.out + O_WKV_P + (size_t)bh * 4096); }
    } else {
        const int worker = (wave - 2) * G + bx, nworkers = 6 * G;
        for (int si = worker; si < 4096; si += nworkers) { const int bh = si >> 4, rg = si & 15, b = bh >> 3, h = bh & 7, i = rg * 4 + (lane >> 4);
            scan_run(RW, Y, MP + b * 4, 4, h, i, lane, a.in[I_SWKV] + (size_t)bh * 4096, a.out + O_WKV_S + (size_t)bh * 4096); }
        cfinal_worker(a, lane, worker, nworkers);
    }
}

#define MFMA32(a_, b_, c_) __builtin_amdgcn_mfma_f32_32x32x16_bf16((a_), (b_), (c_), 0, 0, 0)
DI int crow(int i, int hh) { return (i & 3) + 8 * (i >> 2) + 4 * hh; }
DI bf16x8 pack8(const f32x4& x0, const f32x4& x1) { v4u p; p.x = pk2(x0[0], x0[1]); p.y = pk2(x0[2], x0[3]); p.z = pk2(x1[0], x1[1]); p.w = pk2(x1[2], x1[3]); return __builtin_bit_cast(bf16x8, p); }
DI f32x16 zero16() { f32x16 z;
#pragma unroll
    for (int i = 0; i < 16; ++i) z[i] = 0.f; return z; }
DI f32x16 qk_tile(const bf16* Kp, const bf16x8 (&qf)[4], int lane) {
    const bf16* kr = Kp + (size_t)(lane & 31) * 64 + 8 * (lane >> 5);
    f32x16 p = zero16();
#pragma unroll
    for (int s = 0; s < 4; ++s) { const bf16x8 kf = *(const bf16x8*)(kr + 16 * s); p = MFMA32(kf, qf[s], p); }
    return p;
}
DI void pack_p(const f32x16& P, bf16x8 (&pf)[2]) {
#pragma unroll
    for (int s = 0; s < 2; ++s) { v4u w; w.x = pk2(P[8 * s], P[8 * s + 1]); w.y = pk2(P[8 * s + 2], P[8 * s + 3]); w.z = pk2(P[8 * s + 4], P[8 * s + 5]); w.w = pk2(P[8 * s + 6], P[8 * s + 7]); pf[s] = __builtin_bit_cast(bf16x8, w); }
}
DI void pv_tile(f32x16 (&o)[2], const bf16* Vt, int ldv, const bf16x8 (&pf)[2], int lane) {
    const int hh = lane >> 5;
#pragma unroll
    for (int s = 0; s < 2; ++s)
#pragma unroll
        for (int db = 0; db < 2; ++db) { const bf16* vr = Vt + (size_t)((lane & 31) + 32 * db) * ldv + 16 * s + 4 * hh;
            const s16x4 lo = *(const s16x4*)vr, hi = *(const s16x4*)(vr + 8);
            const bf16x8 vf = __builtin_shufflevector(lo, hi, 0, 1, 2, 3, 4, 5, 6, 7);
            o[db] = MFMA32(vf, pf[s], o[db]); }
}
DI void osm_step(f32x16& p, unsigned okm, float& m, float& l, f32x16 (&o)[2]) {
    float mx = NEGF;
#pragma unroll
    for (int i = 0; i < 16; ++i) mx = ((okm >> i) & 1u) ? fmaxf(mx, p[i]) : mx;
    mx = fmaxf(mx, __shfl_xor(mx, 32));
    const float mn = fmaxf(m, mx), al = __builtin_amdgcn_exp2f(m - mn);
    l *= al; o[0] = o[0] * al; o[1] = o[1] * al;
#pragma unroll
    for (int i = 0; i < 16; ++i) { const float e = ((okm >> i) & 1u) ? __builtin_amdgcn_exp2f(p[i] - mn) : 0.f; p[i] = e; l += e; }
    m = mn;
}
constexpr int IMP_LD = 65;
constexpr int SMASK_OFF = 2 * 4 * 32 * IMP_LD * 4;
constexpr int SATT_OFF = 69632;
DI void attn_prompt_unit(const Args& a, LAS unsigned char* lds, int lane, int wave, int b, int g, int tile) {
    const float* PROJ = WSF(WS_PROJ);
    const int hl = wave & 3, qh = wave >> 2, head = g * 4 + hl, q0 = tile * 64 + qh * 32, r = lane & 31, hh = lane >> 5, t = q0 + r, bg = b * 2 + g;
    const float* prow = PROJ + (size_t)(b * T + t) * NINP;
    bf16x8 qf[4];
    { const float qs = 0.125f * LOG2E;
#pragma unroll
      for (int s = 0; s < 4; ++s) { const float* qp = prow + C_Q + head * 64 + 16 * s + 8 * hh; qf[s] = pack8(*(const f32x4*)qp * qs, *(const f32x4*)(qp + 4) * qs); } }
    const float g0 = sigmoidf_(prow[C_GATE + head * 3]), g1 = sigmoidf_(prow[C_GATE + head * 3 + 1]), g2 = sigmoidf_(prow[C_GATE + head * 3 + 2]);
    f32x16 of[2]; of[0] = zero16(); of[1] = zero16();
    LAS float* sImp = (LAS float*)lds; LAS unsigned long long* sMask = (LAS unsigned long long*)(lds + SMASK_OFF);
    {
        const bf16* Kc = WSB(WS_KCP) + (size_t)bg * 256 * 64; const bf16* Vct = WSB(WS_VCTP) + (size_t)bg * 64 * 256;
        const int tmax = q0 + 31, nvis = tmax >= 31 ? (tmax - 31) / 16 + 1 : 0, ntile = (nvis + 31) >> 5;
        float m = NEGF, l = 0.f;
        for (int kt = 0; kt < ntile; ++kt) {
            const f32x16 p = qk_tile(Kc + (size_t)kt * 32 * 64, qf, lane);
            float mx = NEGF;
#pragma unroll
            for (int i = 0; i < 16; ++i) { const int n = kt * 32 + crow(i, hh); mx = (16 * n + 31 <= t) ? fmaxf(mx, p[i]) : mx; }
            mx = fmaxf(mx, __shfl_xor(mx, 32));
            const float mn = fmaxf(m, mx); l *= __builtin_amdgcn_exp2f(m - mn);
#pragma unroll
            for (int i = 0; i < 16; ++i) { const int n = kt * 32 + crow(i, hh); l += (16 * n + 31 <= t) ? __builtin_amdgcn_exp2f(p[i] - mn) : 0.f; }
            m = mn;
        }
        l += __shfl_xor(l, 32);
        const float inv = l > 0.f ? 1.0f / l : 0.f;
        f32x16 oc[2], im[2]; oc[0] = zero16(); oc[1] = zero16(); im[0] = zero16(); im[1] = zero16();
        for (int kt = 0; kt < ntile; ++kt) {
            f32x16 p = qk_tile(Kc + (size_t)kt * 32 * 64, qf, lane);
#pragma unroll
            for (int i = 0; i < 16; ++i) { const int n = kt * 32 + crow(i, hh); p[i] = (16 * n + 31 <= t) ? __builtin_amdgcn_exp2f(p[i] - m) * inv : 0.f; }
            bf16x8 pf[2]; pack_p(p, pf);
            pv_tile(oc, Vct + kt * 32, 256, pf, lane);
#pragma unroll
            for (int blk = 0; blk < 2; ++blk) {
                if ((blk == 0 && kt <= 3) || (blk == 1 && kt >= 3)) {
                    const int jb = r + 32 * blk;
#pragma unroll
                    for (int s = 0; s < 2; ++s) { bf16x8 af;
#pragma unroll
                        for (int j = 0; j < 8; ++j) { const int n = kt * 32 + 16 * s + 8 * (j >> 2) + 4 * hh + (j & 3); af[j] = (n >= 4 * jb - 1 && n <= 4 * jb + 3) ? (short)0x3F80 : (short)0; }
                        im[blk] = MFMA32(af, pf[s], im[blk]); }
                }
            }
        }
        of[0] = of[0] + oc[0] * g0; of[1] = of[1] + oc[1] * g0;
        LAS float* slab = sImp + (size_t)((qh * 4 + hl) * 32 + r) * IMP_LD;
#pragma unroll
        for (int blk = 0; blk < 2; ++blk)
#pragma unroll
            for (int i = 0; i < 16; ++i) slab[32 * blk + crow(i, hh)] = im[blk][i];
    }
    __syncthreads();
    for (int e = 0; e < 8; ++e) {
        const int qq = wave * 8 + e, qh2 = qq >> 5, rq = qq & 31, tq = tile * 64 + qq, cur = tq >> 6;
        float s = 0.f;
#pragma unroll
        for (int h2 = 0; h2 < 4; ++h2) s += sImp[(size_t)((qh2 * 4 + h2) * 32 + rq) * IMP_LD + lane];
        const float v = lane > cur ? -1e9f : ((lane == 0 || lane == cur || lane == cur - 1) ? 1e9f : s);
        int rank = 0;
#pragma unroll 16
        for (int j = 0; j < 64; ++j) { const float vj = __builtin_bit_cast(float, __builtin_amdgcn_readlane(__builtin_bit_cast(int, v), j)); rank += (vj > v || (vj == v && j < lane)) ? 1 : 0; }
        const unsigned long long mask = __ballot(rank < 16 && lane <= cur);
        if (lane == 0) sMask[qq] = mask;
    }
    __syncthreads();
    const unsigned long long smask = sMask[qh * 32 + r];
    {
        const bf16* Ks = WSB(WS_KSEL) + (size_t)bg * T * 64; const bf16* Vts = WSB(WS_VTSEL) + (size_t)bg * 64 * T;
        float m = NEGF, l = 0.f; f32x16 o[2]; o[0] = zero16(); o[1] = zero16();
        const int jbmax = (q0 + 31) >> 6;
        for (int jb = 0; jb <= jbmax; ++jb) {
            const bool bit = (smask >> jb) & 1ull;
            if (__ballot(bit) == 0ull) continue;
            for (int sub = 0; sub < 2; ++sub) { const int k0 = jb * 64 + sub * 32; if (k0 > q0 + 31) break;
                f32x16 p = qk_tile(Ks + (size_t)k0 * 64, qf, lane);
                unsigned okm = 0u;
#pragma unroll
                for (int i = 0; i < 16; ++i) okm |= (bit && (k0 + crow(i, hh) <= t)) ? (1u << i) : 0u;
                osm_step(p, okm, m, l, o);
                bf16x8 pf[2]; pack_p(p, pf); pv_tile(o, Vts + k0, T, pf, lane); }
        }
        l += __shfl_xor(l, 32); const float sc = l > 0.f ? g1 / l : 0.f;
        of[0] = of[0] + o[0] * sc; of[1] = of[1] + o[1] * sc;
    }
    {
        const bf16* Kw = WSB(WS_KWIN) + (size_t)bg * T * 64; const bf16* Vtw = WSB(WS_VTWIN) + (size_t)bg * 64 * T;
        float m = NEGF, l = 0.f; f32x16 o[2]; o[0] = zero16(); o[1] = zero16();
        for (int k0 = (q0 >= 512 ? q0 - 512 : 0); k0 <= q0; k0 += 32) {
            f32x16 p = qk_tile(Kw + (size_t)k0 * 64, qf, lane);
            unsigned okm = 0u;
#pragma unroll
            for (int i = 0; i < 16; ++i) { const int key = k0 + crow(i, hh); okm |= (key <= t && key > t - 512) ? (1u << i) : 0u; }
            osm_step(p, okm, m, l, o);
            bf16x8 pf[2]; pack_p(p, pf); pv_tile(o, Vtw + k0, T, pf, lane);
        }
        l += __shfl_xor(l, 32); const float sc = l > 0.f ? g2 / l : 0.f;
        of[0] = of[0] + o[0] * sc; of[1] = of[1] + o[1] * sc;
    }
    bf16* yb = WSB(WS_AST) + (size_t)(MA + b * T + t) * RWW + head * 64;
#pragma unroll
    for (int db = 0; db < 2; ++db)
#pragma unroll
        for (int gq = 0; gq < 4; ++gq) { v2u w; w.x = pk2(of[db][4 * gq], of[db][4 * gq + 1]); w.y = pk2(of[db][4 * gq + 2], of[db][4 * gq + 3]); *(v2u*)(yb + 32 * db + 8 * gq + 4 * hh) = w; }
}

DI void sa_scores(const float* Kb, int stride, int nrows, int pos0, int lo, int hi, LAS float* sc, int off, const LAS float* qv, int lane) {
    for (int base = 0; base < nrows; base += 64) {
        const int idx = base + lane; const bool inr = idx < nrows; const float* kr = Kb + (size_t)(inr ? idx : 0) * stride; const int pos = pos0 + idx;
        float s0 = 0.f, s1 = 0.f, s2 = 0.f, s3 = 0.f;
#pragma unroll 4
        for (int d4 = 0; d4 < 16; ++d4) { const f32x4 kv = *(const f32x4*)(kr + 4 * d4);
            const f32x4 q0 = *(const LAS f32x4*)(qv + 4 * d4), q1 = *(const LAS f32x4*)(qv + 64 + 4 * d4), q2 = *(const LAS f32x4*)(qv + 128 + 4 * d4), q3 = *(const LAS f32x4*)(qv + 192 + 4 * d4);
            s0 += (kv[0] * q0[0] + kv[1] * q0[1]) + (kv[2] * q0[2] + kv[3] * q0[3]); s1 += (kv[0] * q1[0] + kv[1] * q1[1]) + (kv[2] * q1[2] + kv[3] * q1[3]);
            s2 += (kv[0] * q2[0] + kv[1] * q2[1]) + (kv[2] * q2[2] + kv[3] * q2[3]); s3 += (kv[0] * q3[0] + kv[1] * q3[1]) + (kv[2] * q3[2] + kv[3] * q3[3]); }
        const bool ok = pos >= lo && pos <= hi;
        if (inr) *(LAS f32x4*)(sc + (size_t)(off + idx) * 4) = ok ? (f32x4){s0, s1, s2, s3} : (f32x4){NEGF, NEGF, NEGF, NEGF};
    }
}
DI void sa_softmax(LAS float* sc, int nk, int lane, float (&inv)[4]) {
    LDS_WAIT();
    float mx[4] = {NEGF, NEGF, NEGF, NEGF};
    for (int idx = lane; idx < nk; idx += 64) { const f32x4 v = *(const LAS f32x4*)(sc + (size_t)idx * 4);
#pragma unroll
        for (int h = 0; h < 4; ++h) mx[h] = fmaxf(mx[h], v[h]); }
#pragma unroll
    for (int h = 0; h < 4; ++h) mx[h] = wave_max(mx[h]);
    float sm[4] = {0.f, 0.f, 0.f, 0.f};
    for (int idx = lane; idx < nk; idx += 64) { const f32x4 v = *(const LAS f32x4*)(sc + (size_t)idx * 4); f32x4 e;
#pragma unroll
        for (int h = 0; h < 4; ++h) { e[h] = v[h] > -1e29f ? __expf(v[h] - mx[h]) : 0.f; sm[h] += e[h]; }
        *(LAS f32x4*)(sc + (size_t)idx * 4) = e; }
#pragma unroll
    for (int h = 0; h < 4; ++h) { sm[h] = wave_sum(sm[h]); inv[h] = 1.0f / fmaxf(sm[h], 1e-30f); }
    LDS_WAIT();
}
DI void sa_pv(const float* Vb, int stride, int nrows, const LAS float* sc, int off, int lane, float (&acc)[4]) {
#pragma unroll 8
    for (int idx = 0; idx < nrows; ++idx) { const float vv = Vb[(size_t)idx * stride + lane]; const f32x4 pp = *(const LAS f32x4*)(sc + (size_t)(off + idx) * 4);
        acc[0] += pp[0] * vv; acc[1] += pp[1] * vv; acc[2] += pp[2] * vv; acc[3] += pp[3] * vv; }
}
DI void attn_sample_item(const Args& a, LAS unsigned char* lds, int lane, int item) {
    const float* PROJ = WSF(WS_PROJ);
    const int b = item >> 3, g = (item >> 2) & 1, q = item & 3, row = MP + b * 4 + q, qpos = 16384 + q;
    const float* prow = PROJ + (size_t)row * NINP; const float* pnew = PROJ + (size_t)(MP + b * 4) * NINP + C_KV;
    LAS float* sc = (LAS float*)(lds + SATT_OFF); LAS float* qv = sc + 1040 * 4; LAS float* iv = qv + 256; LAS int* lst = (LAS int*)(iv + 264);
#pragma unroll
    for (int h = 0; h < 4; ++h) qv[h * 64 + lane] = prow[C_Q + (g * 4 + h) * 64 + lane] * 0.125f;
    LDS_WAIT();
    float gt[4][3];
#pragma unroll
    for (int h = 0; h < 4; ++h)
#pragma unroll
        for (int br = 0; br < 3; ++br) gt[h][br] = sigmoidf_(prow[C_GATE + (g * 4 + h) * 3 + br]);
    float of[4] = {0.f, 0.f, 0.f, 0.f};
    float inv[4];
    {
        const float* Kb = WSF(WS_KCS) + ((size_t)b * NCMP_S * 2 + g) * 64; const float* Vb = Kb + KCS_STRIDE;
        sa_scores(Kb, 128, NCMP_S, 0, -1, 1 << 30, sc, 0, qv, lane);
        sa_softmax(sc, NCMP_S, lane, inv);
        float acc[4] = {0.f, 0.f, 0.f, 0.f}; sa_pv(Vb, 128, NCMP_S, sc, 0, lane, acc);
#pragma unroll
        for (int h = 0; h < 4; ++h) of[h] += gt[h][0] * acc[h] * inv[h];
        float val[5];
#pragma unroll
        for (int i = 0; i < 5; ++i) { const int jb = lane + 64 * i; float s = 0.f;
            if (jb <= 256) { for (int n = 4 * jb - 1; n <= 4 * jb + 3; ++n) if (n >= 0 && n < NCMP_S) { const f32x4 p = *(const LAS f32x4*)(sc + (size_t)n * 4); s += (p[0] * inv[0] + p[1] * inv[1]) + (p[2] * inv[2] + p[3] * inv[3]); } }
            val[i] = (jb == 0 || jb == 255 || jb == 256) ? 1e9f : s;
            if (jb <= 256) iv[jb] = val[i]; }
        LDS_WAIT();
        int rank[5] = {0, 0, 0, 0, 0};
        for (int y = 0; y <= 256; ++y) { const float vy = iv[y];
#pragma unroll
            for (int i = 0; i < 5; ++i) { const int jb = lane + 64 * i; rank[i] += (vy > val[i] || (vy == val[i] && y < jb)) ? 1 : 0; } }
        int cnt = 0;
#pragma unroll
        for (int i = 0; i < 5; ++i) { const int jb = lane + 64 * i; const bool sel = jb <= 256 && rank[i] < 16; const unsigned long long bal = __ballot(sel);
            const int pos = cnt + __popcll(bal & ((1ull << lane) - 1ull)); if (sel) lst[pos] = jb; cnt += __popcll(bal); }
        LDS_WAIT();
    }
    {
        int nk = 0;
        for (int si = 0; si < 16; ++si) { const int blk = __builtin_amdgcn_readfirstlane(lst[si]);
            if (blk < 256) { const int page = ((const int*)a.in[I_PT])[b * 128 + (blk >> 1)]; const float* Kb = a.in[I_CKS] + ((size_t)page * 128 + (blk & 1) * 64) * 256 + g * 64;
                sa_scores(Kb, 256, 64, blk * 64, -1, qpos, sc, nk, qv, lane); nk += 64; }
            else { sa_scores(pnew + 256 + g * 64, NINP, 4, 16384, -1, qpos, sc, nk, qv, lane); nk += 4; } }
        sa_softmax(sc, nk, lane, inv);
        float acc[4] = {0.f, 0.f, 0.f, 0.f}; nk = 0;
        for (int si = 0; si < 16; ++si) { const int blk = __builtin_amdgcn_readfirstlane(lst[si]);
            if (blk < 256) { const int page = ((const int*)a.in[I_PT])[b * 128 + (blk >> 1)]; const float* Vb = a.in[I_CKS] + ((size_t)page * 128 + (blk & 1) * 64) * 256 + 128 + g * 64;
                sa_pv(Vb, 256, 64, sc, nk, lane, acc); nk += 64; }
            else { sa_pv(pnew + 256 + 128 + g * 64, NINP, 4, sc, nk, lane, acc); nk += 4; } }
#pragma unroll
        for (int h = 0; h < 4; ++h) of[h] += gt[h][1] * acc[h] * inv[h];
    }
    {
        const float* Kb = a.in[I_SKW] + (size_t)b * 512 * 256 + g * 64;
        sa_scores(Kb, 256, 512, 15872, qpos - 511, qpos, sc, 0, qv, lane);
        sa_scores(pnew + 512 + g * 64, NINP, 4, 16384, qpos - 511, qpos, sc, 512, qv, lane);
        sa_softmax(sc, 516, lane, inv);
        float acc[4] = {0.f, 0.f, 0.f, 0.f};
        sa_pv(Kb + 128, 256, 512, sc, 0, lane, acc); sa_pv(pnew + 512 + 128 + g * 64, NINP, 4, sc, 512, lane, acc);
#pragma unroll
        for (int h = 0; h < 4; ++h) of[h] += gt[h][2] * acc[h] * inv[h];
    }
    bf16* yb = WSB(WS_AST) + (size_t)(MA + row) * RWW + g * 256;
#pragma unroll
    for (int h = 0; h < 4; ++h) yb[h * 64 + lane] = (bf16)f2bf(of[h]);
}
DI void rwpost_items(const Args& a, int lane, int wave, int G, int bx) {
    const int gw = wave * G + bx, NGW = G * NWAVES;
    for (int it = gw; it < MR * 8; it += NGW) { const int row = it >> 3, c = (it & 7) * 64 + lane; const size_t o = (size_t)row * RWW + c;
        const float y = WSF(WS_YS)[o]; const float mean = wave_sum(y) * (1.0f / 64.0f); const float dlt = y - mean; const float var = wave_sum(dlt * dlt) * (1.0f / 64.0f);
        const float yn = dlt * rsqrtf(var + GN_EPS) * a.in[I_LNW][c] + a.in[I_LNBB][c];
        WSB(WS_AST)[o] = (bf16)f2bf((yn + WSF(WS_BON)[o]) * WSF(WS_G)[o]); }
}
DI void ph_attention(const Args& a, LAS unsigned char* lds, int lane, int wave, int G, int bx) {
    for (int i = 0; i < 4; ++i) {
        const int base = (i >> 1) * G, u0 = base + bx; if (u0 >= 256) break;
        const int u = (i & 1) ? 511 - u0 : u0;
        __syncthreads();
        attn_prompt_unit(a, lds, lane, wave, u >> 7, (u >> 6) & 1, u & 63);
    }
    if (wave == 0) for (int it = bx; it < 256; it += G) attn_sample_item(a, lds, lane, it);
    rwpost_items(a, lane, wave, G, bx);
}

constexpr int N_PHASES = 16;
#ifndef MK_PER_PHASE
#define MK_PER_PHASE 0
#endif
__global__ void __launch_bounds__(NWAVES * 64, 2) fwd_kernel(Args a) {
    extern __shared__ __attribute__((aligned(16))) unsigned char lds_raw[];
    LAS unsigned char* lds = (LAS unsigned char*)lds_raw;
    const int tid = threadIdx.x, lane = tid & 63, wave = __builtin_amdgcn_readfirstlane(tid >> 6), G = gridDim.x, bx = blockIdx.x;
    for (int u = tid; u < (LDS_BYTES - LDSCTL_OFF) / 4; u += NWAVES * 64) ((LAS unsigned*)(lds + LDSCTL_OFF))[u] = 0u;
    __syncthreads();
    volatile LAS unsigned* MISC = (volatile LAS unsigned*)(lds + MISC_OFF);
    unsigned* ctl = (unsigned*)(a.ws + WS_CTL);
    XcdBarrier bar; bar.bar = ctl + CW_BAR; bar.x = 0; bar.st = nullptr;
    if (!MK_PER_PHASE) bar = xcd_barrier_post(ctl + CW_BAR, MISC + 8);
    const int lo = a.ph_lo, hi = a.ph_hi;
#define IN(k) (lo <= (k) && (k) < hi)
#define SEAM(k) do { if (IN(k) && IN((k) + 1)) xcd_barrier(bar); } while (0)
    LAS unsigned char* ring = lds + RING_OFF;
    if (IN(0)) ph_prologue(a, lds, tid, lane, wave, G, bx);
    SEAM(0);
    if (IN(1)) ph_u1(a, lane, wave, G, bx);
    SEAM(1);
    if (IN(2)) { pg8::Gemm g{WSB(WS_U), WSB(WS_WGU), MA, 5632, D}; pg8::StaticOrder S; S.init(MA, 5632, G, bx); pg8::EpiSwiglu E{WSB(WS_H)};
        pg8::gemm_phase<pg8::EpiSwiglu, pg8::StaticOrder, true, true>(ring, g, S, E); }
    SEAM(2);
    if (IN(3)) { pg8::Gemm g{WSB(WS_H), WSB(WS_WDN), MA, D, FF}; pg8::StaticOrder S; S.init(MA, D, G, bx); pg8::EpiResid E{a.in[I_XP], a.in[I_XS], WSF(WS_MOD), 2, 0.5f, WSF(WS_Z)};
        pg8::gemm_phase<pg8::EpiResid, pg8::StaticOrder, true, true>(ring, g, S, E); }
    SEAM(3);
    if (IN(4)) ph_ln<0>(a, lane, wave, G, bx);
    SEAM(4);
    if (IN(5)) { pg8::Gemm g{WSB(WS_U), WSB(WS_WIN), MA, NINP, D}; pg8::StaticOrder S; S.init(MA, NINP, G, bx); pg8::EpiProj E{a.in[I_BIN], WSF(WS_PROJ)};
        pg8::gemm_phase<pg8::EpiProj, pg8::StaticOrder, true, true>(ring, g, S, E); }
    SEAM(5);
    if (IN(6)) ph_dist_rwprep(a, lds, tid, lane, wave, G, bx);
    SEAM(6);
    if (IN(7)) { pg8::Gemm g{WSB(WS_ACMP), WSB(WS_WC1), 2 * CROWS, 512, 1024}; pg8::DiagOrder S{CROWS / 256, 1, 2, G, bx}; pg8::EpiF32 E{WSF(WS_HC), 256, 0};
        pg8::gemm_phase<pg8::EpiF32, pg8::DiagOrder, true, true>(ring, g, S, E); }
    SEAM(7);
    if (IN(8)) ph_scan_cfinal(a, lane, wave, G, bx);
    SEAM(8);
    if (IN(9)) ph_attention(a, lds, lane, wave, G, bx);
    SEAM(9);
    if (IN(10)) { pg8::Gemm g{WSB(WS_AST), WSB(WS_WOAB), 2 * MA, 2048, 512}; pg8::PairOrder S{MA / 256, 4, G, bx}; pg8::EpiOutAB E{WSF(WS_PROJ), WSF(WS_M1), WSB(WS_MIN), MA / 256};
        pg8::gemm_phase<pg8::EpiOutAB, pg8::PairOrder, true, true>(ring, g, S, E); }
    SEAM(10);
    if (IN(11)) { pg8::Gemm g{WSB(WS_MIN), WSB(WS_WO), MA, D, D}; pg8::StaticOrder S; S.init(MA, D, G, bx); pg8::EpiResid E{WSF(WS_X1), WSF(WS_X1) + (size_t)MP * D, WSF(WS_MOD), 5, 1.0f, WSF(WS_Z)};
        pg8::gemm_phase<pg8::EpiResid, pg8::StaticOrder, true, true>(ring, g, S, E); }
    SEAM(11);
    if (IN(12)) ph_ln<1>(a, lane, wave, G, bx);
    SEAM(12);
    if (IN(13)) { pg8::Gemm g{WSB(WS_U), WSB(WS_WGU) + (size_t)5632 * D, MA, 5632, D}; pg8::StaticOrder S; S.init(MA, 5632, G, bx); pg8::EpiSwiglu E{WSB(WS_H)};
        pg8::gemm_phase<pg8::EpiSwiglu, pg8::StaticOrder, true, true>(ring, g, S, E); }
    SEAM(13);
    if (IN(14)) { pg8::Gemm g{WSB(WS_H), WSB(WS_WDN) + (size_t)D * FF, MA, D, FF}; pg8::StaticOrder S; S.init(MA, D, G, bx); pg8::EpiResid E{WSF(WS_X2), WSF(WS_X2) + (size_t)MP * D, WSF(WS_MOD), 8, 0.5f, WSF(WS_Z)};
        pg8::gemm_phase<pg8::EpiResid, pg8::StaticOrder, true, true>(ring, g, S, E); }
    SEAM(14);
    if (IN(15)) ph_ln<2>(a, lane, wave, G, bx);
#undef IN
#undef SEAM
}

extern "C" void kernel_launch(void* const* d_in, const int* in_sizes, int n_in, void* d_out, int out_size, void* d_ws, size_t ws_size, hipStream_t stream) {
    static int grid = 0;
    if (grid == 0) {
        if (n_in != N_IN || (size_t)out_size != O_END || ws_size < WS_END) { fprintf(stderr, "kernel_launch: unexpected shapes: n_in %d out %d ws %zu (need %zu)\n", n_in, out_size, ws_size, (size_t)WS_END); grid = -1; return; }
        int dev = 0, cus = 0, per_cu = 0;
        if (hipGetDevice(&dev) != hipSuccess || hipDeviceGetAttribute(&cus, hipDeviceAttributeMultiprocessorCount, dev) != hipSuccess) { grid = -1; return; }
        if (hipFuncSetAttribute((const void*)fwd_kernel, hipFuncAttributeMaxDynamicSharedMemorySize, LDS_BYTES) != hipSuccess) { fprintf(stderr, "kernel_launch: hipFuncSetAttribute failed\n"); grid = -1; return; }
        if (hipOccupancyMaxActiveBlocksPerMultiprocessor(&per_cu, (const void*)fwd_kernel, NWAVES * 64, LDS_BYTES) != hipSuccess || per_cu < 1)
            fprintf(stderr, "kernel_launch: note: occupancy query reports %d workgroups per CU\n", per_cu);
        (void)hipGetLastError();
        grid = cus;
    }
    if (grid < 0) return;
    if (hipMemsetAsync((char*)d_ws + WS_CTL, 0, CTL_ZERO_BYTES, stream) != hipSuccess) return;
    Args a{};
    for (int i = 0; i < N_IN; ++i) a.in[i] = (const float*)d_in[i];
    a.out = (float*)d_out; a.ws = (unsigned char*)d_ws;
#if MK_PER_PHASE
    for (int p = 0; p < N_PHASES; ++p) { a.ph_lo = p; a.ph_hi = p + 1; hipLaunchKernelGGL(fwd_kernel, dim3(grid), dim3(NWAVES * 64), LDS_BYTES, stream, a); }
#else
    a.ph_lo = 0; a.ph_hi = N_PHASES;
    hipLaunchKernelGGL(fwd_kernel, dim3(grid), dim3(NWAVES * 64), LDS_BYTES, stream, a);
#endif
    const hipError_t le = hipPeekAtLastError();
    if (le != hipSuccess) fprintf(stderr, "kernel_launch: launch failed: %s\n", hipGetErrorName(le));
}
```

```cpp
#include <hip/hip_runtime.h>
#include <cstdio>
#include <cstdint>
#define DI __device__ __forceinline__
constexpr int D = 1024, FF = 2816, T = 4096, NBP = 4, NBS = 32, ST = 4;
constexpr int MP = NBP * T;
constexpr int MS = NBS * ST;
constexpr int MR = MP + MS;
constexpr int MA = 16640;
constexpr int NIN = 5144, NINP = 5376;
constexpr int C_Q = 1792, C_KV = 2304, C_GATE = 3072, C_MERGE = 3096;
constexpr int RWW = 512;
constexpr int NCH_S = 1024, NCH_P = 256;
constexpr int NCMP_S = 1023, NCMP_P = 255;
constexpr int CROWS_S = NBS * NCH_S * 2;
constexpr int CROWS = CROWS_S + NBP * NCH_P * 2;
constexpr float ALPHA = 1.189207115002721f;
constexpr float LN_EPS = 1e-5f, GN_EPS = 64e-5f;
constexpr float LOG2E = 1.4426950408889634f;
constexpr float NEGF = -1e30f;
constexpr size_t O_Y = 0;
constexpr size_t O_KVC_P = 16908288, O_KVS_P = 21102592, O_KVW_P = 25296896, O_WKV_P = 25821184, O_SH_P = 25952256;
constexpr size_t O_KVC_S = 25959424, O_KVS_S = 25992192, O_KVW_S = 26024960, O_WKV_S = 30219264, O_SH_S = 31267840, O_END = 31325184;
DI int bb_of_row(int row) { return row < MP ? (row >> 12) : (row < MR ? 4 + ((row - MP) >> 2) : 35); }
namespace pg8 {
#define PG8_LAS __attribute__((address_space(3)))
typedef unsigned short bf16_t;
typedef short bf16x8 __attribute__((ext_vector_type(8)));
typedef float f32x4 __attribute__((ext_vector_type(4)));
typedef unsigned u32x4 __attribute__((ext_vector_type(4)));
constexpr int BM = 256, BK = 64, HALF = 128, HTB = HALF * BK * 2  , STAGE_BYTES = 8 * HTB, NXCD = 8, WGM = 8;

__host__ __device__ __forceinline__ int lds_byte(int r, int c) { const int st = (r >> 4) * 2 + (c >> 5), rr = r & 15, cc = c & 31, ob = rr * 64 + cc * 2; return st * 1024 + (ob ^ (((ob >> 9) & 1) << 5)); }
__host__ __device__ __forceinline__ void stage_rc(int b, int& R, int& C) { const int st = b / 1024, sb = b % 1024, swz = sb ^ (((sb >> 9) & 1) << 5); R = (st >> 1) * 16 + swz / 64; C = (st & 1) * 32 + (swz % 64) / 2; }
__host__ __device__ __forceinline__ int perm32(int rho) { const int n = rho >> 4, i = rho & 15; return 8 * (i >> 2) + 4 * n + (i & 3); }

struct Unit { int pm, pn; };
struct Gemm { const bf16_t* A; const bf16_t* Bt; int M, N, K; };

struct StaticOrder {
    int nM, nN, nwg, G, c;
    __host__ __device__ void init(int M, int N, int G_, int c_) { nM = M / BM; nN = N / BM; nwg = nM * nN; G = G_; c = c_; }
    __host__ __device__ bool next(int i, Unit& u) const {
        const long L = (long)i * G + c; if (L >= nwg) return false;
        int wgid = (int)L; { const int q = nwg / NXCD, r = nwg % NXCD, xcd = wgid % NXCD, off = wgid / NXCD; wgid = (xcd < r ? xcd * (q + 1) : r * (q + 1) + (xcd - r) * q) + off; }
        const int nig = WGM * nN, gid = wgid / nig, fm = gid * WGM, gsz = (nM - fm) < WGM ? (nM - fm) : WGM;
        u.pm = fm + ((wgid % nig) % gsz); u.pn = (wgid % nig) / gsz; return true;
    }
    __device__ __forceinline__ void a_ready(const Unit&) const {}
    __device__ __forceinline__ void done(const Unit&) const {}
};

struct PairOrder {
    int nm, nn, G, c;
    __device__ __forceinline__ bool next(int i, Unit& u) const {
        const int tile = (i >> 1) * G + c; if (tile >= nm * nn) return false;
        const int rep = i & 1; u.pm = tile / nn + rep * nm; u.pn = tile % nn + rep * nn; return true;
    }
    __device__ __forceinline__ void a_ready(const Unit&) const {}
    __device__ __forceinline__ void done(const Unit&) const {}
};
struct DiagOrder {
    int nm, nn, nrep, G, c;
    __device__ __forceinline__ bool next(int i, Unit& u) const {
        const int L = i * G + c; if (L >= nrep * nm * nn) return false;
        const int rep = L / (nm * nn), rem = L % (nm * nn); u.pm = rem / nn + rep * nm; u.pn = rem % nn + rep * nn; return true;
    }
    __device__ __forceinline__ void a_ready(const Unit&) const {}
    __device__ __forceinline__ void done(const Unit&) const {}
};

typedef float f32x2 __attribute__((ext_vector_type(2)));
typedef __bf16 bf16x2_t __attribute__((ext_vector_type(2)));
__device__ __forceinline__ unsigned cvt_pk_bf16(float lo, float hi) { f32x2 v = {lo, hi}; bf16x2_t b = __builtin_convertvector(v, bf16x2_t); return __builtin_bit_cast(unsigned, b); }
__device__ __forceinline__ float fast_sigmoid(float x) { return __builtin_amdgcn_rcpf(1.0f + __builtin_amdgcn_exp2f(-x * LOG2E)); }

struct EpiSwiglu {
    static constexpr bool PERM = true, AFTER_DRAIN = false;
    bf16_t* H;
    __device__ __forceinline__ void operator()(const f32x4 (&acc)[2][2][4][2], const Unit& u, int wr, int wc, int fr, int fq) const {
        const int row0 = u.pm * BM + wr * 64 + fr, hc0 = u.pn * HALF + wc * 32 + 8 * fq;
#pragma unroll
        for (int ai = 0; ai < 2; ++ai)
#pragma unroll
            for (int m = 0; m < 4; ++m) {
                bf16_t* rowp = H + (size_t)(row0 + ai * HALF + m * 16) * FF + hc0;
                float h[8];
#pragma unroll
                for (int n = 0; n < 2; ++n)
#pragma unroll
                    for (int e = 0; e < 4; ++e) { const float g = acc[ai][0][m][n][e], up = acc[ai][1][m][n][e]; h[4 * n + e] = g * fast_sigmoid(g) * up; }
                u32x4 w; w.x = cvt_pk_bf16(h[0], h[1]); w.y = cvt_pk_bf16(h[2], h[3]); w.z = cvt_pk_bf16(h[4], h[5]); w.w = cvt_pk_bf16(h[6], h[7]);
                *(u32x4*)rowp = w;
            }
    }
};
struct EpiResid {
    static constexpr bool PERM = false, AFTER_DRAIN = false;
    const float* xp; const float* xs; const float* mod; int slot; float coef; float* Z;
    __device__ __forceinline__ void operator()(const f32x4 (&acc)[2][2][4][2], const Unit& u, int wr, int wc, int fr, int fq) const {
        const int row0 = u.pm * BM + wr * 64 + fr, col0 = u.pn * BM + wc * 32 + 4 * fq;
#pragma unroll
        for (int ai = 0; ai < 2; ++ai)
#pragma unroll
            for (int m = 0; m < 4; ++m) {
                const int row = row0 + ai * HALF + m * 16; const bool valid = row < MR;
                const float* xr = row < MP ? xp + (size_t)row * D : xs + (size_t)(row - MP) * D;
                const float* mr = mod + (size_t)(bb_of_row(row) * 9 + slot) * D;
#pragma unroll
                for (int bj = 0; bj < 2; ++bj)
#pragma unroll
                    for (int n = 0; n < 2; ++n) { const int col = col0 + bj * HALF + n * 16;
                        const f32x4 xv = valid ? *(const f32x4*)(xr + col) : (f32x4){0.f, 0.f, 0.f, 0.f}; const f32x4 mv = *(const f32x4*)(mr + col);
                        *(f32x4*)(Z + (size_t)row * D + col) = ALPHA * xv + coef * (1.0f + mv) * acc[ai][bj][m][n]; }
            }
    }
};
struct EpiProj {
    static constexpr bool PERM = false, AFTER_DRAIN = false;
    const float* bias; float* P;
    __device__ __forceinline__ void operator()(const f32x4 (&acc)[2][2][4][2], const Unit& u, int wr, int wc, int fr, int fq) const {
        const int row0 = u.pm * BM + wr * 64 + fr, col0 = u.pn * BM + wc * 32 + 4 * fq;
        f32x4 bv[2][2];
#pragma unroll
        for (int bj = 0; bj < 2; ++bj)
#pragma unroll
            for (int n = 0; n < 2; ++n) { const int col = col0 + bj * HALF + n * 16; bv[bj][n] = col < NIN ? *(const f32x4*)(bias + col) : (f32x4){0.f, 0.f, 0.f, 0.f}; }
#pragma unroll
        for (int ai = 0; ai < 2; ++ai)
#pragma unroll
            for (int m = 0; m < 4; ++m) { float* rp = P + (size_t)(row0 + ai * HALF + m * 16) * NINP + col0;
#pragma unroll
                for (int bj = 0; bj < 2; ++bj)
#pragma unroll
                    for (int n = 0; n < 2; ++n) *(f32x4*)(rp + bj * HALF + n * 16) = acc[ai][bj][m][n] + bv[bj][n]; }
    }
};
struct EpiF32 {
    static constexpr bool PERM = false, AFTER_DRAIN = false;
    float* O; int ldc; int nm;
    __device__ __forceinline__ void operator()(const f32x4 (&acc)[2][2][4][2], const Unit& u, int wr, int wc, int fr, int fq) const {
        const int row0 = u.pm * BM + wr * 64 + fr, col0 = wc * 32 + 4 * fq;
#pragma unroll
        for (int ai = 0; ai < 2; ++ai)
#pragma unroll
            for (int m = 0; m < 4; ++m) { float* rp = O + (size_t)(row0 + ai * HALF + m * 16) * ldc + col0;
#pragma unroll
                for (int bj = 0; bj < 2; ++bj)
#pragma unroll
                    for (int n = 0; n < 2; ++n) *(f32x4*)(rp + bj * HALF + n * 16) = acc[ai][bj][m][n]; }
    }
};
struct EpiOutAB {
    static constexpr bool PERM = false, AFTER_DRAIN = false;
    const float* P; float* M1; bf16_t* MIN; int nm;
    __device__ __forceinline__ void operator()(const f32x4 (&acc)[2][2][4][2], const Unit& u, int wr, int wc, int fr, int fq) const {
        const int rep = u.pm >= nm ? 1 : 0;
        const int row0 = (u.pm - rep * nm) * BM + wr * 64 + fr, col0 = (u.pn - rep * 4) * BM + wc * 32 + 4 * fq;
#pragma unroll
        for (int ai = 0; ai < 2; ++ai)
#pragma unroll
            for (int m = 0; m < 4; ++m) { const int row = row0 + ai * HALF + m * 16;
#pragma unroll
                for (int bj = 0; bj < 2; ++bj)
#pragma unroll
                    for (int n = 0; n < 2; ++n) { const int col = col0 + bj * HALF + n * 16;
                        const f32x4 pm = *(const f32x4*)(P + (size_t)row * NINP + C_MERGE + rep * D + col);
                        f32x4 g; g[0] = fast_sigmoid(pm[0]); g[1] = fast_sigmoid(pm[1]); g[2] = fast_sigmoid(pm[2]); g[3] = fast_sigmoid(pm[3]);
                        const f32x4 v = g * acc[ai][bj][m][n];
                        if (rep == 0) *(f32x4*)(M1 + (size_t)row * D + col) = v;
                        else { const f32x4 s = *(const f32x4*)(M1 + (size_t)row * D + col) + v;
                               typedef unsigned u32x2v __attribute__((ext_vector_type(2))); u32x2v w; w.x = cvt_pk_bf16(s[0], s[1]); w.y = cvt_pk_bf16(s[2], s[3]);
                               *(u32x2v*)(MIN + (size_t)row * D + col) = w; } }
            }
    }
};
template <class Epi, class Sched, bool ALIGN_EPI = false, bool SP2 = false>
__device__ __forceinline__ void gemm_phase(PG8_LAS unsigned char* lds, const Gemm g, const Sched& S, const Epi& E) {
    const int tid = threadIdx.x, wid = __builtin_amdgcn_readfirstlane(tid >> 6), lane = tid & 63, wr = wid >> 2, wc = wid & 3, fr = lane & 15, fq = lane >> 4;
    const int K = g.K, nt = K / BK;
    unsigned voffA[2], voffB[2];
#pragma unroll
    for (int i = 0; i < 2; ++i) { int R, C; stage_rc(tid * 16 + i * 8192, R, C); const int Rb = Epi::PERM ? ((R & ~31) + perm32(R & 31)) : R;
        voffA[i] = (unsigned)(R * K + C) * 2u; voffB[i] = (unsigned)(Rb * K + C) * 2u; }
    const size_t kstep = (size_t)(BK * 2);
    const size_t hstep = (size_t)HALF * K * 2;
    const size_t tstep = 2 * hstep;
    const unsigned ldsw = (unsigned)wid * 1024u;
    const int aoff = lds_byte(wr * 64 + fr, fq * 8), boff = lds_byte(wc * 32 + fr, fq * 8);
#define PG8_SA(b, h) (((b) * 2 + (h)) * HTB)
#define PG8_SB(b, h) ((4 + (b) * 2 + (h)) * HTB)
#define PG8_STAGE(bufoff, gbase, voff) do { _Pragma("unroll") for (int _i = 0; _i < 2; ++_i) \
        __builtin_amdgcn_global_load_lds((const unsigned*)((const char*)(gbase) + (voff)[_i]), (PG8_LAS unsigned*)(lds + (bufoff) + ldsw + _i * 8192), 16, 0, 0); } while (0)
#define PG8_LDA(dst, b, h) do { _Pragma("unroll") for (int m = 0; m < 4; ++m) _Pragma("unroll") for (int k = 0; k < 2; ++k) dst[m][k] = *(const PG8_LAS bf16x8*)(lds + PG8_SA(b, h) + aoff + m * 2048 + k * 1024); } while (0)
#define PG8_LDB(dst, b, h) do { _Pragma("unroll") for (int n = 0; n < 2; ++n) _Pragma("unroll") for (int k = 0; k < 2; ++k) dst[n][k] = *(const PG8_LAS bf16x8*)(lds + PG8_SB(b, h) + boff + n * 2048 + k * 1024); } while (0)
#define PG8_MMA(ai, bj, At, Bt) do { __builtin_amdgcn_s_setprio(1); _Pragma("unroll") for (int m = 0; m < 4; ++m) _Pragma("unroll") for (int n = 0; n < 2; ++n) _Pragma("unroll") for (int k = 0; k < 2; ++k) \
        acc[ai][bj][m][n] = __builtin_amdgcn_mfma_f32_16x16x32_bf16(Bt[n][k], At[m][k], acc[ai][bj][m][n], 0, 0, 0); __builtin_amdgcn_s_setprio(0); } while (0)
#define PG8_WAIT_V(n) asm volatile("s_waitcnt vmcnt(" #n ")" ::: "memory")
#define PG8_WAIT_L(n) asm volatile("s_waitcnt lgkmcnt(" #n ")" ::: "memory")
#define PG8_BAR __builtin_amdgcn_s_barrier()
#define PG8_SCHED __builtin_amdgcn_sched_barrier(0)
    Unit cur, nxt; int ui = 0;
    if (!S.next(0, cur)) return;
    f32x4 acc[2][2][4][2];
#pragma unroll
    for (int a = 0; a < 2; ++a)
#pragma unroll
        for (int b = 0; b < 2; ++b)
#pragma unroll
            for (int m = 0; m < 4; ++m)
#pragma unroll
                for (int n = 0; n < 2; ++n) acc[a][b][m][n] = (f32x4){0.f, 0.f, 0.f, 0.f};
    bf16x8 At[4][2], B0[2][2], B1[2][2];
    const char* cA = (const char*)g.A + (size_t)cur.pm * tstep; const char* cB = (const char*)g.Bt + (size_t)cur.pn * tstep;
    S.a_ready(cur);
    if constexpr (SP2) {
        PG8_STAGE(PG8_SB(0, 0), cB, voffB); PG8_STAGE(PG8_SB(0, 1), cB + hstep, voffB); PG8_STAGE(PG8_SA(0, 0), cA, voffA); PG8_STAGE(PG8_SA(0, 1), cA + hstep, voffA);
        if (wr == 1) PG8_BAR;
        PG8_WAIT_V(2); PG8_BAR;
        PG8_STAGE(PG8_SB(1, 0), cB + kstep, voffB); PG8_STAGE(PG8_SA(1, 0), cA + kstep, voffA); PG8_STAGE(PG8_SB(1, 1), cB + hstep + kstep, voffB);
        PG8_WAIT_V(6); PG8_BAR;
    } else {
        PG8_STAGE(PG8_SB(0, 0), cB, voffB); PG8_STAGE(PG8_SA(0, 0), cA, voffA); PG8_STAGE(PG8_SB(0, 1), cB + hstep, voffB); PG8_STAGE(PG8_SA(0, 1), cA + hstep, voffA);
        if (wr == 1) PG8_BAR;
        PG8_WAIT_V(4); PG8_BAR;
        PG8_STAGE(PG8_SB(1, 0), cB + kstep, voffB); PG8_STAGE(PG8_SA(1, 0), cA + kstep, voffA); PG8_STAGE(PG8_SB(1, 1), cB + hstep + kstep, voffB);
        PG8_WAIT_V(6); PG8_BAR;
    }
    for (;;) {
        const bool has_next = S.next(ui + 1, nxt);
        const char* nA = has_next ? (const char*)g.A + (size_t)nxt.pm * tstep : cA; const char* nB = has_next ? (const char*)g.Bt + (size_t)nxt.pn * tstep : cB;
        for (int t = 0; t < nt; t += 2) {
            const bool last = (t == nt - 2);
            const char* a1 = cA + (size_t)(t + 1) * kstep;
            const char* a2 = last ? nA : cA + (size_t)(t + 2) * kstep; const char* b2 = last ? nB : cB + (size_t)(t + 2) * kstep;
            const char* a3 = a2 + kstep; const char* b3 = b2 + kstep;
            if (last && has_next) S.a_ready(nxt);
            if constexpr (SP2) {
            PG8_LDB(B0, 0, 0); PG8_LDB(B1, 0, 1); PG8_SCHED; PG8_LDA(At, 0, 0); PG8_STAGE(PG8_SA(1, 1), a1 + hstep, voffA);
            PG8_WAIT_V(8); PG8_WAIT_L(0); PG8_BAR; PG8_MMA(0, 0, At, B0); PG8_MMA(0, 1, At, B1); PG8_BAR; PG8_SCHED;
            PG8_LDA(At, 0, 1); PG8_STAGE(PG8_SB(0, 0), b2, voffB); PG8_STAGE(PG8_SB(0, 1), b2 + hstep, voffB); PG8_STAGE(PG8_SA(0, 0), a2, voffA);
            PG8_WAIT_V(8); PG8_WAIT_L(0); PG8_BAR; PG8_MMA(1, 0, At, B0); PG8_MMA(1, 1, At, B1); PG8_BAR; PG8_SCHED;
            PG8_LDB(B0, 1, 0); PG8_LDB(B1, 1, 1); PG8_SCHED; PG8_LDA(At, 1, 0); PG8_STAGE(PG8_SA(0, 1), a2 + hstep, voffA);
            PG8_WAIT_V(8); PG8_WAIT_L(0); PG8_BAR; PG8_MMA(0, 0, At, B0); PG8_MMA(0, 1, At, B1); PG8_BAR; PG8_SCHED;
            PG8_LDA(At, 1, 1); PG8_STAGE(PG8_SB(1, 0), b3, voffB); PG8_STAGE(PG8_SB(1, 1), b3 + hstep, voffB); PG8_STAGE(PG8_SA(1, 0), a3, voffA);
            PG8_WAIT_V(8); PG8_WAIT_L(0); PG8_BAR; PG8_MMA(1, 0, At, B0); PG8_MMA(1, 1, At, B1); PG8_BAR; PG8_SCHED;
            } else {
            PG8_LDB(B0, 0, 0); PG8_SCHED; PG8_LDA(At, 0, 0); PG8_STAGE(PG8_SA(1, 1), a1 + hstep, voffA);
            PG8_WAIT_L(8); PG8_BAR; PG8_WAIT_L(0); PG8_MMA(0, 0, At, B0); PG8_BAR; PG8_SCHED;
            PG8_LDB(B1, 0, 1); PG8_STAGE(PG8_SB(0, 0), b2, voffB);
            PG8_BAR; PG8_WAIT_L(0); PG8_MMA(0, 1, At, B1); PG8_BAR;
            PG8_LDA(At, 0, 1); PG8_STAGE(PG8_SA(0, 0), a2, voffA);
            PG8_BAR; PG8_WAIT_L(0); PG8_MMA(1, 0, At, B0); PG8_BAR; PG8_SCHED;
            PG8_STAGE(PG8_SB(0, 1), b2 + hstep, voffB);
            PG8_WAIT_V(6); PG8_BAR; PG8_MMA(1, 1, At, B1); PG8_BAR;
            PG8_LDB(B0, 1, 0); PG8_SCHED; PG8_LDA(At, 1, 0); PG8_STAGE(PG8_SA(0, 1), a2 + hstep, voffA);
            PG8_WAIT_L(8); PG8_BAR; PG8_WAIT_L(0); PG8_MMA(0, 0, At, B0); PG8_BAR; PG8_SCHED;
            PG8_LDB(B1, 1, 1); PG8_STAGE(PG8_SB(1, 0), b3, voffB);
            PG8_BAR; PG8_WAIT_L(0); PG8_MMA(0, 1, At, B1); PG8_BAR;
            PG8_LDA(At, 1, 1); PG8_STAGE(PG8_SA(1, 0), a3, voffA);
            PG8_BAR; PG8_WAIT_L(0); PG8_MMA(1, 0, At, B0); PG8_BAR; PG8_SCHED;
            PG8_STAGE(PG8_SB(1, 1), b3 + hstep, voffB);
            PG8_WAIT_V(6); PG8_BAR; PG8_MMA(1, 1, At, B1); PG8_BAR;
            }
        }
        if constexpr (ALIGN_EPI) { if (wr == 0) PG8_BAR; }
        if constexpr (!Epi::AFTER_DRAIN) { E(acc, cur, wr, wc, fr, fq); S.done(cur); }
        if (!has_next) break;
#pragma unroll
        for (int a = 0; a < 2; ++a)
#pragma unroll
            for (int b = 0; b < 2; ++b)
#pragma unroll
                for (int m = 0; m < 4; ++m)
#pragma unroll
                    for (int n = 0; n < 2; ++n) acc[a][b][m][n] = (f32x4){0.f, 0.f, 0.f, 0.f};
        cur = nxt; cA = nA; cB = nB; ++ui;
        if constexpr (ALIGN_EPI) { if (wr == 1) PG8_BAR; }
    }
    PG8_WAIT_V(0);
    if constexpr (!ALIGN_EPI) { if (wr == 0) PG8_BAR; }
    PG8_BAR;
    if constexpr (Epi::AFTER_DRAIN) { E.fused(acc, cur, wr, wc, fr, fq, lds, wid, lane); S.done(cur); }
#undef PG8_SA
#undef PG8_SB
#undef PG8_STAGE
#undef PG8_LDA
#undef PG8_LDB
#undef PG8_MMA
#undef PG8_WAIT_V
#undef PG8_WAIT_L
#undef PG8_BAR
#undef PG8_SCHED
}
}

constexpr size_t al256(size_t x) { return (x + 255) & ~(size_t)255; }
constexpr size_t WS_CTL = 0, CTL_ZERO_BYTES = 1u << 20;
constexpr int CW_BAR = 4096;
constexpr size_t WS_MOD  = CTL_ZERO_BYTES;
constexpr size_t WS_PET  = al256(WS_MOD + (size_t)36 * 9 * D * 4);
constexpr size_t WS_WGU  = al256(WS_PET + 2 * 128 * 4);
constexpr size_t WS_WDN  = al256(WS_WGU + (size_t)2 * 5632 * D * 2);
constexpr size_t WS_WIN  = al256(WS_WDN + (size_t)2 * D * FF * 2);
constexpr size_t WS_WOAB = al256(WS_WIN + (size_t)NINP * D * 2);
constexpr size_t WS_WO   = al256(WS_WOAB + (size_t)2048 * 512 * 2);
constexpr size_t WS_WC1  = al256(WS_WO + (size_t)D * D * 2);
constexpr size_t WS_U    = al256(WS_WC1 + (size_t)512 * 1024 * 2);
constexpr size_t WS_H    = al256(WS_U + (size_t)MA * D * 2);
constexpr size_t WS_Z    = al256(WS_H + (size_t)MA * FF * 2);
constexpr size_t WS_X1   = al256(WS_Z + (size_t)MA * D * 4);
constexpr size_t WS_X2   = al256(WS_X1 + (size_t)MA * D * 4);
constexpr size_t WS_M1   = al256(WS_X2 + (size_t)MA * D * 4);
constexpr size_t WS_MIN  = al256(WS_M1 + (size_t)MA * D * 4);
constexpr size_t WS_PROJ = al256(WS_MIN + (size_t)MA * D * 2);
constexpr size_t WS_RW   = al256(WS_PROJ + (size_t)MA * NINP * 4);
constexpr size_t RW_STRIDE = (size_t)MA * RWW;
constexpr size_t WS_G    = al256(WS_RW + 6 * RW_STRIDE * 4);
constexpr size_t WS_BON  = al256(WS_G + RW_STRIDE * 4);
constexpr size_t WS_YS   = al256(WS_BON + RW_STRIDE * 4);
constexpr size_t WS_AST  = al256(WS_YS + RW_STRIDE * 4);
constexpr size_t WS_KSEL = al256(WS_AST + (size_t)2 * MA * RWW * 2);
constexpr size_t KV_BYTES = (size_t)NBP * 2 * T * 64 * 2;
constexpr size_t WS_KWIN = WS_KSEL + KV_BYTES, WS_VTSEL = WS_KWIN + KV_BYTES, WS_VTWIN = WS_VTSEL + KV_BYTES;
constexpr size_t WS_KCP  = WS_VTWIN + KV_BYTES;
constexpr size_t WS_VCTP = WS_KCP + (size_t)NBP * 2 * 256 * 64 * 2;
constexpr size_t WS_KCS  = al256(WS_VCTP + (size_t)NBP * 2 * 256 * 64 * 2);
constexpr size_t KCS_STRIDE = (size_t)NBS * NCMP_S * 2 * 64;
constexpr size_t WS_ACMP = al256(WS_KCS + 2 * KCS_STRIDE * 4);
constexpr size_t WS_HC   = al256(WS_ACMP + (size_t)2 * CROWS * 1024 * 2);
constexpr size_t WS_END  = al256(WS_HC + (size_t)2 * CROWS * 256 * 4);

constexpr int NWAVES = 8;
constexpr int RING_OFF = 0, RING_BYTES = 131072;
constexpr int LDSCTL_OFF = RING_BYTES, MISC_OFF = LDSCTL_OFF + 320;
constexpr int LDS_BYTES = 147456;

#define GAS __attribute__((address_space(1)))
#define LAS __attribute__((address_space(3)))
typedef unsigned short bf16;
typedef unsigned v4u __attribute__((ext_vector_type(4)));
typedef unsigned v2u __attribute__((ext_vector_type(2)));
typedef float f32x4 __attribute__((ext_vector_type(4)));
typedef float f32x16 __attribute__((ext_vector_type(16)));
typedef short bf16x8 __attribute__((ext_vector_type(8)));
typedef short s16x4 __attribute__((ext_vector_type(4)));
typedef GAS unsigned gu32;
#define RLX_AGENT __ATOMIC_RELAXED, __HIP_MEMORY_SCOPE_AGENT
#define LDS_WAIT() asm volatile("s_waitcnt lgkmcnt(0)" ::: "memory")
#define VM_WAIT() asm volatile("s_waitcnt vmcnt(0)" ::: "memory")
DI unsigned f2bf(float f) { unsigned u = __builtin_bit_cast(unsigned, f); return (u + 0x7fffu + ((u >> 16) & 1u)) >> 16; }
DI unsigned pk2(float lo, float hi) { return pg8::cvt_pk_bf16(lo, hi); }
DI float sigmoidf_(float x) { return 1.0f / (1.0f + __expf(-x)); }
DI float wave_sum(float v) {
#pragma unroll
    for (int o = 1; o < 64; o <<= 1) v += __shfl_xor(v, o);
    return v;
}
DI float wave_max(float v) {
#pragma unroll
    for (int o = 1; o < 64; o <<= 1) v = fmaxf(v, __shfl_xor(v, o));
    return v;
}
template <int CTRL> DI float dpp_f(float x) { return __builtin_bit_cast(float, __builtin_amdgcn_update_dpp(0, __builtin_bit_cast(int, x), CTRL, 0xf, 0xf, false)); }
DI float row16_sum(float x) {
    x += dpp_f<0x128>(x); x += dpp_f<0x124>(x); x += dpp_f<0x122>(x); x += dpp_f<0x121>(x); return x;
}
DI float gelu_tanh(float x) { const float u = 0.7978845608028654f * (x + 0.044715f * x * x * x); const float e = __expf(2.0f * u); const float th = 1.0f - 2.0f / (e + 1.0f); return 0.5f * x * (1.0f + th); }
#define XB_TMO      128
#define XB_XCNT(j)  (256  + 64 * (j))
#define XB_XSUB(j)  (1280 + 64 * (j))
#define XB_XGEN(j)  (2304 + 64 * (j))
#define XB_TOP      3328
#define XB_TOPGEN   3392
#define XCD_BAR_WORDS 3456
#define XB_SPIN_CAP (1u << 18)

__device__ __forceinline__ unsigned xb_ld(unsigned* p)              { return __hip_atomic_load(p, __ATOMIC_RELAXED, __HIP_MEMORY_SCOPE_AGENT); }
__device__ __forceinline__ unsigned xb_add(unsigned* p, unsigned v) { return __hip_atomic_fetch_add(p, v, __ATOMIC_RELAXED, __HIP_MEMORY_SCOPE_AGENT); }
__device__ __forceinline__ unsigned xb_xcc_id() { return (unsigned)__builtin_amdgcn_s_getreg((3 << 11) | 20) & 0xFu; }
#define XB_SPIN(cond, bar) do { unsigned _sp = 0; while (cond) { __builtin_amdgcn_s_sleep(1); \
    if ((++_sp & 255u) == 0u) { if (xb_ld(&(bar)[XB_TMO])) break; if (_sp > XB_SPIN_CAP) { atomicAdd(&(bar)[XB_TMO], 1u); break; } } } } while (0)

struct XcdBarrier {
    unsigned* bar; unsigned x;
    volatile LAS unsigned* st;
};

__device__ __forceinline__ XcdBarrier xcd_barrier_post(unsigned* bar, volatile LAS unsigned* st) {
    XcdBarrier b; b.bar = bar; b.x = xb_xcc_id(); b.st = st;
    if (threadIdx.x == 0) (void)xb_add(&bar[XB_XCNT(b.x)], 1u);
    return b;
}
__device__ __forceinline__ void xcd_barrier_complete(unsigned* bar, unsigned x, unsigned& nloc, unsigned& nx) {
    const unsigned G = gridDim.x * gridDim.y * gridDim.z;
    unsigned sum, cnt, mine, sp = 0u;
    for (;;) {
        sum = 0u; cnt = 0u; mine = 0u;
#pragma unroll
        for (unsigned j = 0; j < 16; ++j) { const unsigned c = xb_ld(&bar[XB_XCNT(j)]); sum += c; cnt += (c > 0u) ? 1u : 0u; mine = (j == x) ? c : mine; }
        if (sum == G) break;
        __builtin_amdgcn_s_sleep(1);
        if ((++sp & 255u) == 0u) { if (xb_ld(&bar[XB_TMO])) break; if (sp > XB_SPIN_CAP) { atomicAdd(&bar[XB_TMO], 1u); break; } }
    }
    nloc = mine > 0u ? mine : 1u; nx = cnt > 0u ? cnt : 1u;
}

__device__ __forceinline__ void xcd_barrier(const XcdBarrier& b) {
    asm volatile("s_waitcnt vmcnt(0)" ::: "memory");
    __syncthreads();
    if (threadIdx.x == 0) {
        unsigned* bar = b.bar;
        __builtin_amdgcn_s_waitcnt(0);
        unsigned nloc = b.st[0], nx = b.st[1];
        if (nloc == 0u) { xcd_barrier_complete(bar, b.x, nloc, nx); b.st[0] = nloc; b.st[1] = nx; }
        const unsigned old = xb_add(&bar[XB_XSUB(b.x)], 1u);
        const unsigned gen = old / nloc;
        if (old + 1u == (gen + 1u) * nloc) {
            __builtin_amdgcn_fence(__ATOMIC_RELEASE, "agent");
            asm volatile("s_waitcnt vmcnt(0)" ::: "memory");
            const unsigned og = xb_add(&bar[XB_TOP], 1u);
            const unsigned tg = og / nx;
            if (og + 1u == (tg + 1u) * nx) xb_add(&bar[XB_TOPGEN], 1u);
            else XB_SPIN(xb_ld(&bar[XB_TOPGEN]) == tg, bar);
            __builtin_amdgcn_fence(__ATOMIC_ACQUIRE, "agent");
            xb_add(&bar[XB_XGEN(b.x)], 1u);
            asm volatile("s_waitcnt vmcnt(0)" ::: "memory");
        } else {
            XB_SPIN(xb_ld(&bar[XB_XGEN(b.x)]) == gen, bar);
            __builtin_amdgcn_fence(__ATOMIC_ACQUIRE, "agent");
            asm volatile("s_waitcnt vmcnt(0)" ::: "memory");
        }
    }
    __syncthreads();
}

enum { I_XP = 0, I_XS, I_CP, I_CS, I_CKC, I_CKS, I_SKW, I_SWKV, I_SSH, I_PT, I_WADA, I_BADA, I_LNG, I_LNB, I_WG, I_WU, I_WD, I_WIN, I_BIN, I_MU, I_W0, I_W2, I_A0, I_A2, I_G2,
       I_KK, I_KA, I_RK, I_LNW, I_LNBB, I_PE, I_PW1, I_PW2, I_WOA, I_WOB, I_WOO, N_IN };
struct Args { const float* in[N_IN]; float* out; unsigned char* ws; int ph_lo, ph_hi; };
#define WSF(off) ((float*)(a.ws + (off)))
#define WSB(off) ((bf16*)(a.ws + (off)))

DI void tr_item(const float* __restrict__ W, int ldw, int ncols, int k0, int n0, bf16* WT, int ldo, int dr0, LAS float* scr, int lane) {
#pragma unroll 8
    for (int i = 0; i < 32; ++i) { const int kk = 2 * i + (lane >> 5), col = n0 + (lane & 31); scr[kk * 33 + (lane & 31)] = col < ncols ? W[(size_t)(k0 + kk) * ldw + col] : 0.f; }
    LDS_WAIT(); asm volatile("" ::: "memory");
    const int c = lane & 7;
#pragma unroll
    for (int j = 0; j < 4; ++j) { const int n = (lane >> 3) + 8 * j; const LAS float* s = scr + (8 * c) * 33 + n;
        v4u o; o.x = pk2(s[0 * 33], s[1 * 33]); o.y = pk2(s[2 * 33], s[3 * 33]); o.z = pk2(s[4 * 33], s[5 * 33]); o.w = pk2(s[6 * 33], s[7 * 33]);
        *(v4u*)(WT + (size_t)(dr0 + n) * ldo + k0 + 8 * c) = o; }
    LDS_WAIT(); asm volatile("" ::: "memory");
}
DI void mod_gemv_item(const Args& a, LAS unsigned char* lds, int tid, int lane, int wave, int item) {
    LAS float* S = (LAS float*)lds;
    const float* wada = a.in[I_WADA];
    float acc[36];
#pragma unroll
    for (int i = 0; i < 36; ++i) acc[i] = 0.f;
    const int col = item * 64 + lane;
    for (int kh = 0; kh < 2; ++kh) {
        __syncthreads();
        for (int e = tid; e < 36 * 512; e += 512) { const int bbv = e >> 9, kk = e & 511;
            const float c = bbv < 4 ? a.in[I_CP][bbv * D + kh * 512 + kk] : a.in[I_CS][(bbv - 4) * D + kh * 512 + kk];
            S[kk * 36 + bbv] = c / (1.0f + __expf(-c)); }
        __syncthreads();
        for (int kk = wave * 64; kk < wave * 64 + 64; ++kk) {
            const float wv = wada[(size_t)(kh * 512 + kk) * 9216 + col];
            const LAS f32x4* sp = (const LAS f32x4*)(S + kk * 36);
#pragma unroll
            for (int q = 0; q < 9; ++q) { const f32x4 s = sp[q]; acc[4 * q] += s[0] * wv; acc[4 * q + 1] += s[1] * wv; acc[4 * q + 2] += s[2] * wv; acc[4 * q + 3] += s[3] * wv; }
        }
    }
    __syncthreads();
    LAS float* P = (LAS float*)lds;
#pragma unroll
    for (int i = 0; i < 36; ++i) P[(wave * 36 + i) * 64 + lane] = acc[i];
    __syncthreads();
    float* MOD = WSF(WS_MOD);
    for (int o = tid; o < 36 * 64; o += 512) { const int bbv = o >> 6, l = o & 63; float s = 0.f;
#pragma unroll
        for (int w = 0; w < 8; ++w) s += P[(w * 36 + bbv) * 64 + l];
        const int cc = item * 64 + l; MOD[(size_t)bbv * 9216 + cc] = s + a.in[I_BADA][cc]; }
    __syncthreads();
}
DI void pet_item(const Args& a, LAS unsigned char* lds, int tid, int lane, int wave, int item) {
    const int kv = item >> 1, e = (item & 1) * 64 + lane;
    const float* pe = a.in[I_PE] + kv * 2048; const float* w1 = a.in[I_PW1] + (size_t)kv * 2048 * 128;
    float acc = 0.f;
    for (int k = wave * 256; k < wave * 256 + 256; ++k) acc += pe[k] * w1[(size_t)k * 128 + e];
    LAS float* P = (LAS float*)lds;
    __syncthreads();
    P[wave * 64 + lane] = acc;
    __syncthreads();
    if (tid < 64) { float s = 0.f;
#pragma unroll
        for (int w = 0; w < 8; ++w) s += P[w * 64 + tid];
        WSF(WS_PET)[kv * 128 + (item & 1) * 64 + tid] = s; }
    __syncthreads();
}
DI void ph_prologue(const Args& a, LAS unsigned char* lds, int tid, int lane, int wave, int G, int bx) {
    for (int it = bx; it < 148; it += G) { if (it < 144) mod_gemv_item(a, lds, tid, lane, wave, it); else pet_item(a, lds, tid, lane, wave, it - 144); }
    __syncthreads();
    LAS float* scr = (LAS float*)(lds + wave * 16384);
    const int gw = wave * G + bx, NGW = G * NWAVES;
    constexpr int I_GU = 16 * 88, I_DN = 44 * 32, I_IN = 16 * 168, I_OAB = 8 * 32, I_O = 16 * 32, I_C1 = 16 * 4, I_CONV = NBS * NCH_S, I_WCP = 1016, I_ZERO = 128;
    constexpr int NITEMS = 4 * I_GU + 2 * I_DN + I_IN + 2 * I_OAB + I_O + 4 * I_C1 + I_CONV + I_WCP + I_ZERO;
    for (int it = gw; it < NITEMS; it += NGW) {
        int r = it;
        if (r < 4 * I_GU) { const int which = r / I_GU, l = which & 1, up = which >> 1; r %= I_GU; const int kb = r / 88, nb = r % 88, n0 = nb * 32;
            tr_item((up ? a.in[I_WU] : a.in[I_WG]) + (size_t)l * D * FF, FF, FF, kb * 64, n0, WSB(WS_WGU) + (size_t)l * 5632 * D, D, (n0 >> 7) * 256 + up * 128 + (n0 & 127), scr, lane); continue; } r -= 4 * I_GU;
        if (r < 2 * I_DN) { const int l = r / I_DN; r %= I_DN; const int kb = r / 32, nb = r % 32;
            tr_item(a.in[I_WD] + (size_t)l * FF * D, D, D, kb * 64, nb * 32, WSB(WS_WDN) + (size_t)l * D * FF, FF, nb * 32, scr, lane); continue; } r -= 2 * I_DN;
        if (r < I_IN) { const int kb = r / 168, nb = r % 168; tr_item(a.in[I_WIN], NIN, NIN, kb * 64, nb * 32, WSB(WS_WIN), D, nb * 32, scr, lane); continue; } r -= I_IN;
        if (r < 2 * I_OAB) { const int w = r / I_OAB; r %= I_OAB; const int kb = r / 32, nb = r % 32;
            tr_item(w ? a.in[I_WOB] : a.in[I_WOA], D, D, kb * 64, nb * 32, WSB(WS_WOAB), 512, w * 1024 + nb * 32, scr, lane); continue; } r -= 2 * I_OAB;
        if (r < I_O) { const int kb = r / 32, nb = r % 32; tr_item(a.in[I_WOO], D, D, kb * 64, nb * 32, WSB(WS_WO), D, nb * 32, scr, lane); continue; } r -= I_O;
        if (r < 4 * I_C1) { const int mat = r / I_C1; r %= I_C1; const int kb = r / 4, nb = r % 4;
            tr_item(a.in[I_PW1] + (size_t)mat * 1024 * 128, 128, 128, kb * 64, nb * 32, WSB(WS_WC1), 1024, mat * 128 + nb * 32, scr, lane); continue; } r -= 4 * I_C1;
        if (r < I_CONV) {
            const int b = r >> 10, c = r & 1023; const int page = ((const int*)a.in[I_PT])[b * 128 + (c >> 3)];
            const float* src = a.in[I_CKC] + ((size_t)page * 128 + (c & 7) * 16) * 256 + lane * 4;
            const int kv = lane >> 5, g = (lane >> 4) & 1, d = (lane & 15) * 4;
            bf16* dst = WSB(WS_ACMP) + ((size_t)kv * CROWS + (size_t)(b * NCH_S + c) * 2 + g) * 1024 + d;
#pragma unroll 4
            for (int j = 0; j < 16; ++j) { const f32x4 v = *(const f32x4*)(src + j * 256); v2u o; o.x = pk2(v[0], v[1]); o.y = pk2(v[2], v[3]); *(v2u*)(dst + j * 64) = o; }
            continue; } r -= I_CONV;
        if (r < I_WCP) {
#pragma unroll 4
            for (int i = 0; i < 16; ++i) { const int f = r * 1024 + i * 64 + lane; const int b = f / 32512, i4 = f % 32512;
                *(f32x4*)(a.out + O_KVW_S + (size_t)b * 131072 + (size_t)i4 * 4) = *(const f32x4*)(a.in[I_SKW] + (size_t)b * 131072 + 1024 + (size_t)i4 * 4); }
            continue; } r -= I_WCP;
        { v4u z = {0u, 0u, 0u, 0u}; unsigned char* p = a.ws + WS_KCP + (size_t)r * 4096 + lane * 64;
#pragma unroll
          for (int i = 0; i < 4; ++i) *(v4u*)(p + 16 * i) = z; }
    }
}
DI void ph_u1(const Args& a, int lane, int wave, int G, int bx) {
    const int gw = wave * G + bx, NGW = G * NWAVES; const float* MOD = WSF(WS_MOD); bf16* U = WSB(WS_U);
    for (int row = gw; row < MA; row += NGW) {
        const float* xr = row < MP ? a.in[I_XP] + (size_t)row * D : a.in[I_XS] + (size_t)(row - MP) * D;
        const float* ms = MOD + (size_t)(bb_of_row(row) * 9) * D;
#pragma unroll
        for (int j = 0; j < 4; ++j) { const int col = lane * 4 + 256 * j;
            f32x4 u = {0.f, 0.f, 0.f, 0.f};
            if (row < MR) { const f32x4 x = *(const f32x4*)(xr + col); u = x * (1.0f + *(const f32x4*)(ms + D + col)) + *(const f32x4*)(ms + col); }
            v2u o; o.x = pk2(u[0], u[1]); o.y = pk2(u[2], u[3]); *(v2u*)(U + (size_t)row * D + col) = o; }
    }
}
template <int WHICH> DI void ph_ln(const Args& a, int lane, int wave, int G, int bx) {
    const int gw = wave * G + bx, NGW = G * NWAVES; const float* MOD = WSF(WS_MOD); const float* Z = WSF(WS_Z); bf16* U = WSB(WS_U);
    float* XN = WHICH == 0 ? WSF(WS_X1) : (WHICH == 1 ? WSF(WS_X2) : a.out);
    const float* lg = a.in[I_LNG] + WHICH * D; const float* lb = a.in[I_LNB] + WHICH * D;
    for (int row = gw; row < MA; row += NGW) {
        if (WHICH == 2 && row >= MR) break;
        f32x4 v[4]; float s = 0.f;
#pragma unroll
        for (int j = 0; j < 4; ++j) { v[j] = *(const f32x4*)(Z + (size_t)row * D + lane * 4 + 256 * j); s += (v[j][0] + v[j][1]) + (v[j][2] + v[j][3]); }
        const float mean = wave_sum(s) * (1.0f / D); float s2 = 0.f;
#pragma unroll
        for (int j = 0; j < 4; ++j) { v[j] = v[j] - mean; s2 += (v[j][0] * v[j][0] + v[j][1] * v[j][1]) + (v[j][2] * v[j][2] + v[j][3] * v[j][3]); }
        const float rstd = 1.0f / sqrtf(wave_sum(s2) * (1.0f / D) + LN_EPS);
        const float* ms = MOD + (size_t)(bb_of_row(row) * 9 + 3 * WHICH + 3) * D;
#pragma unroll
        for (int j = 0; j < 4; ++j) { const int col = lane * 4 + 256 * j;
            const f32x4 x = v[j] * rstd * *(const f32x4*)(lg + col) + *(const f32x4*)(lb + col);
            *(f32x4*)(XN + (size_t)row * D + col) = x;
            if (WHICH < 2) { const f32x4 u = x * (1.0f + *(const f32x4*)(ms + D + col)) + *(const f32x4*)(ms + col);
                v2u o; o.x = pk2(u[0], u[1]); o.y = pk2(u[2], u[3]); *(v2u*)(U + (size_t)row * D + col) = o; } }
    }
}

DI float proj_prev(const Args& a, const float* PROJ, int row, int col) {
    if (row < MP) return (row & (T - 1)) ? PROJ[(size_t)(row - 1) * NINP + col] : 0.f;
    const int s = row - MP; return (s & 3) ? PROJ[(size_t)(row - 1) * NINP + col] : a.in[I_SSH][(size_t)(s >> 2) * C_Q + col];
}
DI void ph_dist_rwprep(const Args& a, LAS unsigned char* lds, int tid, int lane, int wave, int G, int bx) {
    const float* PROJ = WSF(WS_PROJ);
    LAS float* vt = (LAS float*)lds;
    LAS float* L = (LAS float*)(lds + 36864);
    for (int it = bx; it < MR / 32; it += G) {
        const int r0 = it * 32;
        __syncthreads();
        {
            const int rr = tid >> 4, seg = tid & 15, row = r0 + rr;
            const float* pr = PROJ + (size_t)row * NINP + C_KV;
            if (row < MP) {
                const int b = row >> 12, t = row & (T - 1);
#pragma unroll
                for (int i = 0; i < 12; ++i) { const int col = 4 * (seg + 16 * i), br = col >> 8, within = col & 255, kv = within >> 7, g = (within >> 6) & 1, d = within & 63;
                    const f32x4 v = *(const f32x4*)(pr + col); v2u pk; pk.x = pk2(v[0], v[1]); pk.y = pk2(v[2], v[3]);
                    if (br == 0) { *(f32x4*)(a.out + O_KVC_P + (size_t)row * 256 + within) = v;
                        *(v2u*)(WSB(WS_ACMP) + ((size_t)kv * CROWS + CROWS_S + (size_t)(b * NCH_P + (t >> 4)) * 2 + g) * 1024 + (t & 15) * 64 + d) = pk; }
                    else { if (br == 1) *(f32x4*)(a.out + O_KVS_P + (size_t)row * 256 + within) = v;
                           else if (t >= T - 512) *(f32x4*)(a.out + O_KVW_P + ((size_t)b * 512 + (t - (T - 512))) * 256 + within) = v;
                           if (kv == 0) *(v2u*)(WSB(br == 1 ? WS_KSEL : WS_KWIN) + ((size_t)(b * 2 + g) * T + t) * 64 + d) = pk;
                           else { LAS float* q = vt + ((br - 1) * 32 + rr) * 132 + g * 64 + d; q[0] = v[0]; q[1] = v[1]; q[2] = v[2]; q[3] = v[3]; } }
                }
                if (t == T - 1) { const float* ps = PROJ + (size_t)row * NINP;
#pragma unroll 4
                    for (int i = 0; i < 28; ++i) *(f32x4*)(a.out + O_SH_P + (size_t)b * C_Q + 4 * (seg + 16 * i)) = *(const f32x4*)(ps + 4 * (seg + 16 * i)); }
            } else {
                const int s = row - MP, b = s >> 2, tq = s & 3;
#pragma unroll
                for (int i = 0; i < 12; ++i) { const int col = 4 * (seg + 16 * i), br = col >> 8, within = col & 255;
                    const f32x4 v = *(const f32x4*)(pr + col);
                    if (br == 0) *(f32x4*)(a.out + O_KVC_S + (size_t)s * 256 + within) = v;
                    else if (br == 1) *(f32x4*)(a.out + O_KVS_S + (size_t)s * 256 + within) = v;
                    else *(f32x4*)(a.out + O_KVW_S + ((size_t)b * 512 + 508 + tq) * 256 + within) = v; }
                if (tq == 3) { const float* ps = PROJ + (size_t)row * NINP;
#pragma unroll 4
                    for (int i = 0; i < 28; ++i) *(f32x4*)(a.out + O_SH_S + (size_t)b * C_Q + 4 * (seg + 16 * i)) = *(const f32x4*)(ps + 4 * (seg + 16 * i)); }
            }
        }
#pragma unroll 4
        for (int i = 0; i < 16; ++i) { const int e = tid + 512 * i, tt = e >> 8, k = e & 255, row = r0 + tt, col = 1536 + k;
            const float p = PROJ[(size_t)row * NINP + col], pp = proj_prev(a, PROJ, row, col); const float xs = p + (pp - p) * a.in[I_MU][col];
            L[k * 36 + tt] = k < 64 ? tanhf(xs) : (k < 128 ? xs : sigmoidf_(xs)); }
        __syncthreads();
        if (r0 < MP) {
            const int gd = tid >> 2, tc = tid & 3, g = gd >> 6, d = gd & 63, b = r0 >> 12, t0 = r0 & (T - 1);
#pragma unroll
            for (int br = 0; br < 2; ++br) { const LAS float* q = vt + (br * 32 + tc * 8) * 132 + gd;
                v4u o; o.x = pk2(q[0], q[132]); o.y = pk2(q[2 * 132], q[3 * 132]); o.z = pk2(q[4 * 132], q[5 * 132]); o.w = pk2(q[6 * 132], q[7 * 132]);
                *(v4u*)(WSB(br == 0 ? WS_VTSEL : WS_VTWIN) + ((size_t)(b * 2 + g) * 64 + d) * T + t0 + tc * 8) = o; }
        }
        {
            const int c = tid;
            float aw[32], aa[32], ag[32];
#pragma unroll
            for (int i = 0; i < 32; ++i) { aw[i] = 0.f; aa[i] = 0.f; ag[i] = 0.f; }
            const float* w2 = a.in[I_W2] + c; const float* a2 = a.in[I_A2] + c; const float* g2 = a.in[I_G2] + c;
            for (int k = 0; k < 64; ++k) { const float w = w2[k * RWW], av = a2[k * RWW];
#pragma unroll
                for (int q = 0; q < 8; ++q) { const f32x4 s = *(const LAS f32x4*)(L + k * 36 + 4 * q), s2 = *(const LAS f32x4*)(L + (64 + k) * 36 + 4 * q);
#pragma unroll
                    for (int e = 0; e < 4; ++e) { aw[4 * q + e] += s[e] * w; aa[4 * q + e] += s2[e] * av; } } }
            for (int k = 0; k < 128; ++k) { const float w = g2[k * RWW];
#pragma unroll
                for (int q = 0; q < 8; ++q) { const f32x4 s = *(const LAS f32x4*)(L + (128 + k) * 36 + 4 * q);
#pragma unroll
                    for (int e = 0; e < 4; ++e) ag[4 * q + e] += s[e] * w; } }
            const float mu_r = a.in[I_MU][c], mu_k = a.in[I_MU][512 + c], mu_v = a.in[I_MU][1024 + c];
            const float w0 = a.in[I_W0][c], a0 = a.in[I_A0][c], kkc = a.in[I_KK][c], kac = a.in[I_KA][c], rkc = a.in[I_RK][c];
            float* RW = WSF(WS_RW);
#pragma unroll
            for (int tt = 0; tt < 32; ++tt) { const int row = r0 + tt; const float* pr = PROJ + (size_t)row * NINP;
                float pr_ = pr[c], pk_ = pr[512 + c], pv_ = pr[1024 + c];
                const float r = pr_ + (proj_prev(a, PROJ, row, c) - pr_) * mu_r, k = pk_ + (proj_prev(a, PROJ, row, 512 + c) - pk_) * mu_k, v = pv_ + (proj_prev(a, PROJ, row, 1024 + c) - pv_) * mu_v;
                const float z = -(w0 + aw[tt]);
                const float sp = fmaxf(z, 0.f) + log1pf(__expf(-fabsf(z)));
                const float decay = __expf(-__expf(-sp - 0.5f));
                const float av = sigmoidf_(a0 + aa[tt]);
                float kk = k * kkc; const float ss = wave_sum(kk * kk); kk *= rsqrtf(fmaxf(ss, 1e-24f));
                const float k2 = k * (1.0f + (av - 1.0f) * kac);
                const float rk = wave_sum(r * k2 * rkc);
                const size_t o = (size_t)row * RWW + c;
                RW[o] = r; RW[RW_STRIDE + o] = decay; RW[2 * RW_STRIDE + o] = k2; RW[3 * RW_STRIDE + o] = v; RW[4 * RW_STRIDE + o] = kk; RW[5 * RW_STRIDE + o] = kk * av;
                WSF(WS_G)[o] = ag[tt]; WSF(WS_BON)[o] = rk * v; }
        }
    }
}

struct StepD { f32x4 r, w, k, kk, b; float v; };
DI void scan_run(const float* RW, float* Y, int rowbase, int nsteps, int h, int i, int lane, const float* s_in, float* s_out) {
    const int j0 = (lane & 15) * 4; const size_t cofs = (size_t)h * 64 + j0, vofs = (size_t)h * 64 + i;
    f32x4 S = s_in ? *(const f32x4*)(s_in + i * 64 + j0) : (f32x4){0.f, 0.f, 0.f, 0.f};
#define SC_LD(sd, t) { const size_t o_ = (size_t)(rowbase + (t)) * RWW; sd.r = *(const f32x4*)(RW + o_ + cofs); sd.w = *(const f32x4*)(RW + RW_STRIDE + o_ + cofs); sd.k = *(const f32x4*)(RW + 2 * RW_STRIDE + o_ + cofs); \
        sd.v = RW[3 * RW_STRIDE + o_ + vofs]; sd.kk = *(const f32x4*)(RW + 4 * RW_STRIDE + o_ + cofs); sd.b = *(const f32x4*)(RW + 5 * RW_STRIDE + o_ + cofs); }
#define SC_DO(sd, t) { float d_ = (S[0] * sd.kk[0] + S[1] * sd.kk[1]) + (S[2] * sd.kk[2] + S[3] * sd.kk[3]); d_ = row16_sum(d_); const float sa_ = -d_; \
        S = S * sd.w + (sa_ * sd.b + sd.v * sd.k); float y_ = (S[0] * sd.r[0] + S[1] * sd.r[1]) + (S[2] * sd.r[2] + S[3] * sd.r[3]); y_ = row16_sum(y_); \
        if ((lane & 15) == 0) Y[(size_t)(rowbase + (t)) * RWW + vofs] = y_; }
    StepD c0, c1, c2, c3, n0, n1, n2, n3;
    SC_LD(c0, 0) SC_LD(c1, 1) SC_LD(c2, 2) SC_LD(c3, 3)
    for (int t = 0; t < nsteps; t += 4) {
        const int tn = (t + 4 < nsteps) ? t + 4 : t;
        SC_LD(n0, tn) SC_LD(n1, tn + 1) SC_LD(n2, tn + 2) SC_LD(n3, tn + 3)
        SC_DO(c0, t) SC_DO(c1, t + 1) SC_DO(c2, t + 2) SC_DO(c3, t + 3)
        c0 = n0; c1 = n1; c2 = n2; c3 = n3;
    }
#undef SC_LD
#undef SC_DO
    *(f32x4*)(s_out + i * 64 + j0) = S;
}
DI void cfinal_worker(const Args& a, int lane, int worker, int nworkers) {
    const int kv = worker & 1; const int NIT = (NBS * NCMP_S + NBP * NCMP_P) * 2;
    float w2c[128];
#pragma unroll
    for (int e = 0; e < 128; ++e) w2c[e] = a.in[I_PW2][(size_t)(kv * 128 + e) * 64 + lane];
    const float pe0 = WSF(WS_PET)[kv * 128 + lane], pe1 = WSF(WS_PET)[kv * 128 + 64 + lane];
    const float* HC = WSF(WS_HC) + (size_t)kv * CROWS * 256;
    for (int j = worker >> 1; j < NIT; j += nworkers >> 1) {
        const int g = j & 1; int q = j >> 1; int b, n, rowlo; const bool smp = q < NBS * NCMP_S;
        if (smp) { b = q / NCMP_S; n = q % NCMP_S; rowlo = (b * NCH_S + n) * 2 + g; } else { q -= NBS * NCMP_S; b = q / NCMP_P; n = q % NCMP_P; rowlo = CROWS_S + (b * NCH_P + n) * 2 + g; }
        const float* lo = HC + (size_t)rowlo * 256; const float* hi = lo + 2 * 256 + 128;
        const float h0 = gelu_tanh(lo[lane] + hi[lane] + pe0), h1 = gelu_tanh(lo[64 + lane] + hi[64 + lane] + pe1);
        float acc = 0.f;
#pragma unroll
        for (int e = 0; e < 64; ++e) acc += __builtin_bit_cast(float, __builtin_amdgcn_readlane(__builtin_bit_cast(int, h0), e)) * w2c[e];
#pragma unroll
        for (int e = 0; e < 64; ++e) acc += __builtin_bit_cast(float, __builtin_amdgcn_readlane(__builtin_bit_cast(int, h1), e)) * w2c[64 + e];
        if (smp) WSF(WS_KCS)[(size_t)kv * KCS_STRIDE + ((size_t)(b * NCMP_S + n) * 2 + g) * 64 + lane] = acc;
        else if (kv == 0) WSB(WS_KCP)[((size_t)(b * 2 + g) * 256 + n) * 64 + lane] = (bf16)f2bf(acc);
        else WSB(WS_VCTP)[((size_t)(b * 2 + g) * 64 + lane) * 256 + n] = (bf16)f2bf(acc);
    }
}
DI void ph_cfinal_sscan(const Args& a, int lane, int wave, int G, int bx) {
    const float* RW = WSF(WS_RW); float* Y = WSF(WS_YS);
    const int worker = wave * G + bx, nworkers = NWAVES * G;
    for (int si = worker; si < 4096; si += nworkers) { const int bh = si >> 4, rg = si & 15, b = bh >> 3, h = bh & 7, i = rg * 4 + (lane >> 4);
        scan_run(RW, Y, MP + b * 4, 4, h, i, lane, a.in[I_SWKV] + (size_t)bh * 4096, a.out + O_WKV_S + (size_t)bh * 4096); }
    cfinal_worker(a, lane, worker, nworkers);
}
constexpr int SCH = 32, SCHF = SCH * 384;
DI void ph_scan_prompt(const Args& a, LAS unsigned char* lds, int tid, int lane, int wave, int G, int bx) {
    const float* RW = WSF(WS_RW); float* Y = WSF(WS_YS);
    LAS float* buf = (LAS float*)lds;
    constexpr int NCH = T / SCH;
    for (int it = bx; it < 256; it += G) {
        const int bh = it >> 3, b = bh >> 3, h = bh & 7, rowbase = b * T;
        __syncthreads();
        if (wave >= 2) {
            const int lt = tid - 128;
            f32x4 ra[8], rb[8];
#define LD_CHUNK(reg, c) { _Pragma("unroll") for (int q = 0; q < 8; ++q) { const int f = lt + 384 * q, aa = f >> 9, rem = f & 511, t_ = rem >> 4, c4 = rem & 15; \
                reg[q] = *(const f32x4*)(RW + (size_t)aa * RW_STRIDE + (size_t)(rowbase + (c) * SCH + t_) * RWW + h * 64 + c4 * 4); } }
#define ST_CHUNK(reg, c) { _Pragma("unroll") for (int q = 0; q < 8; ++q) { const int f = lt + 384 * q, aa = f >> 9, rem = f & 511, t_ = rem >> 4, c4 = rem & 15; \
                *(LAS f32x4*)(buf + ((c) & 1) * SCHF + (t_ * 6 + aa) * 64 + c4 * 4) = reg[q]; } }
            LD_CHUNK(ra, 0) ST_CHUNK(ra, 0)
            LD_CHUNK(rb, 1) LD_CHUNK(ra, 2)
            __syncthreads();
            for (int c = 0; c < NCH; c += 2) {
                ST_CHUNK(rb, c + 1) if (c + 3 < NCH) LD_CHUNK(rb, c + 3)
                __syncthreads();
                if (c + 2 < NCH) ST_CHUNK(ra, c + 2) if (c + 4 < NCH) LD_CHUNK(ra, c + 4)
                __syncthreads();
            }
#undef LD_CHUNK
#undef ST_CHUNK
        } else {
            const int rg = (it & 7) * 2 + wave, i = rg * 4 + (lane >> 4), j0 = (lane & 15) * 4, k16 = lane & 15; const size_t vofs = (size_t)h * 64 + i;
            f32x4 S = {0.f, 0.f, 0.f, 0.f}, rp = {0.f, 0.f, 0.f, 0.f}; float ysel = 0.f;
#define RED2(x_, y_) x_ += dpp_f<0x128>(x_); y_ += dpp_f<0x128>(y_); x_ += dpp_f<0x124>(x_); y_ += dpp_f<0x124>(y_); x_ += dpp_f<0x122>(x_); y_ += dpp_f<0x122>(y_); x_ += dpp_f<0x121>(x_); y_ += dpp_f<0x121>(y_);
            __syncthreads();
            for (int c = 0; c < NCH; ++c) {
                const LAS float* cb = buf + (c & 1) * SCHF; const int tb = c * SCH;
                StepD q0, q1, q2;
#define L_LD(sd, t) { const LAS float* p_ = cb + (t) * 384; sd.r = *(const LAS f32x4*)(p_ + j0); sd.w = *(const LAS f32x4*)(p_ + 64 + j0); sd.k = *(const LAS f32x4*)(p_ + 128 + j0); sd.v = p_[192 + i]; \
                sd.kk = *(const LAS f32x4*)(p_ + 256 + j0); sd.b = *(const LAS f32x4*)(p_ + 320 + j0); }
                L_LD(q0, 0) L_LD(q1, 1)
#pragma unroll
                for (int t = 0; t < SCH; ++t) {
                    if (t + 2 < SCH) L_LD(q2, t + 2)
                    __builtin_amdgcn_sched_barrier(0);
                    float pd = __builtin_fmaf(S[3], q0.kk[3], __builtin_fmaf(S[2], q0.kk[2], __builtin_fmaf(S[1], q0.kk[1], S[0] * q0.kk[0])));
                    float py = __builtin_fmaf(S[3], rp[3], __builtin_fmaf(S[2], rp[2], __builtin_fmaf(S[1], rp[1], S[0] * rp[0])));
                    RED2(pd, py)
                    ysel = (k16 == ((t + 15) & 15)) ? py : ysel;
                    if ((t & 15) == 0 && (t > 0 || c > 0)) Y[(size_t)(rowbase + tb + t - 16 + k16) * RWW + vofs] = ysel;
                    S = S * q0.w + (q0.v * q0.k - pd * q0.b);
                    rp = q0.r;
                    q0 = q1; q1 = q2;
                    __builtin_amdgcn_sched_barrier(0);
                }
#undef L_LD
                __syncthreads();
            }
            { float pd = 0.f, py = (S[0] * rp[0] + S[1] * rp[1]) + (S[2] * rp[2] + S[3] * rp[3]); RED2(pd, py) ysel = (k16 == 15) ? py : ysel; Y[(size_t)(rowbase + T - 16 + k16) * RWW + vofs] = ysel; }
#undef RED2
            *(f32x4*)(a.out + O_WKV_P + (size_t)bh * 4096 + i * 64 + j0) = S;
        }
    }
}

#define MFMA32(a_, b_, c_) __builtin_amdgcn_mfma_f32_32x32x16_bf16((a_), (b_), (c_), 0, 0, 0)
DI int crow(int i, int hh) { return (i & 3) + 8 * (i >> 2) + 4 * hh; }
DI bf16x8 pack8(const f32x4& x0, const f32x4& x1) { v4u p; p.x = pk2(x0[0], x0[1]); p.y = pk2(x0[2], x0[3]); p.z = pk2(x1[0], x1[1]); p.w = pk2(x1[2], x1[3]); return __builtin_bit_cast(bf16x8, p); }
DI f32x16 zero16() { f32x16 z;
#pragma unroll
    for (int i = 0; i < 16; ++i) z[i] = 0.f; return z; }
DI f32x16 qk_tile(const bf16* Kp, const bf16x8 (&qf)[4], int lane) {
    const bf16* kr = Kp + (size_t)(lane & 31) * 64 + 8 * (lane >> 5);
    f32x16 p = zero16();
#pragma unroll
    for (int s = 0; s < 4; ++s) { const bf16x8 kf = *(const bf16x8*)(kr + 16 * s); p = MFMA32(kf, qf[s], p); }
    return p;
}
DI void pack_p(const f32x16& P, bf16x8 (&pf)[2]) {
#pragma unroll
    for (int s = 0; s < 2; ++s) { v4u w; w.x = pk2(P[8 * s], P[8 * s + 1]); w.y = pk2(P[8 * s + 2], P[8 * s + 3]); w.z = pk2(P[8 * s + 4], P[8 * s + 5]); w.w = pk2(P[8 * s + 6], P[8 * s + 7]); pf[s] = __builtin_bit_cast(bf16x8, w); }
}
DI void pv_tile(f32x16 (&o)[2], const bf16* Vt, int ldv, const bf16x8 (&pf)[2], int lane) {
    const int hh = lane >> 5;
#pragma unroll
    for (int s = 0; s < 2; ++s)
#pragma unroll
        for (int db = 0; db < 2; ++db) { const bf16* vr = Vt + (size_t)((lane & 31) + 32 * db) * ldv + 16 * s + 4 * hh;
            const s16x4 lo = *(const s16x4*)vr, hi = *(const s16x4*)(vr + 8);
            const bf16x8 vf = __builtin_shufflevector(lo, hi, 0, 1, 2, 3, 4, 5, 6, 7);
            o[db] = MFMA32(vf, pf[s], o[db]); }
}
DI void osm_step(f32x16& p, unsigned okm, float& m, float& l, f32x16 (&o)[2]) {
    float mx = NEGF;
#pragma unroll
    for (int i = 0; i < 16; ++i) mx = ((okm >> i) & 1u) ? fmaxf(mx, p[i]) : mx;
    mx = fmaxf(mx, __shfl_xor(mx, 32));
    const float mn = fmaxf(m, mx), al = __builtin_amdgcn_exp2f(m - mn);
    l *= al; o[0] = o[0] * al; o[1] = o[1] * al;
#pragma unroll
    for (int i = 0; i < 16; ++i) { const float e = ((okm >> i) & 1u) ? __builtin_amdgcn_exp2f(p[i] - mn) : 0.f; p[i] = e; l += e; }
    m = mn;
}
constexpr int IMP_LD = 65;
constexpr int SMASK_OFF = 2 * 4 * 32 * IMP_LD * 4;
constexpr int SATT_OFF = 69632;
DI void attn_prompt_unit(const Args& a, LAS unsigned char* lds, int lane, int wave, int b, int g, int tile) {
    const float* PROJ = WSF(WS_PROJ);
    const int hl = wave & 3, qh = wave >> 2, head = g * 4 + hl, q0 = tile * 64 + qh * 32, r = lane & 31, hh = lane >> 5, t = q0 + r, bg = b * 2 + g;
    const float* prow = PROJ + (size_t)(b * T + t) * NINP;
    bf16x8 qf[4];
    { const float qs = 0.125f * LOG2E;
#pragma unroll
      for (int s = 0; s < 4; ++s) { const float* qp = prow + C_Q + head * 64 + 16 * s + 8 * hh; qf[s] = pack8(*(const f32x4*)qp * qs, *(const f32x4*)(qp + 4) * qs); } }
    const float g0 = sigmoidf_(prow[C_GATE + head * 3]), g1 = sigmoidf_(prow[C_GATE + head * 3 + 1]), g2 = sigmoidf_(prow[C_GATE + head * 3 + 2]);
    f32x16 of[2]; of[0] = zero16(); of[1] = zero16();
    LAS float* sImp = (LAS float*)lds; LAS unsigned long long* sMask = (LAS unsigned long long*)(lds + SMASK_OFF);
    {
        const bf16* Kc = WSB(WS_KCP) + (size_t)bg * 256 * 64; const bf16* Vct = WSB(WS_VCTP) + (size_t)bg * 64 * 256;
        const int tmax = q0 + 31, nvis = tmax >= 31 ? (tmax - 31) / 16 + 1 : 0, ntile = (nvis + 31) >> 5;
        float m = NEGF, l = 0.f;
        for (int kt = 0; kt < ntile; ++kt) {
            const f32x16 p = qk_tile(Kc + (size_t)kt * 32 * 64, qf, lane);
            float mx = NEGF;
#pragma unroll
            for (int i = 0; i < 16; ++i) { const int n = kt * 32 + crow(i, hh); mx = (16 * n + 31 <= t) ? fmaxf(mx, p[i]) : mx; }
            mx = fmaxf(mx, __shfl_xor(mx, 32));
            const float mn = fmaxf(m, mx); l *= __builtin_amdgcn_exp2f(m - mn);
#pragma unroll
            for (int i = 0; i < 16; ++i) { const int n = kt * 32 + crow(i, hh); l += (16 * n + 31 <= t) ? __builtin_amdgcn_exp2f(p[i] - mn) : 0.f; }
            m = mn;
        }
        l += __shfl_xor(l, 32);
        const float inv = l > 0.f ? 1.0f / l : 0.f;
        f32x16 oc[2], im[2]; oc[0] = zero16(); oc[1] = zero16(); im[0] = zero16(); im[1] = zero16();
        for (int kt = 0; kt < ntile; ++kt) {
            f32x16 p = qk_tile(Kc + (size_t)kt * 32 * 64, qf, lane);
#pragma unroll
            for (int i = 0; i < 16; ++i) { const int n = kt * 32 + crow(i, hh); p[i] = (16 * n + 31 <= t) ? __builtin_amdgcn_exp2f(p[i] - m) * inv : 0.f; }
            bf16x8 pf[2]; pack_p(p, pf);
            pv_tile(oc, Vct + kt * 32, 256, pf, lane);
#pragma unroll
            for (int blk = 0; blk < 2; ++blk) {
                if ((blk == 0 && kt <= 3) || (blk == 1 && kt >= 3)) {
                    const int jb = r + 32 * blk;
#pragma unroll
                    for (int s = 0; s < 2; ++s) { bf16x8 af;
#pragma unroll
                        for (int j = 0; j < 8; ++j) { const int n = kt * 32 + 16 * s + 8 * (j >> 2) + 4 * hh + (j & 3); af[j] = (n >= 4 * jb - 1 && n <= 4 * jb + 3) ? (short)0x3F80 : (short)0; }
                        im[blk] = MFMA32(af, pf[s], im[blk]); }
                }
            }
        }
        of[0] = of[0] + oc[0] * g0; of[1] = of[1] + oc[1] * g0;
        LAS float* slab = sImp + (size_t)((qh * 4 + hl) * 32 + r) * IMP_LD;
#pragma unroll
        for (int blk = 0; blk < 2; ++blk)
#pragma unroll
            for (int i = 0; i < 16; ++i) slab[32 * blk + crow(i, hh)] = im[blk][i];
    }
    __syncthreads();
    for (int e = 0; e < 8; ++e) {
        const int qq = wave * 8 + e, qh2 = qq >> 5, rq = qq & 31, tq = tile * 64 + qq, cur = tq >> 6;
        float s = 0.f;
#pragma unroll
        for (int h2 = 0; h2 < 4; ++h2) s += sImp[(size_t)((qh2 * 4 + h2) * 32 + rq) * IMP_LD + lane];
        const float v = lane > cur ? -1e9f : ((lane == 0 || lane == cur || lane == cur - 1) ? 1e9f : s);
        int rank = 0;
#pragma unroll 16
        for (int j = 0; j < 64; ++j) { const float vj = __builtin_bit_cast(float, __builtin_amdgcn_readlane(__builtin_bit_cast(int, v), j)); rank += (vj > v || (vj == v && j < lane)) ? 1 : 0; }
        const unsigned long long mask = __ballot(rank < 16 && lane <= cur);
        if (lane == 0) sMask[qq] = mask;
    }
    __syncthreads();
    const unsigned long long smask = sMask[qh * 32 + r];
    {
        const bf16* Ks = WSB(WS_KSEL) + (size_t)bg * T * 64; const bf16* Vts = WSB(WS_VTSEL) + (size_t)bg * 64 * T;
        float m = NEGF, l = 0.f; f32x16 o[2]; o[0] = zero16(); o[1] = zero16();
        const int jbmax = (q0 + 31) >> 6;
        for (int jb = 0; jb <= jbmax; ++jb) {
            const bool bit = (smask >> jb) & 1ull;
            if (__ballot(bit) == 0ull) continue;
            for (int sub = 0; sub < 2; ++sub) { const int k0 = jb * 64 + sub * 32; if (k0 > q0 + 31) break;
                f32x16 p = qk_tile(Ks + (size_t)k0 * 64, qf, lane);
                unsigned okm = 0u;
#pragma unroll
                for (int i = 0; i < 16; ++i) okm |= (bit && (k0 + crow(i, hh) <= t)) ? (1u << i) : 0u;
                osm_step(p, okm, m, l, o);
                bf16x8 pf[2]; pack_p(p, pf); pv_tile(o, Vts + k0, T, pf, lane); }
        }
        l += __shfl_xor(l, 32); const float sc = l > 0.f ? g1 / l : 0.f;
        of[0] = of[0] + o[0] * sc; of[1] = of[1] + o[1] * sc;
    }
    {
        const bf16* Kw = WSB(WS_KWIN) + (size_t)bg * T * 64; const bf16* Vtw = WSB(WS_VTWIN) + (size_t)bg * 64 * T;
        float m = NEGF, l = 0.f; f32x16 o[2]; o[0] = zero16(); o[1] = zero16();
        for (int k0 = (q0 >= 512 ? q0 - 512 : 0); k0 <= q0; k0 += 32) {
            f32x16 p = qk_tile(Kw + (size_t)k0 * 64, qf, lane);
            unsigned okm = 0u;
#pragma unroll
            for (int i = 0; i < 16; ++i) { const int key = k0 + crow(i, hh); okm |= (key <= t && key > t - 512) ? (1u << i) : 0u; }
            osm_step(p, okm, m, l, o);
            bf16x8 pf[2]; pack_p(p, pf); pv_tile(o, Vtw + k0, T, pf, lane);
        }
        l += __shfl_xor(l, 32); const float sc = l > 0.f ? g2 / l : 0.f;
        of[0] = of[0] + o[0] * sc; of[1] = of[1] + o[1] * sc;
    }
    bf16* yb = WSB(WS_AST) + (size_t)(MA + b * T + t) * RWW + head * 64;
#pragma unroll
    for (int db = 0; db < 2; ++db)
#pragma unroll
        for (int gq = 0; gq < 4; ++gq) { v2u w; w.x = pk2(of[db][4 * gq], of[db][4 * gq + 1]); w.y = pk2(of[db][4 * gq + 2], of[db][4 * gq + 3]); *(v2u*)(yb + 32 * db + 8 * gq + 4 * hh) = w; }
}

DI void sa_scores(const float* Kb, int stride, int nrows, int pos0, int lo, int hi, LAS float* sc, int off, const LAS float* qv, int lane) {
    for (int base = 0; base < nrows; base += 64) {
        const int idx = base + lane; const bool inr = idx < nrows; const float* kr = Kb + (size_t)(inr ? idx : 0) * stride; const int pos = pos0 + idx;
        float s0 = 0.f, s1 = 0.f, s2 = 0.f, s3 = 0.f;
#pragma unroll 4
        for (int d4 = 0; d4 < 16; ++d4) { const f32x4 kv = *(const f32x4*)(kr + 4 * d4);
            const f32x4 q0 = *(const LAS f32x4*)(qv + 4 * d4), q1 = *(const LAS f32x4*)(qv + 64 + 4 * d4), q2 = *(const LAS f32x4*)(qv + 128 + 4 * d4), q3 = *(const LAS f32x4*)(qv + 192 + 4 * d4);
            s0 += (kv[0] * q0[0] + kv[1] * q0[1]) + (kv[2] * q0[2] + kv[3] * q0[3]); s1 += (kv[0] * q1[0] + kv[1] * q1[1]) + (kv[2] * q1[2] + kv[3] * q1[3]);
            s2 += (kv[0] * q2[0] + kv[1] * q2[1]) + (kv[2] * q2[2] + kv[3] * q2[3]); s3 += (kv[0] * q3[0] + kv[1] * q3[1]) + (kv[2] * q3[2] + kv[3] * q3[3]); }
        const bool ok = pos >= lo && pos <= hi;
        if (inr) *(LAS f32x4*)(sc + (size_t)(off + idx) * 4) = ok ? (f32x4){s0, s1, s2, s3} : (f32x4){NEGF, NEGF, NEGF, NEGF};
    }
}
DI void sa_softmax(LAS float* sc, int nk, int lane, float (&inv)[4]) {
    LDS_WAIT();
    float mx[4] = {NEGF, NEGF, NEGF, NEGF};
    for (int idx = lane; idx < nk; idx += 64) { const f32x4 v = *(const LAS f32x4*)(sc + (size_t)idx * 4);
#pragma unroll
        for (int h = 0; h < 4; ++h) mx[h] = fmaxf(mx[h], v[h]); }
#pragma unroll
    for (int h = 0; h < 4; ++h) mx[h] = wave_max(mx[h]);
    float sm[4] = {0.f, 0.f, 0.f, 0.f};
    for (int idx = lane; idx < nk; idx += 64) { const f32x4 v = *(const LAS f32x4*)(sc + (size_t)idx * 4); f32x4 e;
#pragma unroll
        for (int h = 0; h < 4; ++h) { e[h] = v[h] > -1e29f ? __expf(v[h] - mx[h]) : 0.f; sm[h] += e[h]; }
        *(LAS f32x4*)(sc + (size_t)idx * 4) = e; }
#pragma unroll
    for (int h = 0; h < 4; ++h) { sm[h] = wave_sum(sm[h]); inv[h] = 1.0f / fmaxf(sm[h], 1e-30f); }
    LDS_WAIT();
}
DI void sa_pv(const float* Vb, int stride, int nrows, const LAS float* sc, int off, int lane, float (&acc)[4]) {
#pragma unroll 8
    for (int idx = 0; idx < nrows; ++idx) { const float vv = Vb[(size_t)idx * stride + lane]; const f32x4 pp = *(const LAS f32x4*)(sc + (size_t)(off + idx) * 4);
        acc[0] += pp[0] * vv; acc[1] += pp[1] * vv; acc[2] += pp[2] * vv; acc[3] += pp[3] * vv; }
}
DI void attn_sample_item(const Args& a, LAS unsigned char* lds, int lane, int item) {
    const float* PROJ = WSF(WS_PROJ);
    const int b = item >> 3, g = (item >> 2) & 1, q = item & 3, row = MP + b * 4 + q, qpos = 16384 + q;
    const float* prow = PROJ + (size_t)row * NINP; const float* pnew = PROJ + (size_t)(MP + b * 4) * NINP + C_KV;
    LAS float* sc = (LAS float*)(lds + SATT_OFF); LAS float* qv = sc + 1040 * 4; LAS float* iv = qv + 256; LAS int* lst = (LAS int*)(iv + 264);
#pragma unroll
    for (int h = 0; h < 4; ++h) qv[h * 64 + lane] = prow[C_Q + (g * 4 + h) * 64 + lane] * 0.125f;
    LDS_WAIT();
    float gt[4][3];
#pragma unroll
    for (int h = 0; h < 4; ++h)
#pragma unroll
        for (int br = 0; br < 3; ++br) gt[h][br] = sigmoidf_(prow[C_GATE + (g * 4 + h) * 3 + br]);
    float of[4] = {0.f, 0.f, 0.f, 0.f};
    float inv[4];
    {
        const float* Kb = WSF(WS_KCS) + ((size_t)b * NCMP_S * 2 + g) * 64; const float* Vb = Kb + KCS_STRIDE;
        sa_scores(Kb, 128, NCMP_S, 0, -1, 1 << 30, sc, 0, qv, lane);
        sa_softmax(sc, NCMP_S, lane, inv);
        float acc[4] = {0.f, 0.f, 0.f, 0.f}; sa_pv(Vb, 128, NCMP_S, sc, 0, lane, acc);
#pragma unroll
        for (int h = 0; h < 4; ++h) of[h] += gt[h][0] * acc[h] * inv[h];
        float val[5];
#pragma unroll
        for (int i = 0; i < 5; ++i) { const int jb = lane + 64 * i; float s = 0.f;
            if (jb <= 256) { for (int n = 4 * jb - 1; n <= 4 * jb + 3; ++n) if (n >= 0 && n < NCMP_S) { const f32x4 p = *(const LAS f32x4*)(sc + (size_t)n * 4); s += (p[0] * inv[0] + p[1] * inv[1]) + (p[2] * inv[2] + p[3] * inv[3]); } }
            val[i] = (jb == 0 || jb == 255 || jb == 256) ? 1e9f : s;
            if (jb <= 256) iv[jb] = val[i]; }
        LDS_WAIT();
        int rank[5] = {0, 0, 0, 0, 0};
        for (int y = 0; y <= 256; ++y) { const float vy = iv[y];
#pragma unroll
            for (int i = 0; i < 5; ++i) { const int jb = lane + 64 * i; rank[i] += (vy > val[i] || (vy == val[i] && y < jb)) ? 1 : 0; } }
        int cnt = 0;
#pragma unroll
        for (int i = 0; i < 5; ++i) { const int jb = lane + 64 * i; const bool sel = jb <= 256 && rank[i] < 16; const unsigned long long bal = __ballot(sel);
            const int pos = cnt + __popcll(bal & ((1ull << lane) - 1ull)); if (sel) lst[pos] = jb; cnt += __popcll(bal); }
        LDS_WAIT();
    }
    {
        int nk = 0;
        for (int si = 0; si < 16; ++si) { const int blk = __builtin_amdgcn_readfirstlane(lst[si]);
            if (blk < 256) { const int page = ((const int*)a.in[I_PT])[b * 128 + (blk >> 1)]; const float* Kb = a.in[I_CKS] + ((size_t)page * 128 + (blk & 1) * 64) * 256 + g * 64;
                sa_scores(Kb, 256, 64, blk * 64, -1, qpos, sc, nk, qv, lane); nk += 64; }
            else { sa_scores(pnew + 256 + g * 64, NINP, 4, 16384, -1, qpos, sc, nk, qv, lane); nk += 4; } }
        sa_softmax(sc, nk, lane, inv);
        float acc[4] = {0.f, 0.f, 0.f, 0.f}; nk = 0;
        for (int si = 0; si < 16; ++si) { const int blk = __builtin_amdgcn_readfirstlane(lst[si]);
            if (blk < 256) { const int page = ((const int*)a.in[I_PT])[b * 128 + (blk >> 1)]; const float* Vb = a.in[I_CKS] + ((size_t)page * 128 + (blk & 1) * 64) * 256 + 128 + g * 64;
                sa_pv(Vb, 256, 64, sc, nk, lane, acc); nk += 64; }
            else { sa_pv(pnew + 256 + 128 + g * 64, NINP, 4, sc, nk, lane, acc); nk += 4; } }
#pragma unroll
        for (int h = 0; h < 4; ++h) of[h] += gt[h][1] * acc[h] * inv[h];
    }
    {
        const float* Kb = a.in[I_SKW] + (size_t)b * 512 * 256 + g * 64;
        sa_scores(Kb, 256, 512, 15872, qpos - 511, qpos, sc, 0, qv, lane);
        sa_scores(pnew + 512 + g * 64, NINP, 4, 16384, qpos - 511, qpos, sc, 512, qv, lane);
        sa_softmax(sc, 516, lane, inv);
        float acc[4] = {0.f, 0.f, 0.f, 0.f};
        sa_pv(Kb + 128, 256, 512, sc, 0, lane, acc); sa_pv(pnew + 512 + 128 + g * 64, NINP, 4, sc, 512, lane, acc);
#pragma unroll
        for (int h = 0; h < 4; ++h) of[h] += gt[h][2] * acc[h] * inv[h];
    }
    bf16* yb = WSB(WS_AST) + (size_t)(MA + row) * RWW + g * 256;
#pragma unroll
    for (int h = 0; h < 4; ++h) yb[h * 64 + lane] = (bf16)f2bf(of[h]);
}
DI void rwpost_items(const Args& a, int lane, int wave, int G, int bx) {
    const int gw = wave * G + bx, NGW = G * NWAVES;
    for (int it = gw; it < MR * 8; it += NGW) { const int row = it >> 3, c = (it & 7) * 64 + lane; const size_t o = (size_t)row * RWW + c;
        const float y = WSF(WS_YS)[o]; const float mean = wave_sum(y) * (1.0f / 64.0f); const float dlt = y - mean; const float var = wave_sum(dlt * dlt) * (1.0f / 64.0f);
        const float yn = dlt * rsqrtf(var + GN_EPS) * a.in[I_LNW][c] + a.in[I_LNBB][c];
        WSB(WS_AST)[o] = (bf16)f2bf((yn + WSF(WS_BON)[o]) * WSF(WS_G)[o]); }
}
DI void ph_attention(const Args& a, LAS unsigned char* lds, int lane, int wave, int G, int bx) {
    for (int i = 0; i < 4; ++i) {
        const int base = (i >> 1) * G, u0 = base + bx; if (u0 >= 256) break;
        const int u = (i & 1) ? 511 - u0 : u0;
        __syncthreads();
        attn_prompt_unit(a, lds, lane, wave, u >> 7, (u >> 6) & 1, u & 63);
    }
    if (wave == 0) for (int it = bx; it < 256; it += G) attn_sample_item(a, lds, lane, it);
    rwpost_items(a, lane, wave, G, bx);
}

constexpr int N_PHASES = 17;
#ifndef PROBE_MASK
#define PROBE_MASK 0
#endif
#ifndef MK_PER_PHASE
#define MK_PER_PHASE 0
#endif
__global__ void __launch_bounds__(NWAVES * 64, 2) fwd_kernel(Args a) {
    extern __shared__ __attribute__((aligned(16))) unsigned char lds_raw[];
    LAS unsigned char* lds = (LAS unsigned char*)lds_raw;
    const int tid = threadIdx.x, lane = tid & 63, wave = __builtin_amdgcn_readfirstlane(tid >> 6), G = gridDim.x, bx = blockIdx.x;
    for (int u = tid; u < (LDS_BYTES - LDSCTL_OFF) / 4; u += NWAVES * 64) ((LAS unsigned*)(lds + LDSCTL_OFF))[u] = 0u;
    __syncthreads();
    volatile LAS unsigned* MISC = (volatile LAS unsigned*)(lds + MISC_OFF);
    unsigned* ctl = (unsigned*)(a.ws + WS_CTL);
    XcdBarrier bar; bar.bar = ctl + CW_BAR; bar.x = 0; bar.st = nullptr;
    if (!MK_PER_PHASE) bar = xcd_barrier_post(ctl + CW_BAR, MISC + 8);
    const int lo = a.ph_lo, hi = a.ph_hi;
#define IN(k) (lo <= (k) && (k) < hi)
#define SEAM(k) do { if (IN(k) && IN((k) + 1)) xcd_barrier(bar); } while (0)
#define RUN(k, ...) do { if (IN(k)) { __VA_ARGS__ if ((PROBE_MASK >> (k)) & 1) { xcd_barrier(bar); __VA_ARGS__ } } } while (0)
    LAS unsigned char* ring = lds + RING_OFF;
    RUN(0, ph_prologue(a, lds, tid, lane, wave, G, bx););
    SEAM(0);
    RUN(1, ph_u1(a, lane, wave, G, bx););
    SEAM(1);
    RUN(2, { pg8::Gemm g{WSB(WS_U), WSB(WS_WGU), MA, 5632, D}; pg8::StaticOrder S; S.init(MA, 5632, G, bx); pg8::EpiSwiglu E{WSB(WS_H)}; pg8::gemm_phase<pg8::EpiSwiglu, pg8::StaticOrder, true, true>(ring, g, S, E); });
    SEAM(2);
    RUN(3, { pg8::Gemm g{WSB(WS_H), WSB(WS_WDN), MA, D, FF}; pg8::StaticOrder S; S.init(MA, D, G, bx); pg8::EpiResid E{a.in[I_XP], a.in[I_XS], WSF(WS_MOD), 2, 0.5f, WSF(WS_Z)}; pg8::gemm_phase<pg8::EpiResid, pg8::StaticOrder, true, true>(ring, g, S, E); });
    SEAM(3);
    RUN(4, ph_ln<0>(a, lane, wave, G, bx););
    SEAM(4);
    RUN(5, { pg8::Gemm g{WSB(WS_U), WSB(WS_WIN), MA, NINP, D}; pg8::StaticOrder S; S.init(MA, NINP, G, bx); pg8::EpiProj E{a.in[I_BIN], WSF(WS_PROJ)}; pg8::gemm_phase<pg8::EpiProj, pg8::StaticOrder, true, true>(ring, g, S, E); });
    SEAM(5);
    RUN(6, ph_dist_rwprep(a, lds, tid, lane, wave, G, bx););
    SEAM(6);
    RUN(7, { pg8::Gemm g{WSB(WS_ACMP), WSB(WS_WC1), 2 * CROWS, 512, 1024}; pg8::DiagOrder S{CROWS / 256, 1, 2, G, bx}; pg8::EpiF32 E{WSF(WS_HC), 256, 0}; pg8::gemm_phase<pg8::EpiF32, pg8::DiagOrder, true, true>(ring, g, S, E); });
    SEAM(7);
    RUN(8, ph_cfinal_sscan(a, lane, wave, G, bx););
    SEAM(8);
    RUN(9, ph_scan_prompt(a, lds, tid, lane, wave, G, bx););
    SEAM(9);
    RUN(10, ph_attention(a, lds, lane, wave, G, bx););
    SEAM(10);
    RUN(11, { pg8::Gemm g{WSB(WS_AST), WSB(WS_WOAB), 2 * MA, 2048, 512}; pg8::PairOrder S{MA / 256, 4, G, bx}; pg8::EpiOutAB E{WSF(WS_PROJ), WSF(WS_M1), WSB(WS_MIN), MA / 256}; pg8::gemm_phase<pg8::EpiOutAB, pg8::PairOrder, true, true>(ring, g, S, E); });
    SEAM(11);
    RUN(12, { pg8::Gemm g{WSB(WS_MIN), WSB(WS_WO), MA, D, D}; pg8::StaticOrder S; S.init(MA, D, G, bx); pg8::EpiResid E{WSF(WS_X1), WSF(WS_X1) + (size_t)MP * D, WSF(WS_MOD), 5, 1.0f, WSF(WS_Z)}; pg8::gemm_phase<pg8::EpiResid, pg8::StaticOrder, true, true>(ring, g, S, E); });
    SEAM(12);
    RUN(13, ph_ln<1>(a, lane, wave, G, bx););
    SEAM(13);
    RUN(14, { pg8::Gemm g{WSB(WS_U), WSB(WS_WGU) + (size_t)5632 * D, MA, 5632, D}; pg8::StaticOrder S; S.init(MA, 5632, G, bx); pg8::EpiSwiglu E{WSB(WS_H)}; pg8::gemm_phase<pg8::EpiSwiglu, pg8::StaticOrder, true, true>(ring, g, S, E); });
    SEAM(14);
    RUN(15, { pg8::Gemm g{WSB(WS_H), WSB(WS_WDN) + (size_t)D * FF, MA, D, FF}; pg8::StaticOrder S; S.init(MA, D, G, bx); pg8::EpiResid E{WSF(WS_X2), WSF(WS_X2) + (size_t)MP * D, WSF(WS_MOD), 8, 0.5f, WSF(WS_Z)}; pg8::gemm_phase<pg8::EpiResid, pg8::StaticOrder, true, true>(ring, g, S, E); });
    SEAM(15);
    RUN(16, ph_ln<2>(a, lane, wave, G, bx););
#undef IN
#undef SEAM
}

extern "C" void kernel_launch(void* const* d_in, const int* in_sizes, int n_in, void* d_out, int out_size, void* d_ws, size_t ws_size, hipStream_t stream) {
    static int grid = 0;
    if (grid == 0) {
        if (n_in != N_IN || (size_t)out_size != O_END || ws_size < WS_END) { fprintf(stderr, "kernel_launch: unexpected shapes: n_in %d out %d ws %zu (need %zu)\n", n_in, out_size, ws_size, (size_t)WS_END); grid = -1; return; }
        int dev = 0, cus = 0, per_cu = 0;
        if (hipGetDevice(&dev) != hipSuccess || hipDeviceGetAttribute(&cus, hipDeviceAttributeMultiprocessorCount, dev) != hipSuccess) { grid = -1; return; }
        if (hipFuncSetAttribute((const void*)fwd_kernel, hipFuncAttributeMaxDynamicSharedMemorySize, LDS_BYTES) != hipSuccess) { fprintf(stderr, "kernel_launch: hipFuncSetAttribute failed\n"); grid = -1; return; }
        if (hipOccupancyMaxActiveBlocksPerMultiprocessor(&per_cu, (const void*)fwd_kernel, NWAVES * 64, LDS_BYTES) != hipSuccess || per_cu < 1)
            fprintf(stderr, "kernel_launch: note: occupancy query reports %d workgroups per CU\n", per_cu);
        (void)hipGetLastError();
        grid = cus;
    }
    if (grid < 0) return;
    if (hipMemsetAsync((char*)d_ws + WS_CTL, 0, CTL_ZERO_BYTES, stream) != hipSuccess) return;
    Args a{};
    for (int i = 0; i < N_IN; ++i) a.in[i] = (const float*)d_in[i];
    a.out = (float*)d_out; a.ws = (unsigned char*)d_ws;
#if MK_PER_PHASE
    for (int p = 0; p < N_PHASES; ++p) { a.ph_lo = p; a.ph_hi = p + 1; hipLaunchKernelGGL(fwd_kernel, dim3(grid), dim3(NWAVES * 64), LDS_BYTES, stream, a); }
#else
    a.ph_lo = 0; a.ph_hi = N_PHASES;
    hipLaunchKernelGGL(fwd_kernel, dim3(grid), dim3(NWAVES * 64), LDS_BYTES, stream, a);
#endif
    const hipError_t le = hipPeekAtLastError();
    if (le != hipSuccess) fprintf(stderr, "kernel_launch: launch failed: %s\n", hipGetErrorName(le));
}
```

```cpp
#include <hip/hip_runtime.h>
#include <cstdio>
#include <cstdint>
#define DI __device__ __forceinline__
constexpr int D = 1024, FF = 2816, T = 4096, NBP = 4, NBS = 32, ST = 4;
constexpr int MP = NBP * T;
constexpr int MS = NBS * ST;
constexpr int MR = MP + MS;
constexpr int MA = 16640;
constexpr int NIN = 5144, NINP = 5376;
constexpr int C_Q = 1792, C_KV = 2304, C_GATE = 3072, C_MERGE = 3096;
constexpr int RWW = 512;
constexpr int NCH_S = 1024, NCH_P = 256;
constexpr int NCMP_S = 1023, NCMP_P = 255;
constexpr int CROWS_S = NBS * NCH_S * 2;
constexpr int CROWS = CROWS_S + NBP * NCH_P * 2;
constexpr float ALPHA = 1.189207115002721f;
constexpr float LN_EPS = 1e-5f, GN_EPS = 64e-5f;
constexpr float LOG2E = 1.4426950408889634f;
constexpr float NEGF = -1e30f;
constexpr size_t O_Y = 0;
constexpr size_t O_KVC_P = 16908288, O_KVS_P = 21102592, O_KVW_P = 25296896, O_WKV_P = 25821184, O_SH_P = 25952256;
constexpr size_t O_KVC_S = 25959424, O_KVS_S = 25992192, O_KVW_S = 26024960, O_WKV_S = 30219264, O_SH_S = 31267840, O_END = 31325184;
DI int bb_of_row(int row) { return row < MP ? (row >> 12) : (row < MR ? 4 + ((row - MP) >> 2) : 35); }
namespace pg8 {
#define PG8_LAS __attribute__((address_space(3)))
typedef unsigned short bf16_t;
typedef short bf16x8 __attribute__((ext_vector_type(8)));
typedef float f32x4 __attribute__((ext_vector_type(4)));
typedef unsigned u32x4 __attribute__((ext_vector_type(4)));
constexpr int BM = 256, BK = 64, HALF = 128, HTB = HALF * BK * 2  , STAGE_BYTES = 8 * HTB, NXCD = 8, WGM = 8;

__host__ __device__ __forceinline__ int lds_byte(int r, int c) { const int st = (r >> 4) * 2 + (c >> 5), rr = r & 15, cc = c & 31, ob = rr * 64 + cc * 2; return st * 1024 + (ob ^ (((ob >> 9) & 1) << 5)); }
__host__ __device__ __forceinline__ void stage_rc(int b, int& R, int& C) { const int st = b / 1024, sb = b % 1024, swz = sb ^ (((sb >> 9) & 1) << 5); R = (st >> 1) * 16 + swz / 64; C = (st & 1) * 32 + (swz % 64) / 2; }
__host__ __device__ __forceinline__ int perm32(int rho) { const int n = rho >> 4, i = rho & 15; return 8 * (i >> 2) + 4 * n + (i & 3); }

struct Unit { int pm, pn; };
struct Gemm { const bf16_t* A; const bf16_t* Bt; int M, N, K; };

struct StaticOrder {
    int nM, nN, nwg, G, c;
    __host__ __device__ void init(int M, int N, int G_, int c_) { nM = M / BM; nN = N / BM; nwg = nM * nN; G = G_; c = c_; }
    __host__ __device__ bool next(int i, Unit& u) const {
        const long L = (long)i * G + c; if (L >= nwg) return false;
        int wgid = (int)L; { const int q = nwg / NXCD, r = nwg % NXCD, xcd = wgid % NXCD, off = wgid / NXCD; wgid = (xcd < r ? xcd * (q + 1) : r * (q + 1) + (xcd - r) * q) + off; }
        const int nig = WGM * nN, gid = wgid / nig, fm = gid * WGM, gsz = (nM - fm) < WGM ? (nM - fm) : WGM;
        u.pm = fm + ((wgid % nig) % gsz); u.pn = (wgid % nig) / gsz; return true;
    }
    __device__ __forceinline__ void a_ready(const Unit&) const {}
    __device__ __forceinline__ void done(const Unit&) const {}
};

struct PairOrder {
    int nm, nn, G, c;
    __device__ __forceinline__ bool next(int i, Unit& u) const {
        const int tile = (i >> 1) * G + c; if (tile >= nm * nn) return false;
        const int rep = i & 1; u.pm = tile / nn + rep * nm; u.pn = tile % nn + rep * nn; return true;
    }
    __device__ __forceinline__ void a_ready(const Unit&) const {}
    __device__ __forceinline__ void done(const Unit&) const {}
};
struct DiagOrder {
    int nm, nn, nrep, G, c;
    __device__ __forceinline__ bool next(int i, Unit& u) const {
        const int L = i * G + c; if (L >= nrep * nm * nn) return false;
        const int rep = L / (nm * nn), rem = L % (nm * nn); u.pm = rem / nn + rep * nm; u.pn = rem % nn + rep * nn; return true;
    }
    __device__ __forceinline__ void a_ready(const Unit&) const {}
    __device__ __forceinline__ void done(const Unit&) const {}
};

typedef float f32x2 __attribute__((ext_vector_type(2)));
typedef __bf16 bf16x2_t __attribute__((ext_vector_type(2)));
__device__ __forceinline__ unsigned cvt_pk_bf16(float lo, float hi) { f32x2 v = {lo, hi}; bf16x2_t b = __builtin_convertvector(v, bf16x2_t); return __builtin_bit_cast(unsigned, b); }
__device__ __forceinline__ float fast_sigmoid(float x) { return __builtin_amdgcn_rcpf(1.0f + __builtin_amdgcn_exp2f(-x * LOG2E)); }

struct EpiSwiglu {
    static constexpr bool PERM = true, AFTER_DRAIN = false;
    bf16_t* H;
    __device__ __forceinline__ void operator()(const f32x4 (&acc)[2][2][4][2], const Unit& u, int wr, int wc, int fr, int fq) const {
        const int row0 = u.pm * BM + wr * 64 + fr, hc0 = u.pn * HALF + wc * 32 + 8 * fq;
#pragma unroll
        for (int ai = 0; ai < 2; ++ai)
#pragma unroll
            for (int m = 0; m < 4; ++m) {
                bf16_t* rowp = H + (size_t)(row0 + ai * HALF + m * 16) * FF + hc0;
                float h[8];
#pragma unroll
                for (int n = 0; n < 2; ++n)
#pragma unroll
                    for (int e = 0; e < 4; ++e) { const float g = acc[ai][0][m][n][e], up = acc[ai][1][m][n][e]; h[4 * n + e] = g * fast_sigmoid(g) * up; }
                u32x4 w; w.x = cvt_pk_bf16(h[0], h[1]); w.y = cvt_pk_bf16(h[2], h[3]); w.z = cvt_pk_bf16(h[4], h[5]); w.w = cvt_pk_bf16(h[6], h[7]);
                *(u32x4*)rowp = w;
            }
    }
};
struct EpiResid {
    static constexpr bool PERM = false, AFTER_DRAIN = false;
    const float* xp; const float* xs; const float* mod; int slot; float coef; float* Z;
    __device__ __forceinline__ void operator()(const f32x4 (&acc)[2][2][4][2], const Unit& u, int wr, int wc, int fr, int fq) const {
        const int row0 = u.pm * BM + wr * 64 + fr, col0 = u.pn * BM + wc * 32 + 4 * fq;
#pragma unroll
        for (int ai = 0; ai < 2; ++ai)
#pragma unroll
            for (int m = 0; m < 4; ++m) {
                const int row = row0 + ai * HALF + m * 16; const bool valid = row < MR;
                const float* xr = row < MP ? xp + (size_t)row * D : xs + (size_t)(row - MP) * D;
                const float* mr = mod + (size_t)(bb_of_row(row) * 9 + slot) * D;
#pragma unroll
                for (int bj = 0; bj < 2; ++bj)
#pragma unroll
                    for (int n = 0; n < 2; ++n) { const int col = col0 + bj * HALF + n * 16;
                        const f32x4 xv = valid ? *(const f32x4*)(xr + col) : (f32x4){0.f, 0.f, 0.f, 0.f}; const f32x4 mv = *(const f32x4*)(mr + col);
                        *(f32x4*)(Z + (size_t)row * D + col) = ALPHA * xv + coef * (1.0f + mv) * acc[ai][bj][m][n]; }
            }
    }
};
struct EpiProj {
    static constexpr bool PERM = false, AFTER_DRAIN = false;
    const float* bias; float* P;
    __device__ __forceinline__ void operator()(const f32x4 (&acc)[2][2][4][2], const Unit& u, int wr, int wc, int fr, int fq) const {
        const int row0 = u.pm * BM + wr * 64 + fr, col0 = u.pn * BM + wc * 32 + 4 * fq;
        f32x4 bv[2][2];
#pragma unroll
        for (int bj = 0; bj < 2; ++bj)
#pragma unroll
            for (int n = 0; n < 2; ++n) { const int col = col0 + bj * HALF + n * 16; bv[bj][n] = col < NIN ? *(const f32x4*)(bias + col) : (f32x4){0.f, 0.f, 0.f, 0.f}; }
#pragma unroll
        for (int ai = 0; ai < 2; ++ai)
#pragma unroll
            for (int m = 0; m < 4; ++m) { float* rp = P + (size_t)(row0 + ai * HALF + m * 16) * NINP + col0;
#pragma unroll
                for (int bj = 0; bj < 2; ++bj)
#pragma unroll
                    for (int n = 0; n < 2; ++n) *(f32x4*)(rp + bj * HALF + n * 16) = acc[ai][bj][m][n] + bv[bj][n]; }
    }
};
struct EpiF32 {
    static constexpr bool PERM = false, AFTER_DRAIN = false;
    float* O; int ldc; int nm;
    __device__ __forceinline__ void operator()(const f32x4 (&acc)[2][2][4][2], const Unit& u, int wr, int wc, int fr, int fq) const {
        const int row0 = u.pm * BM + wr * 64 + fr, col0 = wc * 32 + 4 * fq;
#pragma unroll
        for (int ai = 0; ai < 2; ++ai)
#pragma unroll
            for (int m = 0; m < 4; ++m) { float* rp = O + (size_t)(row0 + ai * HALF + m * 16) * ldc + col0;
#pragma unroll
                for (int bj = 0; bj < 2; ++bj)
#pragma unroll
                    for (int n = 0; n < 2; ++n) *(f32x4*)(rp + bj * HALF + n * 16) = acc[ai][bj][m][n]; }
    }
};
struct EpiOutAB {
    static constexpr bool PERM = false, AFTER_DRAIN = false;
    const float* P; float* M1; bf16_t* MIN; int nm;
    __device__ __forceinline__ void operator()(const f32x4 (&acc)[2][2][4][2], const Unit& u, int wr, int wc, int fr, int fq) const {
        const int rep = u.pm >= nm ? 1 : 0;
        const int row0 = (u.pm - rep * nm) * BM + wr * 64 + fr, col0 = (u.pn - rep * 4) * BM + wc * 32 + 4 * fq;
#pragma unroll
        for (int ai = 0; ai < 2; ++ai)
#pragma unroll
            for (int m = 0; m < 4; ++m) { const int row = row0 + ai * HALF + m * 16;
#pragma unroll
                for (int bj = 0; bj < 2; ++bj)
#pragma unroll
                    for (int n = 0; n < 2; ++n) { const int col = col0 + bj * HALF + n * 16;
                        const f32x4 pm = *(const f32x4*)(P + (size_t)row * NINP + C_MERGE + rep * D + col);
                        f32x4 g; g[0] = fast_sigmoid(pm[0]); g[1] = fast_sigmoid(pm[1]); g[2] = fast_sigmoid(pm[2]); g[3] = fast_sigmoid(pm[3]);
                        const f32x4 v = g * acc[ai][bj][m][n];
                        if (rep == 0) *(f32x4*)(M1 + (size_t)row * D + col) = v;
                        else { const f32x4 s = *(const f32x4*)(M1 + (size_t)row * D + col) + v;
                               typedef unsigned u32x2v __attribute__((ext_vector_type(2))); u32x2v w; w.x = cvt_pk_bf16(s[0], s[1]); w.y = cvt_pk_bf16(s[2], s[3]);
                               *(u32x2v*)(MIN + (size_t)row * D + col) = w; } }
            }
    }
};
template <class Epi, class Sched, bool ALIGN_EPI = false, bool SP2 = false>
__device__ __forceinline__ void gemm_phase(PG8_LAS unsigned char* lds, const Gemm g, const Sched& S, const Epi& E) {
    const int tid = threadIdx.x, wid = __builtin_amdgcn_readfirstlane(tid >> 6), lane = tid & 63, wr = wid >> 2, wc = wid & 3, fr = lane & 15, fq = lane >> 4;
    const int K = g.K, nt = K / BK;
    unsigned voffA[2], voffB[2];
#pragma unroll
    for (int i = 0; i < 2; ++i) { int R, C; stage_rc(tid * 16 + i * 8192, R, C); const int Rb = Epi::PERM ? ((R & ~31) + perm32(R & 31)) : R;
        voffA[i] = (unsigned)(R * K + C) * 2u; voffB[i] = (unsigned)(Rb * K + C) * 2u; }
    const size_t kstep = (size_t)(BK * 2);
    const size_t hstep = (size_t)HALF * K * 2;
    const size_t tstep = 2 * hstep;
    const unsigned ldsw = (unsigned)wid * 1024u;
    const int aoff = lds_byte(wr * 64 + fr, fq * 8), boff = lds_byte(wc * 32 + fr, fq * 8);
#define PG8_SA(b, h) (((b) * 2 + (h)) * HTB)
#define PG8_SB(b, h) ((4 + (b) * 2 + (h)) * HTB)
#define PG8_STAGE(bufoff, gbase, voff) do { _Pragma("unroll") for (int _i = 0; _i < 2; ++_i) \
        __builtin_amdgcn_global_load_lds((const unsigned*)((const char*)(gbase) + (voff)[_i]), (PG8_LAS unsigned*)(lds + (bufoff) + ldsw + _i * 8192), 16, 0, 0); } while (0)
#define PG8_LDA(dst, b, h) do { _Pragma("unroll") for (int m = 0; m < 4; ++m) _Pragma("unroll") for (int k = 0; k < 2; ++k) dst[m][k] = *(const PG8_LAS bf16x8*)(lds + PG8_SA(b, h) + aoff + m * 2048 + k * 1024); } while (0)
#define PG8_LDB(dst, b, h) do { _Pragma("unroll") for (int n = 0; n < 2; ++n) _Pragma("unroll") for (int k = 0; k < 2; ++k) dst[n][k] = *(const PG8_LAS bf16x8*)(lds + PG8_SB(b, h) + boff + n * 2048 + k * 1024); } while (0)
#define PG8_MMA(ai, bj, At, Bt) do { __builtin_amdgcn_s_setprio(1); _Pragma("unroll") for (int m = 0; m < 4; ++m) _Pragma("unroll") for (int n = 0; n < 2; ++n) _Pragma("unroll") for (int k = 0; k < 2; ++k) \
        acc[ai][bj][m][n] = __builtin_amdgcn_mfma_f32_16x16x32_bf16(Bt[n][k], At[m][k], acc[ai][bj][m][n], 0, 0, 0); __builtin_amdgcn_s_setprio(0); } while (0)
#define PG8_WAIT_V(n) asm volatile("s_waitcnt vmcnt(" #n ")" ::: "memory")
#define PG8_WAIT_L(n) asm volatile("s_waitcnt lgkmcnt(" #n ")" ::: "memory")
#define PG8_BAR __builtin_amdgcn_s_barrier()
#define PG8_SCHED __builtin_amdgcn_sched_barrier(0)
    Unit cur, nxt; int ui = 0;
    if (!S.next(0, cur)) return;
    f32x4 acc[2][2][4][2];
#pragma unroll
    for (int a = 0; a < 2; ++a)
#pragma unroll
        for (int b = 0; b < 2; ++b)
#pragma unroll
            for (int m = 0; m < 4; ++m)
#pragma unroll
                for (int n = 0; n < 2; ++n) acc[a][b][m][n] = (f32x4){0.f, 0.f, 0.f, 0.f};
    bf16x8 At[4][2], B0[2][2], B1[2][2];
    const char* cA = (const char*)g.A + (size_t)cur.pm * tstep; const char* cB = (const char*)g.Bt + (size_t)cur.pn * tstep;
    S.a_ready(cur);
    if constexpr (SP2) {
        PG8_STAGE(PG8_SB(0, 0), cB, voffB); PG8_STAGE(PG8_SB(0, 1), cB + hstep, voffB); PG8_STAGE(PG8_SA(0, 0), cA, voffA); PG8_STAGE(PG8_SA(0, 1), cA + hstep, voffA);
        if (wr == 1) PG8_BAR;
        PG8_WAIT_V(2); PG8_BAR;
        PG8_STAGE(PG8_SB(1, 0), cB + kstep, voffB); PG8_STAGE(PG8_SA(1, 0), cA + kstep, voffA); PG8_STAGE(PG8_SB(1, 1), cB + hstep + kstep, voffB);
        PG8_WAIT_V(6); PG8_BAR;
    } else {
        PG8_STAGE(PG8_SB(0, 0), cB, voffB); PG8_STAGE(PG8_SA(0, 0), cA, voffA); PG8_STAGE(PG8_SB(0, 1), cB + hstep, voffB); PG8_STAGE(PG8_SA(0, 1), cA + hstep, voffA);
        if (wr == 1) PG8_BAR;
        PG8_WAIT_V(4); PG8_BAR;
        PG8_STAGE(PG8_SB(1, 0), cB + kstep, voffB); PG8_STAGE(PG8_SA(1, 0), cA + kstep, voffA); PG8_STAGE(PG8_SB(1, 1), cB + hstep + kstep, voffB);
        PG8_WAIT_V(6); PG8_BAR;
    }
    for (;;) {
        const bool has_next = S.next(ui + 1, nxt);
        const char* nA = has_next ? (const char*)g.A + (size_t)nxt.pm * tstep : cA; const char* nB = has_next ? (const char*)g.Bt + (size_t)nxt.pn * tstep : cB;
        for (int t = 0; t < nt; t += 2) {
            const bool last = (t == nt - 2);
            const char* a1 = cA + (size_t)(t + 1) * kstep;
            const char* a2 = last ? nA : cA + (size_t)(t + 2) * kstep; const char* b2 = last ? nB : cB + (size_t)(t + 2) * kstep;
            const char* a3 = a2 + kstep; const char* b3 = b2 + kstep;
            if (last && has_next) S.a_ready(nxt);
            if constexpr (SP2) {
            PG8_LDB(B0, 0, 0); PG8_LDB(B1, 0, 1); PG8_SCHED; PG8_LDA(At, 0, 0); PG8_STAGE(PG8_SA(1, 1), a1 + hstep, voffA);
            PG8_WAIT_V(8); PG8_WAIT_L(0); PG8_BAR; PG8_MMA(0, 0, At, B0); PG8_MMA(0, 1, At, B1); PG8_BAR; PG8_SCHED;
            PG8_LDA(At, 0, 1); PG8_STAGE(PG8_SB(0, 0), b2, voffB); PG8_STAGE(PG8_SB(0, 1), b2 + hstep, voffB); PG8_STAGE(PG8_SA(0, 0), a2, voffA);
            PG8_WAIT_V(8); PG8_WAIT_L(0); PG8_BAR; PG8_MMA(1, 0, At, B0); PG8_MMA(1, 1, At, B1); PG8_BAR; PG8_SCHED;
            PG8_LDB(B0, 1, 0); PG8_LDB(B1, 1, 1); PG8_SCHED; PG8_LDA(At, 1, 0); PG8_STAGE(PG8_SA(0, 1), a2 + hstep, voffA);
            PG8_WAIT_V(8); PG8_WAIT_L(0); PG8_BAR; PG8_MMA(0, 0, At, B0); PG8_MMA(0, 1, At, B1); PG8_BAR; PG8_SCHED;
            PG8_LDA(At, 1, 1); PG8_STAGE(PG8_SB(1, 0), b3, voffB); PG8_STAGE(PG8_SB(1, 1), b3 + hstep, voffB); PG8_STAGE(PG8_SA(1, 0), a3, voffA);
            PG8_WAIT_V(8); PG8_WAIT_L(0); PG8_BAR; PG8_MMA(1, 0, At, B0); PG8_MMA(1, 1, At, B1); PG8_BAR; PG8_SCHED;
            } else {
            PG8_LDB(B0, 0, 0); PG8_SCHED; PG8_LDA(At, 0, 0); PG8_STAGE(PG8_SA(1, 1), a1 + hstep, voffA);
            PG8_WAIT_L(8); PG8_BAR; PG8_WAIT_L(0); PG8_MMA(0, 0, At, B0); PG8_BAR; PG8_SCHED;
            PG8_LDB(B1, 0, 1); PG8_STAGE(PG8_SB(0, 0), b2, voffB);
            PG8_BAR; PG8_WAIT_L(0); PG8_MMA(0, 1, At, B1); PG8_BAR;
            PG8_LDA(At, 0, 1); PG8_STAGE(PG8_SA(0, 0), a2, voffA);
            PG8_BAR; PG8_WAIT_L(0); PG8_MMA(1, 0, At, B0); PG8_BAR; PG8_SCHED;
            PG8_STAGE(PG8_SB(0, 1), b2 + hstep, voffB);
            PG8_WAIT_V(6); PG8_BAR; PG8_MMA(1, 1, At, B1); PG8_BAR;
            PG8_LDB(B0, 1, 0); PG8_SCHED; PG8_LDA(At, 1, 0); PG8_STAGE(PG8_SA(0, 1), a2 + hstep, voffA);
            PG8_WAIT_L(8); PG8_BAR; PG8_WAIT_L(0); PG8_MMA(0, 0, At, B0); PG8_BAR; PG8_SCHED;
            PG8_LDB(B1, 1, 1); PG8_STAGE(PG8_SB(1, 0), b3, voffB);
            PG8_BAR; PG8_WAIT_L(0); PG8_MMA(0, 1, At, B1); PG8_BAR;
            PG8_LDA(At, 1, 1); PG8_STAGE(PG8_SA(1, 0), a3, voffA);
            PG8_BAR; PG8_WAIT_L(0); PG8_MMA(1, 0, At, B0); PG8_BAR; PG8_SCHED;
            PG8_STAGE(PG8_SB(1, 1), b3 + hstep, voffB);
            PG8_WAIT_V(6); PG8_BAR; PG8_MMA(1, 1, At, B1); PG8_BAR;
            }
        }
        if constexpr (ALIGN_EPI) { if (wr == 0) PG8_BAR; }
        if constexpr (!Epi::AFTER_DRAIN) { E(acc, cur, wr, wc, fr, fq); S.done(cur); }
        if (!has_next) break;
#pragma unroll
        for (int a = 0; a < 2; ++a)
#pragma unroll
            for (int b = 0; b < 2; ++b)
#pragma unroll
                for (int m = 0; m < 4; ++m)
#pragma unroll
                    for (int n = 0; n < 2; ++n) acc[a][b][m][n] = (f32x4){0.f, 0.f, 0.f, 0.f};
        cur = nxt; cA = nA; cB = nB; ++ui;
        if constexpr (ALIGN_EPI) { if (wr == 1) PG8_BAR; }
    }
    PG8_WAIT_V(0);
    if constexpr (!ALIGN_EPI) { if (wr == 0) PG8_BAR; }
    PG8_BAR;
    if constexpr (Epi::AFTER_DRAIN) { E.fused(acc, cur, wr, wc, fr, fq, lds, wid, lane); S.done(cur); }
#undef PG8_SA
#undef PG8_SB
#undef PG8_STAGE
#undef PG8_LDA
#undef PG8_LDB
#undef PG8_MMA
#undef PG8_WAIT_V
#undef PG8_WAIT_L
#undef PG8_BAR
#undef PG8_SCHED
}
}

constexpr size_t al256(size_t x) { return (x + 255) & ~(size_t)255; }
constexpr size_t WS_CTL = 0, CTL_ZERO_BYTES = 1u << 20;
constexpr int CW_BAR = 4096;
constexpr size_t WS_MOD  = CTL_ZERO_BYTES;
constexpr size_t WS_PET  = al256(WS_MOD + (size_t)36 * 9 * D * 4);
constexpr size_t WS_WGU  = al256(WS_PET + 2 * 128 * 4);
constexpr size_t WS_WDN  = al256(WS_WGU + (size_t)2 * 5632 * D * 2);
constexpr size_t WS_WIN  = al256(WS_WDN + (size_t)2 * D * FF * 2);
constexpr size_t WS_WOAB = al256(WS_WIN + (size_t)NINP * D * 2);
constexpr size_t WS_WO   = al256(WS_WOAB + (size_t)2048 * 512 * 2);
constexpr size_t WS_WC1  = al256(WS_WO + (size_t)D * D * 2);
constexpr size_t WS_U    = al256(WS_WC1 + (size_t)512 * 1024 * 2);
constexpr size_t WS_H    = al256(WS_U + (size_t)MA * D * 2);
constexpr size_t WS_Z    = al256(WS_H + (size_t)MA * FF * 2);
constexpr size_t WS_X1   = al256(WS_Z + (size_t)MA * D * 4);
constexpr size_t WS_X2   = al256(WS_X1 + (size_t)MA * D * 4);
constexpr size_t WS_M1   = al256(WS_X2 + (size_t)MA * D * 4);
constexpr size_t WS_MIN  = al256(WS_M1 + (size_t)MA * D * 4);
constexpr size_t WS_PROJ = al256(WS_MIN + (size_t)MA * D * 2);
constexpr size_t WS_RW   = al256(WS_PROJ + (size_t)MA * NINP * 4);
constexpr size_t RW_STRIDE = (size_t)MA * RWW;
constexpr size_t WS_G    = al256(WS_RW + 6 * RW_STRIDE * 4);
constexpr size_t WS_BON  = al256(WS_G + RW_STRIDE * 4);
constexpr size_t WS_YS   = al256(WS_BON + RW_STRIDE * 4);
constexpr size_t WS_AST  = al256(WS_YS + RW_STRIDE * 4);
constexpr size_t WS_KSEL = al256(WS_AST + (size_t)2 * MA * RWW * 2);
constexpr size_t KV_BYTES = (size_t)NBP * 2 * T * 64 * 2;
constexpr size_t WS_KWIN = WS_KSEL + KV_BYTES, WS_VTSEL = WS_KWIN + KV_BYTES, WS_VTWIN = WS_VTSEL + KV_BYTES;
constexpr size_t WS_KCP  = WS_VTWIN + KV_BYTES;
constexpr size_t WS_VCTP = WS_KCP + (size_t)NBP * 2 * 256 * 64 * 2;
constexpr size_t WS_KCS  = al256(WS_VCTP + (size_t)NBP * 2 * 256 * 64 * 2);
constexpr size_t KCS_STRIDE = (size_t)NBS * NCMP_S * 2 * 64;
constexpr size_t WS_ACMP = al256(WS_KCS + 2 * KCS_STRIDE * 4);
constexpr size_t WS_HC   = al256(WS_ACMP + (size_t)2 * CROWS * 1024 * 2);
constexpr size_t WS_END  = al256(WS_HC + (size_t)2 * CROWS * 256 * 4);

constexpr int NWAVES = 8;
constexpr int RING_OFF = 0, RING_BYTES = 131072;
constexpr int LDSCTL_OFF = RING_BYTES, MISC_OFF = LDSCTL_OFF + 320;
constexpr int LDS_BYTES = 147456;

#define GAS __attribute__((address_space(1)))
#define LAS __attribute__((address_space(3)))
typedef unsigned short bf16;
typedef unsigned v4u __attribute__((ext_vector_type(4)));
typedef unsigned v2u __attribute__((ext_vector_type(2)));
typedef float f32x4 __attribute__((ext_vector_type(4)));
typedef float f32x16 __attribute__((ext_vector_type(16)));
typedef short bf16x8 __attribute__((ext_vector_type(8)));
typedef short s16x4 __attribute__((ext_vector_type(4)));
typedef GAS unsigned gu32;
#define RLX_AGENT __ATOMIC_RELAXED, __HIP_MEMORY_SCOPE_AGENT
#define LDS_WAIT() asm volatile("s_waitcnt lgkmcnt(0)" ::: "memory")
#define VM_WAIT() asm volatile("s_waitcnt vmcnt(0)" ::: "memory")
DI unsigned f2bf(float f) { unsigned u = __builtin_bit_cast(unsigned, f); return (u + 0x7fffu + ((u >> 16) & 1u)) >> 16; }
DI unsigned pk2(float lo, float hi) { return pg8::cvt_pk_bf16(lo, hi); }
DI float sigmoidf_(float x) { return 1.0f / (1.0f + __expf(-x)); }
DI float wave_sum(float v) {
#pragma unroll
    for (int o = 1; o < 64; o <<= 1) v += __shfl_xor(v, o);
    return v;
}
DI float wave_max(float v) {
#pragma unroll
    for (int o = 1; o < 64; o <<= 1) v = fmaxf(v, __shfl_xor(v, o));
    return v;
}
template <int CTRL> DI float dpp_f(float x) { return __builtin_bit_cast(float, __builtin_amdgcn_update_dpp(0, __builtin_bit_cast(int, x), CTRL, 0xf, 0xf, false)); }
DI float row16_sum(float x) {
    x += dpp_f<0x128>(x); x += dpp_f<0x124>(x); x += dpp_f<0x122>(x); x += dpp_f<0x121>(x); return x;
}
DI float gelu_tanh(float x) { const float u = 0.7978845608028654f * (x + 0.044715f * x * x * x); const float e = __expf(2.0f * u); const float th = 1.0f - 2.0f / (e + 1.0f); return 0.5f * x * (1.0f + th); }
#define XB_TMO      128
#define XB_XCNT(j)  (256  + 64 * (j))
#define XB_XSUB(j)  (1280 + 64 * (j))
#define XB_XGEN(j)  (2304 + 64 * (j))
#define XB_TOP      3328
#define XB_TOPGEN   3392
#define XCD_BAR_WORDS 3456
#define XB_SPIN_CAP (1u << 18)

__device__ __forceinline__ unsigned xb_ld(unsigned* p)              { return __hip_atomic_load(p, __ATOMIC_RELAXED, __HIP_MEMORY_SCOPE_AGENT); }
__device__ __forceinline__ unsigned xb_add(unsigned* p, unsigned v) { return __hip_atomic_fetch_add(p, v, __ATOMIC_RELAXED, __HIP_MEMORY_SCOPE_AGENT); }
__device__ __forceinline__ unsigned xb_xcc_id() { return (unsigned)__builtin_amdgcn_s_getreg((3 << 11) | 20) & 0xFu; }
#define XB_SPIN(cond, bar) do { unsigned _sp = 0; while (cond) { __builtin_amdgcn_s_sleep(1); \
    if ((++_sp & 255u) == 0u) { if (xb_ld(&(bar)[XB_TMO])) break; if (_sp > XB_SPIN_CAP) { atomicAdd(&(bar)[XB_TMO], 1u); break; } } } } while (0)

struct XcdBarrier {
    unsigned* bar; unsigned x;
    volatile LAS unsigned* st;
};

__device__ __forceinline__ XcdBarrier xcd_barrier_post(unsigned* bar, volatile LAS unsigned* st) {
    XcdBarrier b; b.bar = bar; b.x = xb_xcc_id(); b.st = st;
    if (threadIdx.x == 0) (void)xb_add(&bar[XB_XCNT(b.x)], 1u);
    return b;
}
__device__ __forceinline__ void xcd_barrier_complete(unsigned* bar, unsigned x, unsigned& nloc, unsigned& nx) {
    const unsigned G = gridDim.x * gridDim.y * gridDim.z;
    unsigned sum, cnt, mine, sp = 0u;
    for (;;) {
        sum = 0u; cnt = 0u; mine = 0u;
#pragma unroll
        for (unsigned j = 0; j < 16; ++j) { const unsigned c = xb_ld(&bar[XB_XCNT(j)]); sum += c; cnt += (c > 0u) ? 1u : 0u; mine = (j == x) ? c : mine; }
        if (sum == G) break;
        __builtin_amdgcn_s_sleep(1);
        if ((++sp & 255u) == 0u) { if (xb_ld(&bar[XB_TMO])) break; if (sp > XB_SPIN_CAP) { atomicAdd(&bar[XB_TMO], 1u); break; } }
    }
    nloc = mine > 0u ? mine : 1u; nx = cnt > 0u ? cnt : 1u;
}

__device__ __forceinline__ void xcd_barrier(const XcdBarrier& b) {
    asm volatile("s_waitcnt vmcnt(0)" ::: "memory");
    __syncthreads();
    if (threadIdx.x == 0) {
        unsigned* bar = b.bar;
        __builtin_amdgcn_s_waitcnt(0);
        unsigned nloc = b.st[0], nx = b.st[1];
        if (nloc == 0u) { xcd_barrier_complete(bar, b.x, nloc, nx); b.st[0] = nloc; b.st[1] = nx; }
        const unsigned old = xb_add(&bar[XB_XSUB(b.x)], 1u);
        const unsigned gen = old / nloc;
        if (old + 1u == (gen + 1u) * nloc) {
            __builtin_amdgcn_fence(__ATOMIC_RELEASE, "agent");
            asm volatile("s_waitcnt vmcnt(0)" ::: "memory");
            const unsigned og = xb_add(&bar[XB_TOP], 1u);
            const unsigned tg = og / nx;
            if (og + 1u == (tg + 1u) * nx) xb_add(&bar[XB_TOPGEN], 1u);
            else XB_SPIN(xb_ld(&bar[XB_TOPGEN]) == tg, bar);
            __builtin_amdgcn_fence(__ATOMIC_ACQUIRE, "agent");
            xb_add(&bar[XB_XGEN(b.x)], 1u);
            asm volatile("s_waitcnt vmcnt(0)" ::: "memory");
        } else {
            XB_SPIN(xb_ld(&bar[XB_XGEN(b.x)]) == gen, bar);
            __builtin_amdgcn_fence(__ATOMIC_ACQUIRE, "agent");
            asm volatile("s_waitcnt vmcnt(0)" ::: "memory");
        }
    }
    __syncthreads();
}

enum { I_XP = 0, I_XS, I_CP, I_CS, I_CKC, I_CKS, I_SKW, I_SWKV, I_SSH, I_PT, I_WADA, I_BADA, I_LNG, I_LNB, I_WG, I_WU, I_WD, I_WIN, I_BIN, I_MU, I_W0, I_W2, I_A0, I_A2, I_G2,
       I_KK, I_KA, I_RK, I_LNW, I_LNBB, I_PE, I_PW1, I_PW2, I_WOA, I_WOB, I_WOO, N_IN };
struct Args { const float* in[N_IN]; float* out; unsigned char* ws; int ph_lo, ph_hi; };
#define WSF(off) ((float*)(a.ws + (off)))
#define WSB(off) ((bf16*)(a.ws + (off)))

DI void tr_item(const float* __restrict__ W, int ldw, int ncols, int k0, int n0, bf16* WT, int ldo, int dr0, LAS float* scr, int lane) {
#pragma unroll 8
    for (int i = 0; i < 32; ++i) { const int kk = 2 * i + (lane >> 5), col = n0 + (lane & 31); scr[kk * 33 + (lane & 31)] = col < ncols ? W[(size_t)(k0 + kk) * ldw + col] : 0.f; }
    LDS_WAIT(); asm volatile("" ::: "memory");
    const int c = lane & 7;
#pragma unroll
    for (int j = 0; j < 4; ++j) { const int n = (lane >> 3) + 8 * j; const LAS float* s = scr + (8 * c) * 33 + n;
        v4u o; o.x = pk2(s[0 * 33], s[1 * 33]); o.y = pk2(s[2 * 33], s[3 * 33]); o.z = pk2(s[4 * 33], s[5 * 33]); o.w = pk2(s[6 * 33], s[7 * 33]);
        *(v4u*)(WT + (size_t)(dr0 + n) * ldo + k0 + 8 * c) = o; }
    LDS_WAIT(); asm volatile("" ::: "memory");
}
DI void mod_gemv_item(const Args& a, LAS unsigned char* lds, int tid, int lane, int wave, int item) {
    LAS float* S = (LAS float*)lds;
    const float* wada = a.in[I_WADA];
    float acc[36];
#pragma unroll
    for (int i = 0; i < 36; ++i) acc[i] = 0.f;
    const int col = item * 64 + lane;
    for (int kh = 0; kh < 2; ++kh) {
        __syncthreads();
        for (int e = tid; e < 36 * 512; e += 512) { const int bbv = e >> 9, kk = e & 511;
            const float c = bbv < 4 ? a.in[I_CP][bbv * D + kh * 512 + kk] : a.in[I_CS][(bbv - 4) * D + kh * 512 + kk];
            S[kk * 36 + bbv] = c / (1.0f + __expf(-c)); }
        __syncthreads();
        for (int kk = wave * 64; kk < wave * 64 + 64; ++kk) {
            const float wv = wada[(size_t)(kh * 512 + kk) * 9216 + col];
            const LAS f32x4* sp = (const LAS f32x4*)(S + kk * 36);
#pragma unroll
            for (int q = 0; q < 9; ++q) { const f32x4 s = sp[q]; acc[4 * q] += s[0] * wv; acc[4 * q + 1] += s[1] * wv; acc[4 * q + 2] += s[2] * wv; acc[4 * q + 3] += s[3] * wv; }
        }
    }
    __syncthreads();
    LAS float* P = (LAS float*)lds;
#pragma unroll
    for (int i = 0; i < 36; ++i) P[(wave * 36 + i) * 64 + lane] = acc[i];
    __syncthreads();
    float* MOD = WSF(WS_MOD);
    for (int o = tid; o < 36 * 64; o += 512) { const int bbv = o >> 6, l = o & 63; float s = 0.f;
#pragma unroll
        for (int w = 0; w < 8; ++w) s += P[(w * 36 + bbv) * 64 + l];
        const int cc = item * 64 + l; MOD[(size_t)bbv * 9216 + cc] = s + a.in[I_BADA][cc]; }
    __syncthreads();
}
DI void pet_item(const Args& a, LAS unsigned char* lds, int tid, int lane, int wave, int item) {
    const int kv = item >> 1, e = (item & 1) * 64 + lane;
    const float* pe = a.in[I_PE] + kv * 2048; const float* w1 = a.in[I_PW1] + (size_t)kv * 2048 * 128;
    float acc = 0.f;
    for (int k = wave * 256; k < wave * 256 + 256; ++k) acc += pe[k] * w1[(size_t)k * 128 + e];
    LAS float* P = (LAS float*)lds;
    __syncthreads();
    P[wave * 64 + lane] = acc;
    __syncthreads();
    if (tid < 64) { float s = 0.f;
#pragma unroll
        for (int w = 0; w < 8; ++w) s += P[w * 64 + tid];
        WSF(WS_PET)[kv * 128 + (item & 1) * 64 + tid] = s; }
    __syncthreads();
}
DI void ph_prologue(const Args& a, LAS unsigned char* lds, int tid, int lane, int wave, int G, int bx) {
    for (int it = bx; it < 148; it += G) { if (it < 144) mod_gemv_item(a, lds, tid, lane, wave, it); else pet_item(a, lds, tid, lane, wave, it - 144); }
    __syncthreads();
    LAS float* scr = (LAS float*)(lds + wave * 16384);
    const int gw = wave * G + bx, NGW = G * NWAVES;
    constexpr int I_GU = 16 * 88, I_DN = 44 * 32, I_IN = 16 * 168, I_OAB = 8 * 32, I_O = 16 * 32, I_C1 = 16 * 4, I_CONV = NBS * NCH_S, I_WCP = 1016, I_ZERO = 128;
    constexpr int NITEMS = 4 * I_GU + 2 * I_DN + I_IN + 2 * I_OAB + I_O + 4 * I_C1 + I_CONV + I_WCP + I_ZERO;
    for (int it = gw; it < NITEMS; it += NGW) {
        int r = it;
        if (r < 4 * I_GU) { const int which = r / I_GU, l = which & 1, up = which >> 1; r %= I_GU; const int kb = r / 88, nb = r % 88, n0 = nb * 32;
            tr_item((up ? a.in[I_WU] : a.in[I_WG]) + (size_t)l * D * FF, FF, FF, kb * 64, n0, WSB(WS_WGU) + (size_t)l * 5632 * D, D, (n0 >> 7) * 256 + up * 128 + (n0 & 127), scr, lane); continue; } r -= 4 * I_GU;
        if (r < 2 * I_DN) { const int l = r / I_DN; r %= I_DN; const int kb = r / 32, nb = r % 32;
            tr_item(a.in[I_WD] + (size_t)l * FF * D, D, D, kb * 64, nb * 32, WSB(WS_WDN) + (size_t)l * D * FF, FF, nb * 32, scr, lane); continue; } r -= 2 * I_DN;
        if (r < I_IN) { const int kb = r / 168, nb = r % 168; tr_item(a.in[I_WIN], NIN, NIN, kb * 64, nb * 32, WSB(WS_WIN), D, nb * 32, scr, lane); continue; } r -= I_IN;
        if (r < 2 * I_OAB) { const int w = r / I_OAB; r %= I_OAB; const int kb = r / 32, nb = r % 32;
            tr_item(w ? a.in[I_WOB] : a.in[I_WOA], D, D, kb * 64, nb * 32, WSB(WS_WOAB), 512, w * 1024 + nb * 32, scr, lane); continue; } r -= 2 * I_OAB;
        if (r < I_O) { const int kb = r / 32, nb = r % 32; tr_item(a.in[I_WOO], D, D, kb * 64, nb * 32, WSB(WS_WO), D, nb * 32, scr, lane); continue; } r -= I_O;
        if (r < 4 * I_C1) { const int mat = r / I_C1; r %= I_C1; const int kb = r / 4, nb = r % 4;
            tr_item(a.in[I_PW1] + (size_t)mat * 1024 * 128, 128, 128, kb * 64, nb * 32, WSB(WS_WC1), 1024, mat * 128 + nb * 32, scr, lane); continue; } r -= 4 * I_C1;
        if (r < I_CONV) {
            const int b = r >> 10, c = r & 1023; const int page = ((const int*)a.in[I_PT])[b * 128 + (c >> 3)];
            const float* src = a.in[I_CKC] + ((size_t)page * 128 + (c & 7) * 16) * 256 + lane * 4;
            const int kv = lane >> 5, g = (lane >> 4) & 1, d = (lane & 15) * 4;
            bf16* dst = WSB(WS_ACMP) + ((size_t)kv * CROWS + (size_t)(b * NCH_S + c) * 2 + g) * 1024 + d;
#pragma unroll 4
            for (int j = 0; j < 16; ++j) { const f32x4 v = *(const f32x4*)(src + j * 256); v2u o; o.x = pk2(v[0], v[1]); o.y = pk2(v[2], v[3]); *(v2u*)(dst + j * 64) = o; }
            continue; } r -= I_CONV;
        if (r < I_WCP) {
#pragma unroll 4
            for (int i = 0; i < 16; ++i) { const int f = r * 1024 + i * 64 + lane; const int b = f / 32512, i4 = f % 32512;
                *(f32x4*)(a.out + O_KVW_S + (size_t)b * 131072 + (size_t)i4 * 4) = *(const f32x4*)(a.in[I_SKW] + (size_t)b * 131072 + 1024 + (size_t)i4 * 4); }
            continue; } r -= I_WCP;
        { v4u z = {0u, 0u, 0u, 0u}; unsigned char* p = a.ws + WS_KCP + (size_t)r * 4096 + lane * 64;
#pragma unroll
          for (int i = 0; i < 4; ++i) *(v4u*)(p + 16 * i) = z; }
    }
}
DI void ph_u1(const Args& a, int lane, int wave, int G, int bx) {
    const int gw = wave * G + bx, NGW = G * NWAVES; const float* MOD = WSF(WS_MOD); bf16* U = WSB(WS_U);
    for (int row = gw; row < MA; row += NGW) {
        const float* xr = row < MP ? a.in[I_XP] + (size_t)row * D : a.in[I_XS] + (size_t)(row - MP) * D;
        const float* ms = MOD + (size_t)(bb_of_row(row) * 9) * D;
#pragma unroll
        for (int j = 0; j < 4; ++j) { const int col = lane * 4 + 256 * j;
            f32x4 u = {0.f, 0.f, 0.f, 0.f};
            if (row < MR) { const f32x4 x = *(const f32x4*)(xr + col); u = x * (1.0f + *(const f32x4*)(ms + D + col)) + *(const f32x4*)(ms + col); }
            v2u o; o.x = pk2(u[0], u[1]); o.y = pk2(u[2], u[3]); *(v2u*)(U + (size_t)row * D + col) = o; }
    }
}
template <int WHICH> DI void ph_ln(const Args& a, int lane, int wave, int G, int bx) {
    const int gw = wave * G + bx, NGW = G * NWAVES; const float* MOD = WSF(WS_MOD); const float* Z = WSF(WS_Z); bf16* U = WSB(WS_U);
    float* XN = WHICH == 0 ? WSF(WS_X1) : (WHICH == 1 ? WSF(WS_X2) : a.out);
    const float* lg = a.in[I_LNG] + WHICH * D; const float* lb = a.in[I_LNB] + WHICH * D;
    for (int row = gw; row < MA; row += NGW) {
        if (WHICH == 2 && row >= MR) break;
        f32x4 v[4]; float s = 0.f;
#pragma unroll
        for (int j = 0; j < 4; ++j) { v[j] = *(const f32x4*)(Z + (size_t)row * D + lane * 4 + 256 * j); s += (v[j][0] + v[j][1]) + (v[j][2] + v[j][3]); }
        const float mean = wave_sum(s) * (1.0f / D); float s2 = 0.f;
#pragma unroll
        for (int j = 0; j < 4; ++j) { v[j] = v[j] - mean; s2 += (v[j][0] * v[j][0] + v[j][1] * v[j][1]) + (v[j][2] * v[j][2] + v[j][3] * v[j][3]); }
        const float rstd = 1.0f / sqrtf(wave_sum(s2) * (1.0f / D) + LN_EPS);
        const float* ms = MOD + (size_t)(bb_of_row(row) * 9 + 3 * WHICH + 3) * D;
#pragma unroll
        for (int j = 0; j < 4; ++j) { const int col = lane * 4 + 256 * j;
            const f32x4 x = v[j] * rstd * *(const f32x4*)(lg + col) + *(const f32x4*)(lb + col);
            *(f32x4*)(XN + (size_t)row * D + col) = x;
            if (WHICH < 2) { const f32x4 u = x * (1.0f + *(const f32x4*)(ms + D + col)) + *(const f32x4*)(ms + col);
                v2u o; o.x = pk2(u[0], u[1]); o.y = pk2(u[2], u[3]); *(v2u*)(U + (size_t)row * D + col) = o; } }
    }
}

DI float proj_prev(const Args& a, const float* PROJ, int row, int col) {
    if (row < MP) return (row & (T - 1)) ? PROJ[(size_t)(row - 1) * NINP + col] : 0.f;
    const int s = row - MP; return (s & 3) ? PROJ[(size_t)(row - 1) * NINP + col] : a.in[I_SSH][(size_t)(s >> 2) * C_Q + col];
}
DI void ph_dist_rwprep(const Args& a, LAS unsigned char* lds, int tid, int lane, int wave, int G, int bx) {
    const float* PROJ = WSF(WS_PROJ);
    LAS float* vt = (LAS float*)lds;
    LAS float* L = (LAS float*)(lds + 36864);
    for (int it = bx; it < MR / 32; it += G) {
        const int r0 = it * 32;
        __syncthreads();
        {
            const int rr = tid >> 4, seg = tid & 15, row = r0 + rr;
            const float* pr = PROJ + (size_t)row * NINP + C_KV;
            if (row < MP) {
                const int b = row >> 12, t = row & (T - 1);
#pragma unroll
                for (int i = 0; i < 12; ++i) { const int col = 4 * (seg + 16 * i), br = col >> 8, within = col & 255, kv = within >> 7, g = (within >> 6) & 1, d = within & 63;
                    const f32x4 v = *(const f32x4*)(pr + col); v2u pk; pk.x = pk2(v[0], v[1]); pk.y = pk2(v[2], v[3]);
                    if (br == 0) { *(f32x4*)(a.out + O_KVC_P + (size_t)row * 256 + within) = v;
                        *(v2u*)(WSB(WS_ACMP) + ((size_t)kv * CROWS + CROWS_S + (size_t)(b * NCH_P + (t >> 4)) * 2 + g) * 1024 + (t & 15) * 64 + d) = pk; }
                    else { if (br == 1) *(f32x4*)(a.out + O_KVS_P + (size_t)row * 256 + within) = v;
                           else if (t >= T - 512) *(f32x4*)(a.out + O_KVW_P + ((size_t)b * 512 + (t - (T - 512))) * 256 + within) = v;
                           if (kv == 0) *(v2u*)(WSB(br == 1 ? WS_KSEL : WS_KWIN) + ((size_t)(b * 2 + g) * T + t) * 64 + d) = pk;
                           else { LAS float* q = vt + ((br - 1) * 32 + rr) * 132 + g * 64 + d; q[0] = v[0]; q[1] = v[1]; q[2] = v[2]; q[3] = v[3]; } }
                }
                if (t == T - 1) { const float* ps = PROJ + (size_t)row * NINP;
#pragma unroll 4
                    for (int i = 0; i < 28; ++i) *(f32x4*)(a.out + O_SH_P + (size_t)b * C_Q + 4 * (seg + 16 * i)) = *(const f32x4*)(ps + 4 * (seg + 16 * i)); }
            } else {
                const int s = row - MP, b = s >> 2, tq = s & 3;
#pragma unroll
                for (int i = 0; i < 12; ++i) { const int col = 4 * (seg + 16 * i), br = col >> 8, within = col & 255;
                    const f32x4 v = *(const f32x4*)(pr + col);
                    if (br == 0) *(f32x4*)(a.out + O_KVC_S + (size_t)s * 256 + within) = v;
                    else if (br == 1) *(f32x4*)(a.out + O_KVS_S + (size_t)s * 256 + within) = v;
                    else *(f32x4*)(a.out + O_KVW_S + ((size_t)b * 512 + 508 + tq) * 256 + within) = v; }
                if (tq == 3) { const float* ps = PROJ + (size_t)row * NINP;
#pragma unroll 4
                    for (int i = 0; i < 28; ++i) *(f32x4*)(a.out + O_SH_S + (size_t)b * C_Q + 4 * (seg + 16 * i)) = *(const f32x4*)(ps + 4 * (seg + 16 * i)); }
            }
        }
#pragma unroll 4
        for (int i = 0; i < 16; ++i) { const int e = tid + 512 * i, tt = e >> 8, k = e & 255, row = r0 + tt, col = 1536 + k;
            const float p = PROJ[(size_t)row * NINP + col], pp = proj_prev(a, PROJ, row, col); const float xs = p + (pp - p) * a.in[I_MU][col];
            L[k * 36 + tt] = k < 64 ? tanhf(xs) : (k < 128 ? xs : sigmoidf_(xs)); }
        __syncthreads();
        if (r0 < MP) {
            const int gd = tid >> 2, tc = tid & 3, g = gd >> 6, d = gd & 63, b = r0 >> 12, t0 = r0 & (T - 1);
#pragma unroll
            for (int br = 0; br < 2; ++br) { const LAS float* q = vt + (br * 32 + tc * 8) * 132 + gd;
                v4u o; o.x = pk2(q[0], q[132]); o.y = pk2(q[2 * 132], q[3 * 132]); o.z = pk2(q[4 * 132], q[5 * 132]); o.w = pk2(q[6 * 132], q[7 * 132]);
                *(v4u*)(WSB(br == 0 ? WS_VTSEL : WS_VTWIN) + ((size_t)(b * 2 + g) * 64 + d) * T + t0 + tc * 8) = o; }
        }
        {
            const int c = tid;
            float aw[32], aa[32], ag[32];
#pragma unroll
            for (int i = 0; i < 32; ++i) { aw[i] = 0.f; aa[i] = 0.f; ag[i] = 0.f; }
            const float* w2 = a.in[I_W2] + c; const float* a2 = a.in[I_A2] + c; const float* g2 = a.in[I_G2] + c;
            for (int k = 0; k < 64; ++k) { const float w = w2[k * RWW], av = a2[k * RWW];
#pragma unroll
                for (int q = 0; q < 8; ++q) { const f32x4 s = *(const LAS f32x4*)(L + k * 36 + 4 * q), s2 = *(const LAS f32x4*)(L + (64 + k) * 36 + 4 * q);
#pragma unroll
                    for (int e = 0; e < 4; ++e) { aw[4 * q + e] += s[e] * w; aa[4 * q + e] += s2[e] * av; } } }
            for (int k = 0; k < 128; ++k) { const float w = g2[k * RWW];
#pragma unroll
                for (int q = 0; q < 8; ++q) { const f32x4 s = *(const LAS f32x4*)(L + (128 + k) * 36 + 4 * q);
#pragma unroll
                    for (int e = 0; e < 4; ++e) ag[4 * q + e] += s[e] * w; } }
            const float mu_r = a.in[I_MU][c], mu_k = a.in[I_MU][512 + c], mu_v = a.in[I_MU][1024 + c];
            const float w0 = a.in[I_W0][c], a0 = a.in[I_A0][c], kkc = a.in[I_KK][c], kac = a.in[I_KA][c], rkc = a.in[I_RK][c];
            float* RW = WSF(WS_RW);
#pragma unroll
            for (int tt = 0; tt < 32; ++tt) { const int row = r0 + tt; const float* pr = PROJ + (size_t)row * NINP;
                float pr_ = pr[c], pk_ = pr[512 + c], pv_ = pr[1024 + c];
                const float r = pr_ + (proj_prev(a, PROJ, row, c) - pr_) * mu_r, k = pk_ + (proj_prev(a, PROJ, row, 512 + c) - pk_) * mu_k, v = pv_ + (proj_prev(a, PROJ, row, 1024 + c) - pv_) * mu_v;
                const float z = -(w0 + aw[tt]);
                const float sp = fmaxf(z, 0.f) + log1pf(__expf(-fabsf(z)));
                const float decay = __expf(-__expf(-sp - 0.5f));
                const float av = sigmoidf_(a0 + aa[tt]);
                float kk = k * kkc; const float ss = wave_sum(kk * kk); kk *= rsqrtf(fmaxf(ss, 1e-24f));
                const float k2 = k * (1.0f + (av - 1.0f) * kac);
                const float rk = wave_sum(r * k2 * rkc);
                const size_t o = (size_t)row * RWW + c;
                RW[o] = r; RW[RW_STRIDE + o] = decay; RW[2 * RW_STRIDE + o] = k2; RW[3 * RW_STRIDE + o] = v; RW[4 * RW_STRIDE + o] = kk; RW[5 * RW_STRIDE + o] = kk * av;
                WSF(WS_G)[o] = ag[tt]; WSF(WS_BON)[o] = rk * v; }
        }
    }
}

struct StepD { f32x4 r, w, k, kk, b; float v; };
DI void scan_run(const float* RW, float* Y, int rowbase, int nsteps, int h, int i, int lane, const float* s_in, float* s_out) {
    const int j0 = (lane & 15) * 4; const size_t cofs = (size_t)h * 64 + j0, vofs = (size_t)h * 64 + i;
    f32x4 S = s_in ? *(const f32x4*)(s_in + i * 64 + j0) : (f32x4){0.f, 0.f, 0.f, 0.f};
#define SC_LD(sd, t) { const size_t o_ = (size_t)(rowbase + (t)) * RWW; sd.r = *(const f32x4*)(RW + o_ + cofs); sd.w = *(const f32x4*)(RW + RW_STRIDE + o_ + cofs); sd.k = *(const f32x4*)(RW + 2 * RW_STRIDE + o_ + cofs); \
        sd.v = RW[3 * RW_STRIDE + o_ + vofs]; sd.kk = *(const f32x4*)(RW + 4 * RW_STRIDE + o_ + cofs); sd.b = *(const f32x4*)(RW + 5 * RW_STRIDE + o_ + cofs); }
#define SC_DO(sd, t) { float d_ = (S[0] * sd.kk[0] + S[1] * sd.kk[1]) + (S[2] * sd.kk[2] + S[3] * sd.kk[3]); d_ = row16_sum(d_); const float sa_ = -d_; \
        S = S * sd.w + (sa_ * sd.b + sd.v * sd.k); float y_ = (S[0] * sd.r[0] + S[1] * sd.r[1]) + (S[2] * sd.r[2] + S[3] * sd.r[3]); y_ = row16_sum(y_); \
        if ((lane & 15) == 0) Y[(size_t)(rowbase + (t)) * RWW + vofs] = y_; }
    StepD c0, c1, c2, c3, n0, n1, n2, n3;
    SC_LD(c0, 0) SC_LD(c1, 1) SC_LD(c2, 2) SC_LD(c3, 3)
    for (int t = 0; t < nsteps; t += 4) {
        const int tn = (t + 4 < nsteps) ? t + 4 : t;
        SC_LD(n0, tn) SC_LD(n1, tn + 1) SC_LD(n2, tn + 2) SC_LD(n3, tn + 3)
        SC_DO(c0, t) SC_DO(c1, t + 1) SC_DO(c2, t + 2) SC_DO(c3, t + 3)
        c0 = n0; c1 = n1; c2 = n2; c3 = n3;
    }
#undef SC_LD
#undef SC_DO
    *(f32x4*)(s_out + i * 64 + j0) = S;
}
DI void cfinal_worker(const Args& a, int lane, int worker, int nworkers) {
    const int kv = worker & 1; const int NIT = (NBS * NCMP_S + NBP * NCMP_P) * 2;
    float w2c[128];
#pragma unroll
    for (int e = 0; e < 128; ++e) w2c[e] = a.in[I_PW2][(size_t)(kv * 128 + e) * 64 + lane];
    const float pe0 = WSF(WS_PET)[kv * 128 + lane], pe1 = WSF(WS_PET)[kv * 128 + 64 + lane];
    const float* HC = WSF(WS_HC) + (size_t)kv * CROWS * 256;
    for (int j = worker >> 1; j < NIT; j += nworkers >> 1) {
        const int g = j & 1; int q = j >> 1; int b, n, rowlo; const bool smp = q < NBS * NCMP_S;
        if (smp) { b = q / NCMP_S; n = q % NCMP_S; rowlo = (b * NCH_S + n) * 2 + g; } else { q -= NBS * NCMP_S; b = q / NCMP_P; n = q % NCMP_P; rowlo = CROWS_S + (b * NCH_P + n) * 2 + g; }
        const float* lo = HC + (size_t)rowlo * 256; const float* hi = lo + 2 * 256 + 128;
        const float h0 = gelu_tanh(lo[lane] + hi[lane] + pe0), h1 = gelu_tanh(lo[64 + lane] + hi[64 + lane] + pe1);
        float acc = 0.f;
#pragma unroll
        for (int e = 0; e < 64; ++e) acc += __builtin_bit_cast(float, __builtin_amdgcn_readlane(__builtin_bit_cast(int, h0), e)) * w2c[e];
#pragma unroll
        for (int e = 0; e < 64; ++e) acc += __builtin_bit_cast(float, __builtin_amdgcn_readlane(__builtin_bit_cast(int, h1), e)) * w2c[64 + e];
        if (smp) WSF(WS_KCS)[(size_t)kv * KCS_STRIDE + ((size_t)(b * NCMP_S + n) * 2 + g) * 64 + lane] = acc;
        else if (kv == 0) WSB(WS_KCP)[((size_t)(b * 2 + g) * 256 + n) * 64 + lane] = (bf16)f2bf(acc);
        else WSB(WS_VCTP)[((size_t)(b * 2 + g) * 64 + lane) * 256 + n] = (bf16)f2bf(acc);
    }
}
DI void ph_cfinal_sscan(const Args& a, int lane, int wave, int G, int bx) {
    const float* RW = WSF(WS_RW); float* Y = WSF(WS_YS);
    const int worker = wave * G + bx, nworkers = NWAVES * G;
    for (int si = worker; si < 4096; si += nworkers) { const int bh = si >> 4, rg = si & 15, b = bh >> 3, h = bh & 7, i = rg * 4 + (lane >> 4);
        scan_run(RW, Y, MP + b * 4, 4, h, i, lane, a.in[I_SWKV] + (size_t)bh * 4096, a.out + O_WKV_S + (size_t)bh * 4096); }
    cfinal_worker(a, lane, worker, nworkers);
}
constexpr int SCH = 32, SCHF = SCH * 384;
DI void ph_scan_prompt(const Args& a, LAS unsigned char* lds, int tid, int lane, int wave, int G, int bx) {
    const float* RW = WSF(WS_RW); float* Y = WSF(WS_YS);
    LAS float* buf = (LAS float*)lds;
    constexpr int NCH = T / SCH;
    for (int it = bx; it < 256; it += G) {
        const int bh = it >> 3, b = bh >> 3, h = bh & 7, rowbase = b * T;
        __syncthreads();
        if (wave >= 2) {
            const int lt = tid - 128;
            f32x4 ra[8], rb[8];
#define LD_CHUNK(reg, c) { _Pragma("unroll") for (int q = 0; q < 8; ++q) { const int f = lt + 384 * q, aa = f >> 9, rem = f & 511, t_ = rem >> 4, c4 = rem & 15; \
                reg[q] = *(const f32x4*)(RW + (size_t)aa * RW_STRIDE + (size_t)(rowbase + (c) * SCH + t_) * RWW + h * 64 + c4 * 4); } }
#define ST_CHUNK(reg, c) { _Pragma("unroll") for (int q = 0; q < 8; ++q) { const int f = lt + 384 * q, aa = f >> 9, rem = f & 511, t_ = rem >> 4, c4 = rem & 15; \
                *(LAS f32x4*)(buf + ((c) & 1) * SCHF + (t_ * 6 + aa) * 64 + c4 * 4) = reg[q]; } }
            LD_CHUNK(ra, 0) ST_CHUNK(ra, 0)
            LD_CHUNK(rb, 1) LD_CHUNK(ra, 2)
            __syncthreads();
            for (int c = 0; c < NCH; c += 2) {
                ST_CHUNK(rb, c + 1) if (c + 3 < NCH) LD_CHUNK(rb, c + 3)
                __syncthreads();
                if (c + 2 < NCH) ST_CHUNK(ra, c + 2) if (c + 4 < NCH) LD_CHUNK(ra, c + 4)
                __syncthreads();
            }
#undef LD_CHUNK
#undef ST_CHUNK
        } else {
            const int rg = (it & 7) * 2 + wave, i = rg * 4 + (lane >> 4), j0 = (lane & 15) * 4, k16 = lane & 15; const size_t vofs = (size_t)h * 64 + i;
            f32x4 S = {0.f, 0.f, 0.f, 0.f}, rp = {0.f, 0.f, 0.f, 0.f}; float ysel = 0.f;
#define RED2(x_, y_) x_ += dpp_f<0x128>(x_); y_ += dpp_f<0x128>(y_); x_ += dpp_f<0x124>(x_); y_ += dpp_f<0x124>(y_); x_ += dpp_f<0x122>(x_); y_ += dpp_f<0x122>(y_); x_ += dpp_f<0x121>(x_); y_ += dpp_f<0x121>(y_);
            __syncthreads();
            for (int c = 0; c < NCH; ++c) {
                const LAS float* cb = buf + (c & 1) * SCHF; const int tb = c * SCH;
                StepD q0, q1, q2;
#define L_LD(sd, t) { const LAS float* p_ = cb + (t) * 384; sd.r = *(const LAS f32x4*)(p_ + j0); sd.w = *(const LAS f32x4*)(p_ + 64 + j0); sd.k = *(const LAS f32x4*)(p_ + 128 + j0); sd.v = p_[192 + i]; \
                sd.kk = *(const LAS f32x4*)(p_ + 256 + j0); sd.b = *(const LAS f32x4*)(p_ + 320 + j0); }
                L_LD(q0, 0) L_LD(q1, 1)
#pragma unroll
                for (int t = 0; t < SCH; ++t) {
                    if (t + 2 < SCH) L_LD(q2, t + 2)
                    __builtin_amdgcn_sched_barrier(0);
                    float pd = __builtin_fmaf(S[3], q0.kk[3], __builtin_fmaf(S[2], q0.kk[2], __builtin_fmaf(S[1], q0.kk[1], S[0] * q0.kk[0])));
                    float py = __builtin_fmaf(S[3], rp[3], __builtin_fmaf(S[2], rp[2], __builtin_fmaf(S[1], rp[1], S[0] * rp[0])));
                    RED2(pd, py)
                    ysel = (k16 == ((t + 15) & 15)) ? py : ysel;
                    if ((t & 15) == 0 && (t > 0 || c > 0)) Y[(size_t)(rowbase + tb + t - 16 + k16) * RWW + vofs] = ysel;
                    S = S * q0.w + (q0.v * q0.k - pd * q0.b);
                    rp = q0.r;
                    q0 = q1; q1 = q2;
                    __builtin_amdgcn_sched_barrier(0);
                }
#undef L_LD
                __syncthreads();
            }
            { float pd = 0.f, py = (S[0] * rp[0] + S[1] * rp[1]) + (S[2] * rp[2] + S[3] * rp[3]); RED2(pd, py) ysel = (k16 == 15) ? py : ysel; Y[(size_t)(rowbase + T - 16 + k16) * RWW + vofs] = ysel; }
#undef RED2
            *(f32x4*)(a.out + O_WKV_P + (size_t)bh * 4096 + i * 64 + j0) = S;
        }
    }
}

#define MFMA32(a_, b_, c_) __builtin_amdgcn_mfma_f32_32x32x16_bf16((a_), (b_), (c_), 0, 0, 0)
DI int crow(int i, int hh) { return (i & 3) + 8 * (i >> 2) + 4 * hh; }
DI bf16x8 pack8(const f32x4& x0, const f32x4& x1) { v4u p; p.x = pk2(x0[0], x0[1]); p.y = pk2(x0[2], x0[3]); p.z = pk2(x1[0], x1[1]); p.w = pk2(x1[2], x1[3]); return __builtin_bit_cast(bf16x8, p); }
DI f32x16 zero16() { f32x16 z;
#pragma unroll
    for (int i = 0; i < 16; ++i) z[i] = 0.f; return z; }
DI f32x16 qk_tile(const bf16* Kp, const bf16x8 (&qf)[4], int lane) {
    const bf16* kr = Kp + (size_t)(lane & 31) * 64 + 8 * (lane >> 5);
    f32x16 p = zero16();
#pragma unroll
    for (int s = 0; s < 4; ++s) { const bf16x8 kf = *(const bf16x8*)(kr + 16 * s); p = MFMA32(kf, qf[s], p); }
    return p;
}
DI void pack_p(const f32x16& P, bf16x8 (&pf)[2]) {
#pragma unroll
    for (int s = 0; s < 2; ++s) { v4u w; w.x = pk2(P[8 * s], P[8 * s + 1]); w.y = pk2(P[8 * s + 2], P[8 * s + 3]); w.z = pk2(P[8 * s + 4], P[8 * s + 5]); w.w = pk2(P[8 * s + 6], P[8 * s + 7]); pf[s] = __builtin_bit_cast(bf16x8, w); }
}
DI void pv_tile(f32x16 (&o)[2], const bf16* Vt, int ldv, const bf16x8 (&pf)[2], int lane) {
    const int hh = lane >> 5;
#pragma unroll
    for (int s = 0; s < 2; ++s)
#pragma unroll
        for (int db = 0; db < 2; ++db) { const bf16* vr = Vt + (size_t)((lane & 31) + 32 * db) * ldv + 16 * s + 4 * hh;
            const s16x4 lo = *(const s16x4*)vr, hi = *(const s16x4*)(vr + 8);
            const bf16x8 vf = __builtin_shufflevector(lo, hi, 0, 1, 2, 3, 4, 5, 6, 7);
            o[db] = MFMA32(vf, pf[s], o[db]); }
}
DI void osm_step(f32x16& p, unsigned okm, float& m, float& l, f32x16 (&o)[2]) {
    float mx = NEGF;
#pragma unroll
    for (int i = 0; i < 16; ++i) mx = ((okm >> i) & 1u) ? fmaxf(mx, p[i]) : mx;
    mx = fmaxf(mx, __shfl_xor(mx, 32));
    const float mn = fmaxf(m, mx), al = __builtin_amdgcn_exp2f(m - mn);
    l *= al; o[0] = o[0] * al; o[1] = o[1] * al;
#pragma unroll
    for (int i = 0; i < 16; ++i) { const float e = ((okm >> i) & 1u) ? __builtin_amdgcn_exp2f(p[i] - mn) : 0.f; p[i] = e; l += e; }
    m = mn;
}
DI void osm_full(f32x16& p, float& m, float& l, f32x16 (&o)[2]) {
    float mx = fmaxf(fmaxf(fmaxf(p[0], p[1]), fmaxf(p[2], p[3])), fmaxf(fmaxf(p[4], p[5]), fmaxf(p[6], p[7])));
    mx = fmaxf(mx, fmaxf(fmaxf(fmaxf(p[8], p[9]), fmaxf(p[10], p[11])), fmaxf(fmaxf(p[12], p[13]), fmaxf(p[14], p[15]))));
    mx = fmaxf(mx, __shfl_xor(mx, 32));
    if (__ballot(mx > m) != 0ull) { const float mn = fmaxf(m, mx), al = __builtin_amdgcn_exp2f(m - mn); l *= al; o[0] = o[0] * al; o[1] = o[1] * al; m = mn; }
    float ls = 0.f;
#pragma unroll
    for (int i = 0; i < 16; ++i) { const float e = __builtin_amdgcn_exp2f(p[i] - m); p[i] = e; ls += e; }
    l += ls;
}
constexpr int ARING_OFF = 69632, ABUF = 18432, AROW = 144;
template <int BR> DI void attend_blocks(LAS unsigned char* lds, const bf16* Kg, const bf16* Vtg, unsigned long long blkmask, unsigned long long smask,
                                        const bf16x8 (&qf)[4], int q0, int t, int tid, int lane, float& m, float& l, f32x16 (&o)[2]) {
    const int hh = lane >> 5, r = lane & 31, srow = tid >> 3, sch = tid & 7;
    const int nb = __popcll(blkmask);
    if (nb == 0) return;
    unsigned long long rem = blkmask;
    int jb = __ffsll((long long)rem) - 1; rem &= rem - 1;
    v4u kreg = *(const v4u*)(Kg + (size_t)(jb * 64 + srow) * 64 + sch * 8);
    v4u vreg = *(const v4u*)(Vtg + (size_t)srow * T + jb * 64 + sch * 8);
    for (int it = 0; it < nb; ++it) {
        LAS unsigned char* kb = lds + ARING_OFF + (it & 1) * ABUF; LAS unsigned char* vb = kb + 64 * AROW;
        *(LAS v4u*)(kb + srow * AROW + sch * 16) = kreg; *(LAS v4u*)(vb + srow * AROW + sch * 16) = vreg;
        const int jcur = jb;
        __syncthreads();
        if (rem) { jb = __ffsll((long long)rem) - 1; rem &= rem - 1;
            kreg = *(const v4u*)(Kg + (size_t)(jb * 64 + srow) * 64 + sch * 8); vreg = *(const v4u*)(Vtg + (size_t)srow * T + jb * 64 + sch * 8); }
        const bool bit = (BR == 1) ? (((smask >> jcur) & 1ull) != 0ull) : true;
        const unsigned long long bal = (BR == 1) ? __ballot(bit) : ~0ull;
        if (bal != 0ull) {
#pragma unroll
            for (int sub = 0; sub < 2; ++sub) {
                const int k0 = jcur * 64 + sub * 32;
                if (k0 > q0 + 31) break;
                if (BR == 2 && k0 + 31 <= q0 - 512) continue;
                f32x16 p = zero16();
#pragma unroll
                for (int s = 0; s < 4; ++s) { const bf16x8 kf = *(const LAS bf16x8*)(kb + (sub * 32 + r) * AROW + 32 * s + 16 * hh); p = MFMA32(kf, qf[s], p); }
                const bool full = (bal == ~0ull) && (k0 + 31 <= q0) && (BR == 1 || k0 > q0 + 31 - 512);
                if (full) osm_full(p, m, l, o);
                else { unsigned okm = 0u;
#pragma unroll
                    for (int i = 0; i < 16; ++i) { const int key = k0 + crow(i, hh); okm |= (bit && key <= t && (BR == 1 || key > t - 512)) ? (1u << i) : 0u; }
                    osm_step(p, okm, m, l, o); }
                bf16x8 pf[2]; pack_p(p, pf);
#pragma unroll
                for (int s2 = 0; s2 < 2; ++s2)
#pragma unroll
                    for (int db = 0; db < 2; ++db) { const LAS unsigned char* vr = vb + (r + 32 * db) * AROW + 64 * sub + 32 * s2 + 8 * hh;
                        const s16x4 lo = *(const LAS s16x4*)vr, hi = *(const LAS s16x4*)(vr + 16);
                        o[db] = MFMA32(__builtin_shufflevector(lo, hi, 0, 1, 2, 3, 4, 5, 6, 7), pf[s2], o[db]); }
            }
        }
    }
    __syncthreads();
}
constexpr int IMP_LD = 65;
constexpr int SMASK_OFF = 2 * 4 * 32 * IMP_LD * 4;
constexpr int SATT_OFF = 69632;
DI void attn_prompt_unit(const Args& a, LAS unsigned char* lds, int tid, int lane, int wave, int b, int g, int tile) {
    const float* PROJ = WSF(WS_PROJ);
    const int hl = wave & 3, qh = wave >> 2, head = g * 4 + hl, q0 = tile * 64 + qh * 32, r = lane & 31, hh = lane >> 5, t = q0 + r, bg = b * 2 + g;
    const float* prow = PROJ + (size_t)(b * T + t) * NINP;
    bf16x8 qf[4];
    { const float qs = 0.125f * LOG2E;
#pragma unroll
      for (int s = 0; s < 4; ++s) { const float* qp = prow + C_Q + head * 64 + 16 * s + 8 * hh; qf[s] = pack8(*(const f32x4*)qp * qs, *(const f32x4*)(qp + 4) * qs); } }
    const float g0 = sigmoidf_(prow[C_GATE + head * 3]), g1 = sigmoidf_(prow[C_GATE + head * 3 + 1]), g2 = sigmoidf_(prow[C_GATE + head * 3 + 2]);
    f32x16 of[2]; of[0] = zero16(); of[1] = zero16();
    LAS float* sImp = (LAS float*)lds; LAS unsigned long long* sMask = (LAS unsigned long long*)(lds + SMASK_OFF);
    {
        const bf16* Kc = WSB(WS_KCP) + (size_t)bg * 256 * 64; const bf16* Vct = WSB(WS_VCTP) + (size_t)bg * 64 * 256;
        const int tmax = q0 + 31, nvis = tmax >= 31 ? (tmax - 31) / 16 + 1 : 0, ntile = (nvis + 31) >> 5;
        float m = NEGF, l = 0.f;
        for (int kt = 0; kt < ntile; ++kt) {
            const f32x16 p = qk_tile(Kc + (size_t)kt * 32 * 64, qf, lane);
            float mx = NEGF;
#pragma unroll
            for (int i = 0; i < 16; ++i) { const int n = kt * 32 + crow(i, hh); mx = (16 * n + 31 <= t) ? fmaxf(mx, p[i]) : mx; }
            mx = fmaxf(mx, __shfl_xor(mx, 32));
            const float mn = fmaxf(m, mx); l *= __builtin_amdgcn_exp2f(m - mn);
#pragma unroll
            for (int i = 0; i < 16; ++i) { const int n = kt * 32 + crow(i, hh); l += (16 * n + 31 <= t) ? __builtin_amdgcn_exp2f(p[i] - mn) : 0.f; }
            m = mn;
        }
        l += __shfl_xor(l, 32);
        const float inv = l > 0.f ? 1.0f / l : 0.f;
        LAS float* slab = sImp + (size_t)((qh * 4 + hl) * 32 + r) * IMP_LD;
#pragma unroll
        for (int blk = 0; blk < 2; ++blk) {
            f32x16 im = zero16();
            const int kt0 = blk == 0 ? 0 : 3, kt1 = blk == 0 ? (ntile < 4 ? ntile : 4) : ntile;
            for (int kt = kt0; kt < kt1; ++kt) {
                f32x16 p = qk_tile(Kc + (size_t)kt * 32 * 64, qf, lane);
#pragma unroll
                for (int i = 0; i < 16; ++i) { const int n = kt * 32 + crow(i, hh); p[i] = (16 * n + 31 <= t) ? __builtin_amdgcn_exp2f(p[i] - m) * inv : 0.f; }
                bf16x8 pf[2]; pack_p(p, pf);
                if (blk == 0 || kt >= 4) pv_tile(of, Vct + kt * 32, 256, pf, lane);
                const int jb = r + 32 * blk;
#pragma unroll
                for (int s = 0; s < 2; ++s) { bf16x8 af;
#pragma unroll
                    for (int j = 0; j < 8; ++j) { const int n = kt * 32 + 16 * s + 8 * (j >> 2) + 4 * hh + (j & 3); af[j] = (n >= 4 * jb - 1 && n <= 4 * jb + 3) ? (short)0x3F80 : (short)0; }
                    im = MFMA32(af, pf[s], im); }
            }
#pragma unroll
            for (int i = 0; i < 16; ++i) slab[32 * blk + crow(i, hh)] = im[i];
        }
        of[0] = of[0] * g0; of[1] = of[1] * g0;
    }
    __syncthreads();
    for (int e = 0; e < 8; ++e) {
        const int qq = wave * 8 + e, qh2 = qq >> 5, rq = qq & 31, tq = tile * 64 + qq, cur = tq >> 6;
        float s = 0.f;
#pragma unroll
        for (int h2 = 0; h2 < 4; ++h2) s += sImp[(size_t)((qh2 * 4 + h2) * 32 + rq) * IMP_LD + lane];
        const float v = lane > cur ? -1e9f : ((lane == 0 || lane == cur || lane == cur - 1) ? 1e9f : s);
        int rank = 0;
#pragma unroll 16
        for (int j = 0; j < 64; ++j) { const float vj = __builtin_bit_cast(float, __builtin_amdgcn_readlane(__builtin_bit_cast(int, v), j)); rank += (vj > v || (vj == v && j < lane)) ? 1 : 0; }
        const unsigned long long mask = __ballot(rank < 16 && lane <= cur);
        if (lane == 0) sMask[qq] = mask;
    }
    __syncthreads();
    const unsigned long long smask = sMask[qh * 32 + r];
    __syncthreads();
    LAS float* park = (LAS float*)lds + wave * 2048 + lane;
#pragma unroll
    for (int db = 0; db < 2; ++db)
#pragma unroll
        for (int i = 0; i < 16; ++i) park[(db * 16 + i) * 64] = of[db][i];
    {
        float m = NEGF, l = 0.f; f32x16 o[2]; o[0] = zero16(); o[1] = zero16();
        const unsigned long long blk = (tile >= 63) ? ~0ull : ((1ull << (tile + 1)) - 1ull);
        attend_blocks<1>(lds, WSB(WS_KSEL) + (size_t)bg * T * 64, WSB(WS_VTSEL) + (size_t)bg * 64 * T, blk, smask, qf, q0, t, tid, lane, m, l, o);
        l += __shfl_xor(l, 32); const float sc = l > 0.f ? g1 / l : 0.f;
#pragma unroll
        for (int db = 0; db < 2; ++db)
#pragma unroll
            for (int i = 0; i < 16; ++i) park[(db * 16 + i) * 64] += o[db][i] * sc;
    }
    {
        float m = NEGF, l = 0.f; f32x16 o[2]; o[0] = zero16(); o[1] = zero16();
        const unsigned long long hi_ = (tile >= 63) ? ~0ull : ((1ull << (tile + 1)) - 1ull), lo_ = (tile >= 8) ? ((1ull << (tile - 8)) - 1ull) : 0ull;
        attend_blocks<2>(lds, WSB(WS_KWIN) + (size_t)bg * T * 64, WSB(WS_VTWIN) + (size_t)bg * 64 * T, hi_ & ~lo_, 0ull, qf, q0, t, tid, lane, m, l, o);
        l += __shfl_xor(l, 32); const float sc = l > 0.f ? g2 / l : 0.f;
#pragma unroll
        for (int db = 0; db < 2; ++db)
#pragma unroll
            for (int i = 0; i < 16; ++i) of[db][i] = park[(db * 16 + i) * 64] + o[db][i] * sc;
    }
    bf16* yb = WSB(WS_AST) + (size_t)(MA + b * T + t) * RWW + head * 64;
#pragma unroll
    for (int db = 0; db < 2; ++db)
#pragma unroll
        for (int gq = 0; gq < 4; ++gq) { v2u w; w.x = pk2(of[db][4 * gq], of[db][4 * gq + 1]); w.y = pk2(of[db][4 * gq + 2], of[db][4 * gq + 3]); *(v2u*)(yb + 32 * db + 8 * gq + 4 * hh) = w; }
}

constexpr int SA_SC = 0, SA_VP = 16384, SA_QV = 24576, SA_RED = 25600, SA_PACC = 26112, SA_IV = 34304, SA_LST = 35392, SA_CNT = 35456, SA_OUT = 35520;
template <int BR> DI void sa_branch_wg(const Args& a, LAS unsigned char* lds, int tid, int lane, int wave, int b, int g, int qpos, int nk, const float* pnew, float g_h0, float g_h1, float g_h2, float g_h3, float (&inv)[4]) {
    LAS float* sc = (LAS float*)(lds + SA_SC); LAS unsigned long long* vptr = (LAS unsigned long long*)(lds + SA_VP); const LAS float* qv = (const LAS float*)(lds + SA_QV);
    LAS float* red = (LAS float*)(lds + SA_RED); LAS float* pacc = (LAS float*)(lds + SA_PACC); const LAS int* lst = (const LAS int*)(lds + SA_LST); LAS float* outb = (LAS float*)(lds + SA_OUT);
    for (int idx = tid; idx < nk; idx += 512) {
        const float* kr; bool ok = true;
        if (BR == 0) kr = WSF(WS_KCS) + ((size_t)(b * NCMP_S + idx) * 2 + g) * 64;
        else if (BR == 1) { if (idx < 960) { const int blk = lst[idx >> 6]; const int page = ((const int*)a.in[I_PT])[b * 128 + (blk >> 1)]; kr = a.in[I_CKS] + ((size_t)page * 128 + (blk & 1) * 64 + (idx & 63)) * 256 + g * 64; }
                            else { kr = pnew + (size_t)(idx - 960) * NINP + 256 + g * 64; ok = (16384 + idx - 960) <= qpos; } }
        else { if (idx < 512) { kr = a.in[I_SKW] + ((size_t)b * 512 + idx) * 256 + g * 64; ok = (15872 + idx) >= qpos - 511; }
               else { kr = pnew + (size_t)(idx - 512) * NINP + 512 + g * 64; ok = (16384 + idx - 512) <= qpos; } }
        vptr[idx] = (unsigned long long)(BR == 0 ? kr + KCS_STRIDE : kr + 128);
        float s0 = 0.f, s1 = 0.f, s2 = 0.f, s3 = 0.f;
#pragma unroll 8
        for (int d4 = 0; d4 < 16; ++d4) { const f32x4 kv = *(const f32x4*)(kr + 4 * d4);
            const f32x4 q0 = *(const LAS f32x4*)(qv + 4 * d4), q1 = *(const LAS f32x4*)(qv + 64 + 4 * d4), q2 = *(const LAS f32x4*)(qv + 128 + 4 * d4), q3 = *(const LAS f32x4*)(qv + 192 + 4 * d4);
            s0 += (kv[0] * q0[0] + kv[1] * q0[1]) + (kv[2] * q0[2] + kv[3] * q0[3]); s1 += (kv[0] * q1[0] + kv[1] * q1[1]) + (kv[2] * q1[2] + kv[3] * q1[3]);
            s2 += (kv[0] * q2[0] + kv[1] * q2[1]) + (kv[2] * q2[2] + kv[3] * q2[3]); s3 += (kv[0] * q3[0] + kv[1] * q3[1]) + (kv[2] * q3[2] + kv[3] * q3[3]); }
        *(LAS f32x4*)(sc + (size_t)idx * 4) = ok ? (f32x4){s0, s1, s2, s3} : (f32x4){NEGF, NEGF, NEGF, NEGF};
    }
    __syncthreads();
    float mx[4] = {NEGF, NEGF, NEGF, NEGF};
    for (int idx = lane; idx < nk; idx += 64) { const f32x4 v = *(const LAS f32x4*)(sc + (size_t)idx * 4);
#pragma unroll
        for (int h = 0; h < 4; ++h) mx[h] = fmaxf(mx[h], v[h]); }
#pragma unroll
    for (int h = 0; h < 4; ++h) mx[h] = wave_max(mx[h]);
    __syncthreads();
    float sm[4] = {0.f, 0.f, 0.f, 0.f};
    for (int idx = tid; idx < nk; idx += 512) { const f32x4 v = *(const LAS f32x4*)(sc + (size_t)idx * 4); f32x4 e;
#pragma unroll
        for (int h = 0; h < 4; ++h) { e[h] = v[h] > -1e29f ? __expf(v[h] - mx[h]) : 0.f; sm[h] += e[h]; }
        *(LAS f32x4*)(sc + (size_t)idx * 4) = e; }
#pragma unroll
    for (int h = 0; h < 4; ++h) { sm[h] = wave_sum(sm[h]); if (lane == 0) red[wave * 4 + h] = sm[h]; }
    __syncthreads();
#pragma unroll
    for (int h = 0; h < 4; ++h) { float t_ = 0.f;
#pragma unroll
        for (int w = 0; w < 8; ++w) t_ += red[w * 4 + h];
        inv[h] = 1.0f / fmaxf(t_, 1e-30f); }
    const int kpw = (nk + 7) >> 3, kbeg = wave * kpw, kend = (kbeg + kpw < nk) ? kbeg + kpw : nk;
    float acc[4] = {0.f, 0.f, 0.f, 0.f};
#pragma unroll 16
    for (int idx = kbeg; idx < kend; ++idx) { const float* vr = (const float*)vptr[idx]; const float vv = vr[lane]; const f32x4 pp = *(const LAS f32x4*)(sc + (size_t)idx * 4);
        acc[0] += pp[0] * vv; acc[1] += pp[1] * vv; acc[2] += pp[2] * vv; acc[3] += pp[3] * vv; }
#pragma unroll
    for (int h = 0; h < 4; ++h) pacc[(wave * 4 + h) * 64 + lane] = acc[h];
    __syncthreads();
    if (tid < 256) { const int h = tid >> 6; float o = 0.f;
#pragma unroll
        for (int w = 0; w < 8; ++w) o += pacc[(w * 4 + h) * 64 + lane];
        const float gsel = h == 0 ? g_h0 : (h == 1 ? g_h1 : (h == 2 ? g_h2 : g_h3));
        outb[tid] = (BR == 0 ? 0.f : outb[tid]) + gsel * o * inv[h]; }
}
DI void attn_sample_wg(const Args& a, LAS unsigned char* lds, int tid, int lane, int wave, int item) {
    const float* PROJ = WSF(WS_PROJ);
    const int b = item >> 3, g = (item >> 2) & 1, q = item & 3, row = MP + b * 4 + q, qpos = 16384 + q;
    const float* prow = PROJ + (size_t)row * NINP; const float* pnew = PROJ + (size_t)(MP + b * 4) * NINP + C_KV;
    LAS float* sc = (LAS float*)(lds + SA_SC); LAS float* qv = (LAS float*)(lds + SA_QV); LAS float* iv = (LAS float*)(lds + SA_IV); LAS int* lst = (LAS int*)(lds + SA_LST); LAS int* cntw = (LAS int*)(lds + SA_CNT);
    const LAS float* outb = (const LAS float*)(lds + SA_OUT);
    __syncthreads();
    if (tid < 256) qv[tid] = prow[C_Q + g * 256 + tid] * 0.125f;
    float gt[4][3];
#pragma unroll
    for (int h = 0; h < 4; ++h)
#pragma unroll
        for (int br = 0; br < 3; ++br) gt[h][br] = sigmoidf_(prow[C_GATE + (g * 4 + h) * 3 + br]);
    __syncthreads();
    float inv[4];
    sa_branch_wg<0>(a, lds, tid, lane, wave, b, g, qpos, NCMP_S, pnew, gt[0][0], gt[1][0], gt[2][0], gt[3][0], inv);
    float val = 0.f; bool cand = tid <= 256;
    if (cand) { float s = 0.f;
        for (int n = 4 * tid - 1; n <= 4 * tid + 3; ++n) if (n >= 0 && n < NCMP_S) { const f32x4 p = *(const LAS f32x4*)(sc + (size_t)n * 4); s += (p[0] * inv[0] + p[1] * inv[1]) + (p[2] * inv[2] + p[3] * inv[3]); }
        val = (tid == 0 || tid == 255 || tid == 256) ? 1e9f : s; iv[tid] = val; }
    __syncthreads();
    int rank = 0;
    if (cand) for (int y = 0; y <= 256; ++y) { const float vy = iv[y]; rank += (vy > val || (vy == val && y < tid)) ? 1 : 0; }
    const bool sel = cand && rank < 16; const unsigned long long bal = __ballot(sel);
    if (lane == 0) cntw[wave] = __popcll(bal);
    __syncthreads();
    { int pos = __popcll(bal & ((1ull << lane) - 1ull)); for (int w = 0; w < wave; ++w) pos += cntw[w]; if (sel) lst[pos] = tid; }
    __syncthreads();
    sa_branch_wg<1>(a, lds, tid, lane, wave, b, g, qpos, 964, pnew, gt[0][1], gt[1][1], gt[2][1], gt[3][1], inv);
    __syncthreads();
    sa_branch_wg<2>(a, lds, tid, lane, wave, b, g, qpos, 516, pnew, gt[0][2], gt[1][2], gt[2][2], gt[3][2], inv);
    __syncthreads();
    if (tid < 256) WSB(WS_AST)[(size_t)(MA + row) * RWW + g * 256 + tid] = (bf16)f2bf(outb[tid]);
}
DI void rwpost_items(const Args& a, int lane, int wave, int G, int bx) {
    const int gw = wave * G + bx, NGW = G * NWAVES;
    for (int it = gw; it < MR * 8; it += NGW) { const int row = it >> 3, c = (it & 7) * 64 + lane; const size_t o = (size_t)row * RWW + c;
        const float y = WSF(WS_YS)[o]; const float mean = wave_sum(y) * (1.0f / 64.0f); const float dlt = y - mean; const float var = wave_sum(dlt * dlt) * (1.0f / 64.0f);
        const float yn = dlt * rsqrtf(var + GN_EPS) * a.in[I_LNW][c] + a.in[I_LNBB][c];
        WSB(WS_AST)[o] = (bf16)f2bf((yn + WSF(WS_BON)[o]) * WSF(WS_G)[o]); }
}
DI void ph_attention(const Args& a, LAS unsigned char* lds, int tid, int lane, int wave, int G, int bx) {
    for (int i = 0; i < 4; ++i) {
        const int base = (i >> 1) * G, u0 = base + bx; if (u0 >= 256) break;
        const int u = (i & 1) ? 511 - u0 : u0;
        __syncthreads();
        attn_prompt_unit(a, lds, tid, lane, wave, u >> 7, (u >> 6) & 1, u & 63);
    }
    for (int it = bx; it < 256; it += G) attn_sample_wg(a, lds, tid, lane, wave, it);
    rwpost_items(a, lane, wave, G, bx);
}

constexpr int N_PHASES = 17;
#ifndef PROBE_MASK
#define PROBE_MASK 0
#endif
#ifndef ONLY_PHASE
#define ONLY_PHASE (-1)
#endif
#ifndef MK_PER_PHASE
#define MK_PER_PHASE 0
#endif
__global__ void __launch_bounds__(NWAVES * 64, 2) fwd_kernel(Args a) {
    extern __shared__ __attribute__((aligned(16))) unsigned char lds_raw[];
    LAS unsigned char* lds = (LAS unsigned char*)lds_raw;
    const int tid = threadIdx.x, lane = tid & 63, wave = __builtin_amdgcn_readfirstlane(tid >> 6), G = gridDim.x, bx = blockIdx.x;
    for (int u = tid; u < (LDS_BYTES - LDSCTL_OFF) / 4; u += NWAVES * 64) ((LAS unsigned*)(lds + LDSCTL_OFF))[u] = 0u;
    __syncthreads();
    volatile LAS unsigned* MISC = (volatile LAS unsigned*)(lds + MISC_OFF);
    unsigned* ctl = (unsigned*)(a.ws + WS_CTL);
    XcdBarrier bar; bar.bar = ctl + CW_BAR; bar.x = 0; bar.st = nullptr;
    if (!MK_PER_PHASE) bar = xcd_barrier_post(ctl + CW_BAR, MISC + 8);
    const int lo = a.ph_lo, hi = a.ph_hi;
#define IN(k) (lo <= (k) && (k) < hi)
#define SEAM(k) do { if (IN(k) && IN((k) + 1)) xcd_barrier(bar); } while (0)
#define RUN(k, ...) do { if (IN(k) && (ONLY_PHASE < 0 || ONLY_PHASE == (k))) { __VA_ARGS__ if ((PROBE_MASK >> (k)) & 1) { xcd_barrier(bar); __VA_ARGS__ } } } while (0)
    LAS unsigned char* ring = lds + RING_OFF;
    RUN(0, ph_prologue(a, lds, tid, lane, wave, G, bx););
    SEAM(0);
    RUN(1, ph_u1(a, lane, wave, G, bx););
    SEAM(1);
    RUN(2, { pg8::Gemm g{WSB(WS_U), WSB(WS_WGU), MA, 5632, D}; pg8::StaticOrder S; S.init(MA, 5632, G, bx); pg8::EpiSwiglu E{WSB(WS_H)}; pg8::gemm_phase<pg8::EpiSwiglu, pg8::StaticOrder, true, true>(ring, g, S, E); });
    SEAM(2);
    RUN(3, { pg8::Gemm g{WSB(WS_H), WSB(WS_WDN), MA, D, FF}; pg8::StaticOrder S; S.init(MA, D, G, bx); pg8::EpiResid E{a.in[I_XP], a.in[I_XS], WSF(WS_MOD), 2, 0.5f, WSF(WS_Z)}; pg8::gemm_phase<pg8::EpiResid, pg8::StaticOrder, true, true>(ring, g, S, E); });
    SEAM(3);
    RUN(4, ph_ln<0>(a, lane, wave, G, bx););
    SEAM(4);
    RUN(5, { pg8::Gemm g{WSB(WS_U), WSB(WS_WIN), MA, NINP, D}; pg8::StaticOrder S; S.init(MA, NINP, G, bx); pg8::EpiProj E{a.in[I_BIN], WSF(WS_PROJ)}; pg8::gemm_phase<pg8::EpiProj, pg8::StaticOrder, true, true>(ring, g, S, E); });
    SEAM(5);
    RUN(6, ph_dist_rwprep(a, lds, tid, lane, wave, G, bx););
    SEAM(6);
    RUN(7, { pg8::Gemm g{WSB(WS_ACMP), WSB(WS_WC1), 2 * CROWS, 512, 1024}; pg8::DiagOrder S{CROWS / 256, 1, 2, G, bx}; pg8::EpiF32 E{WSF(WS_HC), 256, 0}; pg8::gemm_phase<pg8::EpiF32, pg8::DiagOrder, true, true>(ring, g, S, E); });
    SEAM(7);
    RUN(8, ph_cfinal_sscan(a, lane, wave, G, bx););
    SEAM(8);
    RUN(9, ph_scan_prompt(a, lds, tid, lane, wave, G, bx););
    SEAM(9);
    RUN(10, ph_attention(a, lds, tid, lane, wave, G, bx););
    SEAM(10);
    RUN(11, { pg8::Gemm g{WSB(WS_AST), WSB(WS_WOAB), 2 * MA, 2048, 512}; pg8::PairOrder S{MA / 256, 4, G, bx}; pg8::EpiOutAB E{WSF(WS_PROJ), WSF(WS_M1), WSB(WS_MIN), MA / 256}; pg8::gemm_phase<pg8::EpiOutAB, pg8::PairOrder, true, true>(ring, g, S, E); });
    SEAM(11);
    RUN(12, { pg8::Gemm g{WSB(WS_MIN), WSB(WS_WO), MA, D, D}; pg8::StaticOrder S; S.init(MA, D, G, bx); pg8::EpiResid E{WSF(WS_X1), WSF(WS_X1) + (size_t)MP * D, WSF(WS_MOD), 5, 1.0f, WSF(WS_Z)}; pg8::gemm_phase<pg8::EpiResid, pg8::StaticOrder, true, true>(ring, g, S, E); });
    SEAM(12);
    RUN(13, ph_ln<1>(a, lane, wave, G, bx););
    SEAM(13);
    RUN(14, { pg8::Gemm g{WSB(WS_U), WSB(WS_WGU) + (size_t)5632 * D, MA, 5632, D}; pg8::StaticOrder S; S.init(MA, 5632, G, bx); pg8::EpiSwiglu E{WSB(WS_H)}; pg8::gemm_phase<pg8::EpiSwiglu, pg8::StaticOrder, true, true>(ring, g, S, E); });
    SEAM(14);
    RUN(15, { pg8::Gemm g{WSB(WS_H), WSB(WS_WDN) + (size_t)D * FF, MA, D, FF}; pg8::StaticOrder S; S.init(MA, D, G, bx); pg8::EpiResid E{WSF(WS_X2), WSF(WS_X2) + (size_t)MP * D, WSF(WS_MOD), 8, 0.5f, WSF(WS_Z)}; pg8::gemm_phase<pg8::EpiResid, pg8::StaticOrder, true, true>(ring, g, S, E); });
    SEAM(15);
    RUN(16, ph_ln<2>(a, lane, wave, G, bx););
#undef IN
#undef SEAM
}

extern "C" void kernel_launch(void* const* d_in, const int* in_sizes, int n_in, void* d_out, int out_size, void* d_ws, size_t ws_size, hipStream_t stream) {
    static int grid = 0;
    if (grid == 0) {
        if (n_in != N_IN || (size_t)out_size != O_END || ws_size < WS_END) { fprintf(stderr, "kernel_launch: unexpected shapes: n_in %d out %d ws %zu (need %zu)\n", n_in, out_size, ws_size, (size_t)WS_END); grid = -1; return; }
        int dev = 0, cus = 0, per_cu = 0;
        if (hipGetDevice(&dev) != hipSuccess || hipDeviceGetAttribute(&cus, hipDeviceAttributeMultiprocessorCount, dev) != hipSuccess) { grid = -1; return; }
        if (hipFuncSetAttribute((const void*)fwd_kernel, hipFuncAttributeMaxDynamicSharedMemorySize, LDS_BYTES) != hipSuccess) { fprintf(stderr, "kernel_launch: hipFuncSetAttribute failed\n"); grid = -1; return; }
        if (hipOccupancyMaxActiveBlocksPerMultiprocessor(&per_cu, (const void*)fwd_kernel, NWAVES * 64, LDS_BYTES) != hipSuccess || per_cu < 1)
            fprintf(stderr, "kernel_launch: note: occupancy query reports %d workgroups per CU\n", per_cu);
        (void)hipGetLastError();
        grid = cus;
    }
    if (grid < 0) return;
    if (hipMemsetAsync((char*)d_ws + WS_CTL, 0, CTL_ZERO_BYTES, stream) != hipSuccess) return;
    Args a{};
    for (int i = 0; i < N_IN; ++i) a.in[i] = (const float*)d_in[i];
    a.out = (float*)d_out; a.ws = (unsigned char*)d_ws;
#if MK_PER_PHASE
    for (int p = 0; p < N_PHASES; ++p) { a.ph_lo = p; a.ph_hi = p + 1; hipLaunchKernelGGL(fwd_kernel, dim3(grid), dim3(NWAVES * 64), LDS_BYTES, stream, a); }
#else
    a.ph_lo = 0; a.ph_hi = N_PHASES;
    hipLaunchKernelGGL(fwd_kernel, dim3(grid), dim3(NWAVES * 64), LDS_BYTES, stream, a);
#endif
    const hipError_t le = hipPeekAtLastError();
    if (le != hipSuccess) fprintf(stderr, "kernel_launch: launch failed: %s\n", hipGetErrorName(le));
}
```

```cpp
#include <hip/hip_runtime.h>
#include <cstdio>
#include <cstdint>
#define DI __device__ __forceinline__
constexpr int D = 1024, FF = 2816, T = 4096, NBP = 4, NBS = 32, ST = 4;
constexpr int MP = NBP * T;
constexpr int MS = NBS * ST;
constexpr int MR = MP + MS;
constexpr int MA = 16640;
constexpr int NIN = 5144, NINP = 5376;
constexpr int C_Q = 1792, C_KV = 2304, C_GATE = 3072, C_MERGE = 3096;
constexpr int RWW = 512;
constexpr int NCH_S = 1024, NCH_P = 256;
constexpr int NCMP_S = 1023, NCMP_P = 255;
constexpr int CROWS_S = NBS * NCH_S * 2;
constexpr int CROWS = CROWS_S + NBP * NCH_P * 2;
constexpr float ALPHA = 1.189207115002721f;
constexpr float LN_EPS = 1e-5f, GN_EPS = 64e-5f;
constexpr float LOG2E = 1.4426950408889634f;
constexpr float NEGF = -1e30f;
constexpr size_t O_Y = 0;
constexpr size_t O_KVC_P = 16908288, O_KVS_P = 21102592, O_KVW_P = 25296896, O_WKV_P = 25821184, O_SH_P = 25952256;
constexpr size_t O_KVC_S = 25959424, O_KVS_S = 25992192, O_KVW_S = 26024960, O_WKV_S = 30219264, O_SH_S = 31267840, O_END = 31325184;
DI int bb_of_row(int row) { return row < MP ? (row >> 12) : (row < MR ? 4 + ((row - MP) >> 2) : 35); }
namespace pg8 {
#define PG8_LAS __attribute__((address_space(3)))
typedef unsigned short bf16_t;
typedef short bf16x8 __attribute__((ext_vector_type(8)));
typedef float f32x4 __attribute__((ext_vector_type(4)));
typedef unsigned u32x4 __attribute__((ext_vector_type(4)));
constexpr int BM = 256, BK = 64, HALF = 128, HTB = HALF * BK * 2  , STAGE_BYTES = 8 * HTB, NXCD = 8, WGM = 8;

__host__ __device__ __forceinline__ int lds_byte(int r, int c) { const int st = (r >> 4) * 2 + (c >> 5), rr = r & 15, cc = c & 31, ob = rr * 64 + cc * 2; return st * 1024 + (ob ^ (((ob >> 9) & 1) << 5)); }
__host__ __device__ __forceinline__ void stage_rc(int b, int& R, int& C) { const int st = b / 1024, sb = b % 1024, swz = sb ^ (((sb >> 9) & 1) << 5); R = (st >> 1) * 16 + swz / 64; C = (st & 1) * 32 + (swz % 64) / 2; }
__host__ __device__ __forceinline__ int perm32(int rho) { const int n = rho >> 4, i = rho & 15; return 8 * (i >> 2) + 4 * n + (i & 3); }

struct Unit { int pm, pn; };
struct Gemm { const bf16_t* A; const bf16_t* Bt; int M, N, K; };

struct StaticOrder {
    int nM, nN, nwg, G, c;
    __host__ __device__ void init(int M, int N, int G_, int c_) { nM = M / BM; nN = N / BM; nwg = nM * nN; G = G_; c = c_; }
    __host__ __device__ bool next(int i, Unit& u) const {
        const long L = (long)i * G + c; if (L >= nwg) return false;
        int wgid = (int)L; { const int q = nwg / NXCD, r = nwg % NXCD, xcd = wgid % NXCD, off = wgid / NXCD; wgid = (xcd < r ? xcd * (q + 1) : r * (q + 1) + (xcd - r) * q) + off; }
        const int nig = WGM * nN, gid = wgid / nig, fm = gid * WGM, gsz = (nM - fm) < WGM ? (nM - fm) : WGM;
        u.pm = fm + ((wgid % nig) % gsz); u.pn = (wgid % nig) / gsz; return true;
    }
    __device__ __forceinline__ void a_ready(const Unit&) const {}
    __device__ __forceinline__ void done(const Unit&) const {}
};

struct PairOrder {
    int nm, nn, G, c;
    __device__ __forceinline__ bool next(int i, Unit& u) const {
        const int tile = (i >> 1) * G + c; if (tile >= nm * nn) return false;
        const int rep = i & 1; u.pm = tile / nn + rep * nm; u.pn = tile % nn + rep * nn; return true;
    }
    __device__ __forceinline__ void a_ready(const Unit&) const {}
    __device__ __forceinline__ void done(const Unit&) const {}
};
struct DiagOrder {
    int nm, nn, nrep, G, c;
    __device__ __forceinline__ bool next(int i, Unit& u) const {
        const int L = i * G + c; if (L >= nrep * nm * nn) return false;
        const int rep = L / (nm * nn), rem = L % (nm * nn); u.pm = rem / nn + rep * nm; u.pn = rem % nn + rep * nn; return true;
    }
    __device__ __forceinline__ void a_ready(const Unit&) const {}
    __device__ __forceinline__ void done(const Unit&) const {}
};

typedef float f32x2 __attribute__((ext_vector_type(2)));
typedef __bf16 bf16x2_t __attribute__((ext_vector_type(2)));
__device__ __forceinline__ unsigned cvt_pk_bf16(float lo, float hi) { f32x2 v = {lo, hi}; bf16x2_t b = __builtin_convertvector(v, bf16x2_t); return __builtin_bit_cast(unsigned, b); }
__device__ __forceinline__ float fast_sigmoid(float x) { return __builtin_amdgcn_rcpf(1.0f + __builtin_amdgcn_exp2f(-x * LOG2E)); }

struct EpiSwiglu {
    static constexpr bool PERM = true, AFTER_DRAIN = false;
    bf16_t* H;
    __device__ __forceinline__ void operator()(const f32x4 (&acc)[2][2][4][2], const Unit& u, int wr, int wc, int fr, int fq) const {
        const int row0 = u.pm * BM + wr * 64 + fr, hc0 = u.pn * HALF + wc * 32 + 8 * fq;
#pragma unroll
        for (int ai = 0; ai < 2; ++ai)
#pragma unroll
            for (int m = 0; m < 4; ++m) {
                bf16_t* rowp = H + (size_t)(row0 + ai * HALF + m * 16) * FF + hc0;
                float h[8];
#pragma unroll
                for (int n = 0; n < 2; ++n)
#pragma unroll
                    for (int e = 0; e < 4; ++e) { const float g = acc[ai][0][m][n][e], up = acc[ai][1][m][n][e]; h[4 * n + e] = g * fast_sigmoid(g) * up; }
                u32x4 w; w.x = cvt_pk_bf16(h[0], h[1]); w.y = cvt_pk_bf16(h[2], h[3]); w.z = cvt_pk_bf16(h[4], h[5]); w.w = cvt_pk_bf16(h[6], h[7]);
                *(u32x4*)rowp = w;
            }
    }
};
struct EpiResid {
    static constexpr bool PERM = false, AFTER_DRAIN = false;
    const float* xp; const float* xs; const float* mod; int slot; float coef; float* Z;
    __device__ __forceinline__ void operator()(const f32x4 (&acc)[2][2][4][2], const Unit& u, int wr, int wc, int fr, int fq) const {
        const int row0 = u.pm * BM + wr * 64 + fr, col0 = u.pn * BM + wc * 32 + 4 * fq;
#pragma unroll
        for (int ai = 0; ai < 2; ++ai)
#pragma unroll
            for (int m = 0; m < 4; ++m) {
                const int row = row0 + ai * HALF + m * 16; const bool valid = row < MR;
                const float* xr = row < MP ? xp + (size_t)row * D : xs + (size_t)(row - MP) * D;
                const float* mr = mod + (size_t)(bb_of_row(row) * 9 + slot) * D;
#pragma unroll
                for (int bj = 0; bj < 2; ++bj)
#pragma unroll
                    for (int n = 0; n < 2; ++n) { const int col = col0 + bj * HALF + n * 16;
                        const f32x4 xv = valid ? *(const f32x4*)(xr + col) : (f32x4){0.f, 0.f, 0.f, 0.f}; const f32x4 mv = *(const f32x4*)(mr + col);
                        *(f32x4*)(Z + (size_t)row * D + col) = ALPHA * xv + coef * (1.0f + mv) * acc[ai][bj][m][n]; }
            }
    }
};
struct EpiProj {
    static constexpr bool PERM = false, AFTER_DRAIN = false;
    const float* bias; float* P;
    __device__ __forceinline__ void operator()(const f32x4 (&acc)[2][2][4][2], const Unit& u, int wr, int wc, int fr, int fq) const {
        const int row0 = u.pm * BM + wr * 64 + fr, col0 = u.pn * BM + wc * 32 + 4 * fq;
        f32x4 bv[2][2];
#pragma unroll
        for (int bj = 0; bj < 2; ++bj)
#pragma unroll
            for (int n = 0; n < 2; ++n) { const int col = col0 + bj * HALF + n * 16; bv[bj][n] = col < NIN ? *(const f32x4*)(bias + col) : (f32x4){0.f, 0.f, 0.f, 0.f}; }
#pragma unroll
        for (int ai = 0; ai < 2; ++ai)
#pragma unroll
            for (int m = 0; m < 4; ++m) { float* rp = P + (size_t)(row0 + ai * HALF + m * 16) * NINP + col0;
#pragma unroll
                for (int bj = 0; bj < 2; ++bj)
#pragma unroll
                    for (int n = 0; n < 2; ++n) *(f32x4*)(rp + bj * HALF + n * 16) = acc[ai][bj][m][n] + bv[bj][n]; }
    }
};
struct EpiF32 {
    static constexpr bool PERM = false, AFTER_DRAIN = false;
    float* O; int ldc; int nm;
    __device__ __forceinline__ void operator()(const f32x4 (&acc)[2][2][4][2], const Unit& u, int wr, int wc, int fr, int fq) const {
        const int row0 = u.pm * BM + wr * 64 + fr, col0 = wc * 32 + 4 * fq;
#pragma unroll
        for (int ai = 0; ai < 2; ++ai)
#pragma unroll
            for (int m = 0; m < 4; ++m) { float* rp = O + (size_t)(row0 + ai * HALF + m * 16) * ldc + col0;
#pragma unroll
                for (int bj = 0; bj < 2; ++bj)
#pragma unroll
                    for (int n = 0; n < 2; ++n) *(f32x4*)(rp + bj * HALF + n * 16) = acc[ai][bj][m][n]; }
    }
};
struct EpiOutAB {
    static constexpr bool PERM = false, AFTER_DRAIN = false;
    const float* P; float* M1; bf16_t* MIN; int nm;
    __device__ __forceinline__ void operator()(const f32x4 (&acc)[2][2][4][2], const Unit& u, int wr, int wc, int fr, int fq) const {
        const int rep = u.pm >= nm ? 1 : 0;
        const int row0 = (u.pm - rep * nm) * BM + wr * 64 + fr, col0 = (u.pn - rep * 4) * BM + wc * 32 + 4 * fq;
#pragma unroll
        for (int ai = 0; ai < 2; ++ai)
#pragma unroll
            for (int m = 0; m < 4; ++m) { const int row = row0 + ai * HALF + m * 16;
#pragma unroll
                for (int bj = 0; bj < 2; ++bj)
#pragma unroll
                    for (int n = 0; n < 2; ++n) { const int col = col0 + bj * HALF + n * 16;
                        const f32x4 pm = *(const f32x4*)(P + (size_t)row * NINP + C_MERGE + rep * D + col);
                        f32x4 g; g[0] = fast_sigmoid(pm[0]); g[1] = fast_sigmoid(pm[1]); g[2] = fast_sigmoid(pm[2]); g[3] = fast_sigmoid(pm[3]);
                        const f32x4 v = g * acc[ai][bj][m][n];
                        if (rep == 0) *(f32x4*)(M1 + (size_t)row * D + col) = v;
                        else { const f32x4 s = *(const f32x4*)(M1 + (size_t)row * D + col) + v;
                               typedef unsigned u32x2v __attribute__((ext_vector_type(2))); u32x2v w; w.x = cvt_pk_bf16(s[0], s[1]); w.y = cvt_pk_bf16(s[2], s[3]);
                               *(u32x2v*)(MIN + (size_t)row * D + col) = w; } }
            }
    }
};
template <class Epi, class Sched, bool ALIGN_EPI = false, bool SP2 = false>
__device__ __forceinline__ void gemm_phase(PG8_LAS unsigned char* lds, const Gemm g, const Sched& S, const Epi& E) {
    const int tid = threadIdx.x, wid = __builtin_amdgcn_readfirstlane(tid >> 6), lane = tid & 63, wr = wid >> 2, wc = wid & 3, fr = lane & 15, fq = lane >> 4;
    const int K = g.K, nt = K / BK;
    unsigned voffA[2], voffB[2];
#pragma unroll
    for (int i = 0; i < 2; ++i) { int R, C; stage_rc(tid * 16 + i * 8192, R, C); const int Rb = Epi::PERM ? ((R & ~31) + perm32(R & 31)) : R;
        voffA[i] = (unsigned)(R * K + C) * 2u; voffB[i] = (unsigned)(Rb * K + C) * 2u; }
    const size_t kstep = (size_t)(BK * 2);
    const size_t hstep = (size_t)HALF * K * 2;
    const size_t tstep = 2 * hstep;
    const unsigned ldsw = (unsigned)wid * 1024u;
    const int aoff = lds_byte(wr * 64 + fr, fq * 8), boff = lds_byte(wc * 32 + fr, fq * 8);
#define PG8_SA(b, h) (((b) * 2 + (h)) * HTB)
#define PG8_SB(b, h) ((4 + (b) * 2 + (h)) * HTB)
#define PG8_STAGE(bufoff, gbase, voff) do { _Pragma("unroll") for (int _i = 0; _i < 2; ++_i) \
        __builtin_amdgcn_global_load_lds((const unsigned*)((const char*)(gbase) + (voff)[_i]), (PG8_LAS unsigned*)(lds + (bufoff) + ldsw + _i * 8192), 16, 0, 0); } while (0)
#define PG8_LDA(dst, b, h) do { _Pragma("unroll") for (int m = 0; m < 4; ++m) _Pragma("unroll") for (int k = 0; k < 2; ++k) dst[m][k] = *(const PG8_LAS bf16x8*)(lds + PG8_SA(b, h) + aoff + m * 2048 + k * 1024); } while (0)
#define PG8_LDB(dst, b, h) do { _Pragma("unroll") for (int n = 0; n < 2; ++n) _Pragma("unroll") for (int k = 0; k < 2; ++k) dst[n][k] = *(const PG8_LAS bf16x8*)(lds + PG8_SB(b, h) + boff + n * 2048 + k * 1024); } while (0)
#define PG8_MMA(ai, bj, At, Bt) do { __builtin_amdgcn_s_setprio(1); _Pragma("unroll") for (int m = 0; m < 4; ++m) _Pragma("unroll") for (int n = 0; n < 2; ++n) _Pragma("unroll") for (int k = 0; k < 2; ++k) \
        acc[ai][bj][m][n] = __builtin_amdgcn_mfma_f32_16x16x32_bf16(Bt[n][k], At[m][k], acc[ai][bj][m][n], 0, 0, 0); __builtin_amdgcn_s_setprio(0); } while (0)
#define PG8_WAIT_V(n) asm volatile("s_waitcnt vmcnt(" #n ")" ::: "memory")
#define PG8_WAIT_L(n) asm volatile("s_waitcnt lgkmcnt(" #n ")" ::: "memory")
#define PG8_BAR __builtin_amdgcn_s_barrier()
#define PG8_SCHED __builtin_amdgcn_sched_barrier(0)
    Unit cur, nxt; int ui = 0;
    if (!S.next(0, cur)) return;
    f32x4 acc[2][2][4][2];
#pragma unroll
    for (int a = 0; a < 2; ++a)
#pragma unroll
        for (int b = 0; b < 2; ++b)
#pragma unroll
            for (int m = 0; m < 4; ++m)
#pragma unroll
                for (int n = 0; n < 2; ++n) acc[a][b][m][n] = (f32x4){0.f, 0.f, 0.f, 0.f};
    bf16x8 At[4][2], B0[2][2], B1[2][2];
    const char* cA = (const char*)g.A + (size_t)cur.pm * tstep; const char* cB = (const char*)g.Bt + (size_t)cur.pn * tstep;
    S.a_ready(cur);
    if constexpr (SP2) {
        PG8_STAGE(PG8_SB(0, 0), cB, voffB); PG8_STAGE(PG8_SB(0, 1), cB + hstep, voffB); PG8_STAGE(PG8_SA(0, 0), cA, voffA); PG8_STAGE(PG8_SA(0, 1), cA + hstep, voffA);
        if (wr == 1) PG8_BAR;
        PG8_WAIT_V(2); PG8_BAR;
        PG8_STAGE(PG8_SB(1, 0), cB + kstep, voffB); PG8_STAGE(PG8_SA(1, 0), cA + kstep, voffA); PG8_STAGE(PG8_SB(1, 1), cB + hstep + kstep, voffB);
        PG8_WAIT_V(6); PG8_BAR;
    } else {
        PG8_STAGE(PG8_SB(0, 0), cB, voffB); PG8_STAGE(PG8_SA(0, 0), cA, voffA); PG8_STAGE(PG8_SB(0, 1), cB + hstep, voffB); PG8_STAGE(PG8_SA(0, 1), cA + hstep, voffA);
        if (wr == 1) PG8_BAR;
        PG8_WAIT_V(4); PG8_BAR;
        PG8_STAGE(PG8_SB(1, 0), cB + kstep, voffB); PG8_STAGE(PG8_SA(1, 0), cA + kstep, voffA); PG8_STAGE(PG8_SB(1, 1), cB + hstep + kstep, voffB);
        PG8_WAIT_V(6); PG8_BAR;
    }
    for (;;) {
        const bool has_next = S.next(ui + 1, nxt);
        const char* nA = has_next ? (const char*)g.A + (size_t)nxt.pm * tstep : cA; const char* nB = has_next ? (const char*)g.Bt + (size_t)nxt.pn * tstep : cB;
        for (int t = 0; t < nt; t += 2) {
            const bool last = (t == nt - 2);
            const char* a1 = cA + (size_t)(t + 1) * kstep;
            const char* a2 = last ? nA : cA + (size_t)(t + 2) * kstep; const char* b2 = last ? nB : cB + (size_t)(t + 2) * kstep;
            const char* a3 = a2 + kstep; const char* b3 = b2 + kstep;
            if (last && has_next) S.a_ready(nxt);
            if constexpr (SP2) {
            PG8_LDB(B0, 0, 0); PG8_LDB(B1, 0, 1); PG8_SCHED; PG8_LDA(At, 0, 0); PG8_STAGE(PG8_SA(1, 1), a1 + hstep, voffA);
            PG8_WAIT_V(8); PG8_WAIT_L(0); PG8_BAR; PG8_MMA(0, 0, At, B0); PG8_MMA(0, 1, At, B1); PG8_BAR; PG8_SCHED;
            PG8_LDA(At, 0, 1); PG8_STAGE(PG8_SB(0, 0), b2, voffB); PG8_STAGE(PG8_SB(0, 1), b2 + hstep, voffB); PG8_STAGE(PG8_SA(0, 0), a2, voffA);
            PG8_WAIT_V(8); PG8_WAIT_L(0); PG8_BAR; PG8_MMA(1, 0, At, B0); PG8_MMA(1, 1, At, B1); PG8_BAR; PG8_SCHED;
            PG8_LDB(B0, 1, 0); PG8_LDB(B1, 1, 1); PG8_SCHED; PG8_LDA(At, 1, 0); PG8_STAGE(PG8_SA(0, 1), a2 + hstep, voffA);
            PG8_WAIT_V(8); PG8_WAIT_L(0); PG8_BAR; PG8_MMA(0, 0, At, B0); PG8_MMA(0, 1, At, B1); PG8_BAR; PG8_SCHED;
            PG8_LDA(At, 1, 1); PG8_STAGE(PG8_SB(1, 0), b3, voffB); PG8_STAGE(PG8_SB(1, 1), b3 + hstep, voffB); PG8_STAGE(PG8_SA(1, 0), a3, voffA);
            PG8_WAIT_V(8); PG8_WAIT_L(0); PG8_BAR; PG8_MMA(1, 0, At, B0); PG8_MMA(1, 1, At, B1); PG8_BAR; PG8_SCHED;
            } else {
            PG8_LDB(B0, 0, 0); PG8_SCHED; PG8_LDA(At, 0, 0); PG8_STAGE(PG8_SA(1, 1), a1 + hstep, voffA);
            PG8_WAIT_L(8); PG8_BAR; PG8_WAIT_L(0); PG8_MMA(0, 0, At, B0); PG8_BAR; PG8_SCHED;
            PG8_LDB(B1, 0, 1); PG8_STAGE(PG8_SB(0, 0), b2, voffB);
            PG8_BAR; PG8_WAIT_L(0); PG8_MMA(0, 1, At, B1); PG8_BAR;
            PG8_LDA(At, 0, 1); PG8_STAGE(PG8_SA(0, 0), a2, voffA);
            PG8_BAR; PG8_WAIT_L(0); PG8_MMA(1, 0, At, B0); PG8_BAR; PG8_SCHED;
            PG8_STAGE(PG8_SB(0, 1), b2 + hstep, voffB);
            PG8_WAIT_V(6); PG8_BAR; PG8_MMA(1, 1, At, B1); PG8_BAR;
            PG8_LDB(B0, 1, 0); PG8_SCHED; PG8_LDA(At, 1, 0); PG8_STAGE(PG8_SA(0, 1), a2 + hstep, voffA);
            PG8_WAIT_L(8); PG8_BAR; PG8_WAIT_L(0); PG8_MMA(0, 0, At, B0); PG8_BAR; PG8_SCHED;
            PG8_LDB(B1, 1, 1); PG8_STAGE(PG8_SB(1, 0), b3, voffB);
            PG8_BAR; PG8_WAIT_L(0); PG8_MMA(0, 1, At, B1); PG8_BAR;
            PG8_LDA(At, 1, 1); PG8_STAGE(PG8_SA(1, 0), a3, voffA);
            PG8_BAR; PG8_WAIT_L(0); PG8_MMA(1, 0, At, B0); PG8_BAR; PG8_SCHED;
            PG8_STAGE(PG8_SB(1, 1), b3 + hstep, voffB);
            PG8_WAIT_V(6); PG8_BAR; PG8_MMA(1, 1, At, B1); PG8_BAR;
            }
        }
        if constexpr (ALIGN_EPI) { if (wr == 0) PG8_BAR; }
        if constexpr (!Epi::AFTER_DRAIN) { E(acc, cur, wr, wc, fr, fq); S.done(cur); }
        if (!has_next) break;
#pragma unroll
        for (int a = 0; a < 2; ++a)
#pragma unroll
            for (int b = 0; b < 2; ++b)
#pragma unroll
                for (int m = 0; m < 4; ++m)
#pragma unroll
                    for (int n = 0; n < 2; ++n) acc[a][b][m][n] = (f32x4){0.f, 0.f, 0.f, 0.f};
        cur = nxt; cA = nA; cB = nB; ++ui;
        if constexpr (ALIGN_EPI) { if (wr == 1) PG8_BAR; }
    }
    PG8_WAIT_V(0);
    if constexpr (!ALIGN_EPI) { if (wr == 0) PG8_BAR; }
    PG8_BAR;
    if constexpr (Epi::AFTER_DRAIN) { E.fused(acc, cur, wr, wc, fr, fq, lds, wid, lane); S.done(cur); }
#undef PG8_SA
#undef PG8_SB
#undef PG8_STAGE
#undef PG8_LDA
#undef PG8_LDB
#undef PG8_MMA
#undef PG8_WAIT_V
#undef PG8_WAIT_L
#undef PG8_BAR
#undef PG8_SCHED
}
}

constexpr size_t al256(size_t x) { return (x + 255) & ~(size_t)255; }
constexpr size_t WS_CTL = 0, CTL_ZERO_BYTES = 1u << 20;
constexpr int CW_BAR = 4096;
constexpr size_t WS_MOD  = CTL_ZERO_BYTES;
constexpr size_t WS_PET  = al256(WS_MOD + (size_t)36 * 9 * D * 4);
constexpr size_t WS_WGU  = al256(WS_PET + 2 * 128 * 4);
constexpr size_t WS_WDN  = al256(WS_WGU + (size_t)2 * 5632 * D * 2);
constexpr size_t WS_WIN  = al256(WS_WDN + (size_t)2 * D * FF * 2);
constexpr size_t WS_WOAB = al256(WS_WIN + (size_t)NINP * D * 2);
constexpr size_t WS_WO   = al256(WS_WOAB + (size_t)2048 * 512 * 2);
constexpr size_t WS_WC1  = al256(WS_WO + (size_t)D * D * 2);
constexpr size_t WS_LORA = al256(WS_WC1 + (size_t)512 * 1024 * 2);
constexpr size_t WS_U    = al256(WS_LORA + (size_t)512 * 256 * 2);
constexpr size_t WS_H    = al256(WS_U + (size_t)MA * D * 2);
constexpr size_t WS_Z    = al256(WS_H + (size_t)MA * FF * 2);
constexpr size_t WS_X1   = al256(WS_Z + (size_t)MA * D * 4);
constexpr size_t WS_X2   = al256(WS_X1 + (size_t)MA * D * 4);
constexpr size_t WS_M1   = al256(WS_X2 + (size_t)MA * D * 4);
constexpr size_t WS_MIN  = al256(WS_M1 + (size_t)MA * D * 4);
constexpr size_t WS_PROJ = al256(WS_MIN + (size_t)MA * D * 2);
constexpr size_t WS_RW   = al256(WS_PROJ + (size_t)MA * NINP * 4);
constexpr size_t RW_STRIDE = (size_t)MA * RWW;
constexpr size_t WS_G    = al256(WS_RW + 6 * RW_STRIDE * 4);
constexpr size_t WS_BON  = al256(WS_G + RW_STRIDE * 4);
constexpr size_t WS_YS   = al256(WS_BON + RW_STRIDE * 4);
constexpr size_t WS_AST  = al256(WS_YS + RW_STRIDE * 4);
constexpr size_t WS_KSEL = al256(WS_AST + (size_t)2 * MA * RWW * 2);
constexpr size_t KV_BYTES = (size_t)NBP * 2 * T * 64 * 2;
constexpr size_t WS_KWIN = WS_KSEL + KV_BYTES, WS_VTSEL = WS_KWIN + KV_BYTES, WS_VTWIN = WS_VTSEL + KV_BYTES;
constexpr size_t WS_KCP  = WS_VTWIN + KV_BYTES;
constexpr size_t WS_VCTP = WS_KCP + (size_t)NBP * 2 * 256 * 64 * 2;
constexpr size_t WS_KCS  = al256(WS_VCTP + (size_t)NBP * 2 * 256 * 64 * 2);
constexpr size_t KCS_STRIDE = (size_t)NBS * NCMP_S * 2 * 64;
constexpr size_t WS_ACMP = al256(WS_KCS + 2 * KCS_STRIDE * 4);
constexpr size_t WS_HC   = al256(WS_ACMP + (size_t)2 * CROWS * 1024 * 2);
constexpr size_t WS_END  = al256(WS_HC + (size_t)2 * CROWS * 256 * 4);

constexpr int NWAVES = 8;
constexpr int RING_OFF = 0, RING_BYTES = 131072;
constexpr int LDSCTL_OFF = RING_BYTES, MISC_OFF = LDSCTL_OFF + 320;
constexpr int LDS_BYTES = 147456;

#define GAS __attribute__((address_space(1)))
#define LAS __attribute__((address_space(3)))
typedef unsigned short bf16;
typedef unsigned v4u __attribute__((ext_vector_type(4)));
typedef unsigned v2u __attribute__((ext_vector_type(2)));
typedef float f32x4 __attribute__((ext_vector_type(4)));
typedef float f32x16 __attribute__((ext_vector_type(16)));
typedef short bf16x8 __attribute__((ext_vector_type(8)));
typedef short s16x4 __attribute__((ext_vector_type(4)));
typedef GAS unsigned gu32;
#define RLX_AGENT __ATOMIC_RELAXED, __HIP_MEMORY_SCOPE_AGENT
#define LDS_WAIT() asm volatile("s_waitcnt lgkmcnt(0)" ::: "memory")
#define VM_WAIT() asm volatile("s_waitcnt vmcnt(0)" ::: "memory")
DI unsigned f2bf(float f) { unsigned u = __builtin_bit_cast(unsigned, f); return (u + 0x7fffu + ((u >> 16) & 1u)) >> 16; }
DI unsigned pk2(float lo, float hi) { return pg8::cvt_pk_bf16(lo, hi); }
DI float sigmoidf_(float x) { return 1.0f / (1.0f + __expf(-x)); }
DI float wave_sum(float v) {
#pragma unroll
    for (int o = 1; o < 64; o <<= 1) v += __shfl_xor(v, o);
    return v;
}
DI float wave_max(float v) {
#pragma unroll
    for (int o = 1; o < 64; o <<= 1) v = fmaxf(v, __shfl_xor(v, o));
    return v;
}
template <int CTRL> DI float dpp_f(float x) { return __builtin_bit_cast(float, __builtin_amdgcn_update_dpp(0, __builtin_bit_cast(int, x), CTRL, 0xf, 0xf, false)); }
DI float row16_sum(float x) {
    x += dpp_f<0x128>(x); x += dpp_f<0x124>(x); x += dpp_f<0x122>(x); x += dpp_f<0x121>(x); return x;
}
DI float gelu_tanh(float x) { const float u = 0.7978845608028654f * (x + 0.044715f * x * x * x); const float e = __expf(2.0f * u); const float th = 1.0f - 2.0f / (e + 1.0f); return 0.5f * x * (1.0f + th); }
#define MFMA32(a_, b_, c_) __builtin_amdgcn_mfma_f32_32x32x16_bf16((a_), (b_), (c_), 0, 0, 0)
DI int crow(int i, int hh) { return (i & 3) + 8 * (i >> 2) + 4 * hh; }
DI f32x16 zero16() { f32x16 z;
#pragma unroll
    for (int i = 0; i < 16; ++i) z[i] = 0.f; return z; }
#define XB_TMO      128
#define XB_XCNT(j)  (256  + 64 * (j))
#define XB_XSUB(j)  (1280 + 64 * (j))
#define XB_XGEN(j)  (2304 + 64 * (j))
#define XB_TOP      3328
#define XB_TOPGEN   3392
#define XCD_BAR_WORDS 3456
#define XB_SPIN_CAP (1u << 18)

__device__ __forceinline__ unsigned xb_ld(unsigned* p)              { return __hip_atomic_load(p, __ATOMIC_RELAXED, __HIP_MEMORY_SCOPE_AGENT); }
__device__ __forceinline__ unsigned xb_add(unsigned* p, unsigned v) { return __hip_atomic_fetch_add(p, v, __ATOMIC_RELAXED, __HIP_MEMORY_SCOPE_AGENT); }
__device__ __forceinline__ unsigned xb_xcc_id() { return (unsigned)__builtin_amdgcn_s_getreg((3 << 11) | 20) & 0xFu; }
#define XB_SPIN(cond, bar) do { unsigned _sp = 0; while (cond) { __builtin_amdgcn_s_sleep(1); \
    if ((++_sp & 255u) == 0u) { if (xb_ld(&(bar)[XB_TMO])) break; if (_sp > XB_SPIN_CAP) { atomicAdd(&(bar)[XB_TMO], 1u); break; } } } } while (0)

struct XcdBarrier {
    unsigned* bar; unsigned x;
    volatile LAS unsigned* st;
};

__device__ __forceinline__ XcdBarrier xcd_barrier_post(unsigned* bar, volatile LAS unsigned* st) {
    XcdBarrier b; b.bar = bar; b.x = xb_xcc_id(); b.st = st;
    if (threadIdx.x == 0) (void)xb_add(&bar[XB_XCNT(b.x)], 1u);
    return b;
}
__device__ __forceinline__ void xcd_barrier_complete(unsigned* bar, unsigned x, unsigned& nloc, unsigned& nx) {
    const unsigned G = gridDim.x * gridDim.y * gridDim.z;
    unsigned sum, cnt, mine, sp = 0u;
    for (;;) {
        sum = 0u; cnt = 0u; mine = 0u;
#pragma unroll
        for (unsigned j = 0; j < 16; ++j) { const unsigned c = xb_ld(&bar[XB_XCNT(j)]); sum += c; cnt += (c > 0u) ? 1u : 0u; mine = (j == x) ? c : mine; }
        if (sum == G) break;
        __builtin_amdgcn_s_sleep(1);
        if ((++sp & 255u) == 0u) { if (xb_ld(&bar[XB_TMO])) break; if (sp > XB_SPIN_CAP) { atomicAdd(&bar[XB_TMO], 1u); break; } }
    }
    nloc = mine > 0u ? mine : 1u; nx = cnt > 0u ? cnt : 1u;
}

__device__ __forceinline__ void xcd_barrier(const XcdBarrier& b) {
    asm volatile("s_waitcnt vmcnt(0)" ::: "memory");
    __syncthreads();
    if (threadIdx.x == 0) {
        unsigned* bar = b.bar;
        __builtin_amdgcn_s_waitcnt(0);
        unsigned nloc = b.st[0], nx = b.st[1];
        if (nloc == 0u) { xcd_barrier_complete(bar, b.x, nloc, nx); b.st[0] = nloc; b.st[1] = nx; }
        const unsigned old = xb_add(&bar[XB_XSUB(b.x)], 1u);
        const unsigned gen = old / nloc;
        if (old + 1u == (gen + 1u) * nloc) {
            __builtin_amdgcn_fence(__ATOMIC_RELEASE, "agent");
            asm volatile("s_waitcnt vmcnt(0)" ::: "memory");
            const unsigned og = xb_add(&bar[XB_TOP], 1u);
            const unsigned tg = og / nx;
            if (og + 1u == (tg + 1u) * nx) xb_add(&bar[XB_TOPGEN], 1u);
            else XB_SPIN(xb_ld(&bar[XB_TOPGEN]) == tg, bar);
            __builtin_amdgcn_fence(__ATOMIC_ACQUIRE, "agent");
            xb_add(&bar[XB_XGEN(b.x)], 1u);
            asm volatile("s_waitcnt vmcnt(0)" ::: "memory");
        } else {
            XB_SPIN(xb_ld(&bar[XB_XGEN(b.x)]) == gen, bar);
            __builtin_amdgcn_fence(__ATOMIC_ACQUIRE, "agent");
            asm volatile("s_waitcnt vmcnt(0)" ::: "memory");
        }
    }
    __syncthreads();
}

enum { I_XP = 0, I_XS, I_CP, I_CS, I_CKC, I_CKS, I_SKW, I_SWKV, I_SSH, I_PT, I_WADA, I_BADA, I_LNG, I_LNB, I_WG, I_WU, I_WD, I_WIN, I_BIN, I_MU, I_W0, I_W2, I_A0, I_A2, I_G2,
       I_KK, I_KA, I_RK, I_LNW, I_LNBB, I_PE, I_PW1, I_PW2, I_WOA, I_WOB, I_WOO, N_IN };
struct Args { const float* in[N_IN]; float* out; unsigned char* ws; int ph_lo, ph_hi; };
#define WSF(off) ((float*)(a.ws + (off)))
#define WSB(off) ((bf16*)(a.ws + (off)))

DI void tr_item(const float* __restrict__ W, int ldw, int ncols, int k0, int n0, bf16* WT, int ldo, int dr0, LAS float* scr, int lane) {
#pragma unroll 8
    for (int i = 0; i < 32; ++i) { const int kk = 2 * i + (lane >> 5), col = n0 + (lane & 31); scr[kk * 33 + (lane & 31)] = col < ncols ? W[(size_t)(k0 + kk) * ldw + col] : 0.f; }
    LDS_WAIT(); asm volatile("" ::: "memory");
    const int c = lane & 7;
#pragma unroll
    for (int j = 0; j < 4; ++j) { const int n = (lane >> 3) + 8 * j; const LAS float* s = scr + (8 * c) * 33 + n;
        v4u o; o.x = pk2(s[0 * 33], s[1 * 33]); o.y = pk2(s[2 * 33], s[3 * 33]); o.z = pk2(s[4 * 33], s[5 * 33]); o.w = pk2(s[6 * 33], s[7 * 33]);
        *(v4u*)(WT + (size_t)(dr0 + n) * ldo + k0 + 8 * c) = o; }
    LDS_WAIT(); asm volatile("" ::: "memory");
}
DI void mod_gemv_item(const Args& a, LAS unsigned char* lds, int tid, int lane, int wave, int item) {
    LAS float* S = (LAS float*)lds;
    const float* wada = a.in[I_WADA];
    float acc[36];
#pragma unroll
    for (int i = 0; i < 36; ++i) acc[i] = 0.f;
    const int col = item * 64 + lane;
    for (int kh = 0; kh < 2; ++kh) {
        __syncthreads();
        for (int e = tid; e < 36 * 512; e += 512) { const int bbv = e >> 9, kk = e & 511;
            const float c = bbv < 4 ? a.in[I_CP][bbv * D + kh * 512 + kk] : a.in[I_CS][(bbv - 4) * D + kh * 512 + kk];
            S[kk * 36 + bbv] = c / (1.0f + __expf(-c)); }
        __syncthreads();
        for (int kk = wave * 64; kk < wave * 64 + 64; ++kk) {
            const float wv = wada[(size_t)(kh * 512 + kk) * 9216 + col];
            const LAS f32x4* sp = (const LAS f32x4*)(S + kk * 36);
#pragma unroll
            for (int q = 0; q < 9; ++q) { const f32x4 s = sp[q]; acc[4 * q] += s[0] * wv; acc[4 * q + 1] += s[1] * wv; acc[4 * q + 2] += s[2] * wv; acc[4 * q + 3] += s[3] * wv; }
        }
    }
    __syncthreads();
    LAS float* P = (LAS float*)lds;
#pragma unroll
    for (int i = 0; i < 36; ++i) P[(wave * 36 + i) * 64 + lane] = acc[i];
    __syncthreads();
    float* MOD = WSF(WS_MOD);
    for (int o = tid; o < 36 * 64; o += 512) { const int bbv = o >> 6, l = o & 63; float s = 0.f;
#pragma unroll
        for (int w = 0; w < 8; ++w) s += P[(w * 36 + bbv) * 64 + l];
        const int cc = item * 64 + l; MOD[(size_t)bbv * 9216 + cc] = s + a.in[I_BADA][cc]; }
    __syncthreads();
}
DI void pet_item(const Args& a, LAS unsigned char* lds, int tid, int lane, int wave, int item) {
    const int kv = item >> 1, e = (item & 1) * 64 + lane;
    const float* pe = a.in[I_PE] + kv * 2048; const float* w1 = a.in[I_PW1] + (size_t)kv * 2048 * 128;
    float acc = 0.f;
    for (int k = wave * 256; k < wave * 256 + 256; ++k) acc += pe[k] * w1[(size_t)k * 128 + e];
    LAS float* P = (LAS float*)lds;
    __syncthreads();
    P[wave * 64 + lane] = acc;
    __syncthreads();
    if (tid < 64) { float s = 0.f;
#pragma unroll
        for (int w = 0; w < 8; ++w) s += P[w * 64 + tid];
        WSF(WS_PET)[kv * 128 + (item & 1) * 64 + tid] = s; }
    __syncthreads();
}
DI void ph_prologue(const Args& a, LAS unsigned char* lds, int tid, int lane, int wave, int G, int bx) {
    for (int it = bx; it < 148; it += G) { if (it < 144) mod_gemv_item(a, lds, tid, lane, wave, it); else pet_item(a, lds, tid, lane, wave, it - 144); }
    __syncthreads();
    LAS float* scr = (LAS float*)(lds + wave * 16384);
    const int gw = wave * G + bx, NGW = G * NWAVES;
    constexpr int I_GU = 16 * 88, I_DN = 44 * 32, I_IN = 16 * 168, I_OAB = 8 * 32, I_O = 16 * 32, I_C1 = 16 * 4, I_CONV = NBS * NCH_S, I_WCP = 1016, I_ZERO = 128, I_LORA = 64;
    constexpr int NITEMS = 4 * I_GU + 2 * I_DN + I_IN + 2 * I_OAB + I_O + 4 * I_C1 + I_CONV + I_WCP + I_ZERO + I_LORA;
    for (int it = gw; it < NITEMS; it += NGW) {
        int r = it;
        if (r < 4 * I_GU) { const int which = r / I_GU, l = which & 1, up = which >> 1; r %= I_GU; const int kb = r / 88, nb = r % 88, n0 = nb * 32;
            tr_item((up ? a.in[I_WU] : a.in[I_WG]) + (size_t)l * D * FF, FF, FF, kb * 64, n0, WSB(WS_WGU) + (size_t)l * 5632 * D, D, (n0 >> 7) * 256 + up * 128 + (n0 & 127), scr, lane); continue; } r -= 4 * I_GU;
        if (r < 2 * I_DN) { const int l = r / I_DN; r %= I_DN; const int kb = r / 32, nb = r % 32;
            tr_item(a.in[I_WD] + (size_t)l * FF * D, D, D, kb * 64, nb * 32, WSB(WS_WDN) + (size_t)l * D * FF, FF, nb * 32, scr, lane); continue; } r -= 2 * I_DN;
        if (r < I_IN) { const int kb = r / 168, nb = r % 168; tr_item(a.in[I_WIN], NIN, NIN, kb * 64, nb * 32, WSB(WS_WIN), D, nb * 32, scr, lane); continue; } r -= I_IN;
        if (r < 2 * I_OAB) { const int w = r / I_OAB; r %= I_OAB; const int kb = r / 32, nb = r % 32;
            tr_item(w ? a.in[I_WOB] : a.in[I_WOA], D, D, kb * 64, nb * 32, WSB(WS_WOAB), 512, w * 1024 + nb * 32, scr, lane); continue; } r -= 2 * I_OAB;
        if (r < I_O) { const int kb = r / 32, nb = r % 32; tr_item(a.in[I_WOO], D, D, kb * 64, nb * 32, WSB(WS_WO), D, nb * 32, scr, lane); continue; } r -= I_O;
        if (r < 4 * I_C1) { const int mat = r / I_C1; r %= I_C1; const int kb = r / 4, nb = r % 4;
            tr_item(a.in[I_PW1] + (size_t)mat * 1024 * 128, 128, 128, kb * 64, nb * 32, WSB(WS_WC1), 1024, mat * 128 + nb * 32, scr, lane); continue; } r -= 4 * I_C1;
        if (r < I_CONV) {
            const int b = r >> 10, c = r & 1023; const int page = ((const int*)a.in[I_PT])[b * 128 + (c >> 3)];
            const float* src = a.in[I_CKC] + ((size_t)page * 128 + (c & 7) * 16) * 256 + lane * 4;
            const int kv = lane >> 5, g = (lane >> 4) & 1, d = (lane & 15) * 4;
            bf16* dst = WSB(WS_ACMP) + ((size_t)kv * CROWS + (size_t)(b * NCH_S + c) * 2 + g) * 1024 + d;
#pragma unroll 4
            for (int j = 0; j < 16; ++j) { const f32x4 v = *(const f32x4*)(src + j * 256); v2u o; o.x = pk2(v[0], v[1]); o.y = pk2(v[2], v[3]); *(v2u*)(dst + j * 64) = o; }
            continue; } r -= I_CONV;
        if (r < I_WCP) {
#pragma unroll 4
            for (int i = 0; i < 16; ++i) { const int f = r * 1024 + i * 64 + lane; const int b = f / 32512, i4 = f % 32512;
                *(f32x4*)(a.out + O_KVW_S + (size_t)b * 131072 + (size_t)i4 * 4) = *(const f32x4*)(a.in[I_SKW] + (size_t)b * 131072 + 1024 + (size_t)i4 * 4); }
            continue; } r -= I_WCP;
        if (r < I_ZERO) { v4u z = {0u, 0u, 0u, 0u}; unsigned char* p = a.ws + WS_KCP + (size_t)r * 4096 + lane * 64;
#pragma unroll
          for (int i = 0; i < 4; ++i) *(v4u*)(p + 16 * i) = z; continue; } r -= I_ZERO;
        {
            if (r < 16) tr_item(a.in[I_W2], RWW, RWW, 0, r * 32, WSB(WS_LORA), 64, r * 32, scr, lane);
            else if (r < 32) tr_item(a.in[I_A2], RWW, RWW, 0, (r - 16) * 32, WSB(WS_LORA) + 512 * 64, 64, (r - 16) * 32, scr, lane);
            else { const int q = r - 32; tr_item(a.in[I_G2], RWW, RWW, (q >> 4) * 64, (q & 15) * 32, WSB(WS_LORA) + 2 * 512 * 64, 128, (q & 15) * 32, scr, lane); } }
    }
}
DI void ph_u1(const Args& a, int lane, int wave, int G, int bx) {
    const int gw = wave * G + bx, NGW = G * NWAVES; const float* MOD = WSF(WS_MOD); bf16* U = WSB(WS_U);
    for (int row = gw; row < MA; row += NGW) {
        const float* xr = row < MP ? a.in[I_XP] + (size_t)row * D : a.in[I_XS] + (size_t)(row - MP) * D;
        const float* ms = MOD + (size_t)(bb_of_row(row) * 9) * D;
#pragma unroll
        for (int j = 0; j < 4; ++j) { const int col = lane * 4 + 256 * j;
            f32x4 u = {0.f, 0.f, 0.f, 0.f};
            if (row < MR) { const f32x4 x = *(const f32x4*)(xr + col); u = x * (1.0f + *(const f32x4*)(ms + D + col)) + *(const f32x4*)(ms + col); }
            v2u o; o.x = pk2(u[0], u[1]); o.y = pk2(u[2], u[3]); *(v2u*)(U + (size_t)row * D + col) = o; }
    }
}
template <int WHICH> DI void ph_ln(const Args& a, int lane, int wave, int G, int bx) {
    const int gw = wave * G + bx, NGW = G * NWAVES; const float* MOD = WSF(WS_MOD); const float* Z = WSF(WS_Z); bf16* U = WSB(WS_U);
    float* XN = WHICH == 0 ? WSF(WS_X1) : (WHICH == 1 ? WSF(WS_X2) : a.out);
    const float* lg = a.in[I_LNG] + WHICH * D; const float* lb = a.in[I_LNB] + WHICH * D;
    for (int row = gw; row < MA; row += NGW) {
        if (WHICH == 2 && row >= MR) break;
        f32x4 v[4]; float s = 0.f;
#pragma unroll
        for (int j = 0; j < 4; ++j) { v[j] = *(const f32x4*)(Z + (size_t)row * D + lane * 4 + 256 * j); s += (v[j][0] + v[j][1]) + (v[j][2] + v[j][3]); }
        const float mean = wave_sum(s) * (1.0f / D); float s2 = 0.f;
#pragma unroll
        for (int j = 0; j < 4; ++j) { v[j] = v[j] - mean; s2 += (v[j][0] * v[j][0] + v[j][1] * v[j][1]) + (v[j][2] * v[j][2] + v[j][3] * v[j][3]); }
        const float rstd = 1.0f / sqrtf(wave_sum(s2) * (1.0f / D) + LN_EPS);
        const float* ms = MOD + (size_t)(bb_of_row(row) * 9 + 3 * WHICH + 3) * D;
#pragma unroll
        for (int j = 0; j < 4; ++j) { const int col = lane * 4 + 256 * j;
            const f32x4 x = v[j] * rstd * *(const f32x4*)(lg + col) + *(const f32x4*)(lb + col);
            *(f32x4*)(XN + (size_t)row * D + col) = x;
            if (WHICH < 2) { const f32x4 u = x * (1.0f + *(const f32x4*)(ms + D + col)) + *(const f32x4*)(ms + col);
                v2u o; o.x = pk2(u[0], u[1]); o.y = pk2(u[2], u[3]); *(v2u*)(U + (size_t)row * D + col) = o; } }
    }
}

DI float proj_prev(const Args& a, const float* PROJ, int row, int col) {
    if (row < MP) return (row & (T - 1)) ? PROJ[(size_t)(row - 1) * NINP + col] : 0.f;
    const int s = row - MP; return (s & 3) ? PROJ[(size_t)(row - 1) * NINP + col] : a.in[I_SSH][(size_t)(s >> 2) * C_Q + col];
}
DI void ph_dist_rwprep(const Args& a, LAS unsigned char* lds, int tid, int lane, int wave, int G, int bx) {
    const float* PROJ = WSF(WS_PROJ);
    LAS float* vt = (LAS float*)lds;
    LAS bf16* LA = (LAS bf16*)(lds + 36864);
    for (int it = bx; it < MR / 32; it += G) {
        const int r0 = it * 32;
        __syncthreads();
        {
            const int rr = tid >> 4, seg = tid & 15, row = r0 + rr;
            const float* pr = PROJ + (size_t)row * NINP + C_KV;
            if (row < MP) {
                const int b = row >> 12, t = row & (T - 1);
#pragma unroll
                for (int i = 0; i < 12; ++i) { const int col = 4 * (seg + 16 * i), br = col >> 8, within = col & 255, kv = within >> 7, g = (within >> 6) & 1, d = within & 63;
                    const f32x4 v = *(const f32x4*)(pr + col); v2u pk; pk.x = pk2(v[0], v[1]); pk.y = pk2(v[2], v[3]);
                    if (br == 0) { *(f32x4*)(a.out + O_KVC_P + (size_t)row * 256 + within) = v;
                        *(v2u*)(WSB(WS_ACMP) + ((size_t)kv * CROWS + CROWS_S + (size_t)(b * NCH_P + (t >> 4)) * 2 + g) * 1024 + (t & 15) * 64 + d) = pk; }
                    else { if (br == 1) *(f32x4*)(a.out + O_KVS_P + (size_t)row * 256 + within) = v;
                           else if (t >= T - 512) *(f32x4*)(a.out + O_KVW_P + ((size_t)b * 512 + (t - (T - 512))) * 256 + within) = v;
                           if (kv == 0) *(v2u*)(WSB(br == 1 ? WS_KSEL : WS_KWIN) + ((size_t)(b * 2 + g) * T + t) * 64 + d) = pk;
                           else { LAS float* q = vt + ((br - 1) * 32 + rr) * 132 + g * 64 + d; q[0] = v[0]; q[1] = v[1]; q[2] = v[2]; q[3] = v[3]; } }
                }
                if (t == T - 1) { const float* ps = PROJ + (size_t)row * NINP;
#pragma unroll 4
                    for (int i = 0; i < 28; ++i) *(f32x4*)(a.out + O_SH_P + (size_t)b * C_Q + 4 * (seg + 16 * i)) = *(const f32x4*)(ps + 4 * (seg + 16 * i)); }
            } else {
                const int s = row - MP, b = s >> 2, tq = s & 3;
#pragma unroll
                for (int i = 0; i < 12; ++i) { const int col = 4 * (seg + 16 * i), br = col >> 8, within = col & 255;
                    const f32x4 v = *(const f32x4*)(pr + col);
                    if (br == 0) *(f32x4*)(a.out + O_KVC_S + (size_t)s * 256 + within) = v;
                    else if (br == 1) *(f32x4*)(a.out + O_KVS_S + (size_t)s * 256 + within) = v;
                    else *(f32x4*)(a.out + O_KVW_S + ((size_t)b * 512 + 508 + tq) * 256 + within) = v; }
                if (tq == 3) { const float* ps = PROJ + (size_t)row * NINP;
#pragma unroll 4
                    for (int i = 0; i < 28; ++i) *(f32x4*)(a.out + O_SH_S + (size_t)b * C_Q + 4 * (seg + 16 * i)) = *(const f32x4*)(ps + 4 * (seg + 16 * i)); }
            }
        }
#pragma unroll 4
        for (int i = 0; i < 16; ++i) { const int e = tid + 512 * i, tt = e >> 8, k = e & 255, row = r0 + tt, col = 1536 + k;
            const float p = PROJ[(size_t)row * NINP + col], pp = proj_prev(a, PROJ, row, col); const float xs = p + (pp - p) * a.in[I_MU][col];
            LA[tt * 264 + k] = (bf16)f2bf(k < 64 ? tanhf(xs) : (k < 128 ? xs : sigmoidf_(xs))); }
        __syncthreads();
        if (r0 < MP) {
            const int gd = tid >> 2, tc = tid & 3, g = gd >> 6, d = gd & 63, b = r0 >> 12, t0 = r0 & (T - 1);
#pragma unroll
            for (int br = 0; br < 2; ++br) { const LAS float* q = vt + (br * 32 + tc * 8) * 132 + gd;
                v4u o; o.x = pk2(q[0], q[132]); o.y = pk2(q[2 * 132], q[3 * 132]); o.z = pk2(q[4 * 132], q[5 * 132]); o.w = pk2(q[6 * 132], q[7 * 132]);
                *(v4u*)(WSB(br == 0 ? WS_VTSEL : WS_VTWIN) + ((size_t)(b * 2 + g) * 64 + d) * T + t0 + tc * 8) = o; }
        }
        {
            int lane_l = lane; asm volatile("" : "+v"(lane_l));
            const int hh = lane_l >> 5, cl = lane_l & 31;
            f32x16 aw[2], aa[2], ag[2];
#pragma unroll
            for (int cb = 0; cb < 2; ++cb) { aw[cb] = zero16(); aa[cb] = zero16(); ag[cb] = zero16(); }
            const bf16* W2T = WSB(WS_LORA); const bf16* A2T = W2T + 512 * 64; const bf16* G2T = A2T + 512 * 64;
#define LORA_STEP(acc_, WT_, KW_, s_, koff_) { const bf16x8 af = *(const LAS bf16x8*)(LA + cl * 264 + (koff_) + 16 * (s_) + 8 * hh); \
                _Pragma("unroll") for (int cb = 0; cb < 2; ++cb) { const bf16x8 bf_ = *(const bf16x8*)((WT_) + (wave * 64 + cb * 32 + cl) * (KW_) + 16 * (s_) + 8 * hh); acc_[cb] = MFMA32(af, bf_, acc_[cb]); } \
                asm volatile("" ::: "memory"); }
#pragma unroll
            for (int s2 = 0; s2 < 4; ++s2) LORA_STEP(aw, W2T, 64, s2, 0)
#pragma unroll
            for (int s2 = 0; s2 < 4; ++s2) LORA_STEP(aa, A2T, 64, s2, 64)
#pragma unroll
            for (int s2 = 0; s2 < 8; ++s2) LORA_STEP(ag, G2T, 128, s2, 128)
#undef LORA_STEP
            float* RW = WSF(WS_RW);
            float mu_r[2], mu_k[2], mu_v[2], w0[2], a0[2], kkc[2], kac[2], rkc[2];
#pragma unroll
            for (int cb = 0; cb < 2; ++cb) { const int c = wave * 64 + cb * 32 + cl;
                mu_r[cb] = a.in[I_MU][c]; mu_k[cb] = a.in[I_MU][512 + c]; mu_v[cb] = a.in[I_MU][1024 + c];
                w0[cb] = a.in[I_W0][c]; a0[cb] = a.in[I_A0][c]; kkc[cb] = a.in[I_KK][c]; kac[cb] = a.in[I_KA][c]; rkc[cb] = a.in[I_RK][c]; }
#pragma unroll
            for (int half = 0; half < 4; ++half) {
                float tk[2][4], ta[2][4], tp[2][4], tv[2][4];
#pragma unroll
                for (int i8 = 0; i8 < 4; ++i8) { const int i = half * 4 + i8, row = r0 + crow(i, hh); const float* pr = PROJ + (size_t)row * NINP;
#pragma unroll
                    for (int cb = 0; cb < 2; ++cb) { const int c = wave * 64 + cb * 32 + cl;
                        const float pr_ = pr[c], pk_ = pr[512 + c], pv_ = pr[1024 + c];
                        const float r = pr_ + (proj_prev(a, PROJ, row, c) - pr_) * mu_r[cb], k = pk_ + (proj_prev(a, PROJ, row, 512 + c) - pk_) * mu_k[cb], v = pv_ + (proj_prev(a, PROJ, row, 1024 + c) - pv_) * mu_v[cb];
                        const float z = -(w0[cb] + aw[cb][i]);
                        const float sp = fmaxf(z, 0.f) + log1pf(__expf(-fabsf(z)));
                        const float decay = __expf(-__expf(-sp - 0.5f));
                        const float av = sigmoidf_(a0[cb] + aa[cb][i]);
                        const float kk = k * kkc[cb], k2 = k * (1.0f + (av - 1.0f) * kac[cb]);
                        const size_t o = (size_t)row * RWW + c;
                        RW[o] = r; RW[RW_STRIDE + o] = decay; RW[2 * RW_STRIDE + o] = k2; RW[3 * RW_STRIDE + o] = v; WSF(WS_G)[o] = ag[cb][i];
                        tk[cb][i8] = kk; ta[cb][i8] = av; tp[cb][i8] = r * k2 * rkc[cb]; tv[cb][i8] = v; }
                    asm volatile("" ::: "memory"); }
#pragma unroll
                for (int i8 = 0; i8 < 4; ++i8) { const int i = half * 4 + i8, row = r0 + crow(i, hh);
                    float ss = tk[0][i8] * tk[0][i8] + tk[1][i8] * tk[1][i8], rk = tp[0][i8] + tp[1][i8];
                    ss = row16_sum(ss); rk = row16_sum(rk); ss += __shfl_xor(ss, 16); rk += __shfl_xor(rk, 16);
                    const float rn = rsqrtf(fmaxf(ss, 1e-24f));
#pragma unroll
                    for (int cb = 0; cb < 2; ++cb) { const int c = wave * 64 + cb * 32 + cl; const size_t o = (size_t)row * RWW + c;
                        const float kkn = tk[cb][i8] * rn; RW[4 * RW_STRIDE + o] = kkn; RW[5 * RW_STRIDE + o] = kkn * ta[cb][i8]; WSF(WS_BON)[o] = rk * tv[cb][i8]; }
                }
            }
        }
    }
}

struct StepD { f32x4 r, w, k, kk, b; float v; };
DI void scan_run(const float* RW, float* Y, int rowbase, int nsteps, int h, int i, int lane, const float* s_in, float* s_out) {
    const int j0 = (lane & 15) * 4; const size_t cofs = (size_t)h * 64 + j0, vofs = (size_t)h * 64 + i;
    f32x4 S = s_in ? *(const f32x4*)(s_in + i * 64 + j0) : (f32x4){0.f, 0.f, 0.f, 0.f};
#define SC_LD(sd, t) { const size_t o_ = (size_t)(rowbase + (t)) * RWW; sd.r = *(const f32x4*)(RW + o_ + cofs); sd.w = *(const f32x4*)(RW + RW_STRIDE + o_ + cofs); sd.k = *(const f32x4*)(RW + 2 * RW_STRIDE + o_ + cofs); \
        sd.v = RW[3 * RW_STRIDE + o_ + vofs]; sd.kk = *(const f32x4*)(RW + 4 * RW_STRIDE + o_ + cofs); sd.b = *(const f32x4*)(RW + 5 * RW_STRIDE + o_ + cofs); }
#define SC_DO(sd, t) { float d_ = (S[0] * sd.kk[0] + S[1] * sd.kk[1]) + (S[2] * sd.kk[2] + S[3] * sd.kk[3]); d_ = row16_sum(d_); const float sa_ = -d_; \
        S = S * sd.w + (sa_ * sd.b + sd.v * sd.k); float y_ = (S[0] * sd.r[0] + S[1] * sd.r[1]) + (S[2] * sd.r[2] + S[3] * sd.r[3]); y_ = row16_sum(y_); \
        if ((lane & 15) == 0) Y[(size_t)(rowbase + (t)) * RWW + vofs] = y_; }
    StepD c0, c1, c2, c3, n0, n1, n2, n3;
    SC_LD(c0, 0) SC_LD(c1, 1) SC_LD(c2, 2) SC_LD(c3, 3)
    for (int t = 0; t < nsteps; t += 4) {
        const int tn = (t + 4 < nsteps) ? t + 4 : t;
        SC_LD(n0, tn) SC_LD(n1, tn + 1) SC_LD(n2, tn + 2) SC_LD(n3, tn + 3)
        SC_DO(c0, t) SC_DO(c1, t + 1) SC_DO(c2, t + 2) SC_DO(c3, t + 3)
        c0 = n0; c1 = n1; c2 = n2; c3 = n3;
    }
#undef SC_LD
#undef SC_DO
    *(f32x4*)(s_out + i * 64 + j0) = S;
}
constexpr int CF_NIT = (NBS * NCMP_S + NBP * NCMP_P) * 2;
#define CFINAL_ITEM(kv_, j_) { const float* HC_ = WSF(WS_HC) + (size_t)(kv_) * CROWS * 256; \
    const int g_ = (j_) & 1; int q_ = (j_) >> 1; int b_, n_, rowlo_; const bool smp_ = q_ < NBS * NCMP_S; \
    if (smp_) { b_ = q_ / NCMP_S; n_ = q_ % NCMP_S; rowlo_ = (b_ * NCH_S + n_) * 2 + g_; } else { q_ -= NBS * NCMP_S; b_ = q_ / NCMP_P; n_ = q_ % NCMP_P; rowlo_ = CROWS_S + (b_ * NCH_P + n_) * 2 + g_; } \
    const float* lo_ = HC_ + (size_t)rowlo_ * 256; const float* hi_ = lo_ + 2 * 256 + 128; \
    const float h0_ = gelu_tanh(lo_[lane] + hi_[lane] + pe0), h1_ = gelu_tanh(lo_[64 + lane] + hi_[64 + lane] + pe1); \
    float acc_ = 0.f; \
    _Pragma("unroll") for (int e = 0; e < 64; ++e) acc_ += __builtin_bit_cast(float, __builtin_amdgcn_readlane(__builtin_bit_cast(int, h0_), e)) * w2c[e]; \
    _Pragma("unroll") for (int e = 0; e < 64; ++e) acc_ += __builtin_bit_cast(float, __builtin_amdgcn_readlane(__builtin_bit_cast(int, h1_), e)) * w2c[64 + e]; \
    if (smp_) WSF(WS_KCS)[(size_t)(kv_) * KCS_STRIDE + ((size_t)(b_ * NCMP_S + n_) * 2 + g_) * 64 + lane] = acc_; \
    else if ((kv_) == 0) WSB(WS_KCP)[((size_t)(b_ * 2 + g_) * 256 + n_) * 64 + lane] = (bf16)f2bf(acc_); \
    else WSB(WS_VCTP)[((size_t)(b_ * 2 + g_) * 64 + lane) * 256 + n_] = (bf16)f2bf(acc_); }
constexpr int SCH = 32, SCHF = SCH * 384;
DI void ph_scan_prompt(const Args& a, LAS unsigned char* lds, int tid, int lane, int wave, int G, int bx) {
    const float* RW = WSF(WS_RW); float* Y = WSF(WS_YS);
    LAS float* buf = (LAS float*)lds;
    constexpr int NCH = T / SCH;
    if (wave >= 2) {
      const bool sidew = (wave & 2) != 0; const int sidx = (wave & 1) + ((wave >> 2) << 1); const int lid = sidx * G + bx, nl = 4 * G, ckv = lid & 1;
      if (sidew) for (int si = lid; si < 4096; si += nl) { const int bh2 = si >> 4, rg2 = si & 15, b2 = bh2 >> 3, h2 = bh2 & 7, i2 = rg2 * 4 + (lane >> 4);
          scan_run(RW, Y, MP + b2 * 4, 4, h2, i2, lane, a.in[I_SWKV] + (size_t)bh2 * 4096, a.out + O_WKV_S + (size_t)bh2 * 4096); }
      asm volatile("" ::: "memory");
      float w2c[128];
#pragma unroll
      for (int e = 0; e < 128; ++e) w2c[e] = a.in[I_PW2][(size_t)(ckv * 128 + e) * 64 + lane];
      const float pe0 = WSF(WS_PET)[ckv * 128 + lane], pe1 = WSF(WS_PET)[ckv * 128 + 64 + lane];
      for (int it = bx; it < 256; it += G) {
        const int bh = it >> 3, b = bh >> 3, h = bh & 7, rowbase = b * T, sidebase = ((it - bx) / G) * NCH;
        __syncthreads();
        {
#define DMA_CHUNK(c) { _Pragma("unroll") for (int q = 0; q < 8; ++q) { const int R0 = ((wave - 2) * 8 + q) * 4, R = R0 + (lane >> 4), t_ = R / 6, aa = R - 6 * t_; \
                __builtin_amdgcn_global_load_lds((const unsigned*)(RW + (size_t)aa * RW_STRIDE + (size_t)(rowbase + (c) * SCH + t_) * RWW + h * 64 + (lane & 15) * 4), \
                    (LAS unsigned*)(buf + ((c) & 1) * SCHF + R0 * 64), 16, 0, 0); } }
            DMA_CHUNK(0)
            asm volatile("s_waitcnt vmcnt(0)" ::: "memory");
            __syncthreads();
            for (int c = 0; c < NCH; ++c) {
                if (c + 1 < NCH) DMA_CHUNK(c + 1)
                if (sidew) { const int j = (sidebase + c) * (nl >> 1) + (lid >> 1); if (j < CF_NIT) CFINAL_ITEM(ckv, j)
                             const int j2 = (NCH + sidebase + c) * (nl >> 1) + (lid >> 1); if (j2 < CF_NIT) CFINAL_ITEM(ckv, j2) }
                asm volatile("s_waitcnt vmcnt(0)" ::: "memory");
                __syncthreads();
            }
#undef DMA_CHUNK
        }
      }
    } else {
      for (int it = bx; it < 256; it += G) {
        const int bh = it >> 3, b = bh >> 3, h = bh & 7, rowbase = b * T;
        __syncthreads();
        {
            const int rg = (it & 7) * 2 + wave, i = rg * 4 + (lane >> 4), j0 = (lane & 15) * 4, k16 = lane & 15; const size_t vofs = (size_t)h * 64 + i;
            f32x4 S = {0.f, 0.f, 0.f, 0.f}, rp = {0.f, 0.f, 0.f, 0.f}; float ysel = 0.f;
#define RED2(x_, y_) x_ += dpp_f<0x128>(x_); y_ += dpp_f<0x128>(y_); x_ += dpp_f<0x124>(x_); y_ += dpp_f<0x124>(y_); x_ += dpp_f<0x122>(x_); y_ += dpp_f<0x122>(y_); x_ += dpp_f<0x121>(x_); y_ += dpp_f<0x121>(y_);
            __syncthreads();
            for (int c = 0; c < NCH; ++c) {
                const LAS float* cb = buf + (c & 1) * SCHF; const int tb = c * SCH;
                StepD q0, q1, q2;
#define L_LD(sd, t) { const LAS float* p_ = cb + (t) * 384; sd.r = *(const LAS f32x4*)(p_ + j0); sd.w = *(const LAS f32x4*)(p_ + 64 + j0); sd.k = *(const LAS f32x4*)(p_ + 128 + j0); sd.v = p_[192 + i]; \
                sd.kk = *(const LAS f32x4*)(p_ + 256 + j0); sd.b = *(const LAS f32x4*)(p_ + 320 + j0); }
                L_LD(q0, 0) L_LD(q1, 1)
#pragma unroll
                for (int t = 0; t < SCH; ++t) {
                    if (t + 2 < SCH) L_LD(q2, t + 2)
                    __builtin_amdgcn_sched_barrier(0);
                    float pd = __builtin_fmaf(S[3], q0.kk[3], __builtin_fmaf(S[2], q0.kk[2], __builtin_fmaf(S[1], q0.kk[1], S[0] * q0.kk[0])));
                    float py = __builtin_fmaf(S[3], rp[3], __builtin_fmaf(S[2], rp[2], __builtin_fmaf(S[1], rp[1], S[0] * rp[0])));
                    RED2(pd, py)
                    ysel = (k16 == ((t + 15) & 15)) ? py : ysel;
                    if ((t & 15) == 0 && (t > 0 || c > 0)) Y[(size_t)(rowbase + tb + t - 16 + k16) * RWW + vofs] = ysel;
                    S = S * q0.w + (q0.v * q0.k - pd * q0.b);
                    rp = q0.r;
                    q0 = q1; q1 = q2;
                    __builtin_amdgcn_sched_barrier(0);
                }
#undef L_LD
                __syncthreads();
            }
            { float pd = 0.f, py = (S[0] * rp[0] + S[1] * rp[1]) + (S[2] * rp[2] + S[3] * rp[3]); RED2(pd, py) ysel = (k16 == 15) ? py : ysel; Y[(size_t)(rowbase + T - 16 + k16) * RWW + vofs] = ysel; }
#undef RED2
            *(f32x4*)(a.out + O_WKV_P + (size_t)bh * 4096 + i * 64 + j0) = S;
        }
      }
    }
}

DI bf16x8 pack8(const f32x4& x0, const f32x4& x1) { v4u p; p.x = pk2(x0[0], x0[1]); p.y = pk2(x0[2], x0[3]); p.z = pk2(x1[0], x1[1]); p.w = pk2(x1[2], x1[3]); return __builtin_bit_cast(bf16x8, p); }
DI f32x16 qk_tile(const bf16* Kp, const bf16x8 (&qf)[4], int lane) {
    const bf16* kr = Kp + (size_t)(lane & 31) * 64 + 8 * (lane >> 5);
    f32x16 p = zero16();
#pragma unroll
    for (int s = 0; s < 4; ++s) { const bf16x8 kf = *(const bf16x8*)(kr + 16 * s); p = MFMA32(kf, qf[s], p); }
    return p;
}
DI void pack_p(const f32x16& P, bf16x8 (&pf)[2]) {
#pragma unroll
    for (int s = 0; s < 2; ++s) { v4u w; w.x = pk2(P[8 * s], P[8 * s + 1]); w.y = pk2(P[8 * s + 2], P[8 * s + 3]); w.z = pk2(P[8 * s + 4], P[8 * s + 5]); w.w = pk2(P[8 * s + 6], P[8 * s + 7]); pf[s] = __builtin_bit_cast(bf16x8, w); }
}
DI void pv_tile(f32x16 (&o)[2], const bf16* Vt, int ldv, const bf16x8 (&pf)[2], int lane) {
    const int hh = lane >> 5;
#pragma unroll
    for (int s = 0; s < 2; ++s)
#pragma unroll
        for (int db = 0; db < 2; ++db) { const bf16* vr = Vt + (size_t)((lane & 31) + 32 * db) * ldv + 16 * s + 4 * hh;
            const s16x4 lo = *(const s16x4*)vr, hi = *(const s16x4*)(vr + 8);
            const bf16x8 vf = __builtin_shufflevector(lo, hi, 0, 1, 2, 3, 4, 5, 6, 7);
            o[db] = MFMA32(vf, pf[s], o[db]); }
}
DI void osm_step(f32x16& p, unsigned okm, float& m, float& l, f32x16 (&o)[2]) {
    float mx = NEGF;
#pragma unroll
    for (int i = 0; i < 16; ++i) mx = ((okm >> i) & 1u) ? fmaxf(mx, p[i]) : mx;
    mx = fmaxf(mx, __shfl_xor(mx, 32));
    const float mn = fmaxf(m, mx), al = __builtin_amdgcn_exp2f(m - mn);
    l *= al; o[0] = o[0] * al; o[1] = o[1] * al;
#pragma unroll
    for (int i = 0; i < 16; ++i) { const float e = ((okm >> i) & 1u) ? __builtin_amdgcn_exp2f(p[i] - mn) : 0.f; p[i] = e; l += e; }
    m = mn;
}
DI void osm_full(f32x16& p, float& m, float& l, f32x16 (&o)[2]) {
    float mx = fmaxf(fmaxf(fmaxf(p[0], p[1]), fmaxf(p[2], p[3])), fmaxf(fmaxf(p[4], p[5]), fmaxf(p[6], p[7])));
    mx = fmaxf(mx, fmaxf(fmaxf(fmaxf(p[8], p[9]), fmaxf(p[10], p[11])), fmaxf(fmaxf(p[12], p[13]), fmaxf(p[14], p[15]))));
    mx = fmaxf(mx, __shfl_xor(mx, 32));
    if (__ballot(mx > m) != 0ull) { const float mn = fmaxf(m, mx), al = __builtin_amdgcn_exp2f(m - mn); l *= al; o[0] = o[0] * al; o[1] = o[1] * al; m = mn; }
    float ls = 0.f;
#pragma unroll
    for (int i = 0; i < 16; ++i) { const float e = __builtin_amdgcn_exp2f(p[i] - m); p[i] = e; ls += e; }
    l += ls;
}
constexpr int ARING_OFF = 69632, ABUF = 18432, AROW = 144;
template <int BR> DI void attend_blocks(LAS unsigned char* lds, const bf16* Kg, const bf16* Vtg, unsigned long long blkmask, unsigned long long smask,
                                        const bf16x8 (&qf)[4], int q0, int t, int tid, int lane, float& m, float& l, f32x16 (&o)[2]) {
    const int hh = lane >> 5, r = lane & 31, srow = tid >> 3, sch = tid & 7;
    const int nb = __popcll(blkmask);
    if (nb == 0) return;
    unsigned long long rem = blkmask;
    int jb = __ffsll((long long)rem) - 1; rem &= rem - 1;
    v4u kreg = *(const v4u*)(Kg + (size_t)(jb * 64 + srow) * 64 + sch * 8);
    v4u vreg = *(const v4u*)(Vtg + (size_t)srow * T + jb * 64 + sch * 8);
    for (int it = 0; it < nb; ++it) {
        LAS unsigned char* kb = lds + ARING_OFF + (it & 1) * ABUF; LAS unsigned char* vb = kb + 64 * AROW;
        *(LAS v4u*)(kb + srow * AROW + sch * 16) = kreg; *(LAS v4u*)(vb + srow * AROW + sch * 16) = vreg;
        const int jcur = jb;
        __syncthreads();
        if (rem) { jb = __ffsll((long long)rem) - 1; rem &= rem - 1;
            kreg = *(const v4u*)(Kg + (size_t)(jb * 64 + srow) * 64 + sch * 8); vreg = *(const v4u*)(Vtg + (size_t)srow * T + jb * 64 + sch * 8); }
        const bool bit = (BR == 1) ? (((smask >> jcur) & 1ull) != 0ull) : true;
        const unsigned long long bal = (BR == 1) ? __ballot(bit) : ~0ull;
        if (bal != 0ull) {
#pragma unroll
            for (int sub = 0; sub < 2; ++sub) {
                const int k0 = jcur * 64 + sub * 32;
                if (k0 > q0 + 31) break;
                if (BR == 2 && k0 + 31 <= q0 - 512) continue;
                f32x16 p = zero16();
#pragma unroll
                for (int s = 0; s < 4; ++s) { const bf16x8 kf = *(const LAS bf16x8*)(kb + (sub * 32 + r) * AROW + 32 * s + 16 * hh); p = MFMA32(kf, qf[s], p); }
                const bool full = (bal == ~0ull) && (k0 + 31 <= q0) && (BR == 1 || k0 > q0 + 31 - 512);
                if (full) osm_full(p, m, l, o);
                else { unsigned okm = 0u;
#pragma unroll
                    for (int i = 0; i < 16; ++i) { const int key = k0 + crow(i, hh); okm |= (bit && key <= t && (BR == 1 || key > t - 512)) ? (1u << i) : 0u; }
                    osm_step(p, okm, m, l, o); }
                bf16x8 pf[2]; pack_p(p, pf);
#pragma unroll
                for (int s2 = 0; s2 < 2; ++s2)
#pragma unroll
                    for (int db = 0; db < 2; ++db) { const LAS unsigned char* vr = vb + (r + 32 * db) * AROW + 64 * sub + 32 * s2 + 8 * hh;
                        const s16x4 lo = *(const LAS s16x4*)vr, hi = *(const LAS s16x4*)(vr + 16);
                        o[db] = MFMA32(__builtin_shufflevector(lo, hi, 0, 1, 2, 3, 4, 5, 6, 7), pf[s2], o[db]); }
            }
        }
    }
    __syncthreads();
}
constexpr int IMP_LD = 65;
constexpr int SMASK_OFF = 2 * 4 * 32 * IMP_LD * 4;
constexpr int SATT_OFF = 69632;
DI void attn_prompt_unit(const Args& a, LAS unsigned char* lds, int tid, int lane, int wave, int b, int g, int tile) {
    const float* PROJ = WSF(WS_PROJ);
    const int hl = wave & 3, qh = wave >> 2, head = g * 4 + hl, q0 = tile * 64 + qh * 32, r = lane & 31, hh = lane >> 5, t = q0 + r, bg = b * 2 + g;
    const float* prow = PROJ + (size_t)(b * T + t) * NINP;
    bf16x8 qf[4];
    { const float qs = 0.125f * LOG2E;
#pragma unroll
      for (int s = 0; s < 4; ++s) { const float* qp = prow + C_Q + head * 64 + 16 * s + 8 * hh; qf[s] = pack8(*(const f32x4*)qp * qs, *(const f32x4*)(qp + 4) * qs); } }
    const float g0 = sigmoidf_(prow[C_GATE + head * 3]), g1 = sigmoidf_(prow[C_GATE + head * 3 + 1]), g2 = sigmoidf_(prow[C_GATE + head * 3 + 2]);
    f32x16 of[2]; of[0] = zero16(); of[1] = zero16();
    LAS float* sImp = (LAS float*)lds; LAS unsigned long long* sMask = (LAS unsigned long long*)(lds + SMASK_OFF);
    {
        const bf16* Kc = WSB(WS_KCP) + (size_t)bg * 256 * 64; const bf16* Vct = WSB(WS_VCTP) + (size_t)bg * 64 * 256;
        const int tmax = q0 + 31, nvis = tmax >= 31 ? (tmax - 31) / 16 + 1 : 0, ntile = (nvis + 31) >> 5;
        float m = NEGF, l = 0.f;
        for (int kt = 0; kt < ntile; ++kt) {
            const f32x16 p = qk_tile(Kc + (size_t)kt * 32 * 64, qf, lane);
            float mx = NEGF;
#pragma unroll
            for (int i = 0; i < 16; ++i) { const int n = kt * 32 + crow(i, hh); mx = (16 * n + 31 <= t) ? fmaxf(mx, p[i]) : mx; }
            mx = fmaxf(mx, __shfl_xor(mx, 32));
            const float mn = fmaxf(m, mx); l *= __builtin_amdgcn_exp2f(m - mn);
#pragma unroll
            for (int i = 0; i < 16; ++i) { const int n = kt * 32 + crow(i, hh); l += (16 * n + 31 <= t) ? __builtin_amdgcn_exp2f(p[i] - mn) : 0.f; }
            m = mn;
        }
        l += __shfl_xor(l, 32);
        const float inv = l > 0.f ? 1.0f / l : 0.f;
        LAS float* slab = sImp + (size_t)((qh * 4 + hl) * 32 + r) * IMP_LD;
#pragma unroll
        for (int blk = 0; blk < 2; ++blk) {
            f32x16 im = zero16();
            const int kt0 = blk == 0 ? 0 : 3, kt1 = blk == 0 ? (ntile < 4 ? ntile : 4) : ntile;
            for (int kt = kt0; kt < kt1; ++kt) {
                f32x16 p = qk_tile(Kc + (size_t)kt * 32 * 64, qf, lane);
#pragma unroll
                for (int i = 0; i < 16; ++i) { const int n = kt * 32 + crow(i, hh); p[i] = (16 * n + 31 <= t) ? __builtin_amdgcn_exp2f(p[i] - m) * inv : 0.f; }
                bf16x8 pf[2]; pack_p(p, pf);
                if (blk == 0 || kt >= 4) pv_tile(of, Vct + kt * 32, 256, pf, lane);
                const int jb = r + 32 * blk;
#pragma unroll
                for (int s = 0; s < 2; ++s) { bf16x8 af;
#pragma unroll
                    for (int j = 0; j < 8; ++j) { const int n = kt * 32 + 16 * s + 8 * (j >> 2) + 4 * hh + (j & 3); af[j] = (n >= 4 * jb - 1 && n <= 4 * jb + 3) ? (short)0x3F80 : (short)0; }
                    im = MFMA32(af, pf[s], im); }
            }
#pragma unroll
            for (int i = 0; i < 16; ++i) slab[32 * blk + crow(i, hh)] = im[i];
        }
        of[0] = of[0] * g0; of[1] = of[1] * g0;
    }
    __syncthreads();
    for (int e = 0; e < 8; ++e) {
        const int qq = wave * 8 + e, qh2 = qq >> 5, rq = qq & 31, tq = tile * 64 + qq, cur = tq >> 6;
        float s = 0.f;
#pragma unroll
        for (int h2 = 0; h2 < 4; ++h2) s += sImp[(size_t)((qh2 * 4 + h2) * 32 + rq) * IMP_LD + lane];
        const float v = lane > cur ? -1e9f : ((lane == 0 || lane == cur || lane == cur - 1) ? 1e9f : s);
        int rank = 0;
#pragma unroll 16
        for (int j = 0; j < 64; ++j) { const float vj = __builtin_bit_cast(float, __builtin_amdgcn_readlane(__builtin_bit_cast(int, v), j)); rank += (vj > v || (vj == v && j < lane)) ? 1 : 0; }
        const unsigned long long mask = __ballot(rank < 16 && lane <= cur);
        if (lane == 0) sMask[qq] = mask;
    }
    __syncthreads();
    const unsigned long long smask = sMask[qh * 32 + r];
    __syncthreads();
    LAS float* park = (LAS float*)lds + wave * 2048 + lane;
#pragma unroll
    for (int db = 0; db < 2; ++db)
#pragma unroll
        for (int i = 0; i < 16; ++i) park[(db * 16 + i) * 64] = of[db][i];
    {
        float m = NEGF, l = 0.f; f32x16 o[2]; o[0] = zero16(); o[1] = zero16();
        const unsigned long long blk = (tile >= 63) ? ~0ull : ((1ull << (tile + 1)) - 1ull);
        attend_blocks<1>(lds, WSB(WS_KSEL) + (size_t)bg * T * 64, WSB(WS_VTSEL) + (size_t)bg * 64 * T, blk, smask, qf, q0, t, tid, lane, m, l, o);
        l += __shfl_xor(l, 32); const float sc = l > 0.f ? g1 / l : 0.f;
#pragma unroll
        for (int db = 0; db < 2; ++db)
#pragma unroll
            for (int i = 0; i < 16; ++i) park[(db * 16 + i) * 64] += o[db][i] * sc;
    }
    {
        float m = NEGF, l = 0.f; f32x16 o[2]; o[0] = zero16(); o[1] = zero16();
        const unsigned long long hi_ = (tile >= 63) ? ~0ull : ((1ull << (tile + 1)) - 1ull), lo_ = (tile >= 8) ? ((1ull << (tile - 8)) - 1ull) : 0ull;
        attend_blocks<2>(lds, WSB(WS_KWIN) + (size_t)bg * T * 64, WSB(WS_VTWIN) + (size_t)bg * 64 * T, hi_ & ~lo_, 0ull, qf, q0, t, tid, lane, m, l, o);
        l += __shfl_xor(l, 32); const float sc = l > 0.f ? g2 / l : 0.f;
#pragma unroll
        for (int db = 0; db < 2; ++db)
#pragma unroll
            for (int i = 0; i < 16; ++i) of[db][i] = park[(db * 16 + i) * 64] + o[db][i] * sc;
    }
    bf16* yb = WSB(WS_AST) + (size_t)(MA + b * T + t) * RWW + head * 64;
#pragma unroll
    for (int db = 0; db < 2; ++db)
#pragma unroll
        for (int gq = 0; gq < 4; ++gq) { v2u w; w.x = pk2(of[db][4 * gq], of[db][4 * gq + 1]); w.y = pk2(of[db][4 * gq + 2], of[db][4 * gq + 3]); *(v2u*)(yb + 32 * db + 8 * gq + 4 * hh) = w; }
}

constexpr int SA_SC = 0, SA_VP = 16384, SA_QV = 24576, SA_RED = 25600, SA_PACC = 26112, SA_IV = 34304, SA_LST = 35392, SA_CNT = 35456, SA_OUT = 35520;
template <int BR> DI void sa_branch_wg(const Args& a, LAS unsigned char* lds, int tid, int lane, int wave, int b, int g, int qpos, int nk, const float* pnew, float g_h0, float g_h1, float g_h2, float g_h3, float (&inv)[4]) {
    LAS float* sc = (LAS float*)(lds + SA_SC); LAS unsigned long long* vptr = (LAS unsigned long long*)(lds + SA_VP); const LAS float* qv = (const LAS float*)(lds + SA_QV);
    LAS float* red = (LAS float*)(lds + SA_RED); LAS float* pacc = (LAS float*)(lds + SA_PACC); const LAS int* lst = (const LAS int*)(lds + SA_LST); LAS float* outb = (LAS float*)(lds + SA_OUT);
    for (int idx = tid; idx < nk; idx += 512) {
        const float* kr; bool ok = true;
        if (BR == 0) kr = WSF(WS_KCS) + ((size_t)(b * NCMP_S + idx) * 2 + g) * 64;
        else if (BR == 1) { if (idx < 960) { const int blk = lst[idx >> 6]; const int page = ((const int*)a.in[I_PT])[b * 128 + (blk >> 1)]; kr = a.in[I_CKS] + ((size_t)page * 128 + (blk & 1) * 64 + (idx & 63)) * 256 + g * 64; }
                            else { kr = pnew + (size_t)(idx - 960) * NINP + 256 + g * 64; ok = (16384 + idx - 960) <= qpos; } }
        else { if (idx < 512) { kr = a.in[I_SKW] + ((size_t)b * 512 + idx) * 256 + g * 64; ok = (15872 + idx) >= qpos - 511; }
               else { kr = pnew + (size_t)(idx - 512) * NINP + 512 + g * 64; ok = (16384 + idx - 512) <= qpos; } }
        vptr[idx] = (unsigned long long)(BR == 0 ? kr + KCS_STRIDE : kr + 128);
        float s0 = 0.f, s1 = 0.f, s2 = 0.f, s3 = 0.f;
#pragma unroll 8
        for (int d4 = 0; d4 < 16; ++d4) { const f32x4 kv = *(const f32x4*)(kr + 4 * d4);
            const f32x4 q0 = *(const LAS f32x4*)(qv + 4 * d4), q1 = *(const LAS f32x4*)(qv + 64 + 4 * d4), q2 = *(const LAS f32x4*)(qv + 128 + 4 * d4), q3 = *(const LAS f32x4*)(qv + 192 + 4 * d4);
            s0 += (kv[0] * q0[0] + kv[1] * q0[1]) + (kv[2] * q0[2] + kv[3] * q0[3]); s1 += (kv[0] * q1[0] + kv[1] * q1[1]) + (kv[2] * q1[2] + kv[3] * q1[3]);
            s2 += (kv[0] * q2[0] + kv[1] * q2[1]) + (kv[2] * q2[2] + kv[3] * q2[3]); s3 += (kv[0] * q3[0] + kv[1] * q3[1]) + (kv[2] * q3[2] + kv[3] * q3[3]); }
        *(LAS f32x4*)(sc + (size_t)idx * 4) = ok ? (f32x4){s0, s1, s2, s3} : (f32x4){NEGF, NEGF, NEGF, NEGF};
    }
    __syncthreads();
    float mx[4] = {NEGF, NEGF, NEGF, NEGF};
    for (int idx = lane; idx < nk; idx += 64) { const f32x4 v = *(const LAS f32x4*)(sc + (size_t)idx * 4);
#pragma unroll
        for (int h = 0; h < 4; ++h) mx[h] = fmaxf(mx[h], v[h]); }
#pragma unroll
    for (int h = 0; h < 4; ++h) mx[h] = wave_max(mx[h]);
    __syncthreads();
    float sm[4] = {0.f, 0.f, 0.f, 0.f};
    for (int idx = tid; idx < nk; idx += 512) { const f32x4 v = *(const LAS f32x4*)(sc + (size_t)idx * 4); f32x4 e;
#pragma unroll
        for (int h = 0; h < 4; ++h) { e[h] = v[h] > -1e29f ? __expf(v[h] - mx[h]) : 0.f; sm[h] += e[h]; }
        *(LAS f32x4*)(sc + (size_t)idx * 4) = e; }
#pragma unroll
    for (int h = 0; h < 4; ++h) { sm[h] = wave_sum(sm[h]); if (lane == 0) red[wave * 4 + h] = sm[h]; }
    __syncthreads();
#pragma unroll
    for (int h = 0; h < 4; ++h) { float t_ = 0.f;
#pragma unroll
        for (int w = 0; w < 8; ++w) t_ += red[w * 4 + h];
        inv[h] = 1.0f / fmaxf(t_, 1e-30f); }
    const int kpw = (nk + 7) >> 3, kbeg = wave * kpw, kend = (kbeg + kpw < nk) ? kbeg + kpw : nk;
    float acc[4] = {0.f, 0.f, 0.f, 0.f};
#pragma unroll 16
    for (int idx = kbeg; idx < kend; ++idx) { const float* vr = (const float*)vptr[idx]; const float vv = vr[lane]; const f32x4 pp = *(const LAS f32x4*)(sc + (size_t)idx * 4);
        acc[0] += pp[0] * vv; acc[1] += pp[1] * vv; acc[2] += pp[2] * vv; acc[3] += pp[3] * vv; }
#pragma unroll
    for (int h = 0; h < 4; ++h) pacc[(wave * 4 + h) * 64 + lane] = acc[h];
    __syncthreads();
    if (tid < 256) { const int h = tid >> 6; float o = 0.f;
#pragma unroll
        for (int w = 0; w < 8; ++w) o += pacc[(w * 4 + h) * 64 + lane];
        const float gsel = h == 0 ? g_h0 : (h == 1 ? g_h1 : (h == 2 ? g_h2 : g_h3));
        outb[tid] = (BR == 0 ? 0.f : outb[tid]) + gsel * o * inv[h]; }
}
DI void attn_sample_wg(const Args& a, LAS unsigned char* lds, int tid, int lane, int wave, int item) {
    const float* PROJ = WSF(WS_PROJ);
    const int b = item >> 3, g = (item >> 2) & 1, q = item & 3, row = MP + b * 4 + q, qpos = 16384 + q;
    const float* prow = PROJ + (size_t)row * NINP; const float* pnew = PROJ + (size_t)(MP + b * 4) * NINP + C_KV;
    LAS float* sc = (LAS float*)(lds + SA_SC); LAS float* qv = (LAS float*)(lds + SA_QV); LAS float* iv = (LAS float*)(lds + SA_IV); LAS int* lst = (LAS int*)(lds + SA_LST); LAS int* cntw = (LAS int*)(lds + SA_CNT);
    const LAS float* outb = (const LAS float*)(lds + SA_OUT);
    __syncthreads();
    if (tid < 256) qv[tid] = prow[C_Q + g * 256 + tid] * 0.125f;
    float gt[4][3];
#pragma unroll
    for (int h = 0; h < 4; ++h)
#pragma unroll
        for (int br = 0; br < 3; ++br) gt[h][br] = sigmoidf_(prow[C_GATE + (g * 4 + h) * 3 + br]);
    __syncthreads();
    float inv[4];
    sa_branch_wg<0>(a, lds, tid, lane, wave, b, g, qpos, NCMP_S, pnew, gt[0][0], gt[1][0], gt[2][0], gt[3][0], inv);
    float val = 0.f; bool cand = tid <= 256;
    if (cand) { float s = 0.f;
        for (int n = 4 * tid - 1; n <= 4 * tid + 3; ++n) if (n >= 0 && n < NCMP_S) { const f32x4 p = *(const LAS f32x4*)(sc + (size_t)n * 4); s += (p[0] * inv[0] + p[1] * inv[1]) + (p[2] * inv[2] + p[3] * inv[3]); }
        val = (tid == 0 || tid == 255 || tid == 256) ? 1e9f : s; iv[tid] = val; }
    __syncthreads();
    int rank = 0;
    if (cand) for (int y = 0; y <= 256; ++y) { const float vy = iv[y]; rank += (vy > val || (vy == val && y < tid)) ? 1 : 0; }
    const bool sel = cand && rank < 16; const unsigned long long bal = __ballot(sel);
    if (lane == 0) cntw[wave] = __popcll(bal);
    __syncthreads();
    { int pos = __popcll(bal & ((1ull << lane) - 1ull)); for (int w = 0; w < wave; ++w) pos += cntw[w]; if (sel) lst[pos] = tid; }
    __syncthreads();
    sa_branch_wg<1>(a, lds, tid, lane, wave, b, g, qpos, 964, pnew, gt[0][1], gt[1][1], gt[2][1], gt[3][1], inv);
    __syncthreads();
    sa_branch_wg<2>(a, lds, tid, lane, wave, b, g, qpos, 516, pnew, gt[0][2], gt[1][2], gt[2][2], gt[3][2], inv);
    __syncthreads();
    if (tid < 256) WSB(WS_AST)[(size_t)(MA + row) * RWW + g * 256 + tid] = (bf16)f2bf(outb[tid]);
}
DI void rwpost_items(const Args& a, int lane, int wave, int G, int bx) {
    const int gw = wave * G + bx, NGW = G * NWAVES;
    for (int it = gw; it < MR * 8; it += 4 * NGW) {
        float y[4], bo[4], gg[4]; size_t o[4]; int c[4]; bool ok[4];
#pragma unroll
        for (int u = 0; u < 4; ++u) { const int id = it + u * NGW; ok[u] = id < MR * 8; const int idc = ok[u] ? id : it; c[u] = (idc & 7) * 64 + lane; o[u] = (size_t)(idc >> 3) * RWW + c[u];
            y[u] = WSF(WS_YS)[o[u]]; bo[u] = WSF(WS_BON)[o[u]]; gg[u] = WSF(WS_G)[o[u]]; }
#pragma unroll
        for (int u = 0; u < 4; ++u) { const float mean = wave_sum(y[u]) * (1.0f / 64.0f); const float dlt = y[u] - mean; const float var = wave_sum(dlt * dlt) * (1.0f / 64.0f);
            const float yn = dlt * rsqrtf(var + GN_EPS) * a.in[I_LNW][c[u]] + a.in[I_LNBB][c[u]];
            if (ok[u]) WSB(WS_AST)[o[u]] = (bf16)f2bf((yn + bo[u]) * gg[u]); }
    }
}
DI void ph_attention(const Args& a, LAS unsigned char* lds, int tid, int lane, int wave, int G, int bx) {
    for (int i = 0; i < 4; ++i) {
        const int base = (i >> 1) * G, u0 = base + bx; if (u0 >= 256) break;
        const int u = (i & 1) ? 511 - u0 : u0;
        __syncthreads();
        attn_prompt_unit(a, lds, tid, lane, wave, u >> 7, (u >> 6) & 1, u & 63);
    }
    for (int it = bx; it < 256; it += G) attn_sample_wg(a, lds, tid, lane, wave, it);
    rwpost_items(a, lane, wave, G, bx);
}

constexpr int N_PHASES = 16;
#ifndef PROBE_MASK
#define PROBE_MASK 0
#endif
#ifndef ONLY_PHASE
#define ONLY_PHASE (-1)
#endif
#ifndef MK_PER_PHASE
#define MK_PER_PHASE 0
#endif
__global__ void __launch_bounds__(NWAVES * 64, 2) fwd_kernel(Args a) {
    extern __shared__ __attribute__((aligned(16))) unsigned char lds_raw[];
    LAS unsigned char* lds = (LAS unsigned char*)lds_raw;
    const int tid = threadIdx.x, lane = tid & 63, wave = __builtin_amdgcn_readfirstlane(tid >> 6), G = gridDim.x, bx = blockIdx.x;
    for (int u = tid; u < (LDS_BYTES - LDSCTL_OFF) / 4; u += NWAVES * 64) ((LAS unsigned*)(lds + LDSCTL_OFF))[u] = 0u;
    __syncthreads();
    volatile LAS unsigned* MISC = (volatile LAS unsigned*)(lds + MISC_OFF);
    unsigned* ctl = (unsigned*)(a.ws + WS_CTL);
    XcdBarrier bar; bar.bar = ctl + CW_BAR; bar.x = 0; bar.st = nullptr;
    if (!MK_PER_PHASE) bar = xcd_barrier_post(ctl + CW_BAR, MISC + 8);
    const int lo = a.ph_lo, hi = a.ph_hi;
#define IN(k) (lo <= (k) && (k) < hi)
#define SEAM(k) do { if (IN(k) && IN((k) + 1)) xcd_barrier(bar); } while (0)
#define RUN(k, ...) do { if (IN(k) && (ONLY_PHASE < 0 || ONLY_PHASE == (k))) { __VA_ARGS__ if ((PROBE_MASK >> (k)) & 1) { xcd_barrier(bar); __VA_ARGS__ } } } while (0)
    LAS unsigned char* ring = lds + RING_OFF;
    RUN(0, ph_prologue(a, lds, tid, lane, wave, G, bx););
    SEAM(0);
    RUN(1, ph_u1(a, lane, wave, G, bx););
    SEAM(1);
    RUN(2, { pg8::Gemm g{WSB(WS_U), WSB(WS_WGU), MA, 5632, D}; pg8::StaticOrder S; S.init(MA, 5632, G, bx); pg8::EpiSwiglu E{WSB(WS_H)}; pg8::gemm_phase<pg8::EpiSwiglu, pg8::StaticOrder, true, true>(ring, g, S, E); });
    SEAM(2);
    RUN(3, { pg8::Gemm g{WSB(WS_H), WSB(WS_WDN), MA, D, FF}; pg8::StaticOrder S; S.init(MA, D, G, bx); pg8::EpiResid E{a.in[I_XP], a.in[I_XS], WSF(WS_MOD), 2, 0.5f, WSF(WS_Z)}; pg8::gemm_phase<pg8::EpiResid, pg8::StaticOrder, true, true>(ring, g, S, E); });
    SEAM(3);
    RUN(4, ph_ln<0>(a, lane, wave, G, bx););
    SEAM(4);
    RUN(5, { pg8::Gemm g{WSB(WS_U), WSB(WS_WIN), MA, NINP, D}; pg8::StaticOrder S; S.init(MA, NINP, G, bx); pg8::EpiProj E{a.in[I_BIN], WSF(WS_PROJ)}; pg8::gemm_phase<pg8::EpiProj, pg8::StaticOrder, true, true>(ring, g, S, E); });
    SEAM(5);
    RUN(6, ph_dist_rwprep(a, lds, tid, lane, wave, G, bx););
    SEAM(6);
    RUN(7, { pg8::Gemm g{WSB(WS_ACMP), WSB(WS_WC1), 2 * CROWS, 512, 1024}; pg8::DiagOrder S{CROWS / 256, 1, 2, G, bx}; pg8::EpiF32 E{WSF(WS_HC), 256, 0}; pg8::gemm_phase<pg8::EpiF32, pg8::DiagOrder, true, true>(ring, g, S, E); });
    SEAM(7);
    RUN(8, ph_scan_prompt(a, lds, tid, lane, wave, G, bx););
    SEAM(8);
    RUN(9, ph_attention(a, lds, tid, lane, wave, G, bx););
    SEAM(9);
    RUN(10, { pg8::Gemm g{WSB(WS_AST), WSB(WS_WOAB), 2 * MA, 2048, 512}; pg8::PairOrder S{MA / 256, 4, G, bx}; pg8::EpiOutAB E{WSF(WS_PROJ), WSF(WS_M1), WSB(WS_MIN), MA / 256}; pg8::gemm_phase<pg8::EpiOutAB, pg8::PairOrder, true, true>(ring, g, S, E); });
    SEAM(10);
    RUN(11, { pg8::Gemm g{WSB(WS_MIN), WSB(WS_WO), MA, D, D}; pg8::StaticOrder S; S.init(MA, D, G, bx); pg8::EpiResid E{WSF(WS_X1), WSF(WS_X1) + (size_t)MP * D, WSF(WS_MOD), 5, 1.0f, WSF(WS_Z)}; pg8::gemm_phase<pg8::EpiResid, pg8::StaticOrder, true, true>(ring, g, S, E); });
    SEAM(11);
    RUN(12, ph_ln<1>(a, lane, wave, G, bx););
    SEAM(12);
    RUN(13, { pg8::Gemm g{WSB(WS_U), WSB(WS_WGU) + (size_t)5632 * D, MA, 5632, D}; pg8::StaticOrder S; S.init(MA, 5632, G, bx); pg8::EpiSwiglu E{WSB(WS_H)}; pg8::gemm_phase<pg8::EpiSwiglu, pg8::StaticOrder, true, true>(ring, g, S, E); });
    SEAM(13);
    RUN(14, { pg8::Gemm g{WSB(WS_H), WSB(WS_WDN) + (size_t)D * FF, MA, D, FF}; pg8::StaticOrder S; S.init(MA, D, G, bx); pg8::EpiResid E{WSF(WS_X2), WSF(WS_X2) + (size_t)MP * D, WSF(WS_MOD), 8, 0.5f, WSF(WS_Z)}; pg8::gemm_phase<pg8::EpiResid, pg8::StaticOrder, true, true>(ring, g, S, E); });
    SEAM(14);
    RUN(15, ph_ln<2>(a, lane, wave, G, bx););
#undef IN
#undef SEAM
}

extern "C" void kernel_launch(void* const* d_in, const int* in_sizes, int n_in, void* d_out, int out_size, void* d_ws, size_t ws_size, hipStream_t stream) {
    static int grid = 0;
    if (grid == 0) {
        if (n_in != N_IN || (size_t)out_size != O_END || ws_size < WS_END) { fprintf(stderr, "kernel_launch: unexpected shapes: n_in %d out %d ws %zu (need %zu)\n", n_in, out_size, ws_size, (size_t)WS_END); grid = -1; return; }
        int dev = 0, cus = 0, per_cu = 0;
        if (hipGetDevice(&dev) != hipSuccess || hipDeviceGetAttribute(&cus, hipDeviceAttributeMultiprocessorCount, dev) != hipSuccess) { grid = -1; return; }
        if (hipFuncSetAttribute((const void*)fwd_kernel, hipFuncAttributeMaxDynamicSharedMemorySize, LDS_BYTES) != hipSuccess) { fprintf(stderr, "kernel_launch: hipFuncSetAttribute failed\n"); grid = -1; return; }
        if (hipOccupancyMaxActiveBlocksPerMultiprocessor(&per_cu, (const void*)fwd_kernel, NWAVES * 64, LDS_BYTES) != hipSuccess || per_cu < 1)
            fprintf(stderr, "kernel_launch: note: occupancy query reports %d workgroups per CU\n", per_cu);
        (void)hipGetLastError();
        grid = cus;
    }
    if (grid < 0) return;
    if (hipMemsetAsync((char*)d_ws + WS_CTL, 0, CTL_ZERO_BYTES, stream) != hipSuccess) return;
    Args a{};
    for (int i = 0; i < N_IN; ++i) a.in[i] = (const float*)d_in[i];
    a.out = (float*)d_out; a.ws = (unsigned char*)d_ws;
#if MK_PER_PHASE
    for (int p = 0; p < N_PHASES; ++p) { a.ph_lo = p; a.ph_hi = p + 1; hipLaunchKernelGGL(fwd_kernel, dim3(grid), dim3(NWAVES * 64), LDS_BYTES, stream, a); }
#else
    a.ph_lo = 0; a.ph_hi = N_PHASES;
    hipLaunchKernelGGL(fwd_kernel, dim3(grid), dim3(NWAVES * 64), LDS_BYTES, stream, a);
#endif
    const hipError_t le = hipPeekAtLastError();
    if (le != hipSuccess) fprintf(stderr, "kernel_launch: launch failed: %s\n", hipGetErrorName(le));
}
```

```cpp
#include <hip/hip_runtime.h>
#include <cstdio>
#include <cstdint>
#define DI __device__ __forceinline__
constexpr int D = 1024, FF = 2816, T = 4096, NBP = 4, NBS = 32, ST = 4;
constexpr int MP = NBP * T;
constexpr int MS = NBS * ST;
constexpr int MR = MP + MS;
constexpr int MA = 16640;
constexpr int NIN = 5144, NINP = 5376;
constexpr int C_Q = 1792, C_KV = 2304, C_GATE = 3072, C_MERGE = 3096;
constexpr int RWW = 512;
constexpr int NCH_S = 1024, NCH_P = 256;
constexpr int NCMP_S = 1023, NCMP_P = 255;
constexpr int CROWS_S = NBS * NCH_S * 2;
constexpr int CROWS = CROWS_S + NBP * NCH_P * 2;
constexpr float ALPHA = 1.189207115002721f;
constexpr float LN_EPS = 1e-5f, GN_EPS = 64e-5f;
constexpr float LOG2E = 1.4426950408889634f;
constexpr float NEGF = -1e30f;
constexpr size_t O_Y = 0;
constexpr size_t O_KVC_P = 16908288, O_KVS_P = 21102592, O_KVW_P = 25296896, O_WKV_P = 25821184, O_SH_P = 25952256;
constexpr size_t O_KVC_S = 25959424, O_KVS_S = 25992192, O_KVW_S = 26024960, O_WKV_S = 30219264, O_SH_S = 31267840, O_END = 31325184;
DI int bb_of_row(int row) { return row < MP ? (row >> 12) : (row < MR ? 4 + ((row - MP) >> 2) : 35); }
namespace pg8 {
#define PG8_LAS __attribute__((address_space(3)))
typedef unsigned short bf16_t;
typedef short bf16x8 __attribute__((ext_vector_type(8)));
typedef float f32x4 __attribute__((ext_vector_type(4)));
typedef unsigned u32x4 __attribute__((ext_vector_type(4)));
constexpr int BM = 256, BK = 64, HALF = 128, HTB = HALF * BK * 2  , STAGE_BYTES = 8 * HTB, NXCD = 8, WGM = 8;

__host__ __device__ __forceinline__ int lds_byte(int r, int c) { const int st = (r >> 4) * 2 + (c >> 5), rr = r & 15, cc = c & 31, ob = rr * 64 + cc * 2; return st * 1024 + (ob ^ (((ob >> 9) & 1) << 5)); }
__host__ __device__ __forceinline__ void stage_rc(int b, int& R, int& C) { const int st = b / 1024, sb = b % 1024, swz = sb ^ (((sb >> 9) & 1) << 5); R = (st >> 1) * 16 + swz / 64; C = (st & 1) * 32 + (swz % 64) / 2; }
__host__ __device__ __forceinline__ int perm32(int rho) { const int n = rho >> 4, i = rho & 15; return 8 * (i >> 2) + 4 * n + (i & 3); }

struct Unit { int pm, pn, kt0 = 0, nkt = 0; };
struct Gemm { const bf16_t* A; const bf16_t* Bt; int M, N, K; };

struct StaticOrder {
    int nM, nN, nwg, G, c;
    __host__ __device__ void init(int M, int N, int G_, int c_) { nM = M / BM; nN = N / BM; nwg = nM * nN; G = G_; c = c_; }
    __host__ __device__ bool next(int i, Unit& u) const {
        const long L = (long)i * G + c; if (L >= nwg) return false;
        int wgid = (int)L; { const int q = nwg / NXCD, r = nwg % NXCD, xcd = wgid % NXCD, off = wgid / NXCD; wgid = (xcd < r ? xcd * (q + 1) : r * (q + 1) + (xcd - r) * q) + off; }
        const int nig = WGM * nN, gid = wgid / nig, fm = gid * WGM, gsz = (nM - fm) < WGM ? (nM - fm) : WGM;
        u.pm = fm + ((wgid % nig) % gsz); u.pn = (wgid % nig) / gsz; return true;
    }
    __device__ __forceinline__ void a_ready(const Unit&) const {}
    __device__ __forceinline__ void done(const Unit&) const {}
};

struct PairOrder {
    int nm, nn, G, c;
    __device__ __forceinline__ bool next(int i, Unit& u) const {
        const int tile = (i >> 1) * G + c; if (tile >= nm * nn) return false;
        const int rep = i & 1; u.pm = tile / nn + rep * nm; u.pn = tile % nn + rep * nn; return true;
    }
    __device__ __forceinline__ void a_ready(const Unit&) const {}
    __device__ __forceinline__ void done(const Unit&) const {}
};
struct DiagOrder {
    int nm, nn, nrep, G, c;
    __device__ __forceinline__ bool next(int i, Unit& u) const {
        const int L = i * G + c; if (L >= nrep * nm * nn) return false;
        const int rep = L / (nm * nn), rem = L % (nm * nn); u.pm = rem / nn + rep * nm; u.pn = rem % nn + rep * nn; return true;
    }
    __device__ __forceinline__ void a_ready(const Unit&) const {}
    __device__ __forceinline__ void done(const Unit&) const {}
};

struct PromptCmpOrder {
    int G, c;
    __device__ __forceinline__ bool next(int i, Unit& u) const { const int L = i * G + c; if (L >= 64) return false; const int ks = L & 3, q = L >> 2, rep = q >> 3, rem = q & 7;
        u.pm = CROWS_S / BM + rem + rep * (CROWS / BM); u.pn = rep; u.kt0 = ks * 4; u.nkt = 4; return true; }
    __device__ __forceinline__ void a_ready(const Unit&) const {}
    __device__ __forceinline__ void done(const Unit&) const {}
};
struct PromptPlusSplit {
    StaticOrder S0; int nks, nkt, G, c;
    __device__ __forceinline__ void init(int N, int nks_, int nkt_, int G_, int c_) { S0.init(MP, N, G_, c_); nks = nks_; nkt = nkt_; G = G_; c = c_; }
    __device__ __forceinline__ bool next(int i, Unit& u) const {
        if (S0.next(i, u)) { u.kt0 = 0; u.nkt = 0; return true; }
        const int r0 = (S0.nwg + G - 1) / G; const int j = (i - r0) * G + c; if (j < 0 || j >= 4 * nks) return false;
        u.pm = MP / BM; u.pn = j & 3; u.kt0 = (j >> 2) * nkt; u.nkt = nkt; return true;
    }
    __device__ __forceinline__ void a_ready(const Unit&) const {}
    __device__ __forceinline__ void done(const Unit&) const {}
};

typedef float f32x2 __attribute__((ext_vector_type(2)));
typedef __bf16 bf16x2_t __attribute__((ext_vector_type(2)));
__device__ __forceinline__ unsigned cvt_pk_bf16(float lo, float hi) { f32x2 v = {lo, hi}; bf16x2_t b = __builtin_convertvector(v, bf16x2_t); return __builtin_bit_cast(unsigned, b); }
__device__ __forceinline__ float fast_sigmoid(float x) { return __builtin_amdgcn_rcpf(1.0f + __builtin_amdgcn_exp2f(-x * LOG2E)); }

struct EpiSwiglu {
    static constexpr bool PERM = true, AFTER_DRAIN = false;
    bf16_t* H;
    __device__ __forceinline__ void operator()(const f32x4 (&acc)[2][2][4][2], const Unit& u, int wr, int wc, int fr, int fq) const {
        const int row0 = u.pm * BM + wr * 64 + fr, hc0 = u.pn * HALF + wc * 32 + 8 * fq;
#pragma unroll
        for (int ai = 0; ai < 2; ++ai)
#pragma unroll
            for (int m = 0; m < 4; ++m) {
                bf16_t* rowp = H + (size_t)(row0 + ai * HALF + m * 16) * FF + hc0;
                float h[8];
#pragma unroll
                for (int n = 0; n < 2; ++n)
#pragma unroll
                    for (int e = 0; e < 4; ++e) { const float g = acc[ai][0][m][n][e], up = acc[ai][1][m][n][e]; h[4 * n + e] = g * fast_sigmoid(g) * up; }
                u32x4 w; w.x = cvt_pk_bf16(h[0], h[1]); w.y = cvt_pk_bf16(h[2], h[3]); w.z = cvt_pk_bf16(h[4], h[5]); w.w = cvt_pk_bf16(h[6], h[7]);
                *(u32x4*)rowp = w;
            }
    }
};
struct EpiResid {
    static constexpr bool PERM = false, AFTER_DRAIN = false;
    const float* xp; const float* xs; const float* mod; int slot; float coef; float* Z;
    __device__ __forceinline__ void operator()(const f32x4 (&acc)[2][2][4][2], const Unit& u, int wr, int wc, int fr, int fq) const {
        const int row0 = u.pm * BM + wr * 64 + fr, col0 = u.pn * BM + wc * 32 + 4 * fq;
        if (u.nkt) {
            float* zp = Z + (size_t)MA * D + (size_t)(u.kt0 / u.nkt) * MS * D;
#pragma unroll
            for (int m = 0; m < 4; ++m) { const int row = row0 - MP + m * 16;
#pragma unroll
                for (int bj = 0; bj < 2; ++bj)
#pragma unroll
                    for (int n = 0; n < 2; ++n) *(f32x4*)(zp + (size_t)row * D + col0 + bj * HALF + n * 16) = acc[0][bj][m][n]; }
        } else
#pragma unroll
        for (int ai = 0; ai < 2; ++ai)
#pragma unroll
            for (int m = 0; m < 4; ++m) {
                const int row = row0 + ai * HALF + m * 16; const bool valid = row < MR;
                const float* xr = row < MP ? xp + (size_t)row * D : xs + (size_t)(row - MP) * D;
                const float* mr = mod + (size_t)(bb_of_row(row) * 9 + slot) * D;
#pragma unroll
                for (int bj = 0; bj < 2; ++bj)
#pragma unroll
                    for (int n = 0; n < 2; ++n) { const int col = col0 + bj * HALF + n * 16;
                        const f32x4 xv = valid ? *(const f32x4*)(xr + col) : (f32x4){0.f, 0.f, 0.f, 0.f}; const f32x4 mv = *(const f32x4*)(mr + col);
                        *(f32x4*)(Z + (size_t)row * D + col) = ALPHA * xv + coef * (1.0f + mv) * acc[ai][bj][m][n]; }
            }
    }
};
struct EpiProj {
    static constexpr bool PERM = false, AFTER_DRAIN = false;
    const float* bias; float* P;
    __device__ __forceinline__ void operator()(const f32x4 (&acc)[2][2][4][2], const Unit& u, int wr, int wc, int fr, int fq) const {
        const int row0 = u.pm * BM + wr * 64 + fr, col0 = u.pn * BM + wc * 32 + 4 * fq;
        f32x4 bv[2][2];
#pragma unroll
        for (int bj = 0; bj < 2; ++bj)
#pragma unroll
            for (int n = 0; n < 2; ++n) { const int col = col0 + bj * HALF + n * 16; bv[bj][n] = col < NIN ? *(const f32x4*)(bias + col) : (f32x4){0.f, 0.f, 0.f, 0.f}; }
#pragma unroll
        for (int ai = 0; ai < 2; ++ai)
#pragma unroll
            for (int m = 0; m < 4; ++m) { float* rp = P + (size_t)(row0 + ai * HALF + m * 16) * NINP + col0;
#pragma unroll
                for (int bj = 0; bj < 2; ++bj)
#pragma unroll
                    for (int n = 0; n < 2; ++n) *(f32x4*)(rp + bj * HALF + n * 16) = acc[ai][bj][m][n] + bv[bj][n]; }
    }
};
struct EpiF32 {
    static constexpr bool PERM = false, AFTER_DRAIN = false;
    float* O; int ldc; int nm;
    __device__ __forceinline__ void operator()(const f32x4 (&acc)[2][2][4][2], const Unit& u, int wr, int wc, int fr, int fq) const {
        const int row0 = ((u.kt0 / 4) * 2 + u.pn) * 2048 + (u.pm - u.pn * (CROWS / BM) - CROWS_S / BM) * BM + wr * 64 + fr, col0 = wc * 32 + 4 * fq;
#pragma unroll
        for (int ai = 0; ai < 2; ++ai)
#pragma unroll
            for (int m = 0; m < 4; ++m) { float* rp = O + (size_t)(row0 + ai * HALF + m * 16) * ldc + col0;
#pragma unroll
                for (int bj = 0; bj < 2; ++bj)
#pragma unroll
                    for (int n = 0; n < 2; ++n) *(f32x4*)(rp + bj * HALF + n * 16) = acc[ai][bj][m][n]; }
    }
};
struct EpiOutAB {
    static constexpr bool PERM = false, AFTER_DRAIN = false;
    const float* P; float* M1; bf16_t* MIN; int nm;
    __device__ __forceinline__ void operator()(const f32x4 (&acc)[2][2][4][2], const Unit& u, int wr, int wc, int fr, int fq) const {
        const int rep = u.pm >= nm ? 1 : 0;
        const int row0 = (u.pm - rep * nm) * BM + wr * 64 + fr, col0 = (u.pn - rep * 4) * BM + wc * 32 + 4 * fq;
#pragma unroll
        for (int ai = 0; ai < 2; ++ai)
#pragma unroll
            for (int m = 0; m < 4; ++m) { const int row = row0 + ai * HALF + m * 16;
#pragma unroll
                for (int bj = 0; bj < 2; ++bj)
#pragma unroll
                    for (int n = 0; n < 2; ++n) { const int col = col0 + bj * HALF + n * 16;
                        const f32x4 pm = *(const f32x4*)(P + (size_t)row * NINP + C_MERGE + rep * D + col);
                        f32x4 g; g[0] = fast_sigmoid(pm[0]); g[1] = fast_sigmoid(pm[1]); g[2] = fast_sigmoid(pm[2]); g[3] = fast_sigmoid(pm[3]);
                        const f32x4 v = g * acc[ai][bj][m][n];
                        if (rep == 0) *(f32x4*)(M1 + (size_t)row * D + col) = v;
                        else { const f32x4 s = *(const f32x4*)(M1 + (size_t)row * D + col) + v;
                               typedef unsigned u32x2v __attribute__((ext_vector_type(2))); u32x2v w; w.x = cvt_pk_bf16(s[0], s[1]); w.y = cvt_pk_bf16(s[2], s[3]);
                               *(u32x2v*)(MIN + (size_t)row * D + col) = w; } }
            }
    }
};
template <class Epi, class Sched, bool ALIGN_EPI = false, bool SP2 = false>
__device__ __forceinline__ void gemm_phase(PG8_LAS unsigned char* lds, const Gemm g, const Sched& S, const Epi& E) {
    const int tid = threadIdx.x, wid = __builtin_amdgcn_readfirstlane(tid >> 6), lane = tid & 63, wr = wid >> 2, wc = wid & 3, fr = lane & 15, fq = lane >> 4;
    const int K = g.K, nt = K / BK;
    unsigned voffA[2], voffB[2];
#pragma unroll
    for (int i = 0; i < 2; ++i) { int R, C; stage_rc(tid * 16 + i * 8192, R, C); const int Rb = Epi::PERM ? ((R & ~31) + perm32(R & 31)) : R;
        voffA[i] = (unsigned)(R * K + C) * 2u; voffB[i] = (unsigned)(Rb * K + C) * 2u; }
    const size_t kstep = (size_t)(BK * 2);
    const size_t hstep = (size_t)HALF * K * 2;
    const size_t tstep = 2 * hstep;
    const unsigned ldsw = (unsigned)wid * 1024u;
    const int aoff = lds_byte(wr * 64 + fr, fq * 8), boff = lds_byte(wc * 32 + fr, fq * 8);
#define PG8_SA(b, h) (((b) * 2 + (h)) * HTB)
#define PG8_SB(b, h) ((4 + (b) * 2 + (h)) * HTB)
#define PG8_STAGE(bufoff, gbase, voff) do { _Pragma("unroll") for (int _i = 0; _i < 2; ++_i) \
        __builtin_amdgcn_global_load_lds((const unsigned*)((const char*)(gbase) + (voff)[_i]), (PG8_LAS unsigned*)(lds + (bufoff) + ldsw + _i * 8192), 16, 0, 0); } while (0)
#define PG8_LDA(dst, b, h) do { _Pragma("unroll") for (int m = 0; m < 4; ++m) _Pragma("unroll") for (int k = 0; k < 2; ++k) dst[m][k] = *(const PG8_LAS bf16x8*)(lds + PG8_SA(b, h) + aoff + m * 2048 + k * 1024); } while (0)
#define PG8_LDB(dst, b, h) do { _Pragma("unroll") for (int n = 0; n < 2; ++n) _Pragma("unroll") for (int k = 0; k < 2; ++k) dst[n][k] = *(const PG8_LAS bf16x8*)(lds + PG8_SB(b, h) + boff + n * 2048 + k * 1024); } while (0)
#define PG8_MMA(ai, bj, At, Bt) do { __builtin_amdgcn_s_setprio(1); _Pragma("unroll") for (int m = 0; m < 4; ++m) _Pragma("unroll") for (int n = 0; n < 2; ++n) _Pragma("unroll") for (int k = 0; k < 2; ++k) \
        acc[ai][bj][m][n] = __builtin_amdgcn_mfma_f32_16x16x32_bf16(Bt[n][k], At[m][k], acc[ai][bj][m][n], 0, 0, 0); __builtin_amdgcn_s_setprio(0); } while (0)
#define PG8_WAIT_V(n) asm volatile("s_waitcnt vmcnt(" #n ")" ::: "memory")
#define PG8_WAIT_L(n) asm volatile("s_waitcnt lgkmcnt(" #n ")" ::: "memory")
#define PG8_BAR __builtin_amdgcn_s_barrier()
#define PG8_SCHED __builtin_amdgcn_sched_barrier(0)
    Unit cur, nxt; int ui = 0;
    if (!S.next(0, cur)) return;
    f32x4 acc[2][2][4][2];
#pragma unroll
    for (int a = 0; a < 2; ++a)
#pragma unroll
        for (int b = 0; b < 2; ++b)
#pragma unroll
            for (int m = 0; m < 4; ++m)
#pragma unroll
                for (int n = 0; n < 2; ++n) acc[a][b][m][n] = (f32x4){0.f, 0.f, 0.f, 0.f};
    bf16x8 At[4][2], B0[2][2], B1[2][2];
    const char* cA = (const char*)g.A + (size_t)cur.pm * tstep + (size_t)cur.kt0 * kstep; const char* cB = (const char*)g.Bt + (size_t)cur.pn * tstep + (size_t)cur.kt0 * kstep;
    S.a_ready(cur);
    if constexpr (SP2) {
        PG8_STAGE(PG8_SB(0, 0), cB, voffB); PG8_STAGE(PG8_SB(0, 1), cB + hstep, voffB); PG8_STAGE(PG8_SA(0, 0), cA, voffA); PG8_STAGE(PG8_SA(0, 1), cA + hstep, voffA);
        if (wr == 1) PG8_BAR;
        PG8_WAIT_V(2); PG8_BAR;
        PG8_STAGE(PG8_SB(1, 0), cB + kstep, voffB); PG8_STAGE(PG8_SA(1, 0), cA + kstep, voffA); PG8_STAGE(PG8_SB(1, 1), cB + hstep + kstep, voffB);
        PG8_WAIT_V(6); PG8_BAR;
    } else {
        PG8_STAGE(PG8_SB(0, 0), cB, voffB); PG8_STAGE(PG8_SA(0, 0), cA, voffA); PG8_STAGE(PG8_SB(0, 1), cB + hstep, voffB); PG8_STAGE(PG8_SA(0, 1), cA + hstep, voffA);
        if (wr == 1) PG8_BAR;
        PG8_WAIT_V(4); PG8_BAR;
        PG8_STAGE(PG8_SB(1, 0), cB + kstep, voffB); PG8_STAGE(PG8_SA(1, 0), cA + kstep, voffA); PG8_STAGE(PG8_SB(1, 1), cB + hstep + kstep, voffB);
        PG8_WAIT_V(6); PG8_BAR;
    }
    for (;;) {
        const bool has_next = S.next(ui + 1, nxt);
        const char* nA = has_next ? (const char*)g.A + (size_t)nxt.pm * tstep + (size_t)nxt.kt0 * kstep : cA; const char* nB = has_next ? (const char*)g.Bt + (size_t)nxt.pn * tstep + (size_t)nxt.kt0 * kstep : cB;
        const int ntu = cur.nkt ? cur.nkt : nt;
        for (int t = 0; t < ntu; t += 2) {
            const bool last = (t == ntu - 2);
            const char* a1 = cA + (size_t)(t + 1) * kstep;
            const char* a2 = last ? nA : cA + (size_t)(t + 2) * kstep; const char* b2 = last ? nB : cB + (size_t)(t + 2) * kstep;
            const char* a3 = a2 + kstep; const char* b3 = b2 + kstep;
            if (last && has_next) S.a_ready(nxt);
            if constexpr (SP2) {
            PG8_LDB(B0, 0, 0); PG8_LDB(B1, 0, 1); PG8_SCHED; PG8_LDA(At, 0, 0); PG8_STAGE(PG8_SA(1, 1), a1 + hstep, voffA);
            PG8_WAIT_V(8); PG8_WAIT_L(0); PG8_BAR; PG8_MMA(0, 0, At, B0); PG8_MMA(0, 1, At, B1); PG8_BAR; PG8_SCHED;
            PG8_LDA(At, 0, 1); PG8_STAGE(PG8_SB(0, 0), b2, voffB); PG8_STAGE(PG8_SB(0, 1), b2 + hstep, voffB); PG8_STAGE(PG8_SA(0, 0), a2, voffA);
            PG8_WAIT_V(8); PG8_WAIT_L(0); PG8_BAR; PG8_MMA(1, 0, At, B0); PG8_MMA(1, 1, At, B1); PG8_BAR; PG8_SCHED;
            PG8_LDB(B0, 1, 0); PG8_LDB(B1, 1, 1); PG8_SCHED; PG8_LDA(At, 1, 0); PG8_STAGE(PG8_SA(0, 1), a2 + hstep, voffA);
            PG8_WAIT_V(8); PG8_WAIT_L(0); PG8_BAR; PG8_MMA(0, 0, At, B0); PG8_MMA(0, 1, At, B1); PG8_BAR; PG8_SCHED;
            PG8_LDA(At, 1, 1); PG8_STAGE(PG8_SB(1, 0), b3, voffB); PG8_STAGE(PG8_SB(1, 1), b3 + hstep, voffB); PG8_STAGE(PG8_SA(1, 0), a3, voffA);
            PG8_WAIT_V(8); PG8_WAIT_L(0); PG8_BAR; PG8_MMA(1, 0, At, B0); PG8_MMA(1, 1, At, B1); PG8_BAR; PG8_SCHED;
            } else {
            PG8_LDB(B0, 0, 0); PG8_SCHED; PG8_LDA(At, 0, 0); PG8_STAGE(PG8_SA(1, 1), a1 + hstep, voffA);
            PG8_WAIT_L(8); PG8_BAR; PG8_WAIT_L(0); PG8_MMA(0, 0, At, B0); PG8_BAR; PG8_SCHED;
            PG8_LDB(B1, 0, 1); PG8_STAGE(PG8_SB(0, 0), b2, voffB);
            PG8_BAR; PG8_WAIT_L(0); PG8_MMA(0, 1, At, B1); PG8_BAR;
            PG8_LDA(At, 0, 1); PG8_STAGE(PG8_SA(0, 0), a2, voffA);
            PG8_BAR; PG8_WAIT_L(0); PG8_MMA(1, 0, At, B0); PG8_BAR; PG8_SCHED;
            PG8_STAGE(PG8_SB(0, 1), b2 + hstep, voffB);
            PG8_WAIT_V(6); PG8_BAR; PG8_MMA(1, 1, At, B1); PG8_BAR;
            PG8_LDB(B0, 1, 0); PG8_SCHED; PG8_LDA(At, 1, 0); PG8_STAGE(PG8_SA(0, 1), a2 + hstep, voffA);
            PG8_WAIT_L(8); PG8_BAR; PG8_WAIT_L(0); PG8_MMA(0, 0, At, B0); PG8_BAR; PG8_SCHED;
            PG8_LDB(B1, 1, 1); PG8_STAGE(PG8_SB(1, 0), b3, voffB);
            PG8_BAR; PG8_WAIT_L(0); PG8_MMA(0, 1, At, B1); PG8_BAR;
            PG8_LDA(At, 1, 1); PG8_STAGE(PG8_SA(1, 0), a3, voffA);
            PG8_BAR; PG8_WAIT_L(0); PG8_MMA(1, 0, At, B0); PG8_BAR; PG8_SCHED;
            PG8_STAGE(PG8_SB(1, 1), b3 + hstep, voffB);
            PG8_WAIT_V(6); PG8_BAR; PG8_MMA(1, 1, At, B1); PG8_BAR;
            }
        }
        if constexpr (ALIGN_EPI) { if (wr == 0) PG8_BAR; }
        if constexpr (!Epi::AFTER_DRAIN) { E(acc, cur, wr, wc, fr, fq); S.done(cur); }
        if (!has_next) break;
#pragma unroll
        for (int a = 0; a < 2; ++a)
#pragma unroll
            for (int b = 0; b < 2; ++b)
#pragma unroll
                for (int m = 0; m < 4; ++m)
#pragma unroll
                    for (int n = 0; n < 2; ++n) acc[a][b][m][n] = (f32x4){0.f, 0.f, 0.f, 0.f};
        cur = nxt; cA = nA; cB = nB; ++ui;
        if constexpr (ALIGN_EPI) { if (wr == 1) PG8_BAR; }
    }
    PG8_WAIT_V(0);
    if constexpr (!ALIGN_EPI) { if (wr == 0) PG8_BAR; }
    PG8_BAR;
    if constexpr (Epi::AFTER_DRAIN) { E.fused(acc, cur, wr, wc, fr, fq, lds, wid, lane); S.done(cur); }
#undef PG8_SA
#undef PG8_SB
#undef PG8_STAGE
#undef PG8_LDA
#undef PG8_LDB
#undef PG8_MMA
#undef PG8_WAIT_V
#undef PG8_WAIT_L
#undef PG8_BAR
#undef PG8_SCHED
}
}

constexpr size_t al256(size_t x) { return (x + 255) & ~(size_t)255; }
constexpr size_t WS_CTL = 0, CTL_ZERO_BYTES = 1u << 20;
constexpr int CW_BAR = 4096;
constexpr size_t WS_MOD  = CTL_ZERO_BYTES;
constexpr size_t WS_PET  = al256(WS_MOD + (size_t)36 * 9 * D * 4);
constexpr size_t WS_WGU  = al256(WS_PET + 2 * 128 * 4);
constexpr size_t WS_WDN  = al256(WS_WGU + (size_t)2 * 5632 * D * 2);
constexpr size_t WS_WIN  = al256(WS_WDN + (size_t)2 * D * FF * 2);
constexpr size_t WS_WOAB = al256(WS_WIN + (size_t)NINP * D * 2);
constexpr size_t WS_WO   = al256(WS_WOAB + (size_t)2048 * 512 * 2);
constexpr size_t WS_WC1  = al256(WS_WO + (size_t)D * D * 2);
constexpr size_t WS_LORA = al256(WS_WC1 + (size_t)512 * 1024 * 2);
constexpr size_t WS_U    = al256(WS_LORA + (size_t)512 * 256 * 2);
constexpr size_t WS_H    = al256(WS_U + (size_t)MA * D * 2);
constexpr size_t WS_Z    = al256(WS_H + (size_t)MA * FF * 2);
constexpr size_t WS_ZP   = WS_Z + (size_t)MA * D * 4;
constexpr size_t WS_X1   = al256(WS_ZP + (size_t)11 * MS * D * 4);
constexpr size_t WS_X2   = al256(WS_X1 + (size_t)MA * D * 4);
constexpr size_t WS_M1   = al256(WS_X2 + (size_t)MA * D * 4);
constexpr size_t WS_MIN  = al256(WS_M1 + (size_t)MA * D * 4);
constexpr size_t WS_PROJ = al256(WS_MIN + (size_t)MA * D * 2);
constexpr size_t WS_RW   = al256(WS_PROJ + (size_t)MA * NINP * 4);
constexpr size_t RW_STRIDE = (size_t)MA * RWW;
constexpr size_t WS_G    = al256(WS_RW + 6 * RW_STRIDE * 4);
constexpr size_t WS_BON  = al256(WS_G + RW_STRIDE * 4);
constexpr size_t WS_YS   = al256(WS_BON + RW_STRIDE * 4);
constexpr size_t WS_AST  = al256(WS_YS + RW_STRIDE * 4);
constexpr size_t WS_KSEL = al256(WS_AST + (size_t)2 * MA * RWW * 2);
constexpr size_t KV_BYTES = (size_t)NBP * 2 * T * 64 * 2;
constexpr size_t WS_KWIN = WS_KSEL + KV_BYTES, WS_VTSEL = WS_KWIN + KV_BYTES, WS_VTWIN = WS_VTSEL + KV_BYTES;
constexpr size_t WS_KCP  = WS_VTWIN + KV_BYTES;
constexpr size_t WS_VCTP = WS_KCP + (size_t)NBP * 2 * 256 * 64 * 2;
constexpr size_t WS_KCS  = al256(WS_VCTP + (size_t)NBP * 2 * 256 * 64 * 2);
constexpr size_t KCS_STRIDE = (size_t)NBS * NCMP_S * 2 * 64;
constexpr size_t WS_ACMP = al256(WS_KCS + 2 * KCS_STRIDE * 4);
constexpr size_t WS_HC   = al256(WS_ACMP + (size_t)2 * CROWS * 1024 * 2);
constexpr size_t WS_HCP  = al256(WS_HC + (size_t)2 * CROWS * 256 * 4);
constexpr size_t WS_END  = al256(WS_HCP + (size_t)4 * 2 * 2048 * 256 * 4);

constexpr int NWAVES = 8;
constexpr int RING_OFF = 0, RING_BYTES = 131072;
constexpr int LDSCTL_OFF = 147456 - 512, MISC_OFF = LDSCTL_OFF + 320;
constexpr int LDS_BYTES = 147456;

#define GAS __attribute__((address_space(1)))
#define LAS __attribute__((address_space(3)))
typedef unsigned short bf16;
typedef unsigned v4u __attribute__((ext_vector_type(4)));
typedef unsigned v2u __attribute__((ext_vector_type(2)));
typedef float f32x4 __attribute__((ext_vector_type(4)));
typedef float f32x16 __attribute__((ext_vector_type(16)));
typedef short bf16x8 __attribute__((ext_vector_type(8)));
typedef short s16x4 __attribute__((ext_vector_type(4)));
typedef GAS unsigned gu32;
#define RLX_AGENT __ATOMIC_RELAXED, __HIP_MEMORY_SCOPE_AGENT
#define LDS_WAIT() asm volatile("s_waitcnt lgkmcnt(0)" ::: "memory")
#define VM_WAIT() asm volatile("s_waitcnt vmcnt(0)" ::: "memory")
DI unsigned f2bf(float f) { unsigned u = __builtin_bit_cast(unsigned, f); return (u + 0x7fffu + ((u >> 16) & 1u)) >> 16; }
DI unsigned pk2(float lo, float hi) { return pg8::cvt_pk_bf16(lo, hi); }
DI float sigmoidf_(float x) { return 1.0f / (1.0f + __expf(-x)); }
DI float wave_sum(float v) {
#pragma unroll
    for (int o = 1; o < 64; o <<= 1) v += __shfl_xor(v, o);
    return v;
}
DI float wave_max(float v) {
#pragma unroll
    for (int o = 1; o < 64; o <<= 1) v = fmaxf(v, __shfl_xor(v, o));
    return v;
}
template <int CTRL> DI float dpp_f(float x) { return __builtin_bit_cast(float, __builtin_amdgcn_update_dpp(0, __builtin_bit_cast(int, x), CTRL, 0xf, 0xf, false)); }
DI float row16_sum(float x) {
    x += dpp_f<0x128>(x); x += dpp_f<0x124>(x); x += dpp_f<0x122>(x); x += dpp_f<0x121>(x); return x;
}
DI float gelu_tanh(float x) { const float u = 0.7978845608028654f * (x + 0.044715f * x * x * x); const float e = __expf(2.0f * u); const float th = 1.0f - 2.0f / (e + 1.0f); return 0.5f * x * (1.0f + th); }
#define MFMA32(a_, b_, c_) __builtin_amdgcn_mfma_f32_32x32x16_bf16((a_), (b_), (c_), 0, 0, 0)
DI int crow(int i, int hh) { return (i & 3) + 8 * (i >> 2) + 4 * hh; }
DI f32x16 zero16() { f32x16 z;
#pragma unroll
    for (int i = 0; i < 16; ++i) z[i] = 0.f; return z; }
#define XB_TMO      128
#define XB_XCNT(j)  (256  + 64 * (j))
#define XB_XSUB(j)  (1280 + 64 * (j))
#define XB_XGEN(j)  (2304 + 64 * (j))
#define XB_TOP      3328
#define XB_TOPGEN   3392
#define XCD_BAR_WORDS 3456
#define XB_SPIN_CAP (1u << 18)

__device__ __forceinline__ unsigned xb_ld(unsigned* p)              { return __hip_atomic_load(p, __ATOMIC_RELAXED, __HIP_MEMORY_SCOPE_AGENT); }
__device__ __forceinline__ unsigned xb_add(unsigned* p, unsigned v) { return __hip_atomic_fetch_add(p, v, __ATOMIC_RELAXED, __HIP_MEMORY_SCOPE_AGENT); }
__device__ __forceinline__ unsigned xb_xcc_id() { return (unsigned)__builtin_amdgcn_s_getreg((3 << 11) | 20) & 0xFu; }
#define XB_SPIN(cond, bar) do { unsigned _sp = 0; while (cond) { __builtin_amdgcn_s_sleep(1); \
    if ((++_sp & 255u) == 0u) { if (xb_ld(&(bar)[XB_TMO])) break; if (_sp > XB_SPIN_CAP) { atomicAdd(&(bar)[XB_TMO], 1u); break; } } } } while (0)

struct XcdBarrier {
    unsigned* bar; unsigned x;
    volatile LAS unsigned* st;
};

__device__ __forceinline__ XcdBarrier xcd_barrier_post(unsigned* bar, volatile LAS unsigned* st) {
    XcdBarrier b; b.bar = bar; b.x = xb_xcc_id(); b.st = st;
    if (threadIdx.x == 0) (void)xb_add(&bar[XB_XCNT(b.x)], 1u);
    return b;
}
__device__ __forceinline__ void xcd_barrier_complete(unsigned* bar, unsigned x, unsigned& nloc, unsigned& nx) {
    const unsigned G = gridDim.x * gridDim.y * gridDim.z;
    unsigned sum, cnt, mine, sp = 0u;
    for (;;) {
        sum = 0u; cnt = 0u; mine = 0u;
#pragma unroll
        for (unsigned j = 0; j < 16; ++j) { const unsigned c = xb_ld(&bar[XB_XCNT(j)]); sum += c; cnt += (c > 0u) ? 1u : 0u; mine = (j == x) ? c : mine; }
        if (sum == G) break;
        __builtin_amdgcn_s_sleep(1);
        if ((++sp & 255u) == 0u) { if (xb_ld(&bar[XB_TMO])) break; if (sp > XB_SPIN_CAP) { atomicAdd(&bar[XB_TMO], 1u); break; } }
    }
    nloc = mine > 0u ? mine : 1u; nx = cnt > 0u ? cnt : 1u;
}

__device__ __forceinline__ void xcd_barrier(const XcdBarrier& b) {
    asm volatile("s_waitcnt vmcnt(0)" ::: "memory");
    __syncthreads();
    if (threadIdx.x == 0) {
        unsigned* bar = b.bar;
        __builtin_amdgcn_s_waitcnt(0);
        unsigned nloc = b.st[0], nx = b.st[1];
        if (nloc == 0u) { xcd_barrier_complete(bar, b.x, nloc, nx); b.st[0] = nloc; b.st[1] = nx; }
        const unsigned old = xb_add(&bar[XB_XSUB(b.x)], 1u);
        const unsigned gen = old / nloc;
        if (old + 1u == (gen + 1u) * nloc) {
            __builtin_amdgcn_fence(__ATOMIC_RELEASE, "agent");
            asm volatile("s_waitcnt vmcnt(0)" ::: "memory");
            const unsigned og = xb_add(&bar[XB_TOP], 1u);
            const unsigned tg = og / nx;
            if (og + 1u == (tg + 1u) * nx) xb_add(&bar[XB_TOPGEN], 1u);
            else XB_SPIN(xb_ld(&bar[XB_TOPGEN]) == tg, bar);
            __builtin_amdgcn_fence(__ATOMIC_ACQUIRE, "agent");
            xb_add(&bar[XB_XGEN(b.x)], 1u);
            asm volatile("s_waitcnt vmcnt(0)" ::: "memory");
        } else {
            XB_SPIN(xb_ld(&bar[XB_XGEN(b.x)]) == gen, bar);
            __builtin_amdgcn_fence(__ATOMIC_ACQUIRE, "agent");
            asm volatile("s_waitcnt vmcnt(0)" ::: "memory");
        }
    }
    __syncthreads();
}

enum { I_XP = 0, I_XS, I_CP, I_CS, I_CKC, I_CKS, I_SKW, I_SWKV, I_SSH, I_PT, I_WADA, I_BADA, I_LNG, I_LNB, I_WG, I_WU, I_WD, I_WIN, I_BIN, I_MU, I_W0, I_W2, I_A0, I_A2, I_G2,
       I_KK, I_KA, I_RK, I_LNW, I_LNBB, I_PE, I_PW1, I_PW2, I_WOA, I_WOB, I_WOO, N_IN };
struct Args { const float* in[N_IN]; float* out; unsigned char* ws; int ph_lo, ph_hi; };
#define WSF(off) ((float*)(a.ws + (off)))
#define WSB(off) ((bf16*)(a.ws + (off)))

DI void tr_item(const float* __restrict__ W, int ldw, int ncols, int k0, int n0, bf16* WT, int ldo, int dr0, LAS float* scr, int lane) {
#pragma unroll 8
    for (int i = 0; i < 32; ++i) { const int kk = 2 * i + (lane >> 5), col = n0 + (lane & 31); scr[kk * 33 + (lane & 31)] = col < ncols ? W[(size_t)(k0 + kk) * ldw + col] : 0.f; }
    LDS_WAIT(); asm volatile("" ::: "memory");
    const int c = lane & 7;
#pragma unroll
    for (int j = 0; j < 4; ++j) { const int n = (lane >> 3) + 8 * j; const LAS float* s = scr + (8 * c) * 33 + n;
        v4u o; o.x = pk2(s[0 * 33], s[1 * 33]); o.y = pk2(s[2 * 33], s[3 * 33]); o.z = pk2(s[4 * 33], s[5 * 33]); o.w = pk2(s[6 * 33], s[7 * 33]);
        *(v4u*)(WT + (size_t)(dr0 + n) * ldo + k0 + 8 * c) = o; }
    LDS_WAIT(); asm volatile("" ::: "memory");
}
DI void mod_gemv_item(const Args& a, LAS unsigned char* lds, int tid, int lane, int wave, int item) {
    LAS float* S = (LAS float*)lds;
    const float* wada = a.in[I_WADA];
    float acc[36];
#pragma unroll
    for (int i = 0; i < 36; ++i) acc[i] = 0.f;
    const int col = item * 64 + lane;
    for (int kh = 0; kh < 2; ++kh) {
        __syncthreads();
        for (int e = tid; e < 36 * 512; e += 512) { const int bbv = e >> 9, kk = e & 511;
            const float c = bbv < 4 ? a.in[I_CP][bbv * D + kh * 512 + kk] : a.in[I_CS][(bbv - 4) * D + kh * 512 + kk];
            S[kk * 36 + bbv] = c / (1.0f + __expf(-c)); }
        __syncthreads();
        for (int kk = wave * 64; kk < wave * 64 + 64; ++kk) {
            const float wv = wada[(size_t)(kh * 512 + kk) * 9216 + col];
            const LAS f32x4* sp = (const LAS f32x4*)(S + kk * 36);
#pragma unroll
            for (int q = 0; q < 9; ++q) { const f32x4 s = sp[q]; acc[4 * q] += s[0] * wv; acc[4 * q + 1] += s[1] * wv; acc[4 * q + 2] += s[2] * wv; acc[4 * q + 3] += s[3] * wv; }
        }
    }
    __syncthreads();
    LAS float* P = (LAS float*)lds;
#pragma unroll
    for (int i = 0; i < 36; ++i) P[(wave * 36 + i) * 64 + lane] = acc[i];
    __syncthreads();
    float* MOD = WSF(WS_MOD);
    for (int o = tid; o < 36 * 64; o += 512) { const int bbv = o >> 6, l = o & 63; float s = 0.f;
#pragma unroll
        for (int w = 0; w < 8; ++w) s += P[(w * 36 + bbv) * 64 + l];
        const int cc = item * 64 + l; MOD[(size_t)bbv * 9216 + cc] = s + a.in[I_BADA][cc]; }
    __syncthreads();
}
DI void pet_item(const Args& a, LAS unsigned char* lds, int tid, int lane, int wave, int item) {
    const int kv = item >> 1, e = (item & 1) * 64 + lane;
    const float* pe = a.in[I_PE] + kv * 2048; const float* w1 = a.in[I_PW1] + (size_t)kv * 2048 * 128;
    float acc = 0.f;
    for (int k = wave * 256; k < wave * 256 + 256; ++k) acc += pe[k] * w1[(size_t)k * 128 + e];
    LAS float* P = (LAS float*)lds;
    __syncthreads();
    P[wave * 64 + lane] = acc;
    __syncthreads();
    if (tid < 64) { float s = 0.f;
#pragma unroll
        for (int w = 0; w < 8; ++w) s += P[w * 64 + tid];
        WSF(WS_PET)[kv * 128 + (item & 1) * 64 + tid] = s; }
    __syncthreads();
}
DI void ph_prologue(const Args& a, LAS unsigned char* lds, int tid, int lane, int wave, int G, int bx) {
    for (int it = bx; it < 148; it += G) { if (it < 144) mod_gemv_item(a, lds, tid, lane, wave, it); else pet_item(a, lds, tid, lane, wave, it - 144); }
    __syncthreads();
    LAS float* scr = (LAS float*)(lds + wave * 16384);
    const int gw = wave * G + bx, NGW = G * NWAVES;
    constexpr int I_GU = 16 * 88, I_DN = 44 * 32, I_IN = 16 * 168, I_OAB = 8 * 32, I_O = 16 * 32, I_C1 = 16 * 4, I_CONV = 0, I_WCP = 1016, I_ZERO = 128, I_LORA = 64;
    constexpr int NITEMS = 4 * I_GU + 2 * I_DN + I_IN + 2 * I_OAB + I_O + 4 * I_C1 + I_CONV + I_WCP + I_ZERO + I_LORA;
    for (int it = gw; it < NITEMS; it += NGW) {
        int r = it;
        if (r < 4 * I_GU) { const int which = r / I_GU, l = which & 1, up = which >> 1; r %= I_GU; const int kb = r / 88, nb = r % 88, n0 = nb * 32;
            tr_item((up ? a.in[I_WU] : a.in[I_WG]) + (size_t)l * D * FF, FF, FF, kb * 64, n0, WSB(WS_WGU) + (size_t)l * 5632 * D, D, (n0 >> 7) * 256 + up * 128 + (n0 & 127), scr, lane); continue; } r -= 4 * I_GU;
        if (r < 2 * I_DN) { const int l = r / I_DN; r %= I_DN; const int kb = r / 32, nb = r % 32;
            tr_item(a.in[I_WD] + (size_t)l * FF * D, D, D, kb * 64, nb * 32, WSB(WS_WDN) + (size_t)l * D * FF, FF, nb * 32, scr, lane); continue; } r -= 2 * I_DN;
        if (r < I_IN) { const int kb = r / 168, nb = r % 168; tr_item(a.in[I_WIN], NIN, NIN, kb * 64, nb * 32, WSB(WS_WIN), D, nb * 32, scr, lane); continue; } r -= I_IN;
        if (r < 2 * I_OAB) { const int w = r / I_OAB; r %= I_OAB; const int kb = r / 32, nb = r % 32;
            tr_item(w ? a.in[I_WOB] : a.in[I_WOA], D, D, kb * 64, nb * 32, WSB(WS_WOAB), 512, w * 1024 + nb * 32, scr, lane); continue; } r -= 2 * I_OAB;
        if (r < I_O) { const int kb = r / 32, nb = r % 32; tr_item(a.in[I_WOO], D, D, kb * 64, nb * 32, WSB(WS_WO), D, nb * 32, scr, lane); continue; } r -= I_O;
        if (r < 4 * I_C1) { const int mat = r / I_C1; r %= I_C1; const int kb = r / 4, nb = r % 4;
            tr_item(a.in[I_PW1] + (size_t)mat * 1024 * 128, 128, 128, kb * 64, nb * 32, WSB(WS_WC1), 1024, mat * 128 + nb * 32, scr, lane); continue; } r -= 4 * I_C1;
        if (r < I_CONV) {
            const int b = r >> 10, c = r & 1023; const int page = ((const int*)a.in[I_PT])[b * 128 + (c >> 3)];
            const float* src = a.in[I_CKC] + ((size_t)page * 128 + (c & 7) * 16) * 256 + lane * 4;
            const int kv = lane >> 5, g = (lane >> 4) & 1, d = (lane & 15) * 4;
            bf16* dst = WSB(WS_ACMP) + ((size_t)kv * CROWS + (size_t)(b * NCH_S + c) * 2 + g) * 1024 + d;
#pragma unroll 4
            for (int j = 0; j < 16; ++j) { const f32x4 v = *(const f32x4*)(src + j * 256); v2u o; o.x = pk2(v[0], v[1]); o.y = pk2(v[2], v[3]); *(v2u*)(dst + j * 64) = o; }
            continue; } r -= I_CONV;
        if (r < I_WCP) {
#pragma unroll 4
            for (int i = 0; i < 16; ++i) { const int f = r * 1024 + i * 64 + lane; const int b = f / 32512, i4 = f % 32512;
                *(f32x4*)(a.out + O_KVW_S + (size_t)b * 131072 + (size_t)i4 * 4) = *(const f32x4*)(a.in[I_SKW] + (size_t)b * 131072 + 1024 + (size_t)i4 * 4); }
            continue; } r -= I_WCP;
        if (r < I_ZERO) { v4u z = {0u, 0u, 0u, 0u}; unsigned char* p = a.ws + WS_KCP + (size_t)r * 4096 + lane * 64;
#pragma unroll
          for (int i = 0; i < 4; ++i) *(v4u*)(p + 16 * i) = z; continue; } r -= I_ZERO;
        {
            if (r < 16) tr_item(a.in[I_W2], RWW, RWW, 0, r * 32, WSB(WS_LORA), 64, r * 32, scr, lane);
            else if (r < 32) tr_item(a.in[I_A2], RWW, RWW, 0, (r - 16) * 32, WSB(WS_LORA) + 512 * 64, 64, (r - 16) * 32, scr, lane);
            else { const int q = r - 32; tr_item(a.in[I_G2], RWW, RWW, (q >> 4) * 64, (q & 15) * 32, WSB(WS_LORA) + 2 * 512 * 64, 128, (q & 15) * 32, scr, lane); } }
    }
}
DI void ph_u1(const Args& a, int lane, int wave, int G, int bx) {
    const int gw = wave * G + bx, NGW = G * NWAVES; const float* MOD = WSF(WS_MOD); bf16* U = WSB(WS_U);
    for (int row = gw; row < MA; row += NGW) {
        const float* xr = row < MP ? a.in[I_XP] + (size_t)row * D : a.in[I_XS] + (size_t)(row - MP) * D;
        const float* ms = MOD + (size_t)(bb_of_row(row) * 9) * D;
#pragma unroll
        for (int j = 0; j < 4; ++j) { const int col = lane * 4 + 256 * j;
            f32x4 u = {0.f, 0.f, 0.f, 0.f};
            if (row < MR) { const f32x4 x = *(const f32x4*)(xr + col); u = x * (1.0f + *(const f32x4*)(ms + D + col)) + *(const f32x4*)(ms + col); }
            v2u o; o.x = pk2(u[0], u[1]); o.y = pk2(u[2], u[3]); *(v2u*)(U + (size_t)row * D + col) = o; }
    }
}
constexpr int CS_ROW = 144, CS_BUF = 2 * 128 * CS_ROW;
DI void ph_compress_sample(const Args& a, LAS unsigned char* lds, int tid, int lane, int wave, int G, int bx) {
    const int kv = wave >> 2, wn = wave & 3, r = lane & 31, hh = lane >> 5;
    const int cc = tid >> 3, part = tid & 7, skv = part >> 2, sg = (part >> 1) & 1, sh = part & 1;
    const bf16* W1 = WSB(WS_WC1) + (size_t)(kv * 256 + wn * 64 + r) * 1024 + 8 * hh;
    for (int u = bx; u < NBS * 16; u += G) {
        const int b = u >> 4, c0 = (u & 15) * 64;
        const int page = ((const int*)a.in[I_PT])[b * 128 + ((c0 + cc) >> 3)];
        const float* src = a.in[I_CKC] + ((size_t)page * 128 + ((c0 + cc) & 7) * 16) * 256 + part * 32;
        f32x16 acc[4][2];
#pragma unroll
        for (int m = 0; m < 4; ++m) { acc[m][0] = zero16(); acc[m][1] = zero16(); }
        f32x4 ar[8];
#pragma unroll
        for (int q = 0; q < 8; ++q) ar[q] = *(const f32x4*)(src + 4 * q);
        __syncthreads();
        for (int j = 0; j < 16; ++j) {
            LAS unsigned char* buf = lds + (j & 1) * CS_BUF;
            { LAS unsigned char* dst = buf + skv * (128 * CS_ROW) + (cc * 2 + sg) * CS_ROW + sh * 64;
#pragma unroll
              for (int q = 0; q < 4; ++q) { v4u o; o.x = pk2(ar[2 * q][0], ar[2 * q][1]); o.y = pk2(ar[2 * q][2], ar[2 * q][3]); o.z = pk2(ar[2 * q + 1][0], ar[2 * q + 1][1]); o.w = pk2(ar[2 * q + 1][2], ar[2 * q + 1][3]);
                  *(LAS v4u*)(dst + 16 * q) = o; } }
            __syncthreads();
            if (j + 1 < 16) {
#pragma unroll
                for (int q = 0; q < 8; ++q) ar[q] = *(const f32x4*)(src + (size_t)(j + 1) * 256 + 4 * q); }
            bf16x8 bfr[2][4];
#pragma unroll
            for (int n = 0; n < 2; ++n)
#pragma unroll
                for (int s = 0; s < 4; ++s) bfr[n][s] = *(const bf16x8*)(W1 + (size_t)n * 32 * 1024 + j * 64 + 16 * s);
            const LAS unsigned char* ab = buf + kv * (128 * CS_ROW) + r * CS_ROW + 16 * hh;
#pragma unroll
            for (int s = 0; s < 4; ++s) {
#pragma unroll
                for (int m = 0; m < 4; ++m) { const bf16x8 af = *(const LAS bf16x8*)(ab + m * 32 * CS_ROW + 32 * s);
                    acc[m][0] = MFMA32(af, bfr[0][s], acc[m][0]); acc[m][1] = MFMA32(af, bfr[1][s], acc[m][1]); }
                __builtin_amdgcn_sched_barrier(0); }
        }
        float* hc = WSF(WS_HC) + ((size_t)kv * CROWS + (size_t)(b * NCH_S + c0) * 2) * 256 + wn * 64 + r;
#pragma unroll
        for (int m = 0; m < 4; ++m) {
#pragma unroll
            for (int i = 0; i < 16; ++i) { float* hp = hc + (size_t)(32 * m + crow(i, hh)) * 256; hp[0] = acc[m][0][i]; hp[32] = acc[m][1][i]; }
            asm volatile("" ::: "memory"); }
    }
}
template <int WHICH> DI void ph_ln(const Args& a, int lane, int wave, int G, int bx) {
    const int gw = wave * G + bx, NGW = G * NWAVES; const float* MOD = WSF(WS_MOD); const float* Z = WSF(WS_Z); bf16* U = WSB(WS_U);
    float* XN = WHICH == 0 ? WSF(WS_X1) : (WHICH == 1 ? WSF(WS_X2) : a.out);
    const float* lg = a.in[I_LNG] + WHICH * D; const float* lb = a.in[I_LNB] + WHICH * D;
    constexpr int NKS = WHICH == 1 ? 4 : 11; constexpr int RSLOT = WHICH == 0 ? 2 : (WHICH == 1 ? 5 : 8); constexpr float COEF = WHICH == 1 ? 1.0f : 0.5f;
    const float* xres = WHICH == 0 ? a.in[I_XS] : (WHICH == 1 ? WSF(WS_X1) + (size_t)MP * D : WSF(WS_X2) + (size_t)MP * D);
    for (int row = gw; row < MR; row += NGW) {
        f32x4 v[4]; float s = 0.f;
        if (row < MP) {
#pragma unroll
            for (int j = 0; j < 4; ++j) v[j] = *(const f32x4*)(Z + (size_t)row * D + lane * 4 + 256 * j);
        } else {
            const float* mr = MOD + (size_t)(bb_of_row(row) * 9 + RSLOT) * D;
#pragma unroll
            for (int j = 0; j < 4; ++j) { const int col = lane * 4 + 256 * j; f32x4 acc = {0.f, 0.f, 0.f, 0.f};
#pragma unroll
                for (int ks = 0; ks < NKS; ++ks) acc = acc + *(const f32x4*)(WSF(WS_ZP) + ((size_t)ks * MS + (row - MP)) * D + col);
                v[j] = ALPHA * *(const f32x4*)(xres + (size_t)(row - MP) * D + col) + COEF * (1.0f + *(const f32x4*)(mr + col)) * acc; }
        }
#pragma unroll
        for (int j = 0; j < 4; ++j) s += (v[j][0] + v[j][1]) + (v[j][2] + v[j][3]);
        const float mean = wave_sum(s) * (1.0f / D); float s2 = 0.f;
#pragma unroll
        for (int j = 0; j < 4; ++j) { v[j] = v[j] - mean; s2 += (v[j][0] * v[j][0] + v[j][1] * v[j][1]) + (v[j][2] * v[j][2] + v[j][3] * v[j][3]); }
        const float rstd = 1.0f / sqrtf(wave_sum(s2) * (1.0f / D) + LN_EPS);
        const float* ms = MOD + (size_t)(bb_of_row(row) * 9 + 3 * WHICH + 3) * D;
#pragma unroll
        for (int j = 0; j < 4; ++j) { const int col = lane * 4 + 256 * j;
            const f32x4 x = v[j] * rstd * *(const f32x4*)(lg + col) + *(const f32x4*)(lb + col);
            *(f32x4*)(XN + (size_t)row * D + col) = x;
            if (WHICH < 2) { const f32x4 u = x * (1.0f + *(const f32x4*)(ms + D + col)) + *(const f32x4*)(ms + col);
                v2u o; o.x = pk2(u[0], u[1]); o.y = pk2(u[2], u[3]); *(v2u*)(U + (size_t)row * D + col) = o; } }
    }
}

DI float proj_prev(const Args& a, const float* PROJ, int row, int col) {
    if (row < MP) return (row & (T - 1)) ? PROJ[(size_t)(row - 1) * NINP + col] : 0.f;
    const int s = row - MP; return (s & 3) ? PROJ[(size_t)(row - 1) * NINP + col] : a.in[I_SSH][(size_t)(s >> 2) * C_Q + col];
}
DI void ph_dist_rwprep(const Args& a, LAS unsigned char* lds, int tid, int lane, int wave, int G, int bx) {
    const float* PROJ = WSF(WS_PROJ);
    LAS float* vt = (LAS float*)lds;
    LAS bf16* LA = (LAS bf16*)(lds + 36864);
    for (int it = bx; it < MR / 32; it += G) {
        const int r0 = it * 32;
        __syncthreads();
        {
            const int rr = tid >> 4, seg = tid & 15, row = r0 + rr;
            const float* pr = PROJ + (size_t)row * NINP + C_KV;
            if (row < MP) {
                const int b = row >> 12, t = row & (T - 1);
#pragma unroll
                for (int i = 0; i < 12; ++i) { const int col = 4 * (seg + 16 * i), br = col >> 8, within = col & 255, kv = within >> 7, g = (within >> 6) & 1, d = within & 63;
                    const f32x4 v = *(const f32x4*)(pr + col); v2u pk; pk.x = pk2(v[0], v[1]); pk.y = pk2(v[2], v[3]);
                    if (br == 0) { *(f32x4*)(a.out + O_KVC_P + (size_t)row * 256 + within) = v;
                        *(v2u*)(WSB(WS_ACMP) + ((size_t)kv * CROWS + CROWS_S + (size_t)(b * NCH_P + (t >> 4)) * 2 + g) * 1024 + (t & 15) * 64 + d) = pk; }
                    else { if (br == 1) *(f32x4*)(a.out + O_KVS_P + (size_t)row * 256 + within) = v;
                           else if (t >= T - 512) *(f32x4*)(a.out + O_KVW_P + ((size_t)b * 512 + (t - (T - 512))) * 256 + within) = v;
                           if (kv == 0) *(v2u*)(WSB(br == 1 ? WS_KSEL : WS_KWIN) + ((size_t)(b * 2 + g) * T + t) * 64 + d) = pk;
                           else { LAS float* q = vt + ((br - 1) * 32 + rr) * 132 + g * 64 + d; q[0] = v[0]; q[1] = v[1]; q[2] = v[2]; q[3] = v[3]; } }
                }
                if (t == T - 1) { const float* ps = PROJ + (size_t)row * NINP;
#pragma unroll 4
                    for (int i = 0; i < 28; ++i) *(f32x4*)(a.out + O_SH_P + (size_t)b * C_Q + 4 * (seg + 16 * i)) = *(const f32x4*)(ps + 4 * (seg + 16 * i)); }
            } else {
                const int s = row - MP, b = s >> 2, tq = s & 3;
#pragma unroll
                for (int i = 0; i < 12; ++i) { const int col = 4 * (seg + 16 * i), br = col >> 8, within = col & 255;
                    const f32x4 v = *(const f32x4*)(pr + col);
                    if (br == 0) *(f32x4*)(a.out + O_KVC_S + (size_t)s * 256 + within) = v;
                    else if (br == 1) *(f32x4*)(a.out + O_KVS_S + (size_t)s * 256 + within) = v;
                    else *(f32x4*)(a.out + O_KVW_S + ((size_t)b * 512 + 508 + tq) * 256 + within) = v; }
                if (tq == 3) { const float* ps = PROJ + (size_t)row * NINP;
#pragma unroll 4
                    for (int i = 0; i < 28; ++i) *(f32x4*)(a.out + O_SH_S + (size_t)b * C_Q + 4 * (seg + 16 * i)) = *(const f32x4*)(ps + 4 * (seg + 16 * i)); }
            }
        }
#pragma unroll 4
        for (int i = 0; i < 16; ++i) { const int e = tid + 512 * i, tt = e >> 8, k = e & 255, row = r0 + tt, col = 1536 + k;
            const float p = PROJ[(size_t)row * NINP + col], pp = proj_prev(a, PROJ, row, col); const float xs = p + (pp - p) * a.in[I_MU][col];
            LA[tt * 264 + k] = (bf16)f2bf(k < 64 ? tanhf(xs) : (k < 128 ? xs : sigmoidf_(xs))); }
        __syncthreads();
        if (r0 < MP) {
            const int gd = tid >> 2, tc = tid & 3, g = gd >> 6, d = gd & 63, b = r0 >> 12, t0 = r0 & (T - 1);
#pragma unroll
            for (int br = 0; br < 2; ++br) { const LAS float* q = vt + (br * 32 + tc * 8) * 132 + gd;
                v4u o; o.x = pk2(q[0], q[132]); o.y = pk2(q[2 * 132], q[3 * 132]); o.z = pk2(q[4 * 132], q[5 * 132]); o.w = pk2(q[6 * 132], q[7 * 132]);
                *(v4u*)(WSB(br == 0 ? WS_VTSEL : WS_VTWIN) + ((size_t)(b * 2 + g) * 64 + d) * T + t0 + tc * 8) = o; }
        }
        {
            int lane_l = lane; asm volatile("" : "+v"(lane_l));
            const int hh = lane_l >> 5, cl = lane_l & 31;
            f32x16 aw[2], aa[2], ag[2];
#pragma unroll
            for (int cb = 0; cb < 2; ++cb) { aw[cb] = zero16(); aa[cb] = zero16(); ag[cb] = zero16(); }
            const bf16* W2T = WSB(WS_LORA); const bf16* A2T = W2T + 512 * 64; const bf16* G2T = A2T + 512 * 64;
#define LORA_STEP(acc_, WT_, KW_, s_, koff_) { const bf16x8 af = *(const LAS bf16x8*)(LA + cl * 264 + (koff_) + 16 * (s_) + 8 * hh); \
                _Pragma("unroll") for (int cb = 0; cb < 2; ++cb) { const bf16x8 bf_ = *(const bf16x8*)((WT_) + (wave * 64 + cb * 32 + cl) * (KW_) + 16 * (s_) + 8 * hh); acc_[cb] = MFMA32(af, bf_, acc_[cb]); } \
                asm volatile("" ::: "memory"); }
#pragma unroll
            for (int s2 = 0; s2 < 4; ++s2) LORA_STEP(aw, W2T, 64, s2, 0)
#pragma unroll
            for (int s2 = 0; s2 < 4; ++s2) LORA_STEP(aa, A2T, 64, s2, 64)
#pragma unroll
            for (int s2 = 0; s2 < 8; ++s2) LORA_STEP(ag, G2T, 128, s2, 128)
#undef LORA_STEP
            float* RW = WSF(WS_RW);
            float mu_r[2], mu_k[2], mu_v[2], w0[2], a0[2], kkc[2], kac[2], rkc[2];
#pragma unroll
            for (int cb = 0; cb < 2; ++cb) { const int c = wave * 64 + cb * 32 + cl;
                mu_r[cb] = a.in[I_MU][c]; mu_k[cb] = a.in[I_MU][512 + c]; mu_v[cb] = a.in[I_MU][1024 + c];
                w0[cb] = a.in[I_W0][c]; a0[cb] = a.in[I_A0][c]; kkc[cb] = a.in[I_KK][c]; kac[cb] = a.in[I_KA][c]; rkc[cb] = a.in[I_RK][c]; }
#pragma unroll
            for (int half = 0; half < 4; ++half) {
                float tk[2][4], ta[2][4], tp[2][4], tv[2][4];
#pragma unroll
                for (int i8 = 0; i8 < 4; ++i8) { const int i = half * 4 + i8, row = r0 + crow(i, hh); const float* pr = PROJ + (size_t)row * NINP;
#pragma unroll
                    for (int cb = 0; cb < 2; ++cb) { const int c = wave * 64 + cb * 32 + cl;
                        const float pr_ = pr[c], pk_ = pr[512 + c], pv_ = pr[1024 + c];
                        const float r = pr_ + (proj_prev(a, PROJ, row, c) - pr_) * mu_r[cb], k = pk_ + (proj_prev(a, PROJ, row, 512 + c) - pk_) * mu_k[cb], v = pv_ + (proj_prev(a, PROJ, row, 1024 + c) - pv_) * mu_v[cb];
                        const float z = -(w0[cb] + aw[cb][i]);
                        const float sp = fmaxf(z, 0.f) + log1pf(__expf(-fabsf(z)));
                        const float decay = __expf(-__expf(-sp - 0.5f));
                        const float av = sigmoidf_(a0[cb] + aa[cb][i]);
                        const float kk = k * kkc[cb], k2 = k * (1.0f + (av - 1.0f) * kac[cb]);
                        const size_t o = (size_t)row * RWW + c;
                        RW[o] = r; RW[RW_STRIDE + o] = decay; RW[2 * RW_STRIDE + o] = k2; RW[3 * RW_STRIDE + o] = v; WSF(WS_G)[o] = ag[cb][i];
                        tk[cb][i8] = kk; ta[cb][i8] = av; tp[cb][i8] = r * k2 * rkc[cb]; tv[cb][i8] = v; }
                    asm volatile("" ::: "memory"); }
#pragma unroll
                for (int i8 = 0; i8 < 4; ++i8) { const int i = half * 4 + i8, row = r0 + crow(i, hh);
                    float ss = tk[0][i8] * tk[0][i8] + tk[1][i8] * tk[1][i8], rk = tp[0][i8] + tp[1][i8];
                    ss = row16_sum(ss); rk = row16_sum(rk); ss += __shfl_xor(ss, 16); rk += __shfl_xor(rk, 16);
                    const float rn = rsqrtf(fmaxf(ss, 1e-24f));
#pragma unroll
                    for (int cb = 0; cb < 2; ++cb) { const int c = wave * 64 + cb * 32 + cl; const size_t o = (size_t)row * RWW + c;
                        const float kkn = tk[cb][i8] * rn; RW[4 * RW_STRIDE + o] = kkn; RW[5 * RW_STRIDE + o] = kkn * ta[cb][i8]; WSF(WS_BON)[o] = rk * tv[cb][i8]; }
                }
            }
        }
    }
}

struct StepD { f32x4 r, w, k, kk, b; float v; };
DI void scan_run(const float* RW, float* Y, int rowbase, int nsteps, int h, int i, int lane, const float* s_in, float* s_out) {
    const int j0 = (lane & 15) * 4; const size_t cofs = (size_t)h * 64 + j0, vofs = (size_t)h * 64 + i;
    f32x4 S = s_in ? *(const f32x4*)(s_in + i * 64 + j0) : (f32x4){0.f, 0.f, 0.f, 0.f};
#define SC_LD(sd, t) { const size_t o_ = (size_t)(rowbase + (t)) * RWW; sd.r = *(const f32x4*)(RW + o_ + cofs); sd.w = *(const f32x4*)(RW + RW_STRIDE + o_ + cofs); sd.k = *(const f32x4*)(RW + 2 * RW_STRIDE + o_ + cofs); \
        sd.v = RW[3 * RW_STRIDE + o_ + vofs]; sd.kk = *(const f32x4*)(RW + 4 * RW_STRIDE + o_ + cofs); sd.b = *(const f32x4*)(RW + 5 * RW_STRIDE + o_ + cofs); }
#define SC_DO(sd, t) { float d_ = (S[0] * sd.kk[0] + S[1] * sd.kk[1]) + (S[2] * sd.kk[2] + S[3] * sd.kk[3]); d_ = row16_sum(d_); const float sa_ = -d_; \
        S = S * sd.w + (sa_ * sd.b + sd.v * sd.k); float y_ = (S[0] * sd.r[0] + S[1] * sd.r[1]) + (S[2] * sd.r[2] + S[3] * sd.r[3]); y_ = row16_sum(y_); \
        if ((lane & 15) == 0) Y[(size_t)(rowbase + (t)) * RWW + vofs] = y_; }
    StepD c0, c1, c2, c3, n0, n1, n2, n3;
    SC_LD(c0, 0) SC_LD(c1, 1) SC_LD(c2, 2) SC_LD(c3, 3)
    for (int t = 0; t < nsteps; t += 4) {
        const int tn = (t + 4 < nsteps) ? t + 4 : t;
        SC_LD(n0, tn) SC_LD(n1, tn + 1) SC_LD(n2, tn + 2) SC_LD(n3, tn + 3)
        SC_DO(c0, t) SC_DO(c1, t + 1) SC_DO(c2, t + 2) SC_DO(c3, t + 3)
        c0 = n0; c1 = n1; c2 = n2; c3 = n3;
    }
#undef SC_LD
#undef SC_DO
    *(f32x4*)(s_out + i * 64 + j0) = S;
}
constexpr int CF_NIT = (NBS * NCMP_S + NBP * NCMP_P) * 2;
#define CFINAL_ITEM(kv_, j_) { const float* HC_ = WSF(WS_HC) + (size_t)(kv_) * CROWS * 256; \
    const int g_ = (j_) & 1; int q_ = (j_) >> 1; int b_, n_, rowlo_; const bool smp_ = q_ < NBS * NCMP_S; \
    if (smp_) { b_ = q_ / NCMP_S; n_ = q_ % NCMP_S; rowlo_ = (b_ * NCH_S + n_) * 2 + g_; } else { q_ -= NBS * NCMP_S; b_ = q_ / NCMP_P; n_ = q_ % NCMP_P; rowlo_ = CROWS_S + (b_ * NCH_P + n_) * 2 + g_; } \
    float s0_, s1_; \
    if (smp_) { const float* lo_ = HC_ + (size_t)rowlo_ * 256; const float* hi_ = lo_ + 2 * 256 + 128; s0_ = lo_[lane] + hi_[lane]; s1_ = lo_[64 + lane] + hi_[64 + lane]; } \
    else { s0_ = 0.f; s1_ = 0.f; _Pragma("unroll") for (int ks_ = 0; ks_ < 4; ++ks_) { const float* lo_ = WSF(WS_HCP) + ((size_t)(ks_ * 2 + (kv_)) * 2048 + (rowlo_ - CROWS_S)) * 256; const float* hi_ = lo_ + 2 * 256 + 128; \
        s0_ += lo_[lane] + hi_[lane]; s1_ += lo_[64 + lane] + hi_[64 + lane]; } } \
    const float h0_ = gelu_tanh(s0_ + pe0), h1_ = gelu_tanh(s1_ + pe1); \
    float acc_ = 0.f; \
    _Pragma("unroll") for (int e = 0; e < 64; ++e) acc_ += __builtin_bit_cast(float, __builtin_amdgcn_readlane(__builtin_bit_cast(int, h0_), e)) * w2c[e]; \
    _Pragma("unroll") for (int e = 0; e < 64; ++e) acc_ += __builtin_bit_cast(float, __builtin_amdgcn_readlane(__builtin_bit_cast(int, h1_), e)) * w2c[64 + e]; \
    if (smp_) WSF(WS_KCS)[(size_t)(kv_) * KCS_STRIDE + ((size_t)(b_ * NCMP_S + n_) * 2 + g_) * 64 + lane] = acc_; \
    else if ((kv_) == 0) WSB(WS_KCP)[((size_t)(b_ * 2 + g_) * 256 + n_) * 64 + lane] = (bf16)f2bf(acc_); \
    else WSB(WS_VCTP)[((size_t)(b_ * 2 + g_) * 64 + lane) * 256 + n_] = (bf16)f2bf(acc_); }
constexpr int SCH = 32, SCHF = SCH * 384;
DI void ph_scan_prompt(const Args& a, LAS unsigned char* lds, int tid, int lane, int wave, int G, int bx) {
    const float* RW = WSF(WS_RW); float* Y = WSF(WS_YS);
    LAS float* buf = (LAS float*)lds;
    constexpr int NCH = T / SCH;
    if (wave >= 2) {
      const bool sidew = (wave & 2) != 0; const int sidx = (wave & 1) + ((wave >> 2) << 1); const int lid = sidx * G + bx, nl = 4 * G, ckv = lid & 1;
      if (sidew) for (int si = lid; si < 4096; si += nl) { const int bh2 = si >> 4, rg2 = si & 15, b2 = bh2 >> 3, h2 = bh2 & 7, i2 = rg2 * 4 + (lane >> 4);
          scan_run(RW, Y, MP + b2 * 4, 4, h2, i2, lane, a.in[I_SWKV] + (size_t)bh2 * 4096, a.out + O_WKV_S + (size_t)bh2 * 4096); }
      asm volatile("" ::: "memory");
      float w2c[128];
#pragma unroll
      for (int e = 0; e < 128; ++e) w2c[e] = a.in[I_PW2][(size_t)(ckv * 128 + e) * 64 + lane];
      const float pe0 = WSF(WS_PET)[ckv * 128 + lane], pe1 = WSF(WS_PET)[ckv * 128 + 64 + lane];
      for (int it = bx; it < 256; it += G) {
        const int bh = it >> 3, b = bh >> 3, h = bh & 7, rowbase = b * T, sidebase = ((it - bx) / G) * NCH;
        __syncthreads();
        {
#define DMA_CHUNK(c) { _Pragma("unroll") for (int q = 0; q < 8; ++q) { const int R0 = ((wave - 2) * 8 + q) * 4, R = R0 + (lane >> 4), t_ = R / 6, aa = R - 6 * t_; \
                __builtin_amdgcn_global_load_lds((const unsigned*)(RW + (size_t)aa * RW_STRIDE + (size_t)(rowbase + (c) * SCH + t_) * RWW + h * 64 + (lane & 15) * 4), \
                    (LAS unsigned*)(buf + ((c) & 1) * SCHF + R0 * 64), 16, 0, 0); } }
            DMA_CHUNK(0)
            asm volatile("s_waitcnt vmcnt(0)" ::: "memory");
            __syncthreads();
            for (int c = 0; c < NCH; ++c) {
                if (c + 1 < NCH) DMA_CHUNK(c + 1)
                if (sidew) { const int j = (sidebase + c) * (nl >> 1) + (lid >> 1); if (j < CF_NIT) CFINAL_ITEM(ckv, j)
                             const int j2 = (NCH + sidebase + c) * (nl >> 1) + (lid >> 1); if (j2 < CF_NIT) CFINAL_ITEM(ckv, j2) }
                asm volatile("s_waitcnt vmcnt(0)" ::: "memory");
                __syncthreads();
            }
#undef DMA_CHUNK
        }
      }
    } else {
      for (int it = bx; it < 256; it += G) {
        const int bh = it >> 3, b = bh >> 3, h = bh & 7, rowbase = b * T;
        __syncthreads();
        {
            const int rg = (it & 7) * 2 + wave, i = rg * 4 + (lane >> 4), j0 = (lane & 15) * 4, k16 = lane & 15; const size_t vofs = (size_t)h * 64 + i;
            f32x4 S = {0.f, 0.f, 0.f, 0.f}, rp = {0.f, 0.f, 0.f, 0.f}; float ysel = 0.f;
#define RED2(x_, y_) x_ += dpp_f<0x128>(x_); y_ += dpp_f<0x128>(y_); x_ += dpp_f<0x124>(x_); y_ += dpp_f<0x124>(y_); x_ += dpp_f<0x122>(x_); y_ += dpp_f<0x122>(y_); x_ += dpp_f<0x121>(x_); y_ += dpp_f<0x121>(y_);
            __syncthreads();
            for (int c = 0; c < NCH; ++c) {
                const LAS float* cb = buf + (c & 1) * SCHF; const int tb = c * SCH;
                StepD q0, q1, q2;
#define L_LD(sd, t) { const LAS float* p_ = cb + (t) * 384; sd.r = *(const LAS f32x4*)(p_ + j0); sd.w = *(const LAS f32x4*)(p_ + 64 + j0); sd.k = *(const LAS f32x4*)(p_ + 128 + j0); sd.v = p_[192 + i]; \
                sd.kk = *(const LAS f32x4*)(p_ + 256 + j0); sd.b = *(const LAS f32x4*)(p_ + 320 + j0); }
                L_LD(q0, 0) L_LD(q1, 1)
#pragma unroll
                for (int t = 0; t < SCH; ++t) {
                    if (t + 2 < SCH) L_LD(q2, t + 2)
                    __builtin_amdgcn_sched_barrier(0);
                    float pd = __builtin_fmaf(S[3], q0.kk[3], __builtin_fmaf(S[2], q0.kk[2], __builtin_fmaf(S[1], q0.kk[1], S[0] * q0.kk[0])));
                    float py = __builtin_fmaf(S[3], rp[3], __builtin_fmaf(S[2], rp[2], __builtin_fmaf(S[1], rp[1], S[0] * rp[0])));
                    RED2(pd, py)
                    ysel = (k16 == ((t + 15) & 15)) ? py : ysel;
                    if ((t & 15) == 0 && (t > 0 || c > 0)) Y[(size_t)(rowbase + tb + t - 16 + k16) * RWW + vofs] = ysel;
                    S = S * q0.w + (q0.v * q0.k - pd * q0.b);
                    rp = q0.r;
                    q0 = q1; q1 = q2;
                    __builtin_amdgcn_sched_barrier(0);
                }
#undef L_LD
                __syncthreads();
            }
            { float pd = 0.f, py = (S[0] * rp[0] + S[1] * rp[1]) + (S[2] * rp[2] + S[3] * rp[3]); RED2(pd, py) ysel = (k16 == 15) ? py : ysel; Y[(size_t)(rowbase + T - 16 + k16) * RWW + vofs] = ysel; }
#undef RED2
            *(f32x4*)(a.out + O_WKV_P + (size_t)bh * 4096 + i * 64 + j0) = S;
        }
      }
    }
}

#ifndef PROBE_SUB
#define PROBE_SUB 0
#endif
DI bf16x8 pack8(const f32x4& x0, const f32x4& x1) { v4u p; p.x = pk2(x0[0], x0[1]); p.y = pk2(x0[2], x0[3]); p.z = pk2(x1[0], x1[1]); p.w = pk2(x1[2], x1[3]); return __builtin_bit_cast(bf16x8, p); }
DI f32x16 qk_tile(const bf16* Kp, const bf16x8 (&qf)[4], int lane) {
    const bf16* kr = Kp + (size_t)(lane & 31) * 64 + 8 * (lane >> 5);
    f32x16 p = zero16();
#pragma unroll
    for (int s = 0; s < 4; ++s) { const bf16x8 kf = *(const bf16x8*)(kr + 16 * s); p = MFMA32(kf, qf[s], p); }
    return p;
}
DI void pack_p(const f32x16& P, bf16x8 (&pf)[2]) {
#pragma unroll
    for (int s = 0; s < 2; ++s) { v4u w; w.x = pk2(P[8 * s], P[8 * s + 1]); w.y = pk2(P[8 * s + 2], P[8 * s + 3]); w.z = pk2(P[8 * s + 4], P[8 * s + 5]); w.w = pk2(P[8 * s + 6], P[8 * s + 7]); pf[s] = __builtin_bit_cast(bf16x8, w); }
}
DI void pv_tile(f32x16 (&o)[2], const bf16* Vt, int ldv, const bf16x8 (&pf)[2], int lane) {
    const int hh = lane >> 5;
#pragma unroll
    for (int s = 0; s < 2; ++s)
#pragma unroll
        for (int db = 0; db < 2; ++db) { const bf16* vr = Vt + (size_t)((lane & 31) + 32 * db) * ldv + 16 * s + 4 * hh;
            const s16x4 lo = *(const s16x4*)vr, hi = *(const s16x4*)(vr + 8);
            const bf16x8 vf = __builtin_shufflevector(lo, hi, 0, 1, 2, 3, 4, 5, 6, 7);
            o[db] = MFMA32(vf, pf[s], o[db]); }
}
DI void osm_step(f32x16& p, unsigned okm, float& m, float& l, f32x16 (&o)[2]) {
    float mx = NEGF;
#pragma unroll
    for (int i = 0; i < 16; ++i) mx = ((okm >> i) & 1u) ? fmaxf(mx, p[i]) : mx;
    mx = fmaxf(mx, __shfl_xor(mx, 32));
    const float mn = fmaxf(m, mx), al = __builtin_amdgcn_exp2f(m - mn);
    l *= al; o[0] = o[0] * al; o[1] = o[1] * al;
#pragma unroll
    for (int i = 0; i < 16; ++i) { const float e = ((okm >> i) & 1u) ? __builtin_amdgcn_exp2f(p[i] - mn) : 0.f; p[i] = e; l += e; }
    m = mn;
}
DI void swap32_pair(float& a_, float& b_) { asm volatile("s_nop 1\n\tv_permlane32_swap_b32 %0, %1\n\ts_nop 1" : "+v"(a_), "+v"(b_)); }
DI float swap32_max(float x) { float a_ = x, b_ = x; swap32_pair(a_, b_); return fmaxf(a_, b_); }
DI float swap32_sum(float x) { float a_ = x, b_ = x; swap32_pair(a_, b_); return a_ + b_; }
template <int MODE, int BR> DI void osm64(f32x16& p0, f32x16& p1, bool rowok, int kq, float& m, float& l, f32x16 (&o)[2]) {
    float mx = NEGF;
    if (MODE == 2) {
#pragma unroll
        for (int i = 0; i < 16; ++i) { const int c0 = (i & 3) + 8 * (i >> 2), c1 = c0 + 32; const bool a0 = rowok && c0 <= kq && (BR == 1 || c0 > kq - 512), a1 = rowok && c1 <= kq && (BR == 1 || c1 > kq - 512);
            mx = a0 ? fmaxf(mx, p0[i]) : mx; mx = a1 ? fmaxf(mx, p1[i]) : mx; }
    } else {
#pragma unroll
        for (int i = 0; i < 16; i += 2) mx = fmaxf(mx, fmaxf(fmaxf(p0[i], p0[i + 1]), fmaxf(p1[i], p1[i + 1])));
        if (MODE == 1) mx = rowok ? mx : NEGF;
    }
    mx = swap32_max(mx);
    if (__ballot(mx > m) != 0ull) { const float mn = fmaxf(m, mx), al = __builtin_amdgcn_exp2f(m - mn); l *= al; o[0] = o[0] * al; o[1] = o[1] * al; m = mn; }
    const float sub = (MODE == 1 && !rowok) ? 1e30f : m;
    float ls = 0.f;
#pragma unroll
    for (int i = 0; i < 16; ++i) {
        float e0 = __builtin_amdgcn_exp2f(p0[i] - sub), e1 = __builtin_amdgcn_exp2f(p1[i] - sub);
        if (MODE == 2) { const int c0 = (i & 3) + 8 * (i >> 2), c1 = c0 + 32; e0 = (rowok && c0 <= kq && (BR == 1 || c0 > kq - 512)) ? e0 : 0.f; e1 = (rowok && c1 <= kq && (BR == 1 || c1 > kq - 512)) ? e1 : 0.f; }
        p0[i] = e0; p1[i] = e1; ls += e0 + e1; }
    l += ls;
}
constexpr int CMPK_OFF = 69632, CMPV_OFF = CMPK_OFF + 256 * 144, CVROW = 528;
constexpr int ARING_OFF = 69632, ABUF = 18432, AROW = 144, QPARK_OFF = 106496;
template <int BR> DI void attend_blocks(LAS unsigned char* lds, const bf16* Kg, const bf16* Vtg, unsigned long long blkmask, unsigned long long smask,
                                        const LAS bf16x8* qpark, int q0, int t, int tid, int lane, float& m, float& l, f32x16 (&o)[2]) {
    int tid_l = tid; asm volatile("" : "+v"(tid_l));
    const int hh = lane >> 5, r = lane & 31, srow = tid_l >> 3, sch = tid_l & 7;
    const int nb = __popcll(blkmask);
    if (nb == 0) return;
    unsigned long long rem = blkmask;
    int jb = __ffsll((long long)rem) - 1; rem &= rem - 1;
    v4u kreg = *(const v4u*)(Kg + (size_t)(jb * 64 + srow) * 64 + sch * 8);
    v4u vreg = *(const v4u*)(Vtg + (size_t)srow * T + jb * 64 + sch * 8);
    for (int it = 0; it < nb; ++it) {
        LAS unsigned char* kb = lds + ARING_OFF + (it & 1) * ABUF; LAS unsigned char* vb = kb + 64 * AROW;
        *(LAS v4u*)(kb + srow * AROW + sch * 16) = kreg; *(LAS v4u*)(vb + srow * AROW + sch * 16) = vreg;
        const int jcur = jb;
        __syncthreads();
        if (rem) { jb = __ffsll((long long)rem) - 1; rem &= rem - 1;
            kreg = *(const v4u*)(Kg + (size_t)(jb * 64 + srow) * 64 + sch * 8); vreg = *(const v4u*)(Vtg + (size_t)srow * T + jb * 64 + sch * 8); }
        const int k0 = jcur * 64;
        const bool bit = (BR == 1) ? (((smask >> jcur) & 1ull) != 0ull) : true;
        const unsigned long long bal = (BR == 1) ? __ballot(bit) : ~0ull;
        if (bal == 0ull || k0 > q0 + 31 || (BR == 2 && k0 + 63 <= q0 - 512)) continue;
        f32x16 p0 = zero16(), p1 = zero16();
#pragma unroll
        for (int s = 0; s < 4; ++s) { const bf16x8 kf0 = *(const LAS bf16x8*)(kb + r * AROW + 32 * s + 16 * hh), kf1 = *(const LAS bf16x8*)(kb + (32 + r) * AROW + 32 * s + 16 * hh), qs_ = qpark[s * 64];
            p0 = MFMA32(kf0, qs_, p0); p1 = MFMA32(kf1, qs_, p1); }
        const bool interior = (k0 + 63 <= q0) && (BR == 1 || k0 > q0 + 31 - 512);
        if (interior) { if (BR == 2 || bal == ~0ull) osm64<0, BR>(p0, p1, true, 0, m, l, o); else osm64<1, BR>(p0, p1, bit, 0, m, l, o); }
        else osm64<2, BR>(p0, p1, bit, t - k0 - 4 * hh, m, l, o);
        bf16x8 pf0[2], pf1[2]; pack_p(p0, pf0); pack_p(p1, pf1);
#pragma unroll
        for (int s2 = 0; s2 < 2; ++s2)
#pragma unroll
            for (int db = 0; db < 2; ++db) { const LAS unsigned char* vr = vb + (r + 32 * db) * AROW + 32 * s2 + 8 * hh;
                const s16x4 lo0 = *(const LAS s16x4*)vr, hi0 = *(const LAS s16x4*)(vr + 16), lo1 = *(const LAS s16x4*)(vr + 64), hi1 = *(const LAS s16x4*)(vr + 80);
                o[db] = MFMA32(__builtin_shufflevector(lo0, hi0, 0, 1, 2, 3, 4, 5, 6, 7), pf0[s2], o[db]);
                o[db] = MFMA32(__builtin_shufflevector(lo1, hi1, 0, 1, 2, 3, 4, 5, 6, 7), pf1[s2], o[db]); }
    }
    __syncthreads();
}
constexpr int IMP_LD = 65;
constexpr int SMASK_OFF = 2 * 4 * 32 * IMP_LD * 4;
constexpr int SATT_OFF = 69632;
DI void attn_prompt_unit(const Args& a, LAS unsigned char* lds, int tid, int lane, int wave, int b, int g, int tile) {
    const float* PROJ = WSF(WS_PROJ);
    const int hl = wave & 3, qh = wave >> 2, head = g * 4 + hl, q0 = tile * 64 + qh * 32, r = lane & 31, hh = lane >> 5, t = q0 + r, bg = b * 2 + g;
    const float* prow = PROJ + (size_t)(b * T + t) * NINP;
    {
        const bf16* Kc = WSB(WS_KCP) + (size_t)bg * 256 * 64; const bf16* Vct = WSB(WS_VCTP) + (size_t)bg * 64 * 256;
        LAS unsigned char* ck = lds + CMPK_OFF; LAS unsigned char* cv = lds + CMPV_OFF;
        { const int tmu = tile * 64 + 63, nvu = tmu >= 31 ? (tmu - 31) / 16 + 1 : 0, ntu = (nvu + 31) >> 5;
#pragma unroll
          for (int q = 0; q < 4; ++q) { const int e = tid + 512 * q, krow = e >> 3, kch = e & 7, vrow = e >> 5, vch = e & 31;
              if (krow < ntu * 32) *(LAS v4u*)(ck + krow * AROW + kch * 16) = *(const v4u*)(Kc + (size_t)krow * 64 + kch * 8);
              if (vch < ntu * 4) *(LAS v4u*)(cv + vrow * CVROW + vch * 16) = *(const v4u*)(Vct + (size_t)vrow * 256 + vch * 8); } }
    }
    bf16x8 qf[4];
    { const float qs = 0.125f * LOG2E;
#pragma unroll
      for (int s = 0; s < 4; ++s) { const float* qp = prow + C_Q + head * 64 + 16 * s + 8 * hh; qf[s] = pack8(*(const f32x4*)qp * qs, *(const f32x4*)(qp + 4) * qs); } }
    const float g0 = sigmoidf_(prow[C_GATE + head * 3]);
    f32x16 of[2]; of[0] = zero16(); of[1] = zero16();
    LAS float* sImp = (LAS float*)lds; LAS unsigned long long* sMask = (LAS unsigned long long*)(lds + SMASK_OFF);
    {
        const bf16* Kc = WSB(WS_KCP) + (size_t)bg * 256 * 64; const bf16* Vct = WSB(WS_VCTP) + (size_t)bg * 64 * 256;
        LAS unsigned char* ck = lds + CMPK_OFF; LAS unsigned char* cv = lds + CMPV_OFF;
        __syncthreads();
        const int tmax = q0 + 31, nvis = tmax >= 31 ? (tmax - 31) / 16 + 1 : 0, ntile = (nvis + 31) >> 5;
#define CMP_QK(p_, kt_) { p_ = zero16(); _Pragma("unroll") for (int s = 0; s < 4; ++s) { const bf16x8 kf = *(const LAS bf16x8*)(ck + ((kt_) * 32 + r) * AROW + 32 * s + 16 * hh); p_ = MFMA32(kf, qf[s], p_); } }
        float m = NEGF, l = 0.f;
        for (int kt = 0; kt < ntile; ++kt) {
            f32x16 p; CMP_QK(p, kt)
            float mx = NEGF;
#pragma unroll
            for (int i = 0; i < 16; ++i) { const int n = kt * 32 + crow(i, hh); mx = (16 * n + 31 <= t) ? fmaxf(mx, p[i]) : mx; }
            mx = swap32_max(mx);
            const float mn = fmaxf(m, mx); l *= __builtin_amdgcn_exp2f(m - mn);
#pragma unroll
            for (int i = 0; i < 16; ++i) { const int n = kt * 32 + crow(i, hh); l += (16 * n + 31 <= t) ? __builtin_amdgcn_exp2f(p[i] - mn) : 0.f; }
            m = mn;
        }
        l = swap32_sum(l);
        const float inv = l > 0.f ? 1.0f / l : 0.f;
        for (int kt = 0; kt < ntile; ++kt) {
            f32x16 p; CMP_QK(p, kt)
#pragma unroll
            for (int i = 0; i < 16; ++i) { const int n = kt * 32 + crow(i, hh); p[i] = (16 * n + 31 <= t) ? __builtin_amdgcn_exp2f(p[i] - m) * inv : 0.f; }
            bf16x8 pf[2]; pack_p(p, pf);
#pragma unroll
            for (int s2 = 0; s2 < 2; ++s2)
#pragma unroll
                for (int db = 0; db < 2; ++db) { const LAS unsigned char* vr = cv + (r + 32 * db) * CVROW + kt * 64 + 32 * s2 + 8 * hh;
                    const s16x4 lo = *(const LAS s16x4*)vr, hi = *(const LAS s16x4*)(vr + 16);
                    of[db] = MFMA32(__builtin_shufflevector(lo, hi, 0, 1, 2, 3, 4, 5, 6, 7), pf[s2], of[db]); }
        }
        of[0] = of[0] * g0; of[1] = of[1] * g0;
        LAS float* slab = sImp + (size_t)((qh * 4 + hl) * 32 + r) * IMP_LD;
#pragma unroll
        for (int blk = 0; blk < 2; ++blk) {
            f32x16 im = zero16();
            const int kt0 = blk == 0 ? 0 : 3, kt1 = blk == 0 ? (ntile < 4 ? ntile : 4) : ntile;
            for (int kt = kt0; kt < kt1; ++kt) {
                f32x16 p; CMP_QK(p, kt)
#pragma unroll
                for (int i = 0; i < 16; ++i) { const int n = kt * 32 + crow(i, hh); p[i] = (16 * n + 31 <= t) ? __builtin_amdgcn_exp2f(p[i] - m) * inv : 0.f; }
                bf16x8 pf[2]; pack_p(p, pf);
                const int jb = r + 32 * blk;
#pragma unroll
                for (int s = 0; s < 2; ++s) { bf16x8 af;
#pragma unroll
                    for (int j = 0; j < 8; ++j) { const int n = kt * 32 + 16 * s + 8 * (j >> 2) + 4 * hh + (j & 3); af[j] = (n >= 4 * jb - 1 && n <= 4 * jb + 3) ? (short)0x3F80 : (short)0; }
                    im = MFMA32(af, pf[s], im); }
            }
#pragma unroll
            for (int i = 0; i < 16; ++i) slab[32 * blk + crow(i, hh)] = im[i];
        }
#undef CMP_QK
    }
    __syncthreads();
    for (int e = 0; e < 8; ++e) {
        const int qq = wave * 8 + e, qh2 = qq >> 5, rq = qq & 31, tq = tile * 64 + qq, cur = tq >> 6;
        float s = 0.f;
#pragma unroll
        for (int h2 = 0; h2 < 4; ++h2) s += sImp[(size_t)((qh2 * 4 + h2) * 32 + rq) * IMP_LD + lane];
        const float v = lane > cur ? -1e9f : ((lane == 0 || lane == cur || lane == cur - 1) ? 1e9f : s);
        int rank = 0;
#pragma unroll 16
        for (int j = 0; j < 64; ++j) { const float vj = __builtin_bit_cast(float, __builtin_amdgcn_readlane(__builtin_bit_cast(int, v), j)); rank += (vj > v || (vj == v && j < lane)) ? 1 : 0; }
        const unsigned long long mask = __ballot(rank < 16 && lane <= cur);
        if (lane == 0) sMask[qq] = mask;
    }
    __syncthreads();
    const unsigned long long smask = sMask[qh * 32 + r];
    __syncthreads();
    LAS float* park = (LAS float*)lds + wave * 2048 + lane;
    LAS bf16x8* qpark = (LAS bf16x8*)(lds + QPARK_OFF) + wave * 256 + lane;
#pragma unroll
    for (int s = 0; s < 4; ++s) qpark[s * 64] = qf[s];
#pragma unroll
    for (int db = 0; db < 2; ++db)
#pragma unroll
        for (int i = 0; i < 16; ++i) park[(db * 16 + i) * 64] = of[db][i];
    {
        float m = NEGF, l = 0.f; f32x16 o[2]; o[0] = zero16(); o[1] = zero16();
        const unsigned long long blk = (tile >= 63) ? ~0ull : ((1ull << (tile + 1)) - 1ull);
        attend_blocks<1>(lds, WSB(WS_KSEL) + (size_t)bg * T * 64, WSB(WS_VTSEL) + (size_t)bg * 64 * T, blk, smask, qpark, q0, t, tid, lane, m, l, o);
        if (PROBE_SUB & 8) attend_blocks<1>(lds, WSB(WS_KSEL) + (size_t)bg * T * 64, WSB(WS_VTSEL) + (size_t)bg * 64 * T, blk, smask, qpark, q0, t, tid, lane, m, l, o);
        l = swap32_sum(l); const float g1 = sigmoidf_(WSF(WS_PROJ)[(size_t)(b * T + t) * NINP + C_GATE + head * 3 + 1]); const float sc = l > 0.f ? g1 / l : 0.f;
#pragma unroll
        for (int db = 0; db < 2; ++db)
#pragma unroll
            for (int i = 0; i < 16; ++i) park[(db * 16 + i) * 64] += o[db][i] * sc;
    }
    {
        float m = NEGF, l = 0.f; f32x16 o[2]; o[0] = zero16(); o[1] = zero16();
        const unsigned long long hi_ = (tile >= 63) ? ~0ull : ((1ull << (tile + 1)) - 1ull), lo_ = (tile >= 8) ? ((1ull << (tile - 8)) - 1ull) : 0ull;
        attend_blocks<2>(lds, WSB(WS_KWIN) + (size_t)bg * T * 64, WSB(WS_VTWIN) + (size_t)bg * 64 * T, hi_ & ~lo_, 0ull, qpark, q0, t, tid, lane, m, l, o);
        if (PROBE_SUB & 16) attend_blocks<2>(lds, WSB(WS_KWIN) + (size_t)bg * T * 64, WSB(WS_VTWIN) + (size_t)bg * 64 * T, hi_ & ~lo_, 0ull, qpark, q0, t, tid, lane, m, l, o);
        l = swap32_sum(l); const float g2 = sigmoidf_(WSF(WS_PROJ)[(size_t)(b * T + t) * NINP + C_GATE + head * 3 + 2]); const float sc = l > 0.f ? g2 / l : 0.f;
#pragma unroll
        for (int db = 0; db < 2; ++db)
#pragma unroll
            for (int i = 0; i < 16; ++i) of[db][i] = park[(db * 16 + i) * 64] + o[db][i] * sc;
    }
    bf16* yb = WSB(WS_AST) + (size_t)(MA + b * T + t) * RWW + head * 64;
#pragma unroll
    for (int db = 0; db < 2; ++db)
#pragma unroll
        for (int gq = 0; gq < 4; ++gq) { v2u w; w.x = pk2(of[db][4 * gq], of[db][4 * gq + 1]); w.y = pk2(of[db][4 * gq + 2], of[db][4 * gq + 3]); *(v2u*)(yb + 32 * db + 8 * gq + 4 * hh) = w; }
}

constexpr int SA_SC = 0, SA_VP = 16384, SA_QV = 24576, SA_RED = 25600, SA_PACC = 26112, SA_IV = 34304, SA_LST = 35392, SA_CNT = 35456, SA_OUT = 35520;
template <int BR> DI void sa_branch_wg(const Args& a, LAS unsigned char* lds, int tid, int lane, int wave, int b, int g, int qpos, int nk, const float* pnew, float g_h0, float g_h1, float g_h2, float g_h3, float (&inv)[4]) {
    LAS float* sc = (LAS float*)(lds + SA_SC); LAS unsigned long long* vptr = (LAS unsigned long long*)(lds + SA_VP); const LAS float* qv = (const LAS float*)(lds + SA_QV);
    LAS float* red = (LAS float*)(lds + SA_RED); LAS float* pacc = (LAS float*)(lds + SA_PACC); const LAS int* lst = (const LAS int*)(lds + SA_LST); LAS float* outb = (LAS float*)(lds + SA_OUT);
    for (int idx = tid; idx < nk; idx += 512) {
        const float* kr; bool ok = true;
        if (BR == 0) kr = WSF(WS_KCS) + ((size_t)(b * NCMP_S + idx) * 2 + g) * 64;
        else if (BR == 1) { if (idx < 960) { const int blk = lst[idx >> 6]; const int page = ((const int*)a.in[I_PT])[b * 128 + (blk >> 1)]; kr = a.in[I_CKS] + ((size_t)page * 128 + (blk & 1) * 64 + (idx & 63)) * 256 + g * 64; }
                            else { kr = pnew + (size_t)(idx - 960) * NINP + 256 + g * 64; ok = (16384 + idx - 960) <= qpos; } }
        else { if (idx < 512) { kr = a.in[I_SKW] + ((size_t)b * 512 + idx) * 256 + g * 64; ok = (15872 + idx) >= qpos - 511; }
               else { kr = pnew + (size_t)(idx - 512) * NINP + 512 + g * 64; ok = (16384 + idx - 512) <= qpos; } }
        vptr[idx] = (unsigned long long)(BR == 0 ? kr + KCS_STRIDE : kr + 128);
        float s0 = 0.f, s1 = 0.f, s2 = 0.f, s3 = 0.f;
#pragma unroll 8
        for (int d4 = 0; d4 < 16; ++d4) { const f32x4 kv = *(const f32x4*)(kr + 4 * d4);
            const f32x4 q0 = *(const LAS f32x4*)(qv + 4 * d4), q1 = *(const LAS f32x4*)(qv + 64 + 4 * d4), q2 = *(const LAS f32x4*)(qv + 128 + 4 * d4), q3 = *(const LAS f32x4*)(qv + 192 + 4 * d4);
            s0 += (kv[0] * q0[0] + kv[1] * q0[1]) + (kv[2] * q0[2] + kv[3] * q0[3]); s1 += (kv[0] * q1[0] + kv[1] * q1[1]) + (kv[2] * q1[2] + kv[3] * q1[3]);
            s2 += (kv[0] * q2[0] + kv[1] * q2[1]) + (kv[2] * q2[2] + kv[3] * q2[3]); s3 += (kv[0] * q3[0] + kv[1] * q3[1]) + (kv[2] * q3[2] + kv[3] * q3[3]); }
        *(LAS f32x4*)(sc + (size_t)idx * 4) = ok ? (f32x4){s0, s1, s2, s3} : (f32x4){NEGF, NEGF, NEGF, NEGF};
    }
    __syncthreads();
    float mx[4] = {NEGF, NEGF, NEGF, NEGF};
    for (int idx = lane; idx < nk; idx += 64) { const f32x4 v = *(const LAS f32x4*)(sc + (size_t)idx * 4);
#pragma unroll
        for (int h = 0; h < 4; ++h) mx[h] = fmaxf(mx[h], v[h]); }
#pragma unroll
    for (int h = 0; h < 4; ++h) mx[h] = wave_max(mx[h]);
    __syncthreads();
    float sm[4] = {0.f, 0.f, 0.f, 0.f};
    for (int idx = tid; idx < nk; idx += 512) { const f32x4 v = *(const LAS f32x4*)(sc + (size_t)idx * 4); f32x4 e;
#pragma unroll
        for (int h = 0; h < 4; ++h) { e[h] = v[h] > -1e29f ? __expf(v[h] - mx[h]) : 0.f; sm[h] += e[h]; }
        *(LAS f32x4*)(sc + (size_t)idx * 4) = e; }
#pragma unroll
    for (int h = 0; h < 4; ++h) { sm[h] = wave_sum(sm[h]); if (lane == 0) red[wave * 4 + h] = sm[h]; }
    __syncthreads();
#pragma unroll
    for (int h = 0; h < 4; ++h) { float t_ = 0.f;
#pragma unroll
        for (int w = 0; w < 8; ++w) t_ += red[w * 4 + h];
        inv[h] = 1.0f / fmaxf(t_, 1e-30f); }
    const int kpw = (nk + 7) >> 3, kbeg = wave * kpw, kend = (kbeg + kpw < nk) ? kbeg + kpw : nk, ks = lane >> 4, d4 = (lane & 15) * 4;
    f32x4 ac0 = {0.f, 0.f, 0.f, 0.f}, ac1 = ac0, ac2 = ac0, ac3 = ac0;
#pragma unroll 8
    for (int idx = kbeg + ks; idx < kend; idx += 4) { const float* vr = (const float*)vptr[idx]; const f32x4 vv = *(const f32x4*)(vr + d4); const f32x4 pp = *(const LAS f32x4*)(sc + (size_t)idx * 4);
        ac0 = ac0 + pp[0] * vv; ac1 = ac1 + pp[1] * vv; ac2 = ac2 + pp[2] * vv; ac3 = ac3 + pp[3] * vv; }
#pragma unroll
    for (int e = 0; e < 4; ++e) { float a0 = ac0[e], a1 = ac1[e], a2 = ac2[e], a3 = ac3[e];
        a0 += __shfl_xor(a0, 16); a0 += __shfl_xor(a0, 32); a1 += __shfl_xor(a1, 16); a1 += __shfl_xor(a1, 32);
        a2 += __shfl_xor(a2, 16); a2 += __shfl_xor(a2, 32); a3 += __shfl_xor(a3, 16); a3 += __shfl_xor(a3, 32);
        if (lane < 16) { pacc[(wave * 4 + 0) * 64 + d4 + e] = a0; pacc[(wave * 4 + 1) * 64 + d4 + e] = a1; pacc[(wave * 4 + 2) * 64 + d4 + e] = a2; pacc[(wave * 4 + 3) * 64 + d4 + e] = a3; } }
    __syncthreads();
    if (tid < 256) { const int h = tid >> 6; float o = 0.f;
#pragma unroll
        for (int w = 0; w < 8; ++w) o += pacc[(w * 4 + h) * 64 + lane];
        const float gsel = h == 0 ? g_h0 : (h == 1 ? g_h1 : (h == 2 ? g_h2 : g_h3));
        outb[tid] = (BR == 0 ? 0.f : outb[tid]) + gsel * o * inv[h]; }
}
DI void attn_sample_wg(const Args& a, LAS unsigned char* lds, int tid, int lane, int wave, int item) {
    const float* PROJ = WSF(WS_PROJ);
    const int b = item >> 3, g = (item >> 2) & 1, q = item & 3, row = MP + b * 4 + q, qpos = 16384 + q;
    const float* prow = PROJ + (size_t)row * NINP; const float* pnew = PROJ + (size_t)(MP + b * 4) * NINP + C_KV;
    LAS float* sc = (LAS float*)(lds + SA_SC); LAS float* qv = (LAS float*)(lds + SA_QV); LAS float* iv = (LAS float*)(lds + SA_IV); LAS int* lst = (LAS int*)(lds + SA_LST); LAS int* cntw = (LAS int*)(lds + SA_CNT);
    const LAS float* outb = (const LAS float*)(lds + SA_OUT);
    __syncthreads();
    if (tid < 256) qv[tid] = prow[C_Q + g * 256 + tid] * 0.125f;
    float gt[4][3];
#pragma unroll
    for (int h = 0; h < 4; ++h)
#pragma unroll
        for (int br = 0; br < 3; ++br) gt[h][br] = sigmoidf_(prow[C_GATE + (g * 4 + h) * 3 + br]);
    __syncthreads();
    float inv[4];
    sa_branch_wg<0>(a, lds, tid, lane, wave, b, g, qpos, NCMP_S, pnew, gt[0][0], gt[1][0], gt[2][0], gt[3][0], inv);
    float val = 0.f; bool cand = tid <= 256;
    if (cand) { float s = 0.f;
        for (int n = 4 * tid - 1; n <= 4 * tid + 3; ++n) if (n >= 0 && n < NCMP_S) { const f32x4 p = *(const LAS f32x4*)(sc + (size_t)n * 4); s += (p[0] * inv[0] + p[1] * inv[1]) + (p[2] * inv[2] + p[3] * inv[3]); }
        val = (tid == 0 || tid == 255 || tid == 256) ? 1e9f : s; iv[tid] = val; }
    __syncthreads();
    int rank = 0;
    if (cand) for (int y = 0; y <= 256; ++y) { const float vy = iv[y]; rank += (vy > val || (vy == val && y < tid)) ? 1 : 0; }
    const bool sel = cand && rank < 16; const unsigned long long bal = __ballot(sel);
    if (lane == 0) cntw[wave] = __popcll(bal);
    __syncthreads();
    { int pos = __popcll(bal & ((1ull << lane) - 1ull)); for (int w = 0; w < wave; ++w) pos += cntw[w]; if (sel) lst[pos] = tid; }
    __syncthreads();
    sa_branch_wg<1>(a, lds, tid, lane, wave, b, g, qpos, 964, pnew, gt[0][1], gt[1][1], gt[2][1], gt[3][1], inv);
    __syncthreads();
    sa_branch_wg<2>(a, lds, tid, lane, wave, b, g, qpos, 516, pnew, gt[0][2], gt[1][2], gt[2][2], gt[3][2], inv);
    __syncthreads();
    if (tid < 256) WSB(WS_AST)[(size_t)(MA + row) * RWW + g * 256 + tid] = (bf16)f2bf(outb[tid]);
}
DI void rwpost_items(const Args& a, int lane, int wave, int G, int bx) {
    const int gw = wave * G + bx, NGW = G * NWAVES;
    for (int it = gw; it < MR * 8; it += 4 * NGW) {
        float y[4], bo[4], gg[4]; size_t o[4]; int c[4]; bool ok[4];
#pragma unroll
        for (int u = 0; u < 4; ++u) { const int id = it + u * NGW; ok[u] = id < MR * 8; const int idc = ok[u] ? id : it; c[u] = (idc & 7) * 64 + lane; o[u] = (size_t)(idc >> 3) * RWW + c[u];
            y[u] = WSF(WS_YS)[o[u]]; bo[u] = WSF(WS_BON)[o[u]]; gg[u] = WSF(WS_G)[o[u]]; }
#pragma unroll
        for (int u = 0; u < 4; ++u) { const float mean = wave_sum(y[u]) * (1.0f / 64.0f); const float dlt = y[u] - mean; const float var = wave_sum(dlt * dlt) * (1.0f / 64.0f);
            const float yn = dlt * rsqrtf(var + GN_EPS) * a.in[I_LNW][c[u]] + a.in[I_LNBB][c[u]];
            if (ok[u]) WSB(WS_AST)[o[u]] = (bf16)f2bf((yn + bo[u]) * gg[u]); }
    }
}
#ifndef PROBE_SUB
#define PROBE_SUB 0
#endif
DI void ph_attention(const Args& a, LAS unsigned char* lds, int tid, int lane, int wave, int G, int bx) {
    for (int rep = 0; rep < ((PROBE_SUB & 1) ? 2 : 1); ++rep)
    for (int i = 0; i < 4; ++i) {
        const int vbx = (G % 8 == 0) ? (bx % 8) * (G / 8) + bx / 8 : bx;
        const int base = (i >> 1) * G, u0 = base + vbx; if (u0 >= 256) break;
        const int u = (i & 1) ? 511 - u0 : u0;
        __syncthreads();
        attn_prompt_unit(a, lds, tid, lane, wave, u >> 7, (u >> 6) & 1, u & 63);
    }
    for (int rep = 0; rep < ((PROBE_SUB & 2) ? 2 : 1); ++rep)
    for (int it = bx; it < 256; it += G) attn_sample_wg(a, lds, tid, lane, wave, it);
    for (int rep = 0; rep < ((PROBE_SUB & 4) ? 2 : 1); ++rep)
    rwpost_items(a, lane, wave, G, bx);
}

constexpr int N_PHASES = 16;
#ifndef PROBE_MASK
#define PROBE_MASK 0
#endif
#ifndef ONLY_PHASE
#define ONLY_PHASE (-1)
#endif
#ifndef MK_PER_PHASE
#define MK_PER_PHASE 0
#endif
__global__ void __launch_bounds__(NWAVES * 64, 2) fwd_kernel(Args a) {
    extern __shared__ __attribute__((aligned(16))) unsigned char lds_raw[];
    LAS unsigned char* lds = (LAS unsigned char*)lds_raw;
    const int tid = threadIdx.x, lane = tid & 63, wave = __builtin_amdgcn_readfirstlane(tid >> 6), G = gridDim.x, bx = blockIdx.x;
    for (int u = tid; u < (LDS_BYTES - LDSCTL_OFF) / 4; u += NWAVES * 64) ((LAS unsigned*)(lds + LDSCTL_OFF))[u] = 0u;
    __syncthreads();
    volatile LAS unsigned* MISC = (volatile LAS unsigned*)(lds + MISC_OFF);
    unsigned* ctl = (unsigned*)(a.ws + WS_CTL);
    XcdBarrier bar; bar.bar = ctl + CW_BAR; bar.x = 0; bar.st = nullptr;
    if (!MK_PER_PHASE) bar = xcd_barrier_post(ctl + CW_BAR, MISC + 8);
    const int lo = a.ph_lo, hi = a.ph_hi;
#define IN(k) (lo <= (k) && (k) < hi)
#define SEAM(k) do { if (IN(k) && IN((k) + 1)) xcd_barrier(bar); } while (0)
#define RUN(k, ...) do { if (IN(k) && (ONLY_PHASE < 0 || ONLY_PHASE == (k))) { __VA_ARGS__ if ((PROBE_MASK >> (k)) & 1) { xcd_barrier(bar); __VA_ARGS__ } } } while (0)
    LAS unsigned char* ring = lds + RING_OFF;
    RUN(0, ph_prologue(a, lds, tid, lane, wave, G, bx););
    SEAM(0);
    RUN(1, ph_u1(a, lane, wave, G, bx); ph_compress_sample(a, lds, tid, lane, wave, G, bx););
    SEAM(1);
    RUN(2, { pg8::Gemm g{WSB(WS_U), WSB(WS_WGU), MA, 5632, D}; pg8::StaticOrder S; S.init(MA, 5632, G, bx); pg8::EpiSwiglu E{WSB(WS_H)}; pg8::gemm_phase<pg8::EpiSwiglu, pg8::StaticOrder, true, true>(ring, g, S, E); });
    SEAM(2);
    RUN(3, { pg8::Gemm g{WSB(WS_H), WSB(WS_WDN), MA, D, FF}; pg8::PromptPlusSplit S; S.init(D, 11, 4, G, bx); pg8::EpiResid E{a.in[I_XP], a.in[I_XS], WSF(WS_MOD), 2, 0.5f, WSF(WS_Z)}; pg8::gemm_phase<pg8::EpiResid, pg8::PromptPlusSplit, true, true>(ring, g, S, E); });
    SEAM(3);
    RUN(4, ph_ln<0>(a, lane, wave, G, bx););
    SEAM(4);
    RUN(5, { pg8::Gemm g{WSB(WS_U), WSB(WS_WIN), MA, NINP, D}; pg8::StaticOrder S; S.init(MA, NINP, G, bx); pg8::EpiProj E{a.in[I_BIN], WSF(WS_PROJ)}; pg8::gemm_phase<pg8::EpiProj, pg8::StaticOrder, true, true>(ring, g, S, E); });
    SEAM(5);
    RUN(6, ph_dist_rwprep(a, lds, tid, lane, wave, G, bx););
    SEAM(6);
    RUN(7, { pg8::Gemm g{WSB(WS_ACMP), WSB(WS_WC1), 2 * CROWS, 512, 1024}; pg8::PromptCmpOrder S{G, bx}; pg8::EpiF32 E{WSF(WS_HCP), 256, 0}; pg8::gemm_phase<pg8::EpiF32, pg8::PromptCmpOrder, true, true>(ring, g, S, E); });
    SEAM(7);
    RUN(8, ph_scan_prompt(a, lds, tid, lane, wave, G, bx););
    SEAM(8);
    RUN(9, ph_attention(a, lds, tid, lane, wave, G, bx););
    SEAM(9);
    RUN(10, { pg8::Gemm g{WSB(WS_AST), WSB(WS_WOAB), 2 * MA, 2048, 512}; pg8::PairOrder S{MA / 256, 4, G, bx}; pg8::EpiOutAB E{WSF(WS_PROJ), WSF(WS_M1), WSB(WS_MIN), MA / 256}; pg8::gemm_phase<pg8::EpiOutAB, pg8::PairOrder, true, true>(ring, g, S, E); });
    SEAM(10);
    RUN(11, { pg8::Gemm g{WSB(WS_MIN), WSB(WS_WO), MA, D, D}; pg8::PromptPlusSplit S; S.init(D, 4, 4, G, bx); pg8::EpiResid E{WSF(WS_X1), WSF(WS_X1) + (size_t)MP * D, WSF(WS_MOD), 5, 1.0f, WSF(WS_Z)}; pg8::gemm_phase<pg8::EpiResid, pg8::PromptPlusSplit, true, true>(ring, g, S, E); });
    SEAM(11);
    RUN(12, ph_ln<1>(a, lane, wave, G, bx););
    SEAM(12);
    RUN(13, { pg8::Gemm g{WSB(WS_U), WSB(WS_WGU) + (size_t)5632 * D, MA, 5632, D}; pg8::StaticOrder S; S.init(MA, 5632, G, bx); pg8::EpiSwiglu E{WSB(WS_H)}; pg8::gemm_phase<pg8::EpiSwiglu, pg8::StaticOrder, true, true>(ring, g, S, E); });
    SEAM(13);
    RUN(14, { pg8::Gemm g{WSB(WS_H), WSB(WS_WDN) + (size_t)D * FF, MA, D, FF}; pg8::PromptPlusSplit S; S.init(D, 11, 4, G, bx); pg8::EpiResid E{WSF(WS_X2), WSF(WS_X2) + (size_t)MP * D, WSF(WS_MOD), 8, 0.5f, WSF(WS_Z)}; pg8::gemm_phase<pg8::EpiResid, pg8::PromptPlusSplit, true, true>(ring, g, S, E); });
    SEAM(14);
    RUN(15, ph_ln<2>(a, lane, wave, G, bx););
#undef IN
#undef SEAM
}

extern "C" void kernel_launch(void* const* d_in, const int* in_sizes, int n_in, void* d_out, int out_size, void* d_ws, size_t ws_size, hipStream_t stream) {
    static int grid = 0;
    if (grid == 0) {
        if (n_in != N_IN || (size_t)out_size != O_END || ws_size < WS_END) { fprintf(stderr, "kernel_launch: unexpected shapes: n_in %d out %d ws %zu (need %zu)\n", n_in, out_size, ws_size, (size_t)WS_END); grid = -1; return; }
        int dev = 0, cus = 0, per_cu = 0;
        if (hipGetDevice(&dev) != hipSuccess || hipDeviceGetAttribute(&cus, hipDeviceAttributeMultiprocessorCount, dev) != hipSuccess) { grid = -1; return; }
        if (hipFuncSetAttribute((const void*)fwd_kernel, hipFuncAttributeMaxDynamicSharedMemorySize, LDS_BYTES) != hipSuccess) { fprintf(stderr, "kernel_launch: hipFuncSetAttribute failed\n"); grid = -1; return; }
        if (hipOccupancyMaxActiveBlocksPerMultiprocessor(&per_cu, (const void*)fwd_kernel, NWAVES * 64, LDS_BYTES) != hipSuccess || per_cu < 1)
            fprintf(stderr, "kernel_launch: note: occupancy query reports %d workgroups per CU\n", per_cu);
        (void)hipGetLastError();
        grid = cus;
    }
    if (grid < 0) return;
    if (hipMemsetAsync((char*)d_ws + WS_CTL, 0, CTL_ZERO_BYTES, stream) != hipSuccess) return;
    Args a{};
    for (int i = 0; i < N_IN; ++i) a.in[i] = (const float*)d_in[i];
    a.out = (float*)d_out; a.ws = (unsigned char*)d_ws;
#if MK_PER_PHASE
    for (int p = 0; p < N_PHASES; ++p) { a.ph_lo = p; a.ph_hi = p + 1; hipLaunchKernelGGL(fwd_kernel, dim3(grid), dim3(NWAVES * 64), LDS_BYTES, stream, a); }
#else
    a.ph_lo = 0; a.ph_hi = N_PHASES;
    hipLaunchKernelGGL(fwd_kernel, dim3(grid), dim3(NWAVES * 64), LDS_BYTES, stream, a);
#endif
    const hipError_t le = hipPeekAtLastError();
    if (le != hipSuccess) fprintf(stderr, "kernel_launch: launch failed: %s\n", hipGetErrorName(le));
}
```

```cpp
#include <hip/hip_runtime.h>
#include <cstdio>
#include <cstdint>
#define DI __device__ __forceinline__
constexpr int D = 1024, FF = 2816, T = 4096, NBP = 4, NBS = 32, ST = 4;
constexpr int MP = NBP * T;
constexpr int MS = NBS * ST;
constexpr int MR = MP + MS;
constexpr int MA = 16640;
constexpr int NIN = 5144, NINP = 5376;
constexpr int C_Q = 1792, C_KV = 2304, C_GATE = 3072, C_MERGE = 3096;
constexpr int RWW = 512;
constexpr int NCH_S = 1024, NCH_P = 256;
constexpr int NCMP_S = 1023, NCMP_P = 255;
constexpr int CROWS_S = NBS * NCH_S * 2;
constexpr int CROWS = CROWS_S + NBP * NCH_P * 2;
constexpr float ALPHA = 1.189207115002721f;
constexpr float LN_EPS = 1e-5f, GN_EPS = 64e-5f;
constexpr float LOG2E = 1.4426950408889634f;
constexpr float NEGF = -1e30f;
constexpr size_t O_Y = 0;
constexpr size_t O_KVC_P = 16908288, O_KVS_P = 21102592, O_KVW_P = 25296896, O_WKV_P = 25821184, O_SH_P = 25952256;
constexpr size_t O_KVC_S = 25959424, O_KVS_S = 25992192, O_KVW_S = 26024960, O_WKV_S = 30219264, O_SH_S = 31267840, O_END = 31325184;
DI int bb_of_row(int row) { return row < MP ? (row >> 12) : (row < MR ? 4 + ((row - MP) >> 2) : 35); }
namespace pg8 {
#define PG8_LAS __attribute__((address_space(3)))
typedef unsigned short bf16_t;
typedef short bf16x8 __attribute__((ext_vector_type(8)));
typedef float f32x4 __attribute__((ext_vector_type(4)));
typedef unsigned u32x4 __attribute__((ext_vector_type(4)));
constexpr int BM = 256, BK = 64, HALF = 128, HTB = HALF * BK * 2  , STAGE_BYTES = 8 * HTB, NXCD = 8, WGM = 8;

__host__ __device__ __forceinline__ int lds_byte(int r, int c) { const int st = (r >> 4) * 2 + (c >> 5), rr = r & 15, cc = c & 31, ob = rr * 64 + cc * 2; return st * 1024 + (ob ^ (((ob >> 9) & 1) << 5)); }
__host__ __device__ __forceinline__ void stage_rc(int b, int& R, int& C) { const int st = b / 1024, sb = b % 1024, swz = sb ^ (((sb >> 9) & 1) << 5); R = (st >> 1) * 16 + swz / 64; C = (st & 1) * 32 + (swz % 64) / 2; }
__host__ __device__ __forceinline__ int perm32(int rho) { const int n = rho >> 4, i = rho & 15; return 8 * (i >> 2) + 4 * n + (i & 3); }

struct Unit { int pm, pn, kt0 = 0, nkt = 0; };
struct Gemm { const bf16_t* A; const bf16_t* Bt; int M, N, K; };

struct StaticOrder {
    int nM, nN, nwg, G, c;
    __host__ __device__ void init(int M, int N, int G_, int c_) { nM = M / BM; nN = N / BM; nwg = nM * nN; G = G_; c = c_; }
    __host__ __device__ bool next(int i, Unit& u) const {
        const long L = (long)i * G + c; if (L >= nwg) return false;
        int wgid = (int)L; { const int q = nwg / NXCD, r = nwg % NXCD, xcd = wgid % NXCD, off = wgid / NXCD; wgid = (xcd < r ? xcd * (q + 1) : r * (q + 1) + (xcd - r) * q) + off; }
        const int nig = WGM * nN, gid = wgid / nig, fm = gid * WGM, gsz = (nM - fm) < WGM ? (nM - fm) : WGM;
        u.pm = fm + ((wgid % nig) % gsz); u.pn = (wgid % nig) / gsz; return true;
    }
    __device__ __forceinline__ void a_ready(const Unit&) const {}
    __device__ __forceinline__ void done(const Unit&) const {}
};

struct PairOrder {
    int nm, nn, G, c;
    __device__ __forceinline__ bool next(int i, Unit& u) const {
        const int tile = (i >> 1) * G + c; if (tile >= nm * nn) return false;
        const int rep = i & 1; u.pm = tile / nn + rep * nm; u.pn = tile % nn + rep * nn; return true;
    }
    __device__ __forceinline__ void a_ready(const Unit&) const {}
    __device__ __forceinline__ void done(const Unit&) const {}
};
struct DiagOrder {
    int nm, nn, nrep, G, c;
    __device__ __forceinline__ bool next(int i, Unit& u) const {
        const int L = i * G + c; if (L >= nrep * nm * nn) return false;
        const int rep = L / (nm * nn), rem = L % (nm * nn); u.pm = rem / nn + rep * nm; u.pn = rem % nn + rep * nn; return true;
    }
    __device__ __forceinline__ void a_ready(const Unit&) const {}
    __device__ __forceinline__ void done(const Unit&) const {}
};

struct PromptCmpOrder {
    int G, c;
    __device__ __forceinline__ bool next(int i, Unit& u) const { const int L = i * G + c; if (L >= 64) return false; const int ks = L & 3, q = L >> 2, rep = q >> 3, rem = q & 7;
        u.pm = CROWS_S / BM + rem + rep * (CROWS / BM); u.pn = rep; u.kt0 = ks * 4; u.nkt = 4; return true; }
    __device__ __forceinline__ void a_ready(const Unit&) const {}
    __device__ __forceinline__ void done(const Unit&) const {}
};
struct PromptPlusSplit {
    StaticOrder S0; int nks, nkt, G, c;
    __device__ __forceinline__ void init(int N, int nks_, int nkt_, int G_, int c_) { S0.init(MP, N, G_, c_); nks = nks_; nkt = nkt_; G = G_; c = c_; }
    __device__ __forceinline__ bool next(int i, Unit& u) const {
        if (S0.next(i, u)) { u.kt0 = 0; u.nkt = 0; return true; }
        const int r0 = (S0.nwg + G - 1) / G; const int j = (i - r0) * G + c; if (j < 0 || j >= 4 * nks) return false;
        u.pm = MP / BM; u.pn = j & 3; u.kt0 = (j >> 2) * nkt; u.nkt = nkt; return true;
    }
    __device__ __forceinline__ void a_ready(const Unit&) const {}
    __device__ __forceinline__ void done(const Unit&) const {}
};

typedef float f32x2 __attribute__((ext_vector_type(2)));
typedef __bf16 bf16x2_t __attribute__((ext_vector_type(2)));
__device__ __forceinline__ unsigned cvt_pk_bf16(float lo, float hi) { f32x2 v = {lo, hi}; bf16x2_t b = __builtin_convertvector(v, bf16x2_t); return __builtin_bit_cast(unsigned, b); }
__device__ __forceinline__ float fast_sigmoid(float x) { return __builtin_amdgcn_rcpf(1.0f + __builtin_amdgcn_exp2f(-x * LOG2E)); }

struct EpiSwiglu {
    static constexpr bool PERM = true, AFTER_DRAIN = false;
    bf16_t* H;
    __device__ __forceinline__ void operator()(const f32x4 (&acc)[2][2][4][2], const Unit& u, int wr, int wc, int fr, int fq) const {
        const int row0 = u.pm * BM + wr * 64 + fr, hc0 = u.pn * HALF + wc * 32 + 8 * fq;
#pragma unroll
        for (int ai = 0; ai < 2; ++ai)
#pragma unroll
            for (int m = 0; m < 4; ++m) {
                bf16_t* rowp = H + (size_t)(row0 + ai * HALF + m * 16) * FF + hc0;
                float h[8];
#pragma unroll
                for (int n = 0; n < 2; ++n)
#pragma unroll
                    for (int e = 0; e < 4; ++e) { const float g = acc[ai][0][m][n][e], up = acc[ai][1][m][n][e]; h[4 * n + e] = g * fast_sigmoid(g) * up; }
                u32x4 w; w.x = cvt_pk_bf16(h[0], h[1]); w.y = cvt_pk_bf16(h[2], h[3]); w.z = cvt_pk_bf16(h[4], h[5]); w.w = cvt_pk_bf16(h[6], h[7]);
                *(u32x4*)rowp = w;
            }
    }
};
struct EpiResid {
    static constexpr bool PERM = false, AFTER_DRAIN = false;
    const float* xp; const float* xs; const float* mod; int slot; float coef; float* Z;
    __device__ __forceinline__ void operator()(const f32x4 (&acc)[2][2][4][2], const Unit& u, int wr, int wc, int fr, int fq) const {
        const int row0 = u.pm * BM + wr * 64 + fr, col0 = u.pn * BM + wc * 32 + 4 * fq;
        if (u.nkt) {
            float* zp = Z + (size_t)MA * D + (size_t)(u.kt0 / u.nkt) * MS * D;
#pragma unroll
            for (int m = 0; m < 4; ++m) { const int row = row0 - MP + m * 16;
#pragma unroll
                for (int bj = 0; bj < 2; ++bj)
#pragma unroll
                    for (int n = 0; n < 2; ++n) *(f32x4*)(zp + (size_t)row * D + col0 + bj * HALF + n * 16) = acc[0][bj][m][n]; }
        } else
#pragma unroll
        for (int ai = 0; ai < 2; ++ai)
#pragma unroll
            for (int m = 0; m < 4; ++m) {
                const int row = row0 + ai * HALF + m * 16; const bool valid = row < MR;
                const float* xr = row < MP ? xp + (size_t)row * D : xs + (size_t)(row - MP) * D;
                const float* mr = mod + (size_t)(bb_of_row(row) * 9 + slot) * D;
#pragma unroll
                for (int bj = 0; bj < 2; ++bj)
#pragma unroll
                    for (int n = 0; n < 2; ++n) { const int col = col0 + bj * HALF + n * 16;
                        const f32x4 xv = valid ? *(const f32x4*)(xr + col) : (f32x4){0.f, 0.f, 0.f, 0.f}; const f32x4 mv = *(const f32x4*)(mr + col);
                        *(f32x4*)(Z + (size_t)row * D + col) = ALPHA * xv + coef * (1.0f + mv) * acc[ai][bj][m][n]; }
            }
    }
};
struct EpiProj {
    static constexpr bool PERM = false, AFTER_DRAIN = false;
    const float* bias; float* P;
    __device__ __forceinline__ void operator()(const f32x4 (&acc)[2][2][4][2], const Unit& u, int wr, int wc, int fr, int fq) const {
        const int row0 = u.pm * BM + wr * 64 + fr, col0 = u.pn * BM + wc * 32 + 4 * fq;
        f32x4 bv[2][2];
#pragma unroll
        for (int bj = 0; bj < 2; ++bj)
#pragma unroll
            for (int n = 0; n < 2; ++n) { const int col = col0 + bj * HALF + n * 16; bv[bj][n] = col < NIN ? *(const f32x4*)(bias + col) : (f32x4){0.f, 0.f, 0.f, 0.f}; }
#pragma unroll
        for (int ai = 0; ai < 2; ++ai)
#pragma unroll
            for (int m = 0; m < 4; ++m) { float* rp = P + (size_t)(row0 + ai * HALF + m * 16) * NINP + col0;
#pragma unroll
                for (int bj = 0; bj < 2; ++bj)
#pragma unroll
                    for (int n = 0; n < 2; ++n) *(f32x4*)(rp + bj * HALF + n * 16) = acc[ai][bj][m][n] + bv[bj][n]; }
    }
};
struct EpiF32 {
    static constexpr bool PERM = false, AFTER_DRAIN = false;
    float* O; int ldc; int nm;
    __device__ __forceinline__ void operator()(const f32x4 (&acc)[2][2][4][2], const Unit& u, int wr, int wc, int fr, int fq) const {
        const int row0 = ((u.kt0 / 4) * 2 + u.pn) * 2048 + (u.pm - u.pn * (CROWS / BM) - CROWS_S / BM) * BM + wr * 64 + fr, col0 = wc * 32 + 4 * fq;
#pragma unroll
        for (int ai = 0; ai < 2; ++ai)
#pragma unroll
            for (int m = 0; m < 4; ++m) { float* rp = O + (size_t)(row0 + ai * HALF + m * 16) * ldc + col0;
#pragma unroll
                for (int bj = 0; bj < 2; ++bj)
#pragma unroll
                    for (int n = 0; n < 2; ++n) *(f32x4*)(rp + bj * HALF + n * 16) = acc[ai][bj][m][n]; }
    }
};
struct EpiOutAB {
    static constexpr bool PERM = false, AFTER_DRAIN = false;
    const float* P; float* M1; bf16_t* MIN; int nm;
    __device__ __forceinline__ void operator()(const f32x4 (&acc)[2][2][4][2], const Unit& u, int wr, int wc, int fr, int fq) const {
        const int rep = u.pm >= nm ? 1 : 0;
        const int row0 = (u.pm - rep * nm) * BM + wr * 64 + fr, col0 = (u.pn - rep * 4) * BM + wc * 32 + 4 * fq;
#pragma unroll
        for (int ai = 0; ai < 2; ++ai)
#pragma unroll
            for (int m = 0; m < 4; ++m) { const int row = row0 + ai * HALF + m * 16;
#pragma unroll
                for (int bj = 0; bj < 2; ++bj)
#pragma unroll
                    for (int n = 0; n < 2; ++n) { const int col = col0 + bj * HALF + n * 16;
                        const f32x4 pm = *(const f32x4*)(P + (size_t)row * NINP + C_MERGE + rep * D + col);
                        f32x4 g; g[0] = fast_sigmoid(pm[0]); g[1] = fast_sigmoid(pm[1]); g[2] = fast_sigmoid(pm[2]); g[3] = fast_sigmoid(pm[3]);
                        const f32x4 v = g * acc[ai][bj][m][n];
                        if (rep == 0) *(f32x4*)(M1 + (size_t)row * D + col) = v;
                        else { const f32x4 s = *(const f32x4*)(M1 + (size_t)row * D + col) + v;
                               typedef unsigned u32x2v __attribute__((ext_vector_type(2))); u32x2v w; w.x = cvt_pk_bf16(s[0], s[1]); w.y = cvt_pk_bf16(s[2], s[3]);
                               *(u32x2v*)(MIN + (size_t)row * D + col) = w; } }
            }
    }
};
template <class Epi, class Sched, bool ALIGN_EPI = false, bool SP2 = false>
__device__ __forceinline__ void gemm_phase(PG8_LAS unsigned char* lds, const Gemm g, const Sched& S, const Epi& E) {
    const int tid = threadIdx.x, wid = __builtin_amdgcn_readfirstlane(tid >> 6), lane = tid & 63, wr = wid >> 2, wc = wid & 3, fr = lane & 15, fq = lane >> 4;
    const int K = g.K, nt = K / BK;
    unsigned voffA[2], voffB[2];
#pragma unroll
    for (int i = 0; i < 2; ++i) { int R, C; stage_rc(tid * 16 + i * 8192, R, C); const int Rb = Epi::PERM ? ((R & ~31) + perm32(R & 31)) : R;
        voffA[i] = (unsigned)(R * K + C) * 2u; voffB[i] = (unsigned)(Rb * K + C) * 2u; }
    const size_t kstep = (size_t)(BK * 2);
    const size_t hstep = (size_t)HALF * K * 2;
    const size_t tstep = 2 * hstep;
    const unsigned ldsw = (unsigned)wid * 1024u;
    const int aoff = lds_byte(wr * 64 + fr, fq * 8), boff = lds_byte(wc * 32 + fr, fq * 8);
#define PG8_SA(b, h) (((b) * 2 + (h)) * HTB)
#define PG8_SB(b, h) ((4 + (b) * 2 + (h)) * HTB)
#define PG8_STAGE(bufoff, gbase, voff) do { _Pragma("unroll") for (int _i = 0; _i < 2; ++_i) \
        __builtin_amdgcn_global_load_lds((const unsigned*)((const char*)(gbase) + (voff)[_i]), (PG8_LAS unsigned*)(lds + (bufoff) + ldsw + _i * 8192), 16, 0, 0); } while (0)
#define PG8_LDA(dst, b, h) do { _Pragma("unroll") for (int m = 0; m < 4; ++m) _Pragma("unroll") for (int k = 0; k < 2; ++k) dst[m][k] = *(const PG8_LAS bf16x8*)(lds + PG8_SA(b, h) + aoff + m * 2048 + k * 1024); } while (0)
#define PG8_LDB(dst, b, h) do { _Pragma("unroll") for (int n = 0; n < 2; ++n) _Pragma("unroll") for (int k = 0; k < 2; ++k) dst[n][k] = *(const PG8_LAS bf16x8*)(lds + PG8_SB(b, h) + boff + n * 2048 + k * 1024); } while (0)
#define PG8_MMA(ai, bj, At, Bt) do { __builtin_amdgcn_s_setprio(1); _Pragma("unroll") for (int m = 0; m < 4; ++m) _Pragma("unroll") for (int n = 0; n < 2; ++n) _Pragma("unroll") for (int k = 0; k < 2; ++k) \
        acc[ai][bj][m][n] = __builtin_amdgcn_mfma_f32_16x16x32_bf16(Bt[n][k], At[m][k], acc[ai][bj][m][n], 0, 0, 0); __builtin_amdgcn_s_setprio(0); } while (0)
#define PG8_WAIT_V(n) asm volatile("s_waitcnt vmcnt(" #n ")" ::: "memory")
#define PG8_WAIT_L(n) asm volatile("s_waitcnt lgkmcnt(" #n ")" ::: "memory")
#define PG8_BAR __builtin_amdgcn_s_barrier()
#define PG8_SCHED __builtin_amdgcn_sched_barrier(0)
    Unit cur, nxt; int ui = 0;
    if (!S.next(0, cur)) return;
    f32x4 acc[2][2][4][2];
#pragma unroll
    for (int a = 0; a < 2; ++a)
#pragma unroll
        for (int b = 0; b < 2; ++b)
#pragma unroll
            for (int m = 0; m < 4; ++m)
#pragma unroll
                for (int n = 0; n < 2; ++n) acc[a][b][m][n] = (f32x4){0.f, 0.f, 0.f, 0.f};
    bf16x8 At[4][2], B0[2][2], B1[2][2];
    const char* cA = (const char*)g.A + (size_t)cur.pm * tstep + (size_t)cur.kt0 * kstep; const char* cB = (const char*)g.Bt + (size_t)cur.pn * tstep + (size_t)cur.kt0 * kstep;
    S.a_ready(cur);
    if constexpr (SP2) {
        PG8_STAGE(PG8_SB(0, 0), cB, voffB); PG8_STAGE(PG8_SB(0, 1), cB + hstep, voffB); PG8_STAGE(PG8_SA(0, 0), cA, voffA); PG8_STAGE(PG8_SA(0, 1), cA + hstep, voffA);
        if (wr == 1) PG8_BAR;
        PG8_WAIT_V(2); PG8_BAR;
        PG8_STAGE(PG8_SB(1, 0), cB + kstep, voffB); PG8_STAGE(PG8_SA(1, 0), cA + kstep, voffA); PG8_STAGE(PG8_SB(1, 1), cB + hstep + kstep, voffB);
        PG8_WAIT_V(6); PG8_BAR;
    } else {
        PG8_STAGE(PG8_SB(0, 0), cB, voffB); PG8_STAGE(PG8_SA(0, 0), cA, voffA); PG8_STAGE(PG8_SB(0, 1), cB + hstep, voffB); PG8_STAGE(PG8_SA(0, 1), cA + hstep, voffA);
        if (wr == 1) PG8_BAR;
        PG8_WAIT_V(4); PG8_BAR;
        PG8_STAGE(PG8_SB(1, 0), cB + kstep, voffB); PG8_STAGE(PG8_SA(1, 0), cA + kstep, voffA); PG8_STAGE(PG8_SB(1, 1), cB + hstep + kstep, voffB);
        PG8_WAIT_V(6); PG8_BAR;
    }
    for (;;) {
        const bool has_next = S.next(ui + 1, nxt);
        const char* nA = has_next ? (const char*)g.A + (size_t)nxt.pm * tstep + (size_t)nxt.kt0 * kstep : cA; const char* nB = has_next ? (const char*)g.Bt + (size_t)nxt.pn * tstep + (size_t)nxt.kt0 * kstep : cB;
        const int ntu = cur.nkt ? cur.nkt : nt;
        for (int t = 0; t < ntu; t += 2) {
            const bool last = (t == ntu - 2);
            const char* a1 = cA + (size_t)(t + 1) * kstep;
            const char* a2 = last ? nA : cA + (size_t)(t + 2) * kstep; const char* b2 = last ? nB : cB + (size_t)(t + 2) * kstep;
            const char* a3 = a2 + kstep; const char* b3 = b2 + kstep;
            if (last && has_next) S.a_ready(nxt);
            if constexpr (SP2) {
            PG8_LDB(B0, 0, 0); PG8_LDB(B1, 0, 1); PG8_SCHED; PG8_LDA(At, 0, 0); PG8_STAGE(PG8_SA(1, 1), a1 + hstep, voffA);
            PG8_WAIT_V(8); PG8_WAIT_L(0); PG8_BAR; PG8_MMA(0, 0, At, B0); PG8_MMA(0, 1, At, B1); PG8_BAR; PG8_SCHED;
            PG8_LDA(At, 0, 1); PG8_STAGE(PG8_SB(0, 0), b2, voffB); PG8_STAGE(PG8_SB(0, 1), b2 + hstep, voffB); PG8_STAGE(PG8_SA(0, 0), a2, voffA);
            PG8_WAIT_V(8); PG8_WAIT_L(0); PG8_BAR; PG8_MMA(1, 0, At, B0); PG8_MMA(1, 1, At, B1); PG8_BAR; PG8_SCHED;
            PG8_LDB(B0, 1, 0); PG8_LDB(B1, 1, 1); PG8_SCHED; PG8_LDA(At, 1, 0); PG8_STAGE(PG8_SA(0, 1), a2 + hstep, voffA);
            PG8_WAIT_V(8); PG8_WAIT_L(0); PG8_BAR; PG8_MMA(0, 0, At, B0); PG8_MMA(0, 1, At, B1); PG8_BAR; PG8_SCHED;
            PG8_LDA(At, 1, 1); PG8_STAGE(PG8_SB(1, 0), b3, voffB); PG8_STAGE(PG8_SB(1, 1), b3 + hstep, voffB); PG8_STAGE(PG8_SA(1, 0), a3, voffA);
            PG8_WAIT_V(8); PG8_WAIT_L(0); PG8_BAR; PG8_MMA(1, 0, At, B0); PG8_MMA(1, 1, At, B1); PG8_BAR; PG8_SCHED;
            } else {
            PG8_LDB(B0, 0, 0); PG8_SCHED; PG8_LDA(At, 0, 0); PG8_STAGE(PG8_SA(1, 1), a1 + hstep, voffA);
            PG8_WAIT_L(8); PG8_BAR; PG8_WAIT_L(0); PG8_MMA(0, 0, At, B0); PG8_BAR; PG8_SCHED;
            PG8_LDB(B1, 0, 1); PG8_STAGE(PG8_SB(0, 0), b2, voffB);
            PG8_BAR; PG8_WAIT_L(0); PG8_MMA(0, 1, At, B1); PG8_BAR;
            PG8_LDA(At, 0, 1); PG8_STAGE(PG8_SA(0, 0), a2, voffA);
            PG8_BAR; PG8_WAIT_L(0); PG8_MMA(1, 0, At, B0); PG8_BAR; PG8_SCHED;
            PG8_STAGE(PG8_SB(0, 1), b2 + hstep, voffB);
            PG8_WAIT_V(6); PG8_BAR; PG8_MMA(1, 1, At, B1); PG8_BAR;
            PG8_LDB(B0, 1, 0); PG8_SCHED; PG8_LDA(At, 1, 0); PG8_STAGE(PG8_SA(0, 1), a2 + hstep, voffA);
            PG8_WAIT_L(8); PG8_BAR; PG8_WAIT_L(0); PG8_MMA(0, 0, At, B0); PG8_BAR; PG8_SCHED;
            PG8_LDB(B1, 1, 1); PG8_STAGE(PG8_SB(1, 0), b3, voffB);
            PG8_BAR; PG8_WAIT_L(0); PG8_MMA(0, 1, At, B1); PG8_BAR;
            PG8_LDA(At, 1, 1); PG8_STAGE(PG8_SA(1, 0), a3, voffA);
            PG8_BAR; PG8_WAIT_L(0); PG8_MMA(1, 0, At, B0); PG8_BAR; PG8_SCHED;
            PG8_STAGE(PG8_SB(1, 1), b3 + hstep, voffB);
            PG8_WAIT_V(6); PG8_BAR; PG8_MMA(1, 1, At, B1); PG8_BAR;
            }
        }
        if constexpr (ALIGN_EPI) { if (wr == 0) PG8_BAR; }
        if constexpr (!Epi::AFTER_DRAIN) { E(acc, cur, wr, wc, fr, fq); S.done(cur); }
        if (!has_next) break;
#pragma unroll
        for (int a = 0; a < 2; ++a)
#pragma unroll
            for (int b = 0; b < 2; ++b)
#pragma unroll
                for (int m = 0; m < 4; ++m)
#pragma unroll
                    for (int n = 0; n < 2; ++n) acc[a][b][m][n] = (f32x4){0.f, 0.f, 0.f, 0.f};
        cur = nxt; cA = nA; cB = nB; ++ui;
        if constexpr (ALIGN_EPI) { if (wr == 1) PG8_BAR; }
    }
    PG8_WAIT_V(0);
    if constexpr (!ALIGN_EPI) { if (wr == 0) PG8_BAR; }
    PG8_BAR;
    if constexpr (Epi::AFTER_DRAIN) { E.fused(acc, cur, wr, wc, fr, fq, lds, wid, lane); S.done(cur); }
#undef PG8_SA
#undef PG8_SB
#undef PG8_STAGE
#undef PG8_LDA
#undef PG8_LDB
#undef PG8_MMA
#undef PG8_WAIT_V
#undef PG8_WAIT_L
#undef PG8_BAR
#undef PG8_SCHED
}
}

constexpr size_t al256(size_t x) { return (x + 255) & ~(size_t)255; }
constexpr size_t WS_CTL = 0, CTL_ZERO_BYTES = 1u << 20;
constexpr int CW_BAR = 4096;
constexpr size_t WS_MOD  = CTL_ZERO_BYTES;
constexpr size_t WS_PET  = al256(WS_MOD + (size_t)36 * 9 * D * 4);
constexpr size_t WS_WGU  = al256(WS_PET + 2 * 128 * 4);
constexpr size_t WS_WDN  = al256(WS_WGU + (size_t)2 * 5632 * D * 2);
constexpr size_t WS_WIN  = al256(WS_WDN + (size_t)2 * D * FF * 2);
constexpr size_t WS_WOAB = al256(WS_WIN + (size_t)NINP * D * 2);
constexpr size_t WS_WO   = al256(WS_WOAB + (size_t)2048 * 512 * 2);
constexpr size_t WS_WC1  = al256(WS_WO + (size_t)D * D * 2);
constexpr size_t WS_LORA = al256(WS_WC1 + (size_t)512 * 1024 * 2);
constexpr size_t WS_W2T  = al256(WS_LORA + (size_t)512 * 256 * 2);
constexpr size_t WS_U    = al256(WS_W2T + (size_t)2 * 64 * 128 * 2);
constexpr size_t WS_H    = al256(WS_U + (size_t)MA * D * 2);
constexpr size_t WS_Z    = al256(WS_H + (size_t)MA * FF * 2);
constexpr size_t WS_ZP   = WS_Z + (size_t)MA * D * 4;
constexpr size_t WS_X1   = al256(WS_ZP + (size_t)11 * MS * D * 4);
constexpr size_t WS_X2   = al256(WS_X1 + (size_t)MA * D * 4);
constexpr size_t WS_M1   = al256(WS_X2 + (size_t)MA * D * 4);
constexpr size_t WS_MIN  = al256(WS_M1 + (size_t)MA * D * 4);
constexpr size_t WS_PROJ = al256(WS_MIN + (size_t)MA * D * 2);
constexpr size_t WS_RW   = al256(WS_PROJ + (size_t)MA * NINP * 4);
constexpr size_t RW_STRIDE = (size_t)MA * RWW;
constexpr size_t WS_G    = al256(WS_RW + 6 * RW_STRIDE * 4);
constexpr size_t WS_BON  = al256(WS_G + RW_STRIDE * 4);
constexpr size_t WS_YS   = al256(WS_BON + RW_STRIDE * 4);
constexpr size_t WS_AST  = al256(WS_YS + RW_STRIDE * 4);
constexpr size_t WS_KSEL = al256(WS_AST + (size_t)2 * MA * RWW * 2);
constexpr size_t KV_BYTES = (size_t)NBP * 2 * T * 64 * 2;
constexpr size_t WS_KWIN = WS_KSEL + KV_BYTES, WS_VTSEL = WS_KWIN + KV_BYTES, WS_VTWIN = WS_VTSEL + KV_BYTES;
constexpr size_t WS_KCP  = WS_VTWIN + KV_BYTES;
constexpr size_t WS_VCTP = WS_KCP + (size_t)NBP * 2 * 256 * 64 * 2;
constexpr size_t WS_KCS  = al256(WS_VCTP + (size_t)NBP * 2 * 256 * 64 * 2);
constexpr size_t KCS_STRIDE = (size_t)NBS * NCMP_S * 2 * 64;
constexpr size_t WS_ACMP = al256(WS_KCS + 2 * KCS_STRIDE * 4);
constexpr size_t WS_HC   = al256(WS_ACMP + (size_t)2 * CROWS * 1024 * 2);
constexpr size_t WS_HCP  = al256(WS_HC + (size_t)2 * CROWS * 256 * 4);
constexpr size_t WS_END  = al256(WS_HCP + (size_t)4 * 2 * 2048 * 256 * 4);

constexpr int NWAVES = 8;
constexpr int RING_OFF = 0, RING_BYTES = 131072;
constexpr int LDSCTL_OFF = 147456 - 512, MISC_OFF = LDSCTL_OFF + 320;
constexpr int LDS_BYTES = 147456;

#define GAS __attribute__((address_space(1)))
#define LAS __attribute__((address_space(3)))
typedef unsigned short bf16;
typedef unsigned v4u __attribute__((ext_vector_type(4)));
typedef unsigned v2u __attribute__((ext_vector_type(2)));
typedef float f32x4 __attribute__((ext_vector_type(4)));
typedef float f32x16 __attribute__((ext_vector_type(16)));
typedef short bf16x8 __attribute__((ext_vector_type(8)));
typedef short s16x4 __attribute__((ext_vector_type(4)));
typedef GAS unsigned gu32;
#define RLX_AGENT __ATOMIC_RELAXED, __HIP_MEMORY_SCOPE_AGENT
#define LDS_WAIT() asm volatile("s_waitcnt lgkmcnt(0)" ::: "memory")
#define VM_WAIT() asm volatile("s_waitcnt vmcnt(0)" ::: "memory")
DI unsigned f2bf(float f) { unsigned u = __builtin_bit_cast(unsigned, f); return (u + 0x7fffu + ((u >> 16) & 1u)) >> 16; }
DI unsigned pk2(float lo, float hi) { return pg8::cvt_pk_bf16(lo, hi); }
DI float sigmoidf_(float x) { return 1.0f / (1.0f + __expf(-x)); }
DI float wave_sum(float v) {
#pragma unroll
    for (int o = 1; o < 64; o <<= 1) v += __shfl_xor(v, o);
    return v;
}
DI float wave_max(float v) {
#pragma unroll
    for (int o = 1; o < 64; o <<= 1) v = fmaxf(v, __shfl_xor(v, o));
    return v;
}
template <int CTRL> DI float dpp_f(float x) { return __builtin_bit_cast(float, __builtin_amdgcn_update_dpp(0, __builtin_bit_cast(int, x), CTRL, 0xf, 0xf, false)); }
DI float row16_sum(float x) {
    x += dpp_f<0x128>(x); x += dpp_f<0x124>(x); x += dpp_f<0x122>(x); x += dpp_f<0x121>(x); return x;
}
DI float fsig(float x) { return __builtin_amdgcn_rcpf(1.0f + __builtin_amdgcn_exp2f(-x * LOG2E)); }
DI float ftanh(float x) { return 1.0f - 2.0f * __builtin_amdgcn_rcpf(__builtin_amdgcn_exp2f(x * (2.0f * LOG2E)) + 1.0f); }
DI float gelu_tanh(float x) { const float u = 0.7978845608028654f * (x + 0.044715f * x * x * x); const float e = __expf(2.0f * u); const float th = 1.0f - 2.0f / (e + 1.0f); return 0.5f * x * (1.0f + th); }
#define MFMA32(a_, b_, c_) __builtin_amdgcn_mfma_f32_32x32x16_bf16((a_), (b_), (c_), 0, 0, 0)
DI int crow(int i, int hh) { return (i & 3) + 8 * (i >> 2) + 4 * hh; }
DI f32x16 zero16() { f32x16 z;
#pragma unroll
    for (int i = 0; i < 16; ++i) z[i] = 0.f; return z; }
#define XB_TMO      128
#define XB_XCNT(j)  (256  + 64 * (j))
#define XB_XSUB(j)  (1280 + 64 * (j))
#define XB_XGEN(j)  (2304 + 64 * (j))
#define XB_TOP      3328
#define XB_TOPGEN   3392
#define XCD_BAR_WORDS 3456
#define XB_SPIN_CAP (1u << 18)

__device__ __forceinline__ unsigned xb_ld(unsigned* p)              { return __hip_atomic_load(p, __ATOMIC_RELAXED, __HIP_MEMORY_SCOPE_AGENT); }
__device__ __forceinline__ unsigned xb_add(unsigned* p, unsigned v) { return __hip_atomic_fetch_add(p, v, __ATOMIC_RELAXED, __HIP_MEMORY_SCOPE_AGENT); }
__device__ __forceinline__ unsigned xb_xcc_id() { return (unsigned)__builtin_amdgcn_s_getreg((3 << 11) | 20) & 0xFu; }
#define XB_SPIN(cond, bar) do { unsigned _sp = 0; while (cond) { __builtin_amdgcn_s_sleep(1); \
    if ((++_sp & 255u) == 0u) { if (xb_ld(&(bar)[XB_TMO])) break; if (_sp > XB_SPIN_CAP) { atomicAdd(&(bar)[XB_TMO], 1u); break; } } } } while (0)

struct XcdBarrier {
    unsigned* bar; unsigned x;
    volatile LAS unsigned* st;
};

__device__ __forceinline__ XcdBarrier xcd_barrier_post(unsigned* bar, volatile LAS unsigned* st) {
    XcdBarrier b; b.bar = bar; b.x = xb_xcc_id(); b.st = st;
    if (threadIdx.x == 0) (void)xb_add(&bar[XB_XCNT(b.x)], 1u);
    return b;
}
__device__ __forceinline__ void xcd_barrier_complete(unsigned* bar, unsigned x, unsigned& nloc, unsigned& nx) {
    const unsigned G = gridDim.x * gridDim.y * gridDim.z;
    unsigned sum, cnt, mine, sp = 0u;
    for (;;) {
        sum = 0u; cnt = 0u; mine = 0u;
#pragma unroll
        for (unsigned j = 0; j < 16; ++j) { const unsigned c = xb_ld(&bar[XB_XCNT(j)]); sum += c; cnt += (c > 0u) ? 1u : 0u; mine = (j == x) ? c : mine; }
        if (sum == G) break;
        __builtin_amdgcn_s_sleep(1);
        if ((++sp & 255u) == 0u) { if (xb_ld(&bar[XB_TMO])) break; if (sp > XB_SPIN_CAP) { atomicAdd(&bar[XB_TMO], 1u); break; } }
    }
    nloc = mine > 0u ? mine : 1u; nx = cnt > 0u ? cnt : 1u;
}

__device__ __forceinline__ void xcd_barrier(const XcdBarrier& b) {
    asm volatile("s_waitcnt vmcnt(0)" ::: "memory");
    __syncthreads();
    if (threadIdx.x == 0) {
        unsigned* bar = b.bar;
        __builtin_amdgcn_s_waitcnt(0);
        unsigned nloc = b.st[0], nx = b.st[1];
        if (nloc == 0u) { xcd_barrier_complete(bar, b.x, nloc, nx); b.st[0] = nloc; b.st[1] = nx; }
        const unsigned old = xb_add(&bar[XB_XSUB(b.x)], 1u);
        const unsigned gen = old / nloc;
        if (old + 1u == (gen + 1u) * nloc) {
            __builtin_amdgcn_fence(__ATOMIC_RELEASE, "agent");
            asm volatile("s_waitcnt vmcnt(0)" ::: "memory");
            const unsigned og = xb_add(&bar[XB_TOP], 1u);
            const unsigned tg = og / nx;
            if (og + 1u == (tg + 1u) * nx) xb_add(&bar[XB_TOPGEN], 1u);
            else XB_SPIN(xb_ld(&bar[XB_TOPGEN]) == tg, bar);
            __builtin_amdgcn_fence(__ATOMIC_ACQUIRE, "agent");
            xb_add(&bar[XB_XGEN(b.x)], 1u);
            asm volatile("s_waitcnt vmcnt(0)" ::: "memory");
        } else {
            XB_SPIN(xb_ld(&bar[XB_XGEN(b.x)]) == gen, bar);
            __builtin_amdgcn_fence(__ATOMIC_ACQUIRE, "agent");
            asm volatile("s_waitcnt vmcnt(0)" ::: "memory");
        }
    }
    __syncthreads();
}

enum { I_XP = 0, I_XS, I_CP, I_CS, I_CKC, I_CKS, I_SKW, I_SWKV, I_SSH, I_PT, I_WADA, I_BADA, I_LNG, I_LNB, I_WG, I_WU, I_WD, I_WIN, I_BIN, I_MU, I_W0, I_W2, I_A0, I_A2, I_G2,
       I_KK, I_KA, I_RK, I_LNW, I_LNBB, I_PE, I_PW1, I_PW2, I_WOA, I_WOB, I_WOO, N_IN };
struct Args { const float* in[N_IN]; float* out; unsigned char* ws; int ph_lo, ph_hi; };
#define WSF(off) ((float*)(a.ws + (off)))
#define WSB(off) ((bf16*)(a.ws + (off)))

DI void tr_item(const float* __restrict__ W, int ldw, int ncols, int k0, int n0, bf16* WT, int ldo, int dr0, LAS float* scr, int lane) {
    float wv[32];
#pragma unroll
    for (int i = 0; i < 32; ++i) { const int kk = 2 * i + (lane >> 5), col = n0 + (lane & 31); wv[i] = col < ncols ? W[(size_t)(k0 + kk) * ldw + col] : 0.f; }
#pragma unroll
    for (int i = 0; i < 32; ++i) { const int kk = 2 * i + (lane >> 5); scr[kk * 33 + (lane & 31)] = wv[i]; }
    LDS_WAIT(); asm volatile("" ::: "memory");
    const int c = lane & 7;
#pragma unroll
    for (int j = 0; j < 4; ++j) { const int n = (lane >> 3) + 8 * j; const LAS float* s = scr + (8 * c) * 33 + n;
        v4u o; o.x = pk2(s[0 * 33], s[1 * 33]); o.y = pk2(s[2 * 33], s[3 * 33]); o.z = pk2(s[4 * 33], s[5 * 33]); o.w = pk2(s[6 * 33], s[7 * 33]);
        *(v4u*)(WT + (size_t)(dr0 + n) * ldo + k0 + 8 * c) = o; }
    LDS_WAIT(); asm volatile("" ::: "memory");
}
DI void mod_gemv_item(const Args& a, LAS unsigned char* lds, int tid, int lane, int wave, int item) {
    LAS float* S = (LAS float*)lds;
    const float* wada = a.in[I_WADA];
    float acc[36];
#pragma unroll
    for (int i = 0; i < 36; ++i) acc[i] = 0.f;
    const int col = item * 64 + lane;
    for (int kh = 0; kh < 2; ++kh) {
        __syncthreads();
        for (int e = tid; e < 36 * 512; e += 512) { const int bbv = e >> 9, kk = e & 511;
            const float c = bbv < 4 ? a.in[I_CP][bbv * D + kh * 512 + kk] : a.in[I_CS][(bbv - 4) * D + kh * 512 + kk];
            S[kk * 36 + bbv] = c / (1.0f + __expf(-c)); }
        __syncthreads();
#pragma unroll
        for (int k8 = 0; k8 < 64; k8 += 16) {
            float wv[16];
#pragma unroll
            for (int e = 0; e < 16; ++e) wv[e] = wada[(size_t)(kh * 512 + wave * 64 + k8 + e) * 9216 + col];
#pragma unroll
            for (int e = 0; e < 16; ++e) { const LAS f32x4* sp = (const LAS f32x4*)(S + (wave * 64 + k8 + e) * 36);
#pragma unroll
                for (int q = 0; q < 9; ++q) { const f32x4 s = sp[q]; acc[4 * q] += s[0] * wv[e]; acc[4 * q + 1] += s[1] * wv[e]; acc[4 * q + 2] += s[2] * wv[e]; acc[4 * q + 3] += s[3] * wv[e]; } }
        }
    }
    __syncthreads();
    LAS float* P = (LAS float*)lds;
#pragma unroll
    for (int i = 0; i < 36; ++i) P[(wave * 36 + i) * 64 + lane] = acc[i];
    __syncthreads();
    float* MOD = WSF(WS_MOD);
    for (int o = tid; o < 36 * 64; o += 512) { const int bbv = o >> 6, l = o & 63; float s = 0.f;
#pragma unroll
        for (int w = 0; w < 8; ++w) s += P[(w * 36 + bbv) * 64 + l];
        const int cc = item * 64 + l; MOD[(size_t)bbv * 9216 + cc] = s + a.in[I_BADA][cc]; }
    __syncthreads();
}
DI void pet_item(const Args& a, LAS unsigned char* lds, int tid, int lane, int wave, int item) {
    const int kv = item >> 1, e = (item & 1) * 64 + lane;
    const float* pe = a.in[I_PE] + kv * 2048; const float* w1 = a.in[I_PW1] + (size_t)kv * 2048 * 128;
    float acc = 0.f;
    for (int k = wave * 256; k < wave * 256 + 256; ++k) acc += pe[k] * w1[(size_t)k * 128 + e];
    LAS float* P = (LAS float*)lds;
    __syncthreads();
    P[wave * 64 + lane] = acc;
    __syncthreads();
    if (tid < 64) { float s = 0.f;
#pragma unroll
        for (int w = 0; w < 8; ++w) s += P[w * 64 + tid];
        WSF(WS_PET)[kv * 128 + (item & 1) * 64 + tid] = s; }
    __syncthreads();
}
DI void ph_prologue(const Args& a, LAS unsigned char* lds, int tid, int lane, int wave, int G, int bx) {
    for (int it = bx; it < 148; it += G) { if (it < 144) mod_gemv_item(a, lds, tid, lane, wave, it); else pet_item(a, lds, tid, lane, wave, it - 144); }
    __syncthreads();
    LAS float* scr = (LAS float*)(lds + wave * 16384);
    const int gw = wave * G + bx, NGW = G * NWAVES;
    constexpr int I_GU = 16 * 88, I_DN = 44 * 32, I_IN = 16 * 168, I_C1 = 16 * 4, I_ZERO = 128, I_LORA = 64, I_W2T = 8;
    constexpr int NITEMS = 2 * I_GU + I_DN + I_IN + 4 * I_C1 + I_ZERO + I_LORA + I_W2T;
    for (int it = gw; it < NITEMS; it += NGW) {
        int r = it;
        if (r < 2 * I_GU) { const int up = r / I_GU; r %= I_GU; const int kb = r / 88, nb = r % 88, n0 = nb * 32;
            tr_item(up ? a.in[I_WU] : a.in[I_WG], FF, FF, kb * 64, n0, WSB(WS_WGU), D, (n0 >> 7) * 256 + up * 128 + (n0 & 127), scr, lane); continue; } r -= 2 * I_GU;
        if (r < I_DN) { const int kb = r / 32, nb = r % 32; tr_item(a.in[I_WD], D, D, kb * 64, nb * 32, WSB(WS_WDN), FF, nb * 32, scr, lane); continue; } r -= I_DN;
        if (r < I_IN) { const int kb = r / 168, nb = r % 168; tr_item(a.in[I_WIN], NIN, NIN, kb * 64, nb * 32, WSB(WS_WIN), D, nb * 32, scr, lane); continue; } r -= I_IN;
        if (r < 4 * I_C1) { const int mat = r / I_C1; r %= I_C1; const int kb = r / 4, nb = r % 4;
            tr_item(a.in[I_PW1] + (size_t)mat * 1024 * 128, 128, 128, kb * 64, nb * 32, WSB(WS_WC1), 1024, mat * 128 + nb * 32, scr, lane); continue; } r -= 4 * I_C1;
        if (r < I_ZERO) { v4u z = {0u, 0u, 0u, 0u}; unsigned char* p = a.ws + WS_KCP + (size_t)r * 4096 + lane * 64;
#pragma unroll
          for (int i = 0; i < 4; ++i) *(v4u*)(p + 16 * i) = z; continue; } r -= I_ZERO;
        if (r >= I_LORA) { const int q = r - I_LORA, kv = q >> 2, kb = (q >> 1) & 1, nb = q & 1;
            tr_item(a.in[I_PW2] + (size_t)kv * 128 * 64, 64, 64, kb * 64, nb * 32, WSB(WS_W2T) + (size_t)kv * 64 * 128, 128, nb * 32, scr, lane); continue; }
        {
            if (r < 16) tr_item(a.in[I_W2], RWW, RWW, 0, r * 32, WSB(WS_LORA), 64, r * 32, scr, lane);
            else if (r < 32) tr_item(a.in[I_A2], RWW, RWW, 0, (r - 16) * 32, WSB(WS_LORA) + 512 * 64, 64, (r - 16) * 32, scr, lane);
            else { const int q = r - 32; tr_item(a.in[I_G2], RWW, RWW, (q >> 4) * 64, (q & 15) * 32, WSB(WS_LORA) + 2 * 512 * 64, 128, (q & 15) * 32, scr, lane); } }
    }
}
DI void prologue_late(const Args& a, LAS unsigned char* lds, int lane, int wave, int worker, int nworkers) {
    LAS float* scr = (LAS float*)(lds + wave * 16384);
    constexpr int I_GU = 16 * 88, I_DN = 44 * 32, I_OAB = 8 * 32, I_O = 16 * 32, I_WCP = 1016;
    constexpr int NITEMS = 2 * I_GU + I_DN + 2 * I_OAB + I_O + I_WCP;
    for (int it = worker; it < NITEMS; it += nworkers) {
        int r = it;
        if (r < 2 * I_GU) { const int up = r / I_GU; r %= I_GU; const int kb = r / 88, nb = r % 88, n0 = nb * 32;
            tr_item((up ? a.in[I_WU] : a.in[I_WG]) + (size_t)D * FF, FF, FF, kb * 64, n0, WSB(WS_WGU) + (size_t)5632 * D, D, (n0 >> 7) * 256 + up * 128 + (n0 & 127), scr, lane); continue; } r -= 2 * I_GU;
        if (r < I_DN) { const int kb = r / 32, nb = r % 32; tr_item(a.in[I_WD] + (size_t)FF * D, D, D, kb * 64, nb * 32, WSB(WS_WDN) + (size_t)D * FF, FF, nb * 32, scr, lane); continue; } r -= I_DN;
        if (r < 2 * I_OAB) { const int w = r / I_OAB; r %= I_OAB; const int kb = r / 32, nb = r % 32;
            tr_item(w ? a.in[I_WOB] : a.in[I_WOA], D, D, kb * 64, nb * 32, WSB(WS_WOAB), 512, w * 1024 + nb * 32, scr, lane); continue; } r -= 2 * I_OAB;
        if (r < I_O) { const int kb = r / 32, nb = r % 32; tr_item(a.in[I_WOO], D, D, kb * 64, nb * 32, WSB(WS_WO), D, nb * 32, scr, lane); continue; } r -= I_O;
        {
            f32x4 cv[16];
#pragma unroll
            for (int i = 0; i < 16; ++i) { const int f = r * 1024 + i * 64 + lane; const int b = f / 32512, i4 = f % 32512; cv[i] = *(const f32x4*)(a.in[I_SKW] + (size_t)b * 131072 + 1024 + (size_t)i4 * 4); }
#pragma unroll
            for (int i = 0; i < 16; ++i) { const int f = r * 1024 + i * 64 + lane; const int b = f / 32512, i4 = f % 32512; *(f32x4*)(a.out + O_KVW_S + (size_t)b * 131072 + (size_t)i4 * 4) = cv[i]; } }
    }
}
DI void ph_u1(const Args& a, int lane, int wave, int G, int bx) {
    const int gw = wave * G + bx, NGW = G * NWAVES; const float* MOD = WSF(WS_MOD); bf16* U = WSB(WS_U);
    for (int row = gw; row < MA; row += NGW) {
        const float* xr = row < MP ? a.in[I_XP] + (size_t)row * D : a.in[I_XS] + (size_t)(row - MP) * D;
        const float* ms = MOD + (size_t)(bb_of_row(row) * 9) * D;
#pragma unroll
        for (int j = 0; j < 4; ++j) { const int col = lane * 4 + 256 * j;
            f32x4 u = {0.f, 0.f, 0.f, 0.f};
            if (row < MR) { const f32x4 x = *(const f32x4*)(xr + col); u = x * (1.0f + *(const f32x4*)(ms + D + col)) + *(const f32x4*)(ms + col); }
            v2u o; o.x = pk2(u[0], u[1]); o.y = pk2(u[2], u[3]); *(v2u*)(U + (size_t)row * D + col) = o; }
    }
}
constexpr int CS_ROW = 144, CS_BUF = 128 * CS_ROW;
DI void ph_compress_sample(const Args& a, LAS unsigned char* lds, int tid, int lane, int wave, int G, int bx) {
    const int wm = wave >> 2, wn = wave & 3, r = lane & 31, hh = lane >> 5;
    const int sg = (lane & 31) >> 4, sd = (lane & 15) * 4;
    for (int u = bx; u < NBS * 16 * 2; u += G) {
        const int kv = u & 1, b = u >> 5, c0 = ((u >> 1) & 15) * 64;
        const bf16* W1 = WSB(WS_WC1) + (size_t)(kv * 256 + wn * 64 + r) * 1024 + 8 * hh;
        const float* src[4];
#pragma unroll
        for (int q = 0; q < 4; ++q) { const int cq = c0 + wave * 8 + 2 * q + (lane >> 5); const int page = ((const int*)a.in[I_PT])[b * 128 + (cq >> 3)];
            src[q] = a.in[I_CKC] + ((size_t)page * 128 + (cq & 7) * 16) * 256 + kv * 128 + (lane & 31) * 4; }
        f32x16 acc[2][2];
#pragma unroll
        for (int m = 0; m < 2; ++m) { acc[m][0] = zero16(); acc[m][1] = zero16(); }
        f32x4 ar[3][4];
#pragma unroll
        for (int p = 0; p < 3; ++p)
#pragma unroll
            for (int q = 0; q < 4; ++q) ar[p][q] = *(const f32x4*)(src[q] + (size_t)p * 256);
        __syncthreads();
#pragma unroll 3
        for (int j = 0; j < 16; ++j) {
            LAS unsigned char* buf = lds + (j & 1) * CS_BUF;
            { const int p = j % 3;
#pragma unroll
              for (int q = 0; q < 4; ++q) { const int cl = wave * 8 + 2 * q + (lane >> 5); v2u o; o.x = pk2(ar[p][q][0], ar[p][q][1]); o.y = pk2(ar[p][q][2], ar[p][q][3]);
                  *(LAS v2u*)(buf + (cl * 2 + sg) * CS_ROW + sd * 2) = o; } }
            bf16x8 bfr[2][4];
#pragma unroll
            for (int n = 0; n < 2; ++n)
#pragma unroll
                for (int s = 0; s < 4; ++s) bfr[n][s] = *(const bf16x8*)(W1 + (size_t)n * 32 * 1024 + j * 64 + 16 * s);
            asm volatile("" ::: "memory");
            if (j + 3 < 16) { const int p = j % 3;
#pragma unroll
                for (int q = 0; q < 4; ++q) ar[p][q] = *(const f32x4*)(src[q] + (size_t)(j + 3) * 256); }
            __syncthreads();
            const LAS unsigned char* ab = buf + (wm * 64 + r) * CS_ROW + 16 * hh;
#pragma unroll
            for (int s = 0; s < 4; ++s) {
#pragma unroll
                for (int m = 0; m < 2; ++m) { const bf16x8 af = *(const LAS bf16x8*)(ab + m * 32 * CS_ROW + 32 * s);
                    acc[m][0] = MFMA32(af, bfr[0][s], acc[m][0]); acc[m][1] = MFMA32(af, bfr[1][s], acc[m][1]); }
                __builtin_amdgcn_sched_barrier(0); }
        }
        float* hc = WSF(WS_HC) + ((size_t)kv * CROWS + (size_t)(b * NCH_S + c0) * 2 + wm * 64) * 256 + wn * 64 + r;
#pragma unroll
        for (int m = 0; m < 2; ++m) {
#pragma unroll
            for (int i = 0; i < 16; ++i) { float* hp = hc + (size_t)(32 * m + crow(i, hh)) * 256; hp[0] = acc[m][0][i]; hp[32] = acc[m][1][i]; }
            asm volatile("" ::: "memory"); }
    }
}
template <int WHICH> DI void ph_ln(const Args& a, int lane, int wave, int G, int bx) {
    const int gw = wave * G + bx, NGW = G * NWAVES; const float* MOD = WSF(WS_MOD); const float* Z = WSF(WS_Z); bf16* U = WSB(WS_U);
    float* XN = WHICH == 0 ? WSF(WS_X1) : (WHICH == 1 ? WSF(WS_X2) : a.out);
    const float* lg = a.in[I_LNG] + WHICH * D; const float* lb = a.in[I_LNB] + WHICH * D;
    constexpr int NKS = WHICH == 1 ? 4 : 11; constexpr int RSLOT = WHICH == 0 ? 2 : (WHICH == 1 ? 5 : 8); constexpr float COEF = WHICH == 1 ? 1.0f : 0.5f;
    const float* xres = WHICH == 0 ? a.in[I_XS] : (WHICH == 1 ? WSF(WS_X1) + (size_t)MP * D : WSF(WS_X2) + (size_t)MP * D);
    for (int row = gw; row < MR; row += NGW) {
        f32x4 v[4]; float s = 0.f;
        if (row < MP) {
#pragma unroll
            for (int j = 0; j < 4; ++j) v[j] = *(const f32x4*)(Z + (size_t)row * D + lane * 4 + 256 * j);
        } else {
            const float* mr = MOD + (size_t)(bb_of_row(row) * 9 + RSLOT) * D;
#pragma unroll
            for (int j = 0; j < 4; ++j) { const int col = lane * 4 + 256 * j; f32x4 acc = {0.f, 0.f, 0.f, 0.f};
#pragma unroll
                for (int ks = 0; ks < NKS; ++ks) acc = acc + *(const f32x4*)(WSF(WS_ZP) + ((size_t)ks * MS + (row - MP)) * D + col);
                v[j] = ALPHA * *(const f32x4*)(xres + (size_t)(row - MP) * D + col) + COEF * (1.0f + *(const f32x4*)(mr + col)) * acc; }
        }
#pragma unroll
        for (int j = 0; j < 4; ++j) s += (v[j][0] + v[j][1]) + (v[j][2] + v[j][3]);
        const float mean = wave_sum(s) * (1.0f / D); float s2 = 0.f;
#pragma unroll
        for (int j = 0; j < 4; ++j) { v[j] = v[j] - mean; s2 += (v[j][0] * v[j][0] + v[j][1] * v[j][1]) + (v[j][2] * v[j][2] + v[j][3] * v[j][3]); }
        const float rstd = 1.0f / sqrtf(wave_sum(s2) * (1.0f / D) + LN_EPS);
        const float* ms = MOD + (size_t)(bb_of_row(row) * 9 + 3 * WHICH + 3) * D;
#pragma unroll
        for (int j = 0; j < 4; ++j) { const int col = lane * 4 + 256 * j;
            const f32x4 x = v[j] * rstd * *(const f32x4*)(lg + col) + *(const f32x4*)(lb + col);
            *(f32x4*)(XN + (size_t)row * D + col) = x;
            if (WHICH < 2) { const f32x4 u = x * (1.0f + *(const f32x4*)(ms + D + col)) + *(const f32x4*)(ms + col);
                v2u o; o.x = pk2(u[0], u[1]); o.y = pk2(u[2], u[3]); *(v2u*)(U + (size_t)row * D + col) = o; } }
    }
}
#ifndef PROBE_SUB
#define PROBE_SUB 0
#endif

DI float proj_prev(const Args& a, const float* PROJ, int row, int col) {
    if (row < MP) return (row & (T - 1)) ? PROJ[(size_t)(row - 1) * NINP + col] : 0.f;
    const int s = row - MP; return (s & 3) ? PROJ[(size_t)(row - 1) * NINP + col] : a.in[I_SSH][(size_t)(s >> 2) * C_Q + col];
}
DI void ph_dist_rwprep(const Args& a, LAS unsigned char* lds, int tid, int lane, int wave, int G, int bx) {
    const float* PROJ = WSF(WS_PROJ);
    LAS float* vt = (LAS float*)lds;
    LAS bf16* LA = (LAS bf16*)(lds + 36864);
    for (int it = bx; it < MP / 32 + MS / 8; it += G) {
        const int r0 = it < MP / 32 ? it * 32 : MP + (it - MP / 32) * 8, nrows = it < MP / 32 ? 32 : 8, nq = it < MP / 32 ? 4 : 1;
        __syncthreads();
        {
            const int rr = tid >> 4, seg = tid & 15, row = r0 + rr;
            const float* pr = PROJ + (size_t)row * NINP + C_KV;
            if (rr >= nrows) {}
            else if (row < MP) {
                const int b = row >> 12, t = row & (T - 1);
#pragma unroll
                for (int i = 0; i < 12; ++i) { const int col = 4 * (seg + 16 * i), br = col >> 8, within = col & 255, kv = within >> 7, g = (within >> 6) & 1, d = within & 63;
                    const f32x4 v = *(const f32x4*)(pr + col); v2u pk; pk.x = pk2(v[0], v[1]); pk.y = pk2(v[2], v[3]);
                    if (br == 0) { *(f32x4*)(a.out + O_KVC_P + (size_t)row * 256 + within) = v;
                        *(v2u*)(WSB(WS_ACMP) + ((size_t)kv * CROWS + CROWS_S + (size_t)(b * NCH_P + (t >> 4)) * 2 + g) * 1024 + (t & 15) * 64 + d) = pk; }
                    else { if (br == 1) *(f32x4*)(a.out + O_KVS_P + (size_t)row * 256 + within) = v;
                           else if (t >= T - 512) *(f32x4*)(a.out + O_KVW_P + ((size_t)b * 512 + (t - (T - 512))) * 256 + within) = v;
                           if (kv == 0) *(v2u*)(WSB(br == 1 ? WS_KSEL : WS_KWIN) + ((size_t)(b * 2 + g) * T + t) * 64 + d) = pk;
                           else { LAS float* q = vt + ((br - 1) * 32 + rr) * 132 + g * 64 + d; q[0] = v[0]; q[1] = v[1]; q[2] = v[2]; q[3] = v[3]; } }
                }
                if (t == T - 1) { const float* ps = PROJ + (size_t)row * NINP;
#pragma unroll 4
                    for (int i = 0; i < 28; ++i) *(f32x4*)(a.out + O_SH_P + (size_t)b * C_Q + 4 * (seg + 16 * i)) = *(const f32x4*)(ps + 4 * (seg + 16 * i)); }
            } else {
                const int s = row - MP, b = s >> 2, tq = s & 3;
#pragma unroll
                for (int i = 0; i < 12; ++i) { const int col = 4 * (seg + 16 * i), br = col >> 8, within = col & 255;
                    const f32x4 v = *(const f32x4*)(pr + col);
                    if (br == 0) *(f32x4*)(a.out + O_KVC_S + (size_t)s * 256 + within) = v;
                    else if (br == 1) *(f32x4*)(a.out + O_KVS_S + (size_t)s * 256 + within) = v;
                    else *(f32x4*)(a.out + O_KVW_S + ((size_t)b * 512 + 508 + tq) * 256 + within) = v; }
                if (tq == 3) { const float* ps = PROJ + (size_t)row * NINP;
#pragma unroll 4
                    for (int i = 0; i < 28; ++i) *(f32x4*)(a.out + O_SH_S + (size_t)b * C_Q + 4 * (seg + 16 * i)) = *(const f32x4*)(ps + 4 * (seg + 16 * i)); }
            }
        }
#pragma unroll 4
        for (int i = 0; i < 16; ++i) { const int e = tid + 512 * i, tt = e >> 8, k = e & 255, row = r0 + tt, col = 1536 + k;
            const float p = PROJ[(size_t)row * NINP + col], pp = proj_prev(a, PROJ, row, col); const float xs = p + (pp - p) * a.in[I_MU][col];
            LA[tt * 264 + k] = (bf16)f2bf(k < 64 ? ftanh(xs) : (k < 128 ? xs : fsig(xs))); }
        __syncthreads();
        if (r0 < MP) {
            const int gd = tid >> 2, tc = tid & 3, g = gd >> 6, d = gd & 63, b = r0 >> 12, t0 = r0 & (T - 1);
#pragma unroll
            for (int br = 0; br < 2; ++br) { const LAS float* q = vt + (br * 32 + tc * 8) * 132 + gd;
                v4u o; o.x = pk2(q[0], q[132]); o.y = pk2(q[2 * 132], q[3 * 132]); o.z = pk2(q[4 * 132], q[5 * 132]); o.w = pk2(q[6 * 132], q[7 * 132]);
                *(v4u*)(WSB(br == 0 ? WS_VTSEL : WS_VTWIN) + ((size_t)(b * 2 + g) * 64 + d) * T + t0 + tc * 8) = o; }
        }
        for (int prep = 0; prep < ((PROBE_SUB & 64) ? 2 : 1); ++prep) {
            int lane_l = lane; asm volatile("" : "+v"(lane_l));
            const int hh = lane_l >> 5, cl = lane_l & 31;
            f32x16 aw[2], aa[2], ag[2];
#pragma unroll
            for (int cb = 0; cb < 2; ++cb) { aw[cb] = zero16(); aa[cb] = zero16(); ag[cb] = zero16(); }
            const bf16* W2T = WSB(WS_LORA); const bf16* A2T = W2T + 512 * 64; const bf16* G2T = A2T + 512 * 64;
#define LORA_STEP(acc_, WT_, KW_, s_, koff_) { const bf16x8 af = *(const LAS bf16x8*)(LA + cl * 264 + (koff_) + 16 * (s_) + 8 * hh); \
                _Pragma("unroll") for (int cb = 0; cb < 2; ++cb) { const bf16x8 bf_ = *(const bf16x8*)((WT_) + (wave * 64 + cb * 32 + cl) * (KW_) + 16 * (s_) + 8 * hh); acc_[cb] = MFMA32(af, bf_, acc_[cb]); } \
                asm volatile("" ::: "memory"); }
#pragma unroll
            for (int s2 = 0; s2 < 4; ++s2) LORA_STEP(aw, W2T, 64, s2, 0)
#pragma unroll
            for (int s2 = 0; s2 < 4; ++s2) LORA_STEP(aa, A2T, 64, s2, 64)
#pragma unroll
            for (int s2 = 0; s2 < 8; ++s2) LORA_STEP(ag, G2T, 128, s2, 128)
#undef LORA_STEP
            float* RW = WSF(WS_RW);
#pragma unroll
            for (int half = 0; half < 4; ++half) { if (half >= nq) break;
                float mu_r[2], mu_k[2], mu_v[2], w0[2], a0[2], kkc[2], kac[2], rkc[2];
#pragma unroll
                for (int cb = 0; cb < 2; ++cb) { const int c = wave * 64 + cb * 32 + cl;
                mu_r[cb] = a.in[I_MU][c]; mu_k[cb] = a.in[I_MU][512 + c]; mu_v[cb] = a.in[I_MU][1024 + c];
                w0[cb] = a.in[I_W0][c]; a0[cb] = a.in[I_A0][c]; kkc[cb] = a.in[I_KK][c]; kac[cb] = a.in[I_KA][c]; rkc[cb] = a.in[I_RK][c]; }
                float tk[2][4], ta[2][4], tp[2][4], tv[2][4];
                float ld[4][2][6];
#pragma unroll
                for (int i8 = 0; i8 < 4; ++i8) { const int i = half * 4 + i8, row = r0 + crow(i, hh); const float* pr = PROJ + (size_t)row * NINP;
#pragma unroll
                    for (int cb = 0; cb < 2; ++cb) { const int c = wave * 64 + cb * 32 + cl;
                        ld[i8][cb][0] = pr[c]; ld[i8][cb][1] = pr[512 + c]; ld[i8][cb][2] = pr[1024 + c];
                        ld[i8][cb][3] = proj_prev(a, PROJ, row, c); ld[i8][cb][4] = proj_prev(a, PROJ, row, 512 + c); ld[i8][cb][5] = proj_prev(a, PROJ, row, 1024 + c); } }
                asm volatile("" ::: "memory");
#pragma unroll
                for (int i8 = 0; i8 < 4; ++i8) { const int i = half * 4 + i8, row = r0 + crow(i, hh);
#pragma unroll
                    for (int cb = 0; cb < 2; ++cb) { const int c = wave * 64 + cb * 32 + cl;
                        const float pr_ = ld[i8][cb][0], pk_ = ld[i8][cb][1], pv_ = ld[i8][cb][2];
                        const float r = pr_ + (ld[i8][cb][3] - pr_) * mu_r[cb], k = pk_ + (ld[i8][cb][4] - pk_) * mu_k[cb], v = pv_ + (ld[i8][cb][5] - pv_) * mu_v[cb];
                        const float z = -(w0[cb] + aw[cb][i]);
                        const float sp = fmaxf(z, 0.f) + __logf(1.0f + __expf(-fabsf(z)));
                        const float decay = __expf(-__expf(-sp - 0.5f));
                        const float av = fsig(a0[cb] + aa[cb][i]);
                        const float kk = k * kkc[cb], k2 = k * (1.0f + (av - 1.0f) * kac[cb]);
                        const size_t o = (size_t)row * RWW + c;
                        RW[o] = r; RW[RW_STRIDE + o] = decay; RW[2 * RW_STRIDE + o] = k2; RW[3 * RW_STRIDE + o] = v; WSF(WS_G)[o] = ag[cb][i];
                        tk[cb][i8] = kk; ta[cb][i8] = av; tp[cb][i8] = r * k2 * rkc[cb]; tv[cb][i8] = v; } }
#pragma unroll
                for (int i8 = 0; i8 < 4; ++i8) { const int i = half * 4 + i8, row = r0 + crow(i, hh);
                    float ss = tk[0][i8] * tk[0][i8] + tk[1][i8] * tk[1][i8], rk = tp[0][i8] + tp[1][i8];
                    ss = row16_sum(ss); rk = row16_sum(rk); ss += __shfl_xor(ss, 16); rk += __shfl_xor(rk, 16);
                    const float rn = __builtin_amdgcn_rsqf(fmaxf(ss, 1e-24f));
#pragma unroll
                    for (int cb = 0; cb < 2; ++cb) { const int c = wave * 64 + cb * 32 + cl; const size_t o = (size_t)row * RWW + c;
                        const float kkn = tk[cb][i8] * rn; RW[4 * RW_STRIDE + o] = kkn; RW[5 * RW_STRIDE + o] = kkn * ta[cb][i8]; WSF(WS_BON)[o] = rk * tv[cb][i8]; }
                }
            }
        }
    }
}

struct StepD { f32x4 r, w, k, kk, b; float v; };
DI void scan_run(const float* RW, float* Y, int rowbase, int nsteps, int h, int i, int lane, const float* s_in, float* s_out) {
    const int j0 = (lane & 15) * 4; const size_t cofs = (size_t)h * 64 + j0, vofs = (size_t)h * 64 + i;
    f32x4 S = s_in ? *(const f32x4*)(s_in + i * 64 + j0) : (f32x4){0.f, 0.f, 0.f, 0.f};
#define SC_LD(sd, t) { const size_t o_ = (size_t)(rowbase + (t)) * RWW; sd.r = *(const f32x4*)(RW + o_ + cofs); sd.w = *(const f32x4*)(RW + RW_STRIDE + o_ + cofs); sd.k = *(const f32x4*)(RW + 2 * RW_STRIDE + o_ + cofs); \
        sd.v = RW[3 * RW_STRIDE + o_ + vofs]; sd.kk = *(const f32x4*)(RW + 4 * RW_STRIDE + o_ + cofs); sd.b = *(const f32x4*)(RW + 5 * RW_STRIDE + o_ + cofs); }
#define SC_DO(sd, t) { float d_ = (S[0] * sd.kk[0] + S[1] * sd.kk[1]) + (S[2] * sd.kk[2] + S[3] * sd.kk[3]); d_ = row16_sum(d_); const float sa_ = -d_; \
        S = S * sd.w + (sa_ * sd.b + sd.v * sd.k); float y_ = (S[0] * sd.r[0] + S[1] * sd.r[1]) + (S[2] * sd.r[2] + S[3] * sd.r[3]); y_ = row16_sum(y_); \
        if ((lane & 15) == 0) Y[(size_t)(rowbase + (t)) * RWW + vofs] = y_; }
    StepD c0, c1, c2, c3, n0, n1, n2, n3;
    SC_LD(c0, 0) SC_LD(c1, 1) SC_LD(c2, 2) SC_LD(c3, 3)
    for (int t = 0; t < nsteps; t += 4) {
        const int tn = (t + 4 < nsteps) ? t + 4 : t;
        SC_LD(n0, tn) SC_LD(n1, tn + 1) SC_LD(n2, tn + 2) SC_LD(n3, tn + 3)
        SC_DO(c0, t) SC_DO(c1, t + 1) SC_DO(c2, t + 2) SC_DO(c3, t + 3)
        c0 = n0; c1 = n1; c2 = n2; c3 = n3;
    }
#undef SC_LD
#undef SC_DO
    *(f32x4*)(s_out + i * 64 + j0) = S;
}
constexpr int CF_NIT = (NBS * NCMP_S + NBP * NCMP_P) * 2;
#define CFINAL_ITEM(kv_, j_) { const float* HC_ = WSF(WS_HC) + (size_t)(kv_) * CROWS * 256; \
    const int g_ = (j_) & 1; int q_ = (j_) >> 1; int b_, n_, rowlo_; const bool smp_ = q_ < NBS * NCMP_S; \
    if (smp_) { b_ = q_ / NCMP_S; n_ = q_ % NCMP_S; rowlo_ = (b_ * NCH_S + n_) * 2 + g_; } else { q_ -= NBS * NCMP_S; b_ = q_ / NCMP_P; n_ = q_ % NCMP_P; rowlo_ = CROWS_S + (b_ * NCH_P + n_) * 2 + g_; } \
    float s0_, s1_; \
    if (smp_) { const float* lo_ = HC_ + (size_t)rowlo_ * 256; const float* hi_ = lo_ + 2 * 256 + 128; s0_ = lo_[lane] + hi_[lane]; s1_ = lo_[64 + lane] + hi_[64 + lane]; } \
    else { s0_ = 0.f; s1_ = 0.f; _Pragma("unroll") for (int ks_ = 0; ks_ < 4; ++ks_) { const float* lo_ = WSF(WS_HCP) + ((size_t)(ks_ * 2 + (kv_)) * 2048 + (rowlo_ - CROWS_S)) * 256; const float* hi_ = lo_ + 2 * 256 + 128; \
        s0_ += lo_[lane] + hi_[lane]; s1_ += lo_[64 + lane] + hi_[64 + lane]; } } \
    const float h0_ = gelu_tanh(s0_ + pe0), h1_ = gelu_tanh(s1_ + pe1); \
    float acc_ = 0.f; \
    _Pragma("unroll") for (int e = 0; e < 64; ++e) acc_ += __builtin_bit_cast(float, __builtin_amdgcn_readlane(__builtin_bit_cast(int, h0_), e)) * w2c[e]; \
    _Pragma("unroll") for (int e = 0; e < 64; ++e) acc_ += __builtin_bit_cast(float, __builtin_amdgcn_readlane(__builtin_bit_cast(int, h1_), e)) * w2c[64 + e]; \
    if (smp_) WSF(WS_KCS)[(size_t)(kv_) * KCS_STRIDE + ((size_t)(b_ * NCMP_S + n_) * 2 + g_) * 64 + lane] = acc_; \
    else if ((kv_) == 0) WSB(WS_KCP)[((size_t)(b_ * 2 + g_) * 256 + n_) * 64 + lane] = (bf16)f2bf(acc_); \
    else WSB(WS_VCTP)[((size_t)(b_ * 2 + g_) * 64 + lane) * 256 + n_] = (bf16)f2bf(acc_); }
constexpr int SCH = 32, SCHF = SCH * 384;
DI void ph_scan_prompt(const Args& a, LAS unsigned char* lds, int tid, int lane, int wave, int G, int bx) {
    const float* RW = WSF(WS_RW); float* Y = WSF(WS_YS);
    LAS float* buf = (LAS float*)lds;
    constexpr int NCH = T / SCH;
    if (wave >= 2) {
      const bool sidew = (wave & 2) != 0; const int sidx = (wave & 1) + ((wave >> 2) << 1); const int lid = sidx * G + bx, nl = 4 * G, ckv = lid & 1;
      if (sidew) for (int si = lid; si < 4096; si += nl) { const int bh2 = si >> 4, rg2 = si & 15, b2 = bh2 >> 3, h2 = bh2 & 7, i2 = rg2 * 4 + (lane >> 4);
          scan_run(RW, Y, MP + b2 * 4, 4, h2, i2, lane, a.in[I_SWKV] + (size_t)bh2 * 4096, a.out + O_WKV_S + (size_t)bh2 * 4096); }
      asm volatile("" ::: "memory");
      float w2c[128];
#pragma unroll
      for (int e = 0; e < 128; ++e) w2c[e] = a.in[I_PW2][(size_t)(ckv * 128 + e) * 64 + lane];
      const float pe0 = WSF(WS_PET)[ckv * 128 + lane], pe1 = WSF(WS_PET)[ckv * 128 + 64 + lane];
      for (int it = bx; it < 256; it += G) {
        const int bh = it >> 3, b = bh >> 3, h = bh & 7, rowbase = b * T, sidebase = ((it - bx) / G) * NCH;
        __syncthreads();
        {
#define DMA_CHUNK(c) { _Pragma("unroll") for (int q = 0; q < 8; ++q) { const int R0 = ((wave - 2) * 8 + q) * 4, R = R0 + (lane >> 4), t_ = R / 6, aa = R - 6 * t_; \
                __builtin_amdgcn_global_load_lds((const unsigned*)(RW + (size_t)aa * RW_STRIDE + (size_t)(rowbase + (c) * SCH + t_) * RWW + h * 64 + (lane & 15) * 4), \
                    (LAS unsigned*)(buf + ((c) & 1) * SCHF + R0 * 64), 16, 0, 0); } }
            DMA_CHUNK(0)
            asm volatile("s_waitcnt vmcnt(0)" ::: "memory");
            __syncthreads();
            for (int c = 0; c < NCH; ++c) {
                if (c + 1 < NCH) DMA_CHUNK(c + 1)
                if (sidew) { const int j = (sidebase + c) * (nl >> 1) + (lid >> 1); if (j < CF_NIT) CFINAL_ITEM(ckv, j)
                             const int j2 = (NCH + sidebase + c) * (nl >> 1) + (lid >> 1); if (j2 < CF_NIT) CFINAL_ITEM(ckv, j2) }
                asm volatile("s_waitcnt vmcnt(0)" ::: "memory");
                __syncthreads();
            }
#undef DMA_CHUNK
        }
      }
    } else {
      for (int it = bx; it < 256; it += G) {
        const int bh = it >> 3, b = bh >> 3, h = bh & 7, rowbase = b * T;
        __syncthreads();
        {
            const int rg = (it & 7) * 2 + wave, i = rg * 4 + (lane >> 4), j0 = (lane & 15) * 4, k16 = lane & 15; const size_t vofs = (size_t)h * 64 + i;
            typedef float f2 __attribute__((ext_vector_type(2)));
#define RED2(x_, y_) x_ += dpp_f<0x128>(x_); y_ += dpp_f<0x128>(y_); x_ += dpp_f<0x124>(x_); y_ += dpp_f<0x124>(y_); x_ += dpp_f<0x122>(x_); y_ += dpp_f<0x122>(y_); x_ += dpp_f<0x121>(x_); y_ += dpp_f<0x121>(y_);
            f2 Sa = {0.f, 0.f}, Sb = {0.f, 0.f}, ra = {0.f, 0.f}, rb = {0.f, 0.f}; float ysel = 0.f;
            __syncthreads();
            for (int c = 0; c < NCH; ++c) {
                const LAS float* cb = buf + (c & 1) * SCHF; const int tb = c * SCH;
                StepD q0, q1, q2;
#define L_LD(sd, t) { const LAS float* p_ = cb + (t) * 384; sd.r = *(const LAS f32x4*)(p_ + j0); sd.w = *(const LAS f32x4*)(p_ + 64 + j0); sd.k = *(const LAS f32x4*)(p_ + 128 + j0); sd.v = p_[192 + i]; \
                sd.kk = *(const LAS f32x4*)(p_ + 256 + j0); sd.b = *(const LAS f32x4*)(p_ + 320 + j0); }
                L_LD(q0, 0) L_LD(q1, 1)
#pragma unroll
                for (int t = 0; t < SCH; ++t) {
                    if (t + 2 < SCH) L_LD(q2, t + 2)
                    __builtin_amdgcn_sched_barrier(0);
                    f2 td = Sa * (f2){q0.kk[0], q0.kk[1]}; td = Sb * (f2){q0.kk[2], q0.kk[3]} + td;
                    f2 ty = Sa * ra; ty = Sb * rb + ty;
                    float pd = td[0] + td[1], py = ty[0] + ty[1];
                    const f2 vv = {q0.v, q0.v};
                    f2 ua = Sa * (f2){q0.w[0], q0.w[1]}; f2 ub = Sb * (f2){q0.w[2], q0.w[3]};
                    pd += dpp_f<0x128>(pd); py += dpp_f<0x128>(py); ua = vv * (f2){q0.k[0], q0.k[1]} + ua;
                    pd += dpp_f<0x124>(pd); py += dpp_f<0x124>(py); ub = vv * (f2){q0.k[2], q0.k[3]} + ub;
                    pd += dpp_f<0x122>(pd); py += dpp_f<0x122>(py);
                    pd += dpp_f<0x121>(pd); py += dpp_f<0x121>(py);
                    ysel = (k16 == ((t + 15) & 15)) ? py : ysel;
                    if ((t & 15) == 0 && (t > 0 || c > 0)) Y[(size_t)(rowbase + tb + t - 16 + k16) * RWW + vofs] = ysel;
                    const f2 npd = {-pd, -pd};
                    Sa = npd * (f2){q0.b[0], q0.b[1]} + ua; Sb = npd * (f2){q0.b[2], q0.b[3]} + ub;
                    ra = (f2){q0.r[0], q0.r[1]}; rb = (f2){q0.r[2], q0.r[3]};
                    q0 = q1; q1 = q2;
                    __builtin_amdgcn_sched_barrier(0);
                }
#undef L_LD
                __syncthreads();
            }
            { f2 ty = Sa * ra; ty = Sb * rb + ty; float pd = 0.f, py = ty[0] + ty[1]; RED2(pd, py) ysel = (k16 == 15) ? py : ysel; Y[(size_t)(rowbase + T - 16 + k16) * RWW + vofs] = ysel; }
#undef RED2
            const f32x4 S = {Sa[0], Sa[1], Sb[0], Sb[1]};
            *(f32x4*)(a.out + O_WKV_P + (size_t)bh * 4096 + i * 64 + j0) = S;
        }
      }
    }
}

#ifndef PROBE_SUB
#define PROBE_SUB 0
#endif
DI bf16x8 pack8(const f32x4& x0, const f32x4& x1) { v4u p; p.x = pk2(x0[0], x0[1]); p.y = pk2(x0[2], x0[3]); p.z = pk2(x1[0], x1[1]); p.w = pk2(x1[2], x1[3]); return __builtin_bit_cast(bf16x8, p); }
DI f32x16 qk_tile(const bf16* Kp, const bf16x8 (&qf)[4], int lane) {
    const bf16* kr = Kp + (size_t)(lane & 31) * 64 + 8 * (lane >> 5);
    f32x16 p = zero16();
#pragma unroll
    for (int s = 0; s < 4; ++s) { const bf16x8 kf = *(const bf16x8*)(kr + 16 * s); p = MFMA32(kf, qf[s], p); }
    return p;
}
DI void pack_p(const f32x16& P, bf16x8 (&pf)[2]) {
#pragma unroll
    for (int s = 0; s < 2; ++s) { v4u w; w.x = pk2(P[8 * s], P[8 * s + 1]); w.y = pk2(P[8 * s + 2], P[8 * s + 3]); w.z = pk2(P[8 * s + 4], P[8 * s + 5]); w.w = pk2(P[8 * s + 6], P[8 * s + 7]); pf[s] = __builtin_bit_cast(bf16x8, w); }
}
DI void pv_tile(f32x16 (&o)[2], const bf16* Vt, int ldv, const bf16x8 (&pf)[2], int lane) {
    const int hh = lane >> 5;
#pragma unroll
    for (int s = 0; s < 2; ++s)
#pragma unroll
        for (int db = 0; db < 2; ++db) { const bf16* vr = Vt + (size_t)((lane & 31) + 32 * db) * ldv + 16 * s + 4 * hh;
            const s16x4 lo = *(const s16x4*)vr, hi = *(const s16x4*)(vr + 8);
            const bf16x8 vf = __builtin_shufflevector(lo, hi, 0, 1, 2, 3, 4, 5, 6, 7);
            o[db] = MFMA32(vf, pf[s], o[db]); }
}
DI void osm_step(f32x16& p, unsigned okm, float& m, float& l, f32x16 (&o)[2]) {
    float mx = NEGF;
#pragma unroll
    for (int i = 0; i < 16; ++i) mx = ((okm >> i) & 1u) ? fmaxf(mx, p[i]) : mx;
    mx = fmaxf(mx, __shfl_xor(mx, 32));
    const float mn = fmaxf(m, mx), al = __builtin_amdgcn_exp2f(m - mn);
    l *= al; o[0] = o[0] * al; o[1] = o[1] * al;
#pragma unroll
    for (int i = 0; i < 16; ++i) { const float e = ((okm >> i) & 1u) ? __builtin_amdgcn_exp2f(p[i] - mn) : 0.f; p[i] = e; l += e; }
    m = mn;
}
constexpr int IMP_LD = 65;
constexpr int SMASK_OFF = 2 * 4 * 32 * IMP_LD * 4;
DI void swap32_pair(float& a_, float& b_) { asm volatile("s_nop 1\n\tv_permlane32_swap_b32 %0, %1\n\ts_nop 1" : "+v"(a_), "+v"(b_)); }
DI float swap32_max(float x) { float a_ = x, b_ = x; swap32_pair(a_, b_); return fmaxf(a_, b_); }
DI float swap32_sum(float x) { float a_ = x, b_ = x; swap32_pair(a_, b_); return a_ + b_; }
template <int MODE, int BR> DI void osm64(f32x16& p0, f32x16& p1, bool rowok, int kq, float& m, float& l, f32x16 (&o)[2]) {
    float mx = NEGF;
    if (MODE == 2) {
#pragma unroll
        for (int i = 0; i < 16; ++i) { const int c0 = (i & 3) + 8 * (i >> 2), c1 = c0 + 32; const bool a0 = rowok && c0 <= kq && (BR == 1 || c0 > kq - 512), a1 = rowok && c1 <= kq && (BR == 1 || c1 > kq - 512);
            mx = a0 ? fmaxf(mx, p0[i]) : mx; mx = a1 ? fmaxf(mx, p1[i]) : mx; }
    } else {
#pragma unroll
        for (int i = 0; i < 16; i += 2) mx = fmaxf(mx, fmaxf(fmaxf(p0[i], p0[i + 1]), fmaxf(p1[i], p1[i + 1])));
        if (MODE == 1) mx = rowok ? mx : NEGF;
    }
    mx = swap32_max(mx);
    if (__ballot(mx > m) != 0ull) { const float mn = fmaxf(m, mx), al = __builtin_amdgcn_exp2f(m - mn); l *= al; o[0] = o[0] * al; o[1] = o[1] * al; m = mn; }
    const float sub = (MODE == 1 && !rowok) ? 1e30f : m;
    float ls = 0.f;
#pragma unroll
    for (int i = 0; i < 16; ++i) {
        float e0 = __builtin_amdgcn_exp2f(p0[i] - sub), e1 = __builtin_amdgcn_exp2f(p1[i] - sub);
        if (MODE == 2) { const int c0 = (i & 3) + 8 * (i >> 2), c1 = c0 + 32; e0 = (rowok && c0 <= kq && (BR == 1 || c0 > kq - 512)) ? e0 : 0.f; e1 = (rowok && c1 <= kq && (BR == 1 || c1 > kq - 512)) ? e1 : 0.f; }
        p0[i] = e0; p1[i] = e1; ls += e0 + e1; }
    l += ls;
}
constexpr int CMPK_OFF = 69632, CMPV_OFF = CMPK_OFF + 256 * 144, CVROW = 528;
constexpr int ARING_OFF = 69632, ABUF = 18432, AROW = 144, QPARK_OFF = 106496;
template <int BR> DI void attend_blocks(LAS unsigned char* lds, const bf16* Kg, const bf16* Vtg, unsigned long long blkmask, unsigned long long smask,
                                        const LAS bf16x8* qpark, int q0, int t, int tid, int lane, float& m, float& l, f32x16 (&o)[2]) {
    int tid_l = tid; asm volatile("" : "+v"(tid_l));
    const int hh = lane >> 5, r = lane & 31, srow = tid_l >> 3, sch = tid_l & 7;
    const int nb = __popcll(blkmask);
    if (nb == 0) return;
    unsigned long long rem = blkmask;
    int jb = __ffsll((long long)rem) - 1; rem &= rem - 1;
    v4u kreg = *(const v4u*)(Kg + (size_t)(jb * 64 + srow) * 64 + sch * 8);
    v4u vreg = *(const v4u*)(Vtg + (size_t)srow * T + jb * 64 + sch * 8);
    for (int it = 0; it < nb; ++it) {
        LAS unsigned char* kb = lds + ARING_OFF + (it & 1) * ABUF; LAS unsigned char* vb = kb + 64 * AROW;
        *(LAS v4u*)(kb + srow * AROW + sch * 16) = kreg; *(LAS v4u*)(vb + srow * AROW + sch * 16) = vreg;
        const int jcur = jb;
        __syncthreads();
        if (rem) { jb = __ffsll((long long)rem) - 1; rem &= rem - 1;
            kreg = *(const v4u*)(Kg + (size_t)(jb * 64 + srow) * 64 + sch * 8); vreg = *(const v4u*)(Vtg + (size_t)srow * T + jb * 64 + sch * 8); }
        const int k0 = jcur * 64;
        const bool bit = (BR == 1) ? (((*(const LAS unsigned long long*)(lds + SMASK_OFF + ((int)smask) * 8) >> jcur) & 1ull) != 0ull) : true;
        const unsigned long long bal = (BR == 1) ? __ballot(bit) : ~0ull;
        if (bal == 0ull || k0 > q0 + 31 || (BR == 2 && k0 + 63 <= q0 - 512)) continue;
        f32x16 p0 = zero16(), p1 = zero16();
#pragma unroll
        for (int s = 0; s < 4; ++s) { const bf16x8 kf0 = *(const LAS bf16x8*)(kb + r * AROW + 32 * s + 16 * hh), kf1 = *(const LAS bf16x8*)(kb + (32 + r) * AROW + 32 * s + 16 * hh), qs_ = qpark[s * 64];
            p0 = MFMA32(kf0, qs_, p0); p1 = MFMA32(kf1, qs_, p1); }
        const bool interior = (k0 + 63 <= q0) && (BR == 1 || k0 > q0 + 31 - 512);
        if (interior) { if (BR == 2 || bal == ~0ull) osm64<0, BR>(p0, p1, true, 0, m, l, o); else osm64<1, BR>(p0, p1, bit, 0, m, l, o); }
        else osm64<2, BR>(p0, p1, bit, t - k0 - 4 * hh, m, l, o);
        bf16x8 pf0[2], pf1[2]; pack_p(p0, pf0); pack_p(p1, pf1);
#pragma unroll
        for (int s2 = 0; s2 < 2; ++s2)
#pragma unroll
            for (int db = 0; db < 2; ++db) { const LAS unsigned char* vr = vb + (r + 32 * db) * AROW + 32 * s2 + 8 * hh;
                const s16x4 lo0 = *(const LAS s16x4*)vr, hi0 = *(const LAS s16x4*)(vr + 16), lo1 = *(const LAS s16x4*)(vr + 64), hi1 = *(const LAS s16x4*)(vr + 80);
                o[db] = MFMA32(__builtin_shufflevector(lo0, hi0, 0, 1, 2, 3, 4, 5, 6, 7), pf0[s2], o[db]);
                o[db] = MFMA32(__builtin_shufflevector(lo1, hi1, 0, 1, 2, 3, 4, 5, 6, 7), pf1[s2], o[db]); }
    }
    __syncthreads();
}
constexpr int SATT_OFF = 69632;
DI void attn_prompt_unit(const Args& a, LAS unsigned char* lds, int tid, int lane, int wave, int b, int g, int tile) {
    const float* PROJ = WSF(WS_PROJ);
    const int hl = wave & 3, qh = wave >> 2, head = g * 4 + hl, q0 = tile * 64 + qh * 32, r = lane & 31, hh = lane >> 5, t = q0 + r, bg = b * 2 + g;
    const float* prow = PROJ + (size_t)(b * T + t) * NINP;
    {
        const bf16* Kc = WSB(WS_KCP) + (size_t)bg * 256 * 64; const bf16* Vct = WSB(WS_VCTP) + (size_t)bg * 64 * 256;
        LAS unsigned char* ck = lds + CMPK_OFF; LAS unsigned char* cv = lds + CMPV_OFF;
        { const int tmu = tile * 64 + 63, nvu = tmu >= 31 ? (tmu - 31) / 16 + 1 : 0, ntu = (nvu + 31) >> 5;
#pragma unroll
          for (int q = 0; q < 4; ++q) { int tl_ = tid; asm volatile("" : "+v"(tl_)); const int e = tl_ + 512 * q, krow = e >> 3, kch = e & 7, vrow = e >> 5, vch = e & 31;
              if (krow < ntu * 32) *(LAS v4u*)(ck + krow * AROW + kch * 16) = *(const v4u*)(Kc + (size_t)krow * 64 + kch * 8);
              if (vch < ntu * 4) *(LAS v4u*)(cv + vrow * CVROW + vch * 16) = *(const v4u*)(Vct + (size_t)vrow * 256 + vch * 8); } }
    }
    bf16x8 qf[4];
    { const float qs = 0.125f * LOG2E;
#pragma unroll
      for (int s = 0; s < 4; ++s) { const float* qp = prow + C_Q + head * 64 + 16 * s + 8 * hh; qf[s] = pack8(*(const f32x4*)qp * qs, *(const f32x4*)(qp + 4) * qs); } }
    f32x16 of[2]; of[0] = zero16(); of[1] = zero16();
    LAS float* sImp = (LAS float*)lds; LAS unsigned long long* sMask = (LAS unsigned long long*)(lds + SMASK_OFF);
    {
        const bf16* Kc = WSB(WS_KCP) + (size_t)bg * 256 * 64; const bf16* Vct = WSB(WS_VCTP) + (size_t)bg * 64 * 256;
        LAS unsigned char* ck = lds + CMPK_OFF; LAS unsigned char* cv = lds + CMPV_OFF;
        __syncthreads();
        const int tmax = q0 + 31, nvis = tmax >= 31 ? (tmax - 31) / 16 + 1 : 0, ntile = (nvis + 31) >> 5;
#define CMP_QK(p_, kt_) { p_ = zero16(); _Pragma("unroll") for (int s = 0; s < 4; ++s) { const bf16x8 kf = *(const LAS bf16x8*)(ck + ((kt_) * 32 + r) * AROW + 32 * s + 16 * hh); p_ = MFMA32(kf, qf[s], p_); } }
        float m = NEGF, l = 0.f;
        for (int kt = 0; kt < ntile; ++kt) {
            f32x16 p; CMP_QK(p, kt)
            float mx = NEGF;
#pragma unroll
            for (int i = 0; i < 16; ++i) { const int n = kt * 32 + crow(i, hh); mx = (16 * n + 31 <= t) ? fmaxf(mx, p[i]) : mx; }
            mx = swap32_max(mx);
            const float mn = fmaxf(m, mx); l *= __builtin_amdgcn_exp2f(m - mn);
#pragma unroll
            for (int i = 0; i < 16; ++i) { const int n = kt * 32 + crow(i, hh); l += (16 * n + 31 <= t) ? __builtin_amdgcn_exp2f(p[i] - mn) : 0.f; }
            m = mn;
        }
        l = swap32_sum(l);
        const float inv = l > 0.f ? 1.0f / l : 0.f;
        for (int kt = 0; kt < ntile; ++kt) {
            f32x16 p; CMP_QK(p, kt)
#pragma unroll
            for (int i = 0; i < 16; ++i) { const int n = kt * 32 + crow(i, hh); p[i] = (16 * n + 31 <= t) ? __builtin_amdgcn_exp2f(p[i] - m) * inv : 0.f; }
            bf16x8 pf[2]; pack_p(p, pf);
#pragma unroll
            for (int s2 = 0; s2 < 2; ++s2)
#pragma unroll
                for (int db = 0; db < 2; ++db) { const LAS unsigned char* vr = cv + (r + 32 * db) * CVROW + kt * 64 + 32 * s2 + 8 * hh;
                    const s16x4 lo = *(const LAS s16x4*)vr, hi = *(const LAS s16x4*)(vr + 16);
                    of[db] = MFMA32(__builtin_shufflevector(lo, hi, 0, 1, 2, 3, 4, 5, 6, 7), pf[s2], of[db]); }
        }
        { const float g0 = sigmoidf_(WSF(WS_PROJ)[(size_t)(b * T + t) * NINP + C_GATE + head * 3]); of[0] = of[0] * g0; of[1] = of[1] * g0; }
        LAS float* slab = sImp + (size_t)((qh * 4 + hl) * 32 + r) * IMP_LD;
#pragma unroll
        for (int blk = 0; blk < 2; ++blk) {
            f32x16 im = zero16();
            const int kt0 = blk == 0 ? 0 : 3, kt1 = blk == 0 ? (ntile < 4 ? ntile : 4) : ntile;
            for (int kt = kt0; kt < kt1; ++kt) {
                f32x16 p; CMP_QK(p, kt)
#pragma unroll
                for (int i = 0; i < 16; ++i) { const int n = kt * 32 + crow(i, hh); p[i] = (16 * n + 31 <= t) ? __builtin_amdgcn_exp2f(p[i] - m) * inv : 0.f; }
                bf16x8 pf[2]; pack_p(p, pf);
                const int jb = r + 32 * blk;
#pragma unroll
                for (int s = 0; s < 2; ++s) { bf16x8 af;
#pragma unroll
                    for (int j = 0; j < 8; ++j) { const int n = kt * 32 + 16 * s + 8 * (j >> 2) + 4 * hh + (j & 3); af[j] = (n >= 4 * jb - 1 && n <= 4 * jb + 3) ? (short)0x3F80 : (short)0; }
                    im = MFMA32(af, pf[s], im); }
            }
#pragma unroll
            for (int i = 0; i < 16; ++i) slab[32 * blk + crow(i, hh)] = im[i];
        }
#undef CMP_QK
    }
    __syncthreads();
    for (int e = 0; e < 8; ++e) {
        const int qq = wave * 8 + e, qh2 = qq >> 5, rq = qq & 31, tq = tile * 64 + qq, cur = tq >> 6;
        float s = 0.f;
#pragma unroll
        for (int h2 = 0; h2 < 4; ++h2) s += sImp[(size_t)((qh2 * 4 + h2) * 32 + rq) * IMP_LD + lane];
        const float v = lane > cur ? -1e9f : ((lane == 0 || lane == cur || lane == cur - 1) ? 1e9f : s);
        int rank = 0;
#pragma unroll 16
        for (int j = 0; j < 64; ++j) { const float vj = __builtin_bit_cast(float, __builtin_amdgcn_readlane(__builtin_bit_cast(int, v), j)); rank += (vj > v || (vj == v && j < lane)) ? 1 : 0; }
        const unsigned long long mask = __ballot(rank < 16 && lane <= cur);
        if (lane == 0) sMask[qq] = mask;
    }
    __syncthreads();
    const unsigned long long smask = (unsigned long long)(qh * 32 + r);
    __syncthreads();
    LAS float* park = (LAS float*)lds + wave * 2048 + lane;
    LAS bf16x8* qpark = (LAS bf16x8*)(lds + QPARK_OFF) + wave * 256 + lane;
#pragma unroll
    for (int s = 0; s < 4; ++s) qpark[s * 64] = qf[s];
#pragma unroll
    for (int db = 0; db < 2; ++db)
#pragma unroll
        for (int i = 0; i < 16; ++i) park[(db * 16 + i) * 64] = of[db][i];
    {
        float m = NEGF, l = 0.f; f32x16 o[2]; o[0] = zero16(); o[1] = zero16();
        const unsigned long long blk = (tile >= 63) ? ~0ull : ((1ull << (tile + 1)) - 1ull);
        attend_blocks<1>(lds, WSB(WS_KSEL) + (size_t)bg * T * 64, WSB(WS_VTSEL) + (size_t)bg * 64 * T, blk, smask, qpark, q0, t, tid, lane, m, l, o);
        if (PROBE_SUB & 8) attend_blocks<1>(lds, WSB(WS_KSEL) + (size_t)bg * T * 64, WSB(WS_VTSEL) + (size_t)bg * 64 * T, blk, smask, qpark, q0, t, tid, lane, m, l, o);
        l = swap32_sum(l); const float g1 = sigmoidf_(WSF(WS_PROJ)[(size_t)(b * T + t) * NINP + C_GATE + head * 3 + 1]); const float sc = l > 0.f ? g1 / l : 0.f;
#pragma unroll
        for (int db = 0; db < 2; ++db)
#pragma unroll
            for (int i = 0; i < 16; ++i) park[(db * 16 + i) * 64] += o[db][i] * sc;
    }
    {
        float m = NEGF, l = 0.f; f32x16 o[2]; o[0] = zero16(); o[1] = zero16();
        const unsigned long long hi_ = (tile >= 63) ? ~0ull : ((1ull << (tile + 1)) - 1ull), lo_ = (tile >= 8) ? ((1ull << (tile - 8)) - 1ull) : 0ull;
        attend_blocks<2>(lds, WSB(WS_KWIN) + (size_t)bg * T * 64, WSB(WS_VTWIN) + (size_t)bg * 64 * T, hi_ & ~lo_, 0ull, qpark, q0, t, tid, lane, m, l, o);
        if (PROBE_SUB & 16) attend_blocks<2>(lds, WSB(WS_KWIN) + (size_t)bg * T * 64, WSB(WS_VTWIN) + (size_t)bg * 64 * T, hi_ & ~lo_, 0ull, qpark, q0, t, tid, lane, m, l, o);
        l = swap32_sum(l); const float g2 = sigmoidf_(WSF(WS_PROJ)[(size_t)(b * T + t) * NINP + C_GATE + head * 3 + 2]); const float sc = l > 0.f ? g2 / l : 0.f;
#pragma unroll
        for (int db = 0; db < 2; ++db)
#pragma unroll
            for (int i = 0; i < 16; ++i) of[db][i] = park[(db * 16 + i) * 64] + o[db][i] * sc;
    }
    bf16* yb = WSB(WS_AST) + (size_t)(MA + b * T + t) * RWW + head * 64;
#pragma unroll
    for (int db = 0; db < 2; ++db)
#pragma unroll
        for (int gq = 0; gq < 4; ++gq) { v2u w; w.x = pk2(of[db][4 * gq], of[db][4 * gq + 1]); w.y = pk2(of[db][4 * gq + 2], of[db][4 * gq + 3]); *(v2u*)(yb + 32 * db + 8 * gq + 4 * hh) = w; }
}

constexpr int SA_SC = 0, SA_VP = 16384, SA_QV = 24576, SA_RED = 25600, SA_PACC = 26112, SA_IV = 34304, SA_LST = 35392, SA_CNT = 35456, SA_OUT = 35520;
template <int BR> DI void sa_branch_wg(const Args& a, LAS unsigned char* lds, int tid, int lane, int wave, int b, int g, int qpos, int nk, const float* pnew, float g_h0, float g_h1, float g_h2, float g_h3, float (&inv)[4]) {
    LAS float* sc = (LAS float*)(lds + SA_SC); LAS unsigned long long* vptr = (LAS unsigned long long*)(lds + SA_VP); const LAS float* qv = (const LAS float*)(lds + SA_QV);
    LAS float* red = (LAS float*)(lds + SA_RED); LAS float* pacc = (LAS float*)(lds + SA_PACC); const LAS int* lst = (const LAS int*)(lds + SA_LST); LAS float* outb = (LAS float*)(lds + SA_OUT);
    for (int idx = tid; idx < nk; idx += 512) {
        const float* kr; bool ok = true;
        if (BR == 0) kr = WSF(WS_KCS) + ((size_t)(b * NCMP_S + idx) * 2 + g) * 64;
        else if (BR == 1) { if (idx < 960) { const int blk = lst[idx >> 6]; const int page = ((const int*)a.in[I_PT])[b * 128 + (blk >> 1)]; kr = a.in[I_CKS] + ((size_t)page * 128 + (blk & 1) * 64 + (idx & 63)) * 256 + g * 64; }
                            else { kr = pnew + (size_t)(idx - 960) * NINP + 256 + g * 64; ok = (16384 + idx - 960) <= qpos; } }
        else { if (idx < 512) { kr = a.in[I_SKW] + ((size_t)b * 512 + idx) * 256 + g * 64; ok = (15872 + idx) >= qpos - 511; }
               else { kr = pnew + (size_t)(idx - 512) * NINP + 512 + g * 64; ok = (16384 + idx - 512) <= qpos; } }
        vptr[idx] = (unsigned long long)(BR == 0 ? kr + KCS_STRIDE : kr + 128);
        float s0 = 0.f, s1 = 0.f, s2 = 0.f, s3 = 0.f;
#pragma unroll 8
        for (int d4 = 0; d4 < 16; ++d4) { const f32x4 kv = *(const f32x4*)(kr + 4 * d4);
            const f32x4 q0 = *(const LAS f32x4*)(qv + 4 * d4), q1 = *(const LAS f32x4*)(qv + 64 + 4 * d4), q2 = *(const LAS f32x4*)(qv + 128 + 4 * d4), q3 = *(const LAS f32x4*)(qv + 192 + 4 * d4);
            s0 += (kv[0] * q0[0] + kv[1] * q0[1]) + (kv[2] * q0[2] + kv[3] * q0[3]); s1 += (kv[0] * q1[0] + kv[1] * q1[1]) + (kv[2] * q1[2] + kv[3] * q1[3]);
            s2 += (kv[0] * q2[0] + kv[1] * q2[1]) + (kv[2] * q2[2] + kv[3] * q2[3]); s3 += (kv[0] * q3[0] + kv[1] * q3[1]) + (kv[2] * q3[2] + kv[3] * q3[3]); }
        *(LAS f32x4*)(sc + (size_t)idx * 4) = ok ? (f32x4){s0, s1, s2, s3} : (f32x4){NEGF, NEGF, NEGF, NEGF};
    }
    __syncthreads();
    float mx[4] = {NEGF, NEGF, NEGF, NEGF};
    for (int idx = lane; idx < nk; idx += 64) { const f32x4 v = *(const LAS f32x4*)(sc + (size_t)idx * 4);
#pragma unroll
        for (int h = 0; h < 4; ++h) mx[h] = fmaxf(mx[h], v[h]); }
#pragma unroll
    for (int h = 0; h < 4; ++h) mx[h] = wave_max(mx[h]);
    __syncthreads();
    float sm[4] = {0.f, 0.f, 0.f, 0.f};
    for (int idx = tid; idx < nk; idx += 512) { const f32x4 v = *(const LAS f32x4*)(sc + (size_t)idx * 4); f32x4 e;
#pragma unroll
        for (int h = 0; h < 4; ++h) { e[h] = v[h] > -1e29f ? __expf(v[h] - mx[h]) : 0.f; sm[h] += e[h]; }
        *(LAS f32x4*)(sc + (size_t)idx * 4) = e; }
#pragma unroll
    for (int h = 0; h < 4; ++h) { sm[h] = wave_sum(sm[h]); if (lane == 0) red[wave * 4 + h] = sm[h]; }
    __syncthreads();
#pragma unroll
    for (int h = 0; h < 4; ++h) { float t_ = 0.f;
#pragma unroll
        for (int w = 0; w < 8; ++w) t_ += red[w * 4 + h];
        inv[h] = 1.0f / fmaxf(t_, 1e-30f); }
    const int kpw = (nk + 7) >> 3, kbeg = wave * kpw, kend = (kbeg + kpw < nk) ? kbeg + kpw : nk, ks = lane >> 4, d4 = (lane & 15) * 4;
    f32x4 ac0 = {0.f, 0.f, 0.f, 0.f}, ac1 = ac0, ac2 = ac0, ac3 = ac0;
#pragma unroll 8
    for (int idx = kbeg + ks; idx < kend; idx += 4) { const float* vr = (const float*)vptr[idx]; const f32x4 vv = *(const f32x4*)(vr + d4); const f32x4 pp = *(const LAS f32x4*)(sc + (size_t)idx * 4);
        ac0 = ac0 + pp[0] * vv; ac1 = ac1 + pp[1] * vv; ac2 = ac2 + pp[2] * vv; ac3 = ac3 + pp[3] * vv; }
#pragma unroll
    for (int e = 0; e < 4; ++e) { float a0 = ac0[e], a1 = ac1[e], a2 = ac2[e], a3 = ac3[e];
        a0 += __shfl_xor(a0, 16); a0 += __shfl_xor(a0, 32); a1 += __shfl_xor(a1, 16); a1 += __shfl_xor(a1, 32);
        a2 += __shfl_xor(a2, 16); a2 += __shfl_xor(a2, 32); a3 += __shfl_xor(a3, 16); a3 += __shfl_xor(a3, 32);
        if (lane < 16) { pacc[(wave * 4 + 0) * 64 + d4 + e] = a0; pacc[(wave * 4 + 1) * 64 + d4 + e] = a1; pacc[(wave * 4 + 2) * 64 + d4 + e] = a2; pacc[(wave * 4 + 3) * 64 + d4 + e] = a3; } }
    __syncthreads();
    if (tid < 256) { const int h = tid >> 6; float o = 0.f;
#pragma unroll
        for (int w = 0; w < 8; ++w) o += pacc[(w * 4 + h) * 64 + lane];
        const float gsel = h == 0 ? g_h0 : (h == 1 ? g_h1 : (h == 2 ? g_h2 : g_h3));
        outb[tid] = (BR == 0 ? 0.f : outb[tid]) + gsel * o * inv[h]; }
}
DI void attn_sample_wg(const Args& a, LAS unsigned char* lds, int tid, int lane, int wave, int item) {
    const float* PROJ = WSF(WS_PROJ);
    const int b = item >> 3, g = (item >> 2) & 1, q = item & 3, row = MP + b * 4 + q, qpos = 16384 + q;
    const float* prow = PROJ + (size_t)row * NINP; const float* pnew = PROJ + (size_t)(MP + b * 4) * NINP + C_KV;
    LAS float* sc = (LAS float*)(lds + SA_SC); LAS float* qv = (LAS float*)(lds + SA_QV); LAS float* iv = (LAS float*)(lds + SA_IV); LAS int* lst = (LAS int*)(lds + SA_LST); LAS int* cntw = (LAS int*)(lds + SA_CNT);
    const LAS float* outb = (const LAS float*)(lds + SA_OUT);
    __syncthreads();
    if (tid < 256) qv[tid] = prow[C_Q + g * 256 + tid] * 0.125f;
    float gt[4][3];
#pragma unroll
    for (int h = 0; h < 4; ++h)
#pragma unroll
        for (int br = 0; br < 3; ++br) gt[h][br] = sigmoidf_(prow[C_GATE + (g * 4 + h) * 3 + br]);
    __syncthreads();
    float inv[4];
    sa_branch_wg<0>(a, lds, tid, lane, wave, b, g, qpos, NCMP_S, pnew, gt[0][0], gt[1][0], gt[2][0], gt[3][0], inv);
    float val = 0.f; bool cand = tid <= 256;
    if (cand) { float s = 0.f;
        for (int n = 4 * tid - 1; n <= 4 * tid + 3; ++n) if (n >= 0 && n < NCMP_S) { const f32x4 p = *(const LAS f32x4*)(sc + (size_t)n * 4); s += (p[0] * inv[0] + p[1] * inv[1]) + (p[2] * inv[2] + p[3] * inv[3]); }
        val = (tid == 0 || tid == 255 || tid == 256) ? 1e9f : s; iv[tid] = val; }
    __syncthreads();
    int rank = 0;
    if (cand) for (int y = 0; y <= 256; ++y) { const float vy = iv[y]; rank += (vy > val || (vy == val && y < tid)) ? 1 : 0; }
    const bool sel = cand && rank < 16; const unsigned long long bal = __ballot(sel);
    if (lane == 0) cntw[wave] = __popcll(bal);
    __syncthreads();
    { int pos = __popcll(bal & ((1ull << lane) - 1ull)); for (int w = 0; w < wave; ++w) pos += cntw[w]; if (sel) lst[pos] = tid; }
    __syncthreads();
    sa_branch_wg<1>(a, lds, tid, lane, wave, b, g, qpos, 964, pnew, gt[0][1], gt[1][1], gt[2][1], gt[3][1], inv);
    __syncthreads();
    sa_branch_wg<2>(a, lds, tid, lane, wave, b, g, qpos, 516, pnew, gt[0][2], gt[1][2], gt[2][2], gt[3][2], inv);
    __syncthreads();
    if (tid < 256) WSB(WS_AST)[(size_t)(MA + row) * RWW + g * 256 + tid] = (bf16)f2bf(outb[tid]);
}
DI void rwpost_items(const Args& a, int lane, int wave, int G, int bx) {
    const int gw = wave * G + bx, NGW = G * NWAVES, sub = lane >> 4, c4 = (lane & 15) * 4;
    for (int tk = gw; tk < MR * 2; tk += 2 * NGW) {
        f32x4 y[2], bo[2], gg[2]; size_t o[2]; int cc[2]; bool ok[2];
#pragma unroll
        for (int u = 0; u < 2; ++u) { const int t2 = tk + u * NGW; ok[u] = t2 < MR * 2; const int id = (ok[u] ? t2 : tk) * 4 + sub; cc[u] = (id & 7) * 64 + c4; o[u] = (size_t)(id >> 3) * RWW + cc[u];
            y[u] = *(const f32x4*)(WSF(WS_YS) + o[u]); bo[u] = *(const f32x4*)(WSF(WS_BON) + o[u]); gg[u] = *(const f32x4*)(WSF(WS_G) + o[u]); }
#pragma unroll
        for (int u = 0; u < 2; ++u) { const f32x4 lw = *(const f32x4*)(a.in[I_LNW] + cc[u]), lb = *(const f32x4*)(a.in[I_LNBB] + cc[u]);
            const float mean = row16_sum((y[u][0] + y[u][1]) + (y[u][2] + y[u][3])) * (1.0f / 64.0f); const f32x4 dl = y[u] - mean;
            const float var = row16_sum((dl[0] * dl[0] + dl[1] * dl[1]) + (dl[2] * dl[2] + dl[3] * dl[3])) * (1.0f / 64.0f);
            const f32x4 ov = (dl * __builtin_amdgcn_rsqf(var + GN_EPS) * lw + lb + bo[u]) * gg[u];
            if (ok[u]) { v2u w; w.x = pk2(ov[0], ov[1]); w.y = pk2(ov[2], ov[3]); *(v2u*)(WSB(WS_AST) + o[u]) = w; } }
    }
}
#ifndef PROBE_SUB
#define PROBE_SUB 0
#endif
DI void ph_attention(const Args& a, LAS unsigned char* lds, int tid, int lane, int wave, int G, int bx) {
    for (int rep = 0; rep < ((PROBE_SUB & 1) ? 2 : 1); ++rep)
    for (int i = 0; i < 4; ++i) {
        const int vbx = (G % 8 == 0) ? (bx % 8) * (G / 8) + bx / 8 : bx;
        const int base = (i >> 1) * G, u0 = base + vbx; if (u0 >= 256) break;
        const int u = (i & 1) ? 511 - u0 : u0;
        __syncthreads();
        attn_prompt_unit(a, lds, tid, lane, wave, u >> 7, (u >> 6) & 1, u & 63);
    }
    for (int rep = 0; rep < ((PROBE_SUB & 2) ? 2 : 1); ++rep)
    for (int it = bx; it < 256; it += G) attn_sample_wg(a, lds, tid, lane, wave, it);
    for (int rep = 0; rep < ((PROBE_SUB & 4) ? 2 : 1); ++rep)
    rwpost_items(a, lane, wave, G, bx);
}

DI void cfinal_range(const Args& a, int lane, int worker, int nworkers, int j0, int j1) {
    const int ckv = worker & 1;
    float w2c[128];
#pragma unroll
    for (int e = 0; e < 128; ++e) w2c[e] = a.in[I_PW2][(size_t)(ckv * 128 + e) * 64 + lane];
    const float pe0 = WSF(WS_PET)[ckv * 128 + lane], pe1 = WSF(WS_PET)[ckv * 128 + 64 + lane];
    for (int j = j0 + (worker >> 1); j < j1; j += nworkers >> 1) CFINAL_ITEM(ckv, j)
}
DI void cfinal_sample_mfma(const Args& a, int lane, int worker, int nworkers) {
    const int r = lane & 31, hh = lane >> 5;
    for (int task = worker; task < 2 * NBS * 64; task += nworkers) {
        const int kv = task & 1, b = (task >> 1) >> 6, tt = (task >> 1) & 63;
        const int loc = 32 * tt + r, locc = loc < 2 * NCMP_S ? loc : 2 * NCMP_S - 1;
        const float* lo = WSF(WS_HC) + ((size_t)kv * CROWS + (size_t)b * 2048 + locc) * 256 + 8 * hh; const float* hi = lo + 2 * 256 + 128;
        const float* pe = WSF(WS_PET) + kv * 128 + 8 * hh; const bf16* w2t = WSB(WS_W2T) + (size_t)kv * 64 * 128 + (size_t)r * 128 + 8 * hh;
        f32x16 acc0 = zero16(), acc1 = zero16();
#pragma unroll 2
        for (int s = 0; s < 8; ++s) {
            const f32x4 l0 = *(const f32x4*)(lo + 16 * s), l1 = *(const f32x4*)(lo + 16 * s + 4), h0 = *(const f32x4*)(hi + 16 * s), h1 = *(const f32x4*)(hi + 16 * s + 4);
            const f32x4 p0 = *(const f32x4*)(pe + 16 * s), p1 = *(const f32x4*)(pe + 16 * s + 4);
            const bf16x8 b0 = *(const bf16x8*)(w2t + 16 * s), b1 = *(const bf16x8*)(w2t + 32 * 128 + 16 * s);
            f32x4 x0 = l0 + h0 + p0, x1 = l1 + h1 + p1;
#pragma unroll
            for (int e = 0; e < 4; ++e) { x0[e] = gelu_tanh(x0[e]); x1[e] = gelu_tanh(x1[e]); }
            const bf16x8 af = pack8(x0, x1);
            acc0 = MFMA32(af, b0, acc0); acc1 = MFMA32(af, b1, acc1);
        }
        float* out = WSF(WS_KCS) + (size_t)kv * KCS_STRIDE + ((size_t)b * 2 * NCMP_S + 32 * tt) * 64 + r;
#pragma unroll
        for (int i = 0; i < 16; ++i) { const int it = crow(i, hh); if (32 * tt + it < 2 * NCMP_S) { out[(size_t)it * 64] = acc0[i]; out[(size_t)it * 64 + 32] = acc1[i]; } }
    }
}
constexpr int CF_SAMPLE_ITEMS = NBS * NCMP_S * 2;
DI void ph_cfinal_prompt(const Args& a, int lane, int wave, int G, int bx) { cfinal_range(a, lane, wave * G + bx, NWAVES * G, CF_SAMPLE_ITEMS, CF_NIT); }

constexpr int NSCANWG = 64;
DI void scan8(const Args& a, LAS unsigned char* lds, int lane, int wave, int sw) {
    const float* RW = WSF(WS_RW); float* Y = WSF(WS_YS);
    LAS float* buf = (LAS float*)lds;
    constexpr int NCH = T / SCH;
    const int bh = sw >> 1, b = bh >> 3, h = bh & 7, rowbase = b * T;
    const int rg = (sw & 1) * 8 + wave, i = rg * 4 + (lane >> 4), j0 = (lane & 15) * 4, k16 = lane & 15; const size_t vofs = (size_t)h * 64 + i;
    typedef float f2 __attribute__((ext_vector_type(2)));
#define DMA_CHUNK8(c) { _Pragma("unroll") for (int q = 0; q < 6; ++q) { const int R0 = (wave * 6 + q) * 4, R = R0 + (lane >> 4), t_ = R / 6, aa = R - 6 * t_; \
        __builtin_amdgcn_global_load_lds((const unsigned*)(RW + (size_t)aa * RW_STRIDE + (size_t)(rowbase + (c) * SCH + t_) * RWW + h * 64 + (lane & 15) * 4), \
            (LAS unsigned*)(buf + ((c) & 1) * SCHF + R0 * 64), 16, 0, 0); } }
    f2 Sa = {0.f, 0.f}, Sb = {0.f, 0.f}, ra = {0.f, 0.f}, rb = {0.f, 0.f}; float ysel = 0.f;
    __syncthreads();
    DMA_CHUNK8(0)
    asm volatile("s_waitcnt vmcnt(0)" ::: "memory");
    __syncthreads();
    for (int c = 0; c < NCH; ++c) {
        if (c + 1 < NCH) DMA_CHUNK8(c + 1)
        const LAS float* cb = buf + (c & 1) * SCHF; const int tb = c * SCH;
        StepD q0, q1, q2;
#define L_LD8(sd, t) { const LAS float* p_ = cb + (t) * 384; sd.r = *(const LAS f32x4*)(p_ + j0); sd.w = *(const LAS f32x4*)(p_ + 64 + j0); sd.k = *(const LAS f32x4*)(p_ + 128 + j0); sd.v = p_[192 + i]; \
        sd.kk = *(const LAS f32x4*)(p_ + 256 + j0); sd.b = *(const LAS f32x4*)(p_ + 320 + j0); }
        L_LD8(q0, 0) L_LD8(q1, 1)
#pragma unroll
        for (int t = 0; t < SCH; ++t) {
            if (t + 2 < SCH) L_LD8(q2, t + 2)
            __builtin_amdgcn_sched_barrier(0);
            f2 td = Sa * (f2){q0.kk[0], q0.kk[1]}; td = Sb * (f2){q0.kk[2], q0.kk[3]} + td;
            f2 ty = Sa * ra; ty = Sb * rb + ty;
            float pd = td[0] + td[1], py = ty[0] + ty[1];
            const f2 vv = {q0.v, q0.v};
            f2 ua = Sa * (f2){q0.w[0], q0.w[1]}; f2 ub = Sb * (f2){q0.w[2], q0.w[3]};
            pd += dpp_f<0x128>(pd); py += dpp_f<0x128>(py); ua = vv * (f2){q0.k[0], q0.k[1]} + ua;
            pd += dpp_f<0x124>(pd); py += dpp_f<0x124>(py); ub = vv * (f2){q0.k[2], q0.k[3]} + ub;
            pd += dpp_f<0x122>(pd); py += dpp_f<0x122>(py);
            pd += dpp_f<0x121>(pd); py += dpp_f<0x121>(py);
            ysel = (k16 == ((t + 15) & 15)) ? py : ysel;
            if ((t & 15) == 0 && (t > 0 || c > 0)) Y[(size_t)(rowbase + tb + t - 16 + k16) * RWW + vofs] = ysel;
            const f2 npd = {-pd, -pd};
            Sa = npd * (f2){q0.b[0], q0.b[1]} + ua; Sb = npd * (f2){q0.b[2], q0.b[3]} + ub;
            ra = (f2){q0.r[0], q0.r[1]}; rb = (f2){q0.r[2], q0.r[3]};
            q0 = q1; q1 = q2;
            __builtin_amdgcn_sched_barrier(0);
        }
#undef L_LD8
        asm volatile("s_waitcnt vmcnt(0)" ::: "memory");
        __syncthreads();
    }
#undef DMA_CHUNK8
    { f2 ty = Sa * ra; ty = Sb * rb + ty; float py = ty[0] + ty[1];
      py += dpp_f<0x128>(py); py += dpp_f<0x124>(py); py += dpp_f<0x122>(py); py += dpp_f<0x121>(py);
      ysel = (k16 == 15) ? py : ysel; Y[(size_t)(rowbase + T - 16 + k16) * RWW + vofs] = ysel; }
    const f32x4 S = {Sa[0], Sa[1], Sb[0], Sb[1]};
    *(f32x4*)(a.out + O_WKV_P + (size_t)bh * 4096 + i * 64 + j0) = S;
}
constexpr int CW_CFDONE = 512;
DI void ph_mixers(const Args& a, LAS unsigned char* lds, int tid, int lane, int wave, int G, int bx) {
    if (bx < NSCANWG) { scan8(a, lds, lane, wave, bx); if (PROBE_SUB & 128) scan8(a, lds, lane, wave, bx); return; }
    const int j = bx - NSCANWG, NA = G - NSCANWG;
    unsigned* ctl = (unsigned*)(a.ws + WS_CTL);
    { const float* RW = WSF(WS_RW); float* Y = WSF(WS_YS); const int worker = wave * NA + j, nworkers = NWAVES * NA;
      for (int si = worker; si < 4096; si += nworkers) { const int bh2 = si >> 4, rg2 = si & 15, b2 = bh2 >> 3, h2 = bh2 & 7, i2 = rg2 * 4 + (lane >> 4);
          scan_run(RW, Y, MP + b2 * 4, 4, h2, i2, lane, a.in[I_SWKV] + (size_t)bh2 * 4096, a.out + O_WKV_S + (size_t)bh2 * 4096); }
      asm volatile("" ::: "memory");
      cfinal_sample_mfma(a, lane, worker, nworkers);
      asm volatile("" ::: "memory");
      prologue_late(a, lds, lane, wave, worker, nworkers); }
    asm volatile("s_waitcnt vmcnt(0)" ::: "memory");
    __syncthreads();
    if (tid == 0) { __builtin_amdgcn_fence(__ATOMIC_RELEASE, "agent"); asm volatile("s_waitcnt vmcnt(0)" ::: "memory"); __hip_atomic_fetch_add(ctl + CW_CFDONE, 1u, __ATOMIC_RELAXED, __HIP_MEMORY_SCOPE_AGENT); }
    for (int rnd = 0; ; ++rnd) {
        const int k = rnd * NA + ((rnd & 1) ? NA - 1 - j : j); if (k >= 512) break;
        const int tile = 63 - (k >> 3), bg = k & 7;
        __syncthreads();
        attn_prompt_unit(a, lds, tid, lane, wave, bg >> 1, bg & 1, tile);
    }
    __syncthreads();
    if (tid == 0) { unsigned sp = 0;
        while (__hip_atomic_load(ctl + CW_CFDONE, __ATOMIC_RELAXED, __HIP_MEMORY_SCOPE_AGENT) < (unsigned)NA) { __builtin_amdgcn_s_sleep(2); if (++sp > (1u << 22)) break; }
        __builtin_amdgcn_fence(__ATOMIC_ACQUIRE, "agent"); asm volatile("s_waitcnt vmcnt(0)" ::: "memory"); }
    __syncthreads();
    for (int it = NA - 1 - j; it < 256; it += NA) attn_sample_wg(a, lds, tid, lane, wave, it);
}
DI void ph_rwpost(const Args& a, int lane, int wave, int G, int bx) { rwpost_items(a, lane, wave, G, bx); }

constexpr int N_PHASES = 17;
#ifndef PROBE_MASK
#define PROBE_MASK 0
#endif
#ifndef ONLY_PHASE
#define ONLY_PHASE (-1)
#endif
#ifndef MK_PER_PHASE
#define MK_PER_PHASE 0
#endif
__global__ void __launch_bounds__(NWAVES * 64, 2) fwd_kernel(Args a) {
    extern __shared__ __attribute__((aligned(16))) unsigned char lds_raw[];
    LAS unsigned char* lds = (LAS unsigned char*)lds_raw;
    const int tid = threadIdx.x, lane = tid & 63, wave = __builtin_amdgcn_readfirstlane(tid >> 6), G = gridDim.x, bx = blockIdx.x;
    for (int u = tid; u < (LDS_BYTES - LDSCTL_OFF) / 4; u += NWAVES * 64) ((LAS unsigned*)(lds + LDSCTL_OFF))[u] = 0u;
    __syncthreads();
    volatile LAS unsigned* MISC = (volatile LAS unsigned*)(lds + MISC_OFF);
    unsigned* ctl = (unsigned*)(a.ws + WS_CTL);
    XcdBarrier bar; bar.bar = ctl + CW_BAR; bar.x = 0; bar.st = nullptr;
    if (!MK_PER_PHASE) bar = xcd_barrier_post(ctl + CW_BAR, MISC + 8);
    const int lo = a.ph_lo, hi = a.ph_hi;
#define IN(k) (lo <= (k) && (k) < hi)
#define SEAM(k) do { if (IN(k) && IN((k) + 1)) xcd_barrier(bar); } while (0)
#define RUN(k, ...) do { if (IN(k) && (ONLY_PHASE < 0 || ONLY_PHASE == (k))) { __VA_ARGS__ if ((PROBE_MASK >> (k)) & 1) { xcd_barrier(bar); __VA_ARGS__ } } } while (0)
    LAS unsigned char* ring = lds + RING_OFF;
    RUN(0, ph_prologue(a, lds, tid, lane, wave, G, bx););
    SEAM(0);
    RUN(1, ph_u1(a, lane, wave, G, bx); ph_compress_sample(a, lds, tid, lane, wave, G, bx););
    SEAM(1);
    RUN(2, { pg8::Gemm g{WSB(WS_U), WSB(WS_WGU), MA, 5632, D}; pg8::StaticOrder S; S.init(MA, 5632, G, bx); pg8::EpiSwiglu E{WSB(WS_H)}; pg8::gemm_phase<pg8::EpiSwiglu, pg8::StaticOrder, true, true>(ring, g, S, E); });
    SEAM(2);
    RUN(3, { pg8::Gemm g{WSB(WS_H), WSB(WS_WDN), MA, D, FF}; pg8::PromptPlusSplit S; S.init(D, 11, 4, G, bx); pg8::EpiResid E{a.in[I_XP], a.in[I_XS], WSF(WS_MOD), 2, 0.5f, WSF(WS_Z)}; pg8::gemm_phase<pg8::EpiResid, pg8::PromptPlusSplit, true, true>(ring, g, S, E); });
    SEAM(3);
    RUN(4, ph_ln<0>(a, lane, wave, G, bx););
    SEAM(4);
    RUN(5, { pg8::Gemm g{WSB(WS_U), WSB(WS_WIN), MA, NINP, D}; pg8::StaticOrder S; S.init(MA, NINP, G, bx); pg8::EpiProj E{a.in[I_BIN], WSF(WS_PROJ)}; pg8::gemm_phase<pg8::EpiProj, pg8::StaticOrder, true, true>(ring, g, S, E); });
    SEAM(5);
    RUN(6, ph_dist_rwprep(a, lds, tid, lane, wave, G, bx););
    SEAM(6);
    RUN(7, { pg8::Gemm g{WSB(WS_ACMP), WSB(WS_WC1), 2 * CROWS, 512, 1024}; pg8::PromptCmpOrder S{G, bx}; pg8::EpiF32 E{WSF(WS_HCP), 256, 0}; pg8::gemm_phase<pg8::EpiF32, pg8::PromptCmpOrder, true, true>(ring, g, S, E); });
    SEAM(7);
    RUN(8, ph_cfinal_prompt(a, lane, wave, G, bx););
    SEAM(8);
    RUN(9, ph_mixers(a, lds, tid, lane, wave, G, bx););
    SEAM(9);
    RUN(10, ph_rwpost(a, lane, wave, G, bx););
    SEAM(10);
    RUN(11, { pg8::Gemm g{WSB(WS_AST), WSB(WS_WOAB), 2 * MA, 2048, 512}; pg8::PairOrder S{MA / 256, 4, G, bx}; pg8::EpiOutAB E{WSF(WS_PROJ), WSF(WS_M1), WSB(WS_MIN), MA / 256}; pg8::gemm_phase<pg8::EpiOutAB, pg8::PairOrder, true, true>(ring, g, S, E); });
    SEAM(11);
    RUN(12, { pg8::Gemm g{WSB(WS_MIN), WSB(WS_WO), MA, D, D}; pg8::PromptPlusSplit S; S.init(D, 4, 4, G, bx); pg8::EpiResid E{WSF(WS_X1), WSF(WS_X1) + (size_t)MP * D, WSF(WS_MOD), 5, 1.0f, WSF(WS_Z)}; pg8::gemm_phase<pg8::EpiResid, pg8::PromptPlusSplit, true, true>(ring, g, S, E); });
    SEAM(12);
    RUN(13, ph_ln<1>(a, lane, wave, G, bx););
    SEAM(13);
    RUN(14, { pg8::Gemm g{WSB(WS_U), WSB(WS_WGU) + (size_t)5632 * D, MA, 5632, D}; pg8::StaticOrder S; S.init(MA, 5632, G, bx); pg8::EpiSwiglu E{WSB(WS_H)}; pg8::gemm_phase<pg8::EpiSwiglu, pg8::StaticOrder, true, true>(ring, g, S, E); });
    SEAM(14);
    RUN(15, { pg8::Gemm g{WSB(WS_H), WSB(WS_WDN) + (size_t)D * FF, MA, D, FF}; pg8::PromptPlusSplit S; S.init(D, 11, 4, G, bx); pg8::EpiResid E{WSF(WS_X2), WSF(WS_X2) + (size_t)MP * D, WSF(WS_MOD), 8, 0.5f, WSF(WS_Z)}; pg8::gemm_phase<pg8::EpiResid, pg8::PromptPlusSplit, true, true>(ring, g, S, E); });
    SEAM(15);
    RUN(16, ph_ln<2>(a, lane, wave, G, bx););
#undef IN
#undef SEAM
}

extern "C" void kernel_launch(void* const* d_in, const int* in_sizes, int n_in, void* d_out, int out_size, void* d_ws, size_t ws_size, hipStream_t stream) {
    static int grid = 0;
    if (grid == 0) {
        if (n_in != N_IN || (size_t)out_size != O_END || ws_size < WS_END) { fprintf(stderr, "kernel_launch: unexpected shapes: n_in %d out %d ws %zu (need %zu)\n", n_in, out_size, ws_size, (size_t)WS_END); grid = -1; return; }
        int dev = 0, cus = 0, per_cu = 0;
        if (hipGetDevice(&dev) != hipSuccess || hipDeviceGetAttribute(&cus, hipDeviceAttributeMultiprocessorCount, dev) != hipSuccess) { grid = -1; return; }
        if (hipFuncSetAttribute((const void*)fwd_kernel, hipFuncAttributeMaxDynamicSharedMemorySize, LDS_BYTES) != hipSuccess) { fprintf(stderr, "kernel_launch: hipFuncSetAttribute failed\n"); grid = -1; return; }
        if (hipOccupancyMaxActiveBlocksPerMultiprocessor(&per_cu, (const void*)fwd_kernel, NWAVES * 64, LDS_BYTES) != hipSuccess || per_cu < 1)
            fprintf(stderr, "kernel_launch: note: occupancy query reports %d workgroups per CU\n", per_cu);
        (void)hipGetLastError();
        grid = cus;
    }
    if (grid < 0) return;
    if (hipMemsetAsync((char*)d_ws + WS_CTL, 0, CTL_ZERO_BYTES, stream) != hipSuccess) return;
    Args a{};
    for (int i = 0; i < N_IN; ++i) a.in[i] = (const float*)d_in[i];
    a.out = (float*)d_out; a.ws = (unsigned char*)d_ws;
#if MK_PER_PHASE
    for (int p = 0; p < N_PHASES; ++p) { a.ph_lo = p; a.ph_hi = p + 1; hipLaunchKernelGGL(fwd_kernel, dim3(grid), dim3(NWAVES * 64), LDS_BYTES, stream, a); }
#else
    a.ph_lo = 0; a.ph_hi = N_PHASES;
    hipLaunchKernelGGL(fwd_kernel, dim3(grid), dim3(NWAVES * 64), LDS_BYTES, stream, a);
#endif
    const hipError_t le = hipPeekAtLastError();
    if (le != hipSuccess) fprintf(stderr, "kernel_launch: launch failed: %s\n", hipGetErrorName(le));
}
```

```cpp
#include <hip/hip_runtime.h>
#include <cstdio>
#include <cstdint>
#define DI __device__ __forceinline__
constexpr int D = 1024, FF = 2816, T = 4096, NBP = 4, NBS = 32, ST = 4;
constexpr int MP = NBP * T;
constexpr int MS = NBS * ST;
constexpr int MR = MP + MS;
constexpr int MA = 16640;
constexpr int NIN = 5144, NINP = 5376;
constexpr int C_Q = 1792, C_KV = 2304, C_GATE = 3072, C_MERGE = 3096;
constexpr int RWW = 512;
constexpr int NCH_S = 1024, NCH_P = 256;
constexpr int NCMP_S = 1023, NCMP_P = 255;
constexpr int CROWS_S = NBS * NCH_S * 2;
constexpr int CROWS = CROWS_S + NBP * NCH_P * 2;
constexpr float ALPHA = 1.189207115002721f;
constexpr float LN_EPS = 1e-5f, GN_EPS = 64e-5f;
constexpr float LOG2E = 1.4426950408889634f;
constexpr float NEGF = -1e30f;
constexpr size_t O_Y = 0;
constexpr size_t O_KVC_P = 16908288, O_KVS_P = 21102592, O_KVW_P = 25296896, O_WKV_P = 25821184, O_SH_P = 25952256;
constexpr size_t O_KVC_S = 25959424, O_KVS_S = 25992192, O_KVW_S = 26024960, O_WKV_S = 30219264, O_SH_S = 31267840, O_END = 31325184;
DI int bb_of_row(int row) { return row < MP ? (row >> 12) : (row < MR ? 4 + ((row - MP) >> 2) : 35); }

constexpr size_t al256(size_t x) { return (x + 255) & ~(size_t)255; }
constexpr size_t WS_CTL = 0, CTL_ZERO_BYTES = 1u << 20;
constexpr int CW_BAR = 4096;
constexpr size_t WS_MOD  = CTL_ZERO_BYTES;
constexpr size_t WS_PET  = al256(WS_MOD + (size_t)36 * 9 * D * 4);
constexpr size_t WS_WGU  = al256(WS_PET + 2 * 128 * 4);
constexpr size_t WS_WDN  = al256(WS_WGU + (size_t)2 * 5632 * D * 2);
constexpr size_t WS_WIN  = al256(WS_WDN + (size_t)2 * D * FF * 2);
constexpr size_t WS_WOAB = al256(WS_WIN + (size_t)NINP * D * 2);
constexpr size_t WS_WO   = al256(WS_WOAB + (size_t)2048 * 512 * 2);
constexpr size_t WS_WC1  = al256(WS_WO + (size_t)D * D * 2);
constexpr size_t WS_LORA = al256(WS_WC1 + (size_t)512 * 1024 * 2);
constexpr size_t WS_W2T  = al256(WS_LORA + (size_t)512 * 256 * 2);
constexpr size_t WS_U    = al256(WS_W2T + (size_t)2 * 64 * 128 * 2);
constexpr size_t WS_H    = al256(WS_U + (size_t)MA * D * 2);
constexpr size_t WS_Z    = al256(WS_H + (size_t)MA * FF * 2);
constexpr size_t WS_ZP   = WS_Z + (size_t)MA * D * 4;
constexpr size_t WS_X1   = al256(WS_ZP + (size_t)11 * MS * D * 4);
constexpr size_t WS_X2   = al256(WS_X1 + (size_t)MA * D * 4);
constexpr size_t WS_M1   = al256(WS_X2 + (size_t)MA * D * 4);
constexpr size_t WS_MIN  = al256(WS_M1 + (size_t)MA * D * 4);
constexpr size_t WS_PROJ = al256(WS_MIN + (size_t)MA * D * 2);
constexpr size_t WS_RW   = al256(WS_PROJ + (size_t)MA * NINP * 4);
constexpr size_t RW_STRIDE = (size_t)MA * RWW;
constexpr size_t WS_G    = al256(WS_RW + 6 * RW_STRIDE * 4);
constexpr size_t WS_BON  = al256(WS_G + RW_STRIDE * 4);
constexpr size_t WS_YS   = al256(WS_BON + RW_STRIDE * 4);
constexpr size_t WS_AST  = al256(WS_YS + RW_STRIDE * 4);
constexpr size_t WS_KSEL = al256(WS_AST + (size_t)2 * MA * RWW * 2);
constexpr size_t KV_BYTES = (size_t)NBP * 2 * T * 64 * 2;
constexpr size_t WS_KWIN = WS_KSEL + KV_BYTES, WS_VTSEL = WS_KWIN + KV_BYTES, WS_VTWIN = WS_VTSEL + KV_BYTES;
constexpr size_t WS_KCP  = WS_VTWIN + KV_BYTES;
constexpr size_t WS_VCTP = WS_KCP + (size_t)NBP * 2 * 256 * 64 * 2;
constexpr size_t WS_KCS  = al256(WS_VCTP + (size_t)NBP * 2 * 256 * 64 * 2);
constexpr size_t KCS_STRIDE = (size_t)NBS * NCMP_S * 2 * 64;
constexpr size_t WS_ACMP = al256(WS_KCS + 2 * KCS_STRIDE * 4);
constexpr size_t WS_HC   = al256(WS_ACMP + (size_t)2 * CROWS * 1024 * 2);
constexpr size_t WS_HCP  = al256(WS_HC + (size_t)2 * CROWS * 256 * 4);
constexpr size_t WS_END  = al256(WS_HCP + (size_t)4 * 2 * 2048 * 256 * 4);

constexpr int NWAVES = 8;
constexpr int RING_OFF = 0, RING_BYTES = 131072;
constexpr int LDSCTL_OFF = 147456 - 512, MISC_OFF = LDSCTL_OFF + 320;
constexpr int LDS_BYTES = 147456;

namespace pg8 {
#define PG8_LAS __attribute__((address_space(3)))
typedef unsigned short bf16_t;
typedef short bf16x8 __attribute__((ext_vector_type(8)));
typedef float f32x4 __attribute__((ext_vector_type(4)));
typedef unsigned u32x4 __attribute__((ext_vector_type(4)));
constexpr int BM = 256, BK = 64, HALF = 128, HTB = HALF * BK * 2  , STAGE_BYTES = 8 * HTB, NXCD = 8, WGM = 8;

__host__ __device__ __forceinline__ int lds_byte(int r, int c) { const int st = (r >> 4) * 2 + (c >> 5), rr = r & 15, cc = c & 31, ob = rr * 64 + cc * 2; return st * 1024 + (ob ^ (((ob >> 9) & 1) << 5)); }
__host__ __device__ __forceinline__ void stage_rc(int b, int& R, int& C) { const int st = b / 1024, sb = b % 1024, swz = sb ^ (((sb >> 9) & 1) << 5); R = (st >> 1) * 16 + swz / 64; C = (st & 1) * 32 + (swz % 64) / 2; }
__host__ __device__ __forceinline__ int perm32(int rho) { const int n = rho >> 4, i = rho & 15; return 8 * (i >> 2) + 4 * n + (i & 3); }

struct Unit { int pm, pn, kt0 = 0, nkt = 0; };
struct Gemm { const bf16_t* A; const bf16_t* Bt; int M, N, K; };

struct StaticOrder {
    int nM, nN, nwg, G, c;
    __host__ __device__ void init(int M, int N, int G_, int c_) { nM = M / BM; nN = N / BM; nwg = nM * nN; G = G_; c = c_; }
    __host__ __device__ bool next(int i, Unit& u) const {
        const long L = (long)i * G + c; if (L >= nwg) return false;
        int wgid = (int)L; { const int q = nwg / NXCD, r = nwg % NXCD, xcd = wgid % NXCD, off = wgid / NXCD; wgid = (xcd < r ? xcd * (q + 1) : r * (q + 1) + (xcd - r) * q) + off; }
        const int nig = WGM * nN, gid = wgid / nig, fm = gid * WGM, gsz = (nM - fm) < WGM ? (nM - fm) : WGM;
        u.pm = fm + ((wgid % nig) % gsz); u.pn = (wgid % nig) / gsz; return true;
    }
    __device__ __forceinline__ void a_ready(const Unit&) const {}
    __device__ __forceinline__ void done(const Unit&) const {}
};

struct PairOrder {
    int nm, nn, G, c;
    __device__ __forceinline__ bool next(int i, Unit& u) const {
        const int tile = (i >> 1) * G + c; if (tile >= nm * nn) return false;
        const int rep = i & 1; u.pm = tile / nn + rep * nm; u.pn = tile % nn + rep * nn; return true;
    }
    __device__ __forceinline__ void a_ready(const Unit&) const {}
    __device__ __forceinline__ void done(const Unit&) const {}
};
struct DiagOrder {
    int nm, nn, nrep, G, c;
    __device__ __forceinline__ bool next(int i, Unit& u) const {
        const int L = i * G + c; if (L >= nrep * nm * nn) return false;
        const int rep = L / (nm * nn), rem = L % (nm * nn); u.pm = rem / nn + rep * nm; u.pn = rem % nn + rep * nn; return true;
    }
    __device__ __forceinline__ void a_ready(const Unit&) const {}
    __device__ __forceinline__ void done(const Unit&) const {}
};

struct PromptCmpOrder {
    int G, c;
    __device__ __forceinline__ bool next(int i, Unit& u) const { const int L = i * G + c; if (L >= 64) return false; const int ks = L & 3, q = L >> 2, rep = q >> 3, rem = q & 7;
        u.pm = CROWS_S / BM + rem + rep * (CROWS / BM); u.pn = rep; u.kt0 = ks * 4; u.nkt = 4; return true; }
    __device__ __forceinline__ void a_ready(const Unit&) const {}
    __device__ __forceinline__ void done(const Unit&) const {}
};
struct PromptPlusSplit {
    StaticOrder S0; int nks, nkt, G, c;
    __device__ __forceinline__ void init(int N, int nks_, int nkt_, int G_, int c_) { S0.init(MP, N, G_, c_); nks = nks_; nkt = nkt_; G = G_; c = c_; }
    __device__ __forceinline__ bool next(int i, Unit& u) const {
        if (S0.next(i, u)) { u.kt0 = 0; u.nkt = 0; return true; }
        const int r0 = (S0.nwg + G - 1) / G; const int j = (i - r0) * G + c; if (j < 0 || j >= 4 * nks) return false;
        u.pm = MP / BM; u.pn = j & 3; u.kt0 = (j >> 2) * nkt; u.nkt = nkt; return true;
    }
    __device__ __forceinline__ void a_ready(const Unit&) const {}
    __device__ __forceinline__ void done(const Unit&) const {}
};

typedef float f32x2 __attribute__((ext_vector_type(2)));
typedef __bf16 bf16x2_t __attribute__((ext_vector_type(2)));
__device__ __forceinline__ unsigned cvt_pk_bf16(float lo, float hi) { f32x2 v = {lo, hi}; bf16x2_t b = __builtin_convertvector(v, bf16x2_t); return __builtin_bit_cast(unsigned, b); }
__device__ __forceinline__ float fast_sigmoid(float x) { return __builtin_amdgcn_rcpf(1.0f + __builtin_amdgcn_exp2f(-x * LOG2E)); }

struct EpiSwiglu {
    static constexpr bool PERM = true, AFTER_DRAIN = false;
    bf16_t* H;
    __device__ __forceinline__ void operator()(const f32x4 (&acc)[2][2][4][2], const Unit& u, int wr, int wc, int fr, int fq) const {
        const int row0 = u.pm * BM + wr * 64 + fr, hc0 = u.pn * HALF + wc * 32 + 8 * fq;
#pragma unroll
        for (int ai = 0; ai < 2; ++ai)
#pragma unroll
            for (int m = 0; m < 4; ++m) {
                bf16_t* rowp = H + (size_t)(row0 + ai * HALF + m * 16) * FF + hc0;
                float h[8];
#pragma unroll
                for (int n = 0; n < 2; ++n)
#pragma unroll
                    for (int e = 0; e < 4; ++e) { const float g = acc[ai][0][m][n][e], up = acc[ai][1][m][n][e]; h[4 * n + e] = g * fast_sigmoid(g) * up; }
                u32x4 w; w.x = cvt_pk_bf16(h[0], h[1]); w.y = cvt_pk_bf16(h[2], h[3]); w.z = cvt_pk_bf16(h[4], h[5]); w.w = cvt_pk_bf16(h[6], h[7]);
                *(u32x4*)rowp = w;
            }
    }
};
struct EpiResid {
    static constexpr bool PERM = false, AFTER_DRAIN = false;
    const float* xp; const float* xs; const float* mod; int slot; float coef; float* Z;
    __device__ __forceinline__ void operator()(const f32x4 (&acc)[2][2][4][2], const Unit& u, int wr, int wc, int fr, int fq) const {
        const int row0 = u.pm * BM + wr * 64 + fr, col0 = u.pn * BM + wc * 32 + 4 * fq;
        if (u.nkt) {
            float* zp = Z + (size_t)MA * D + (size_t)(u.kt0 / u.nkt) * MS * D;
#pragma unroll
            for (int m = 0; m < 4; ++m) { const int row = row0 - MP + m * 16;
#pragma unroll
                for (int bj = 0; bj < 2; ++bj)
#pragma unroll
                    for (int n = 0; n < 2; ++n) *(f32x4*)(zp + (size_t)row * D + col0 + bj * HALF + n * 16) = acc[0][bj][m][n]; }
        } else
#pragma unroll
        for (int ai = 0; ai < 2; ++ai)
#pragma unroll
            for (int m = 0; m < 4; ++m) {
                const int row = row0 + ai * HALF + m * 16; const bool valid = row < MR;
                const float* xr = row < MP ? xp + (size_t)row * D : xs + (size_t)(row - MP) * D;
                const float* mr = mod + (size_t)(bb_of_row(row) * 9 + slot) * D;
#pragma unroll
                for (int bj = 0; bj < 2; ++bj)
#pragma unroll
                    for (int n = 0; n < 2; ++n) { const int col = col0 + bj * HALF + n * 16;
                        const f32x4 xv = valid ? *(const f32x4*)(xr + col) : (f32x4){0.f, 0.f, 0.f, 0.f}; const f32x4 mv = *(const f32x4*)(mr + col);
                        *(f32x4*)(Z + (size_t)row * D + col) = ALPHA * xv + coef * (1.0f + mv) * acc[ai][bj][m][n]; }
            }
    }
};
struct EpiProj {
    static constexpr bool PERM = false, AFTER_DRAIN = false;
    const float* bias; float* P; float* out; unsigned char* ws;
    __device__ __forceinline__ void operator()(const f32x4 (&acc)[2][2][4][2], const Unit& u, int wr, int wc, int fr, int fq) const {
        const int row0 = u.pm * BM + wr * 64 + fr, col0 = u.pn * BM + wc * 32 + 4 * fq;
        f32x4 bv[2][2];
#pragma unroll
        for (int bj = 0; bj < 2; ++bj)
#pragma unroll
            for (int n = 0; n < 2; ++n) { const int col = col0 + bj * HALF + n * 16; bv[bj][n] = col < NIN ? *(const f32x4*)(bias + col) : (f32x4){0.f, 0.f, 0.f, 0.f}; }
#pragma unroll
        for (int ai = 0; ai < 2; ++ai)
#pragma unroll
            for (int m = 0; m < 4; ++m) { float* rp = P + (size_t)(row0 + ai * HALF + m * 16) * NINP + col0;
#pragma unroll
                for (int bj = 0; bj < 2; ++bj)
#pragma unroll
                    for (int n = 0; n < 2; ++n) *(f32x4*)(rp + bj * HALF + n * 16) = acc[ai][bj][m][n] + bv[bj][n]; }
        const int br = u.pn - C_KV / BM;
        if (br < 0 || br > 2) return;
        int frl = fr; asm volatile("" : "+v"(frl));
#pragma unroll
        for (int ai = 0; ai < 2; ++ai)
#pragma unroll
            for (int m = 0; m < 4; ++m) { const int row = u.pm * BM + wr * 64 + frl + ai * HALF + m * 16;
                if (row < MR) {
#pragma unroll
                for (int bj = 0; bj < 2; ++bj)
#pragma unroll
                    for (int n = 0; n < 2; ++n) { const f32x4 v = acc[ai][bj][m][n] + bv[bj][n];
                        const int within = bj * HALF + wc * 32 + n * 16 + 4 * fq, g = (within >> 6) & 1, d = within & 63;
                        if (row < MP) { const int b = row >> 12, t = row & (T - 1);
                            typedef unsigned u32x2v __attribute__((ext_vector_type(2))); u32x2v pk; pk.x = cvt_pk_bf16(v[0], v[1]); pk.y = cvt_pk_bf16(v[2], v[3]);
                            { const bool wr_ = br != 2 || t >= T - 512;
                              const size_t off = br == 0 ? O_KVC_P + (size_t)row * 256 : (br == 1 ? O_KVS_P + (size_t)row * 256 : O_KVW_P + ((size_t)b * 512 + (t - (T - 512))) * 256);
                              if (wr_) *(f32x4*)(out + off + within) = v; }
                            if (br == 0) {
                                *(u32x2v*)((bf16_t*)(ws + WS_ACMP) + ((size_t)bj * CROWS + CROWS_S + (size_t)(b * NCH_P + (t >> 4)) * 2 + g) * 1024 + (t & 15) * 64 + d) = pk; }
                            else {
                                   if (bj == 0) *(u32x2v*)((bf16_t*)(ws + (br == 1 ? WS_KSEL : WS_KWIN)) + ((size_t)(b * 2 + g) * T + t) * 64 + d) = pk;
                                   else { bf16_t* vt = (bf16_t*)(ws + (br == 1 ? WS_VTSEL : WS_VTWIN)) + ((size_t)(b * 2 + g) * 64 + d) * T + t;
                                          vt[0] = (bf16_t)(pk.x & 0xffffu); vt[T] = (bf16_t)(pk.x >> 16); vt[2 * T] = (bf16_t)(pk.y & 0xffffu); vt[3 * T] = (bf16_t)(pk.y >> 16); } }
                        } else { const int s = row - MP, b = s >> 2, tq = s & 3;
                            const size_t off = br == 0 ? O_KVC_S + (size_t)s * 256 : (br == 1 ? O_KVS_S + (size_t)s * 256 : O_KVW_S + ((size_t)b * 512 + 508 + tq) * 256);
                            *(f32x4*)(out + off + within) = v; }
                    } }
                asm volatile("" ::: "memory"); }
    }
};
struct EpiF32 {
    static constexpr bool PERM = false, AFTER_DRAIN = false;
    float* O; int ldc; int nm;
    __device__ __forceinline__ void operator()(const f32x4 (&acc)[2][2][4][2], const Unit& u, int wr, int wc, int fr, int fq) const {
        const int row0 = ((u.kt0 / 4) * 2 + u.pn) * 2048 + (u.pm - u.pn * (CROWS / BM) - CROWS_S / BM) * BM + wr * 64 + fr, col0 = wc * 32 + 4 * fq;
#pragma unroll
        for (int ai = 0; ai < 2; ++ai)
#pragma unroll
            for (int m = 0; m < 4; ++m) { float* rp = O + (size_t)(row0 + ai * HALF + m * 16) * ldc + col0;
#pragma unroll
                for (int bj = 0; bj < 2; ++bj)
#pragma unroll
                    for (int n = 0; n < 2; ++n) *(f32x4*)(rp + bj * HALF + n * 16) = acc[ai][bj][m][n]; }
    }
};
struct EpiOutAB {
    static constexpr bool PERM = false, AFTER_DRAIN = false;
    const float* P; float* M1; bf16_t* MIN; int nm;
    __device__ __forceinline__ void operator()(const f32x4 (&acc)[2][2][4][2], const Unit& u, int wr, int wc, int fr, int fq) const {
        const int rep = u.pm >= nm ? 1 : 0;
        const int row0 = (u.pm - rep * nm) * BM + wr * 64 + fr, col0 = (u.pn - rep * 4) * BM + wc * 32 + 4 * fq;
#pragma unroll
        for (int ai = 0; ai < 2; ++ai)
#pragma unroll
            for (int m = 0; m < 4; ++m) { const int row = row0 + ai * HALF + m * 16;
#pragma unroll
                for (int bj = 0; bj < 2; ++bj)
#pragma unroll
                    for (int n = 0; n < 2; ++n) { const int col = col0 + bj * HALF + n * 16;
                        const f32x4 pm = *(const f32x4*)(P + (size_t)row * NINP + C_MERGE + rep * D + col);
                        f32x4 g; g[0] = fast_sigmoid(pm[0]); g[1] = fast_sigmoid(pm[1]); g[2] = fast_sigmoid(pm[2]); g[3] = fast_sigmoid(pm[3]);
                        const f32x4 v = g * acc[ai][bj][m][n];
                        if (rep == 0) *(f32x4*)(M1 + (size_t)row * D + col) = v;
                        else { const f32x4 s = *(const f32x4*)(M1 + (size_t)row * D + col) + v;
                               typedef unsigned u32x2v __attribute__((ext_vector_type(2))); u32x2v w; w.x = cvt_pk_bf16(s[0], s[1]); w.y = cvt_pk_bf16(s[2], s[3]);
                               *(u32x2v*)(MIN + (size_t)row * D + col) = w; } }
            }
    }
};
template <class Epi, class Sched, bool ALIGN_EPI = false, bool SP2 = false>
__device__ __forceinline__ void gemm_phase(PG8_LAS unsigned char* lds, const Gemm g, const Sched& S, const Epi& E) {
    const int tid = threadIdx.x, wid = __builtin_amdgcn_readfirstlane(tid >> 6), lane = tid & 63, wr = wid >> 2, wc = wid & 3, fr = lane & 15, fq = lane >> 4;
    const int K = g.K, nt = K / BK;
    unsigned voffA[2], voffB[2];
#pragma unroll
    for (int i = 0; i < 2; ++i) { int R, C; stage_rc(tid * 16 + i * 8192, R, C); const int Rb = Epi::PERM ? ((R & ~31) + perm32(R & 31)) : R;
        voffA[i] = (unsigned)(R * K + C) * 2u; voffB[i] = (unsigned)(Rb * K + C) * 2u; }
    const size_t kstep = (size_t)(BK * 2);
    const size_t hstep = (size_t)HALF * K * 2;
    const size_t tstep = 2 * hstep;
    const unsigned ldsw = (unsigned)wid * 1024u;
    const int aoff = lds_byte(wr * 64 + fr, fq * 8), boff = lds_byte(wc * 32 + fr, fq * 8);
#define PG8_SA(b, h) (((b) * 2 + (h)) * HTB)
#define PG8_SB(b, h) ((4 + (b) * 2 + (h)) * HTB)
#define PG8_STAGE(bufoff, gbase, voff) do { _Pragma("unroll") for (int _i = 0; _i < 2; ++_i) \
        __builtin_amdgcn_global_load_lds((const unsigned*)((const char*)(gbase) + (voff)[_i]), (PG8_LAS unsigned*)(lds + (bufoff) + ldsw + _i * 8192), 16, 0, 0); } while (0)
#define PG8_LDA(dst, b, h) do { _Pragma("unroll") for (int m = 0; m < 4; ++m) _Pragma("unroll") for (int k = 0; k < 2; ++k) dst[m][k] = *(const PG8_LAS bf16x8*)(lds + PG8_SA(b, h) + aoff + m * 2048 + k * 1024); } while (0)
#define PG8_LDB(dst, b, h) do { _Pragma("unroll") for (int n = 0; n < 2; ++n) _Pragma("unroll") for (int k = 0; k < 2; ++k) dst[n][k] = *(const PG8_LAS bf16x8*)(lds + PG8_SB(b, h) + boff + n * 2048 + k * 1024); } while (0)
#define PG8_MMA(ai, bj, At, Bt) do { __builtin_amdgcn_s_setprio(1); _Pragma("unroll") for (int m = 0; m < 4; ++m) _Pragma("unroll") for (int n = 0; n < 2; ++n) _Pragma("unroll") for (int k = 0; k < 2; ++k) \
        acc[ai][bj][m][n] = __builtin_amdgcn_mfma_f32_16x16x32_bf16(Bt[n][k], At[m][k], acc[ai][bj][m][n], 0, 0, 0); __builtin_amdgcn_s_setprio(0); } while (0)
#define PG8_WAIT_V(n) asm volatile("s_waitcnt vmcnt(" #n ")" ::: "memory")
#define PG8_WAIT_L(n) asm volatile("s_waitcnt lgkmcnt(" #n ")" ::: "memory")
#define PG8_BAR __builtin_amdgcn_s_barrier()
#define PG8_SCHED __builtin_amdgcn_sched_barrier(0)
    Unit cur, nxt; int ui = 0;
    if (!S.next(0, cur)) return;
    f32x4 acc[2][2][4][2];
#pragma unroll
    for (int a = 0; a < 2; ++a)
#pragma unroll
        for (int b = 0; b < 2; ++b)
#pragma unroll
            for (int m = 0; m < 4; ++m)
#pragma unroll
                for (int n = 0; n < 2; ++n) acc[a][b][m][n] = (f32x4){0.f, 0.f, 0.f, 0.f};
    bf16x8 At[4][2], B0[2][2], B1[2][2];
    const char* cA = (const char*)g.A + (size_t)cur.pm * tstep + (size_t)cur.kt0 * kstep; const char* cB = (const char*)g.Bt + (size_t)cur.pn * tstep + (size_t)cur.kt0 * kstep;
    S.a_ready(cur);
    if constexpr (SP2) {
        PG8_STAGE(PG8_SB(0, 0), cB, voffB); PG8_STAGE(PG8_SB(0, 1), cB + hstep, voffB); PG8_STAGE(PG8_SA(0, 0), cA, voffA); PG8_STAGE(PG8_SA(0, 1), cA + hstep, voffA);
        if (wr == 1) PG8_BAR;
        PG8_WAIT_V(2); PG8_BAR;
        PG8_STAGE(PG8_SB(1, 0), cB + kstep, voffB); PG8_STAGE(PG8_SA(1, 0), cA + kstep, voffA); PG8_STAGE(PG8_SB(1, 1), cB + hstep + kstep, voffB);
        PG8_WAIT_V(6); PG8_BAR;
    } else {
        PG8_STAGE(PG8_SB(0, 0), cB, voffB); PG8_STAGE(PG8_SA(0, 0), cA, voffA); PG8_STAGE(PG8_SB(0, 1), cB + hstep, voffB); PG8_STAGE(PG8_SA(0, 1), cA + hstep, voffA);
        if (wr == 1) PG8_BAR;
        PG8_WAIT_V(4); PG8_BAR;
        PG8_STAGE(PG8_SB(1, 0), cB + kstep, voffB); PG8_STAGE(PG8_SA(1, 0), cA + kstep, voffA); PG8_STAGE(PG8_SB(1, 1), cB + hstep + kstep, voffB);
        PG8_WAIT_V(6); PG8_BAR;
    }
    for (;;) {
        const bool has_next = S.next(ui + 1, nxt);
        const char* nA = has_next ? (const char*)g.A + (size_t)nxt.pm * tstep + (size_t)nxt.kt0 * kstep : cA; const char* nB = has_next ? (const char*)g.Bt + (size_t)nxt.pn * tstep + (size_t)nxt.kt0 * kstep : cB;
        const int ntu = cur.nkt ? cur.nkt : nt;
        for (int t = 0; t < ntu; t += 2) {
            const bool last = (t == ntu - 2);
            const char* a1 = cA + (size_t)(t + 1) * kstep;
            const char* a2 = last ? nA : cA + (size_t)(t + 2) * kstep; const char* b2 = last ? nB : cB + (size_t)(t + 2) * kstep;
            const char* a3 = a2 + kstep; const char* b3 = b2 + kstep;
            if (last && has_next) S.a_ready(nxt);
            if constexpr (SP2) {
            PG8_LDB(B0, 0, 0); PG8_LDB(B1, 0, 1); PG8_SCHED; PG8_LDA(At, 0, 0); PG8_STAGE(PG8_SA(1, 1), a1 + hstep, voffA);
            PG8_WAIT_V(8); PG8_WAIT_L(0); PG8_BAR; PG8_MMA(0, 0, At, B0); PG8_MMA(0, 1, At, B1); PG8_BAR; PG8_SCHED;
            PG8_LDA(At, 0, 1); PG8_STAGE(PG8_SB(0, 0), b2, voffB); PG8_STAGE(PG8_SB(0, 1), b2 + hstep, voffB); PG8_STAGE(PG8_SA(0, 0), a2, voffA);
            PG8_WAIT_V(8); PG8_WAIT_L(0); PG8_BAR; PG8_MMA(1, 0, At, B0); PG8_MMA(1, 1, At, B1); PG8_BAR; PG8_SCHED;
            PG8_LDB(B0, 1, 0); PG8_LDB(B1, 1, 1); PG8_SCHED; PG8_LDA(At, 1, 0); PG8_STAGE(PG8_SA(0, 1), a2 + hstep, voffA);
            PG8_WAIT_V(8); PG8_WAIT_L(0); PG8_BAR; PG8_MMA(0, 0, At, B0); PG8_MMA(0, 1, At, B1); PG8_BAR; PG8_SCHED;
            PG8_LDA(At, 1, 1); PG8_STAGE(PG8_SB(1, 0), b3, voffB); PG8_STAGE(PG8_SB(1, 1), b3 + hstep, voffB); PG8_STAGE(PG8_SA(1, 0), a3, voffA);
            PG8_WAIT_V(8); PG8_WAIT_L(0); PG8_BAR; PG8_MMA(1, 0, At, B0); PG8_MMA(1, 1, At, B1); PG8_BAR; PG8_SCHED;
            } else {
            PG8_LDB(B0, 0, 0); PG8_SCHED; PG8_LDA(At, 0, 0); PG8_STAGE(PG8_SA(1, 1), a1 + hstep, voffA);
            PG8_WAIT_L(8); PG8_BAR; PG8_WAIT_L(0); PG8_MMA(0, 0, At, B0); PG8_BAR; PG8_SCHED;
            PG8_LDB(B1, 0, 1); PG8_STAGE(PG8_SB(0, 0), b2, voffB);
            PG8_BAR; PG8_WAIT_L(0); PG8_MMA(0, 1, At, B1); PG8_BAR;
            PG8_LDA(At, 0, 1); PG8_STAGE(PG8_SA(0, 0), a2, voffA);
            PG8_BAR; PG8_WAIT_L(0); PG8_MMA(1, 0, At, B0); PG8_BAR; PG8_SCHED;
            PG8_STAGE(PG8_SB(0, 1), b2 + hstep, voffB);
            PG8_WAIT_V(6); PG8_BAR; PG8_MMA(1, 1, At, B1); PG8_BAR;
            PG8_LDB(B0, 1, 0); PG8_SCHED; PG8_LDA(At, 1, 0); PG8_STAGE(PG8_SA(0, 1), a2 + hstep, voffA);
            PG8_WAIT_L(8); PG8_BAR; PG8_WAIT_L(0); PG8_MMA(0, 0, At, B0); PG8_BAR; PG8_SCHED;
            PG8_LDB(B1, 1, 1); PG8_STAGE(PG8_SB(1, 0), b3, voffB);
            PG8_BAR; PG8_WAIT_L(0); PG8_MMA(0, 1, At, B1); PG8_BAR;
            PG8_LDA(At, 1, 1); PG8_STAGE(PG8_SA(1, 0), a3, voffA);
            PG8_BAR; PG8_WAIT_L(0); PG8_MMA(1, 0, At, B0); PG8_BAR; PG8_SCHED;
            PG8_STAGE(PG8_SB(1, 1), b3 + hstep, voffB);
            PG8_WAIT_V(6); PG8_BAR; PG8_MMA(1, 1, At, B1); PG8_BAR;
            }
        }
        if constexpr (ALIGN_EPI) { if (wr == 0) PG8_BAR; }
        if constexpr (!Epi::AFTER_DRAIN) { E(acc, cur, wr, wc, fr, fq); S.done(cur); }
        if (!has_next) break;
#pragma unroll
        for (int a = 0; a < 2; ++a)
#pragma unroll
            for (int b = 0; b < 2; ++b)
#pragma unroll
                for (int m = 0; m < 4; ++m)
#pragma unroll
                    for (int n = 0; n < 2; ++n) acc[a][b][m][n] = (f32x4){0.f, 0.f, 0.f, 0.f};
        cur = nxt; cA = nA; cB = nB; ++ui;
        if constexpr (ALIGN_EPI) { if (wr == 1) PG8_BAR; }
    }
    PG8_WAIT_V(0);
    if constexpr (!ALIGN_EPI) { if (wr == 0) PG8_BAR; }
    PG8_BAR;
    if constexpr (Epi::AFTER_DRAIN) { E.fused(acc, cur, wr, wc, fr, fq, lds, wid, lane); S.done(cur); }
#undef PG8_SA
#undef PG8_SB
#undef PG8_STAGE
#undef PG8_LDA
#undef PG8_LDB
#undef PG8_MMA
#undef PG8_WAIT_V
#undef PG8_WAIT_L
#undef PG8_BAR
#undef PG8_SCHED
}
}
#define GAS __attribute__((address_space(1)))
#define LAS __attribute__((address_space(3)))
typedef unsigned short bf16;
typedef unsigned v4u __attribute__((ext_vector_type(4)));
typedef unsigned v2u __attribute__((ext_vector_type(2)));
typedef float f32x4 __attribute__((ext_vector_type(4)));
typedef float f32x16 __attribute__((ext_vector_type(16)));
typedef short bf16x8 __attribute__((ext_vector_type(8)));
typedef short s16x4 __attribute__((ext_vector_type(4)));
typedef GAS unsigned gu32;
#define RLX_AGENT __ATOMIC_RELAXED, __HIP_MEMORY_SCOPE_AGENT
#define LDS_WAIT() asm volatile("s_waitcnt lgkmcnt(0)" ::: "memory")
#define VM_WAIT() asm volatile("s_waitcnt vmcnt(0)" ::: "memory")
DI unsigned f2bf(float f) { unsigned u = __builtin_bit_cast(unsigned, f); return (u + 0x7fffu + ((u >> 16) & 1u)) >> 16; }
DI unsigned pk2(float lo, float hi) { return pg8::cvt_pk_bf16(lo, hi); }
DI float sigmoidf_(float x) { return 1.0f / (1.0f + __expf(-x)); }
DI float wave_sum(float v) {
#pragma unroll
    for (int o = 1; o < 64; o <<= 1) v += __shfl_xor(v, o);
    return v;
}
DI float wave_max(float v) {
#pragma unroll
    for (int o = 1; o < 64; o <<= 1) v = fmaxf(v, __shfl_xor(v, o));
    return v;
}
template <int CTRL> DI float dpp_f(float x) { return __builtin_bit_cast(float, __builtin_amdgcn_update_dpp(0, __builtin_bit_cast(int, x), CTRL, 0xf, 0xf, false)); }
DI float row16_sum(float x) {
    x += dpp_f<0x128>(x); x += dpp_f<0x124>(x); x += dpp_f<0x122>(x); x += dpp_f<0x121>(x); return x;
}
DI float fsig(float x) { return __builtin_amdgcn_rcpf(1.0f + __builtin_amdgcn_exp2f(-x * LOG2E)); }
DI float ftanh(float x) { return 1.0f - 2.0f * __builtin_amdgcn_rcpf(__builtin_amdgcn_exp2f(x * (2.0f * LOG2E)) + 1.0f); }
DI float gelu_tanh(float x) { const float u = 0.7978845608028654f * (x + 0.044715f * x * x * x); const float e = __expf(2.0f * u); const float th = 1.0f - 2.0f / (e + 1.0f); return 0.5f * x * (1.0f + th); }
#define MFMA32(a_, b_, c_) __builtin_amdgcn_mfma_f32_32x32x16_bf16((a_), (b_), (c_), 0, 0, 0)
DI int crow(int i, int hh) { return (i & 3) + 8 * (i >> 2) + 4 * hh; }
DI f32x16 zero16() { f32x16 z;
#pragma unroll
    for (int i = 0; i < 16; ++i) z[i] = 0.f; return z; }
#define XB_TMO      128
#define XB_XCNT(j)  (256  + 64 * (j))
#define XB_XSUB(j)  (1280 + 64 * (j))
#define XB_XGEN(j)  (2304 + 64 * (j))
#define XB_TOP      3328
#define XB_TOPGEN   3392
#define XCD_BAR_WORDS 3456
#define XB_SPIN_CAP (1u << 18)

__device__ __forceinline__ unsigned xb_ld(unsigned* p)              { return __hip_atomic_load(p, __ATOMIC_RELAXED, __HIP_MEMORY_SCOPE_AGENT); }
__device__ __forceinline__ unsigned xb_add(unsigned* p, unsigned v) { return __hip_atomic_fetch_add(p, v, __ATOMIC_RELAXED, __HIP_MEMORY_SCOPE_AGENT); }
__device__ __forceinline__ unsigned xb_xcc_id() { return (unsigned)__builtin_amdgcn_s_getreg((3 << 11) | 20) & 0xFu; }
#define XB_SPIN(cond, bar) do { unsigned _sp = 0; while (cond) { __builtin_amdgcn_s_sleep(1); \
    if ((++_sp & 255u) == 0u) { if (xb_ld(&(bar)[XB_TMO])) break; if (_sp > XB_SPIN_CAP) { atomicAdd(&(bar)[XB_TMO], 1u); break; } } } } while (0)

struct XcdBarrier {
    unsigned* bar; unsigned x;
    volatile LAS unsigned* st;
};

__device__ __forceinline__ XcdBarrier xcd_barrier_post(unsigned* bar, volatile LAS unsigned* st) {
    XcdBarrier b; b.bar = bar; b.x = xb_xcc_id(); b.st = st;
    if (threadIdx.x == 0) (void)xb_add(&bar[XB_XCNT(b.x)], 1u);
    return b;
}
__device__ __forceinline__ void xcd_barrier_complete(unsigned* bar, unsigned x, unsigned& nloc, unsigned& nx) {
    const unsigned G = gridDim.x * gridDim.y * gridDim.z;
    unsigned sum, cnt, mine, sp = 0u;
    for (;;) {
        sum = 0u; cnt = 0u; mine = 0u;
#pragma unroll
        for (unsigned j = 0; j < 16; ++j) { const unsigned c = xb_ld(&bar[XB_XCNT(j)]); sum += c; cnt += (c > 0u) ? 1u : 0u; mine = (j == x) ? c : mine; }
        if (sum == G) break;
        __builtin_amdgcn_s_sleep(1);
        if ((++sp & 255u) == 0u) { if (xb_ld(&bar[XB_TMO])) break; if (sp > XB_SPIN_CAP) { atomicAdd(&bar[XB_TMO], 1u); break; } }
    }
    nloc = mine > 0u ? mine : 1u; nx = cnt > 0u ? cnt : 1u;
}

__device__ __forceinline__ void xcd_barrier(const XcdBarrier& b) {
    asm volatile("s_waitcnt vmcnt(0)" ::: "memory");
    __syncthreads();
    if (threadIdx.x == 0) {
        unsigned* bar = b.bar;
        __builtin_amdgcn_s_waitcnt(0);
        unsigned nloc = b.st[0], nx = b.st[1];
        if (nloc == 0u) { xcd_barrier_complete(bar, b.x, nloc, nx); b.st[0] = nloc; b.st[1] = nx; }
        const unsigned old = xb_add(&bar[XB_XSUB(b.x)], 1u);
        const unsigned gen = old / nloc;
        if (old + 1u == (gen + 1u) * nloc) {
            __builtin_amdgcn_fence(__ATOMIC_RELEASE, "agent");
            asm volatile("s_waitcnt vmcnt(0)" ::: "memory");
            const unsigned og = xb_add(&bar[XB_TOP], 1u);
            const unsigned tg = og / nx;
            if (og + 1u == (tg + 1u) * nx) xb_add(&bar[XB_TOPGEN], 1u);
            else XB_SPIN(xb_ld(&bar[XB_TOPGEN]) == tg, bar);
            __builtin_amdgcn_fence(__ATOMIC_ACQUIRE, "agent");
            xb_add(&bar[XB_XGEN(b.x)], 1u);
            asm volatile("s_waitcnt vmcnt(0)" ::: "memory");
        } else {
            XB_SPIN(xb_ld(&bar[XB_XGEN(b.x)]) == gen, bar);
            __builtin_amdgcn_fence(__ATOMIC_ACQUIRE, "agent");
            asm volatile("s_waitcnt vmcnt(0)" ::: "memory");
        }
    }
    __syncthreads();
}

enum { I_XP = 0, I_XS, I_CP, I_CS, I_CKC, I_CKS, I_SKW, I_SWKV, I_SSH, I_PT, I_WADA, I_BADA, I_LNG, I_LNB, I_WG, I_WU, I_WD, I_WIN, I_BIN, I_MU, I_W0, I_W2, I_A0, I_A2, I_G2,
       I_KK, I_KA, I_RK, I_LNW, I_LNBB, I_PE, I_PW1, I_PW2, I_WOA, I_WOB, I_WOO, N_IN };
struct Args { const float* in[N_IN]; float* out; unsigned char* ws; int ph_lo, ph_hi; };
#define WSF(off) ((float*)(a.ws + (off)))
#define WSB(off) ((bf16*)(a.ws + (off)))

DI void tr_item(const float* __restrict__ W, int ldw, int ncols, int k0, int n0, bf16* WT, int ldo, int dr0, LAS float* scr, int lane) {
    float wv[32];
#pragma unroll
    for (int i = 0; i < 32; ++i) { const int kk = 2 * i + (lane >> 5), col = n0 + (lane & 31); wv[i] = col < ncols ? W[(size_t)(k0 + kk) * ldw + col] : 0.f; }
#pragma unroll
    for (int i = 0; i < 32; ++i) { const int kk = 2 * i + (lane >> 5); scr[kk * 33 + (lane & 31)] = wv[i]; }
    LDS_WAIT(); asm volatile("" ::: "memory");
    const int c = lane & 7;
#pragma unroll
    for (int j = 0; j < 4; ++j) { const int n = (lane >> 3) + 8 * j; const LAS float* s = scr + (8 * c) * 33 + n;
        v4u o; o.x = pk2(s[0 * 33], s[1 * 33]); o.y = pk2(s[2 * 33], s[3 * 33]); o.z = pk2(s[4 * 33], s[5 * 33]); o.w = pk2(s[6 * 33], s[7 * 33]);
        *(v4u*)(WT + (size_t)(dr0 + n) * ldo + k0 + 8 * c) = o; }
    LDS_WAIT(); asm volatile("" ::: "memory");
}
DI void mod_gemv_item(const Args& a, LAS unsigned char* lds, int tid, int lane, int wave, int item) {
    LAS float* S = (LAS float*)lds;
    const float* wada = a.in[I_WADA];
    float acc[36];
#pragma unroll
    for (int i = 0; i < 36; ++i) acc[i] = 0.f;
    const int col = item * 64 + lane;
    for (int kh = 0; kh < 2; ++kh) {
        __syncthreads();
        for (int e = tid; e < 36 * 512; e += 512) { const int bbv = e >> 9, kk = e & 511;
            const float c = bbv < 4 ? a.in[I_CP][bbv * D + kh * 512 + kk] : a.in[I_CS][(bbv - 4) * D + kh * 512 + kk];
            S[kk * 36 + bbv] = c / (1.0f + __expf(-c)); }
        __syncthreads();
#pragma unroll
        for (int k8 = 0; k8 < 64; k8 += 16) {
            float wv[16];
#pragma unroll
            for (int e = 0; e < 16; ++e) wv[e] = wada[(size_t)(kh * 512 + wave * 64 + k8 + e) * 9216 + col];
#pragma unroll
            for (int e = 0; e < 16; ++e) { const LAS f32x4* sp = (const LAS f32x4*)(S + (wave * 64 + k8 + e) * 36);
#pragma unroll
                for (int q = 0; q < 9; ++q) { const f32x4 s = sp[q]; acc[4 * q] += s[0] * wv[e]; acc[4 * q + 1] += s[1] * wv[e]; acc[4 * q + 2] += s[2] * wv[e]; acc[4 * q + 3] += s[3] * wv[e]; } }
        }
    }
    __syncthreads();
    LAS float* P = (LAS float*)lds;
#pragma unroll
    for (int i = 0; i < 36; ++i) P[(wave * 36 + i) * 64 + lane] = acc[i];
    __syncthreads();
    float* MOD = WSF(WS_MOD);
    for (int o = tid; o < 36 * 64; o += 512) { const int bbv = o >> 6, l = o & 63; float s = 0.f;
#pragma unroll
        for (int w = 0; w < 8; ++w) s += P[(w * 36 + bbv) * 64 + l];
        const int cc = item * 64 + l; MOD[(size_t)bbv * 9216 + cc] = s + a.in[I_BADA][cc]; }
    __syncthreads();
}
DI void pet_item(const Args& a, LAS unsigned char* lds, int tid, int lane, int wave, int item) {
    const int kv = item >> 1, e = (item & 1) * 64 + lane;
    const float* pe = a.in[I_PE] + kv * 2048; const float* w1 = a.in[I_PW1] + (size_t)kv * 2048 * 128;
    float acc = 0.f;
    for (int k = wave * 256; k < wave * 256 + 256; ++k) acc += pe[k] * w1[(size_t)k * 128 + e];
    LAS float* P = (LAS float*)lds;
    __syncthreads();
    P[wave * 64 + lane] = acc;
    __syncthreads();
    if (tid < 64) { float s = 0.f;
#pragma unroll
        for (int w = 0; w < 8; ++w) s += P[w * 64 + tid];
        WSF(WS_PET)[kv * 128 + (item & 1) * 64 + tid] = s; }
    __syncthreads();
}
DI void ph_prologue(const Args& a, LAS unsigned char* lds, int tid, int lane, int wave, int G, int bx) {
    for (int it = bx; it < 148; it += G) { if (it < 144) mod_gemv_item(a, lds, tid, lane, wave, it); else pet_item(a, lds, tid, lane, wave, it - 144); }
    __syncthreads();
    LAS float* scr = (LAS float*)(lds + wave * 16384);
    const int gw = wave * G + bx, NGW = G * NWAVES;
    constexpr int I_GU = 16 * 88, I_DN = 44 * 32, I_IN = 16 * 168, I_C1 = 16 * 4, I_ZERO = 128, I_LORA = 64, I_W2T = 8;
    constexpr int NITEMS = 2 * I_GU + I_DN + I_IN + 4 * I_C1 + I_ZERO + I_LORA + I_W2T;
    for (int it = gw; it < NITEMS; it += NGW) {
        int r = it;
        if (r < 2 * I_GU) { const int up = r / I_GU; r %= I_GU; const int kb = r / 88, nb = r % 88, n0 = nb * 32;
            tr_item(up ? a.in[I_WU] : a.in[I_WG], FF, FF, kb * 64, n0, WSB(WS_WGU), D, (n0 >> 7) * 256 + up * 128 + (n0 & 127), scr, lane); continue; } r -= 2 * I_GU;
        if (r < I_DN) { const int kb = r / 32, nb = r % 32; tr_item(a.in[I_WD], D, D, kb * 64, nb * 32, WSB(WS_WDN), FF, nb * 32, scr, lane); continue; } r -= I_DN;
        if (r < I_IN) { const int kb = r / 168, nb = r % 168; tr_item(a.in[I_WIN], NIN, NIN, kb * 64, nb * 32, WSB(WS_WIN), D, nb * 32, scr, lane); continue; } r -= I_IN;
        if (r < 4 * I_C1) { const int mat = r / I_C1; r %= I_C1; const int kb = r / 4, nb = r % 4;
            tr_item(a.in[I_PW1] + (size_t)mat * 1024 * 128, 128, 128, kb * 64, nb * 32, WSB(WS_WC1), 1024, mat * 128 + nb * 32, scr, lane); continue; } r -= 4 * I_C1;
        if (r < I_ZERO) { v4u z = {0u, 0u, 0u, 0u}; unsigned char* p = a.ws + WS_KCP + (size_t)r * 4096 + lane * 64;
#pragma unroll
          for (int i = 0; i < 4; ++i) *(v4u*)(p + 16 * i) = z; continue; } r -= I_ZERO;
        if (r >= I_LORA) { const int q = r - I_LORA, kv = q >> 2, kb = (q >> 1) & 1, nb = q & 1;
            tr_item(a.in[I_PW2] + (size_t)kv * 128 * 64, 64, 64, kb * 64, nb * 32, WSB(WS_W2T) + (size_t)kv * 64 * 128, 128, nb * 32, scr, lane); continue; }
        {
            if (r < 16) tr_item(a.in[I_W2], RWW, RWW, 0, r * 32, WSB(WS_LORA), 64, r * 32, scr, lane);
            else if (r < 32) tr_item(a.in[I_A2], RWW, RWW, 0, (r - 16) * 32, WSB(WS_LORA) + 512 * 64, 64, (r - 16) * 32, scr, lane);
            else { const int q = r - 32; tr_item(a.in[I_G2], RWW, RWW, (q >> 4) * 64, (q & 15) * 32, WSB(WS_LORA) + 2 * 512 * 64, 128, (q & 15) * 32, scr, lane); } }
    }
}
DI void prologue_late(const Args& a, LAS unsigned char* lds, int lane, int wave, int worker, int nworkers) {
    LAS float* scr = (LAS float*)(lds + wave * 16384);
    constexpr int I_GU = 16 * 88, I_DN = 44 * 32, I_OAB = 8 * 32, I_O = 16 * 32, I_WCP = 1016;
    constexpr int NITEMS = 2 * I_GU + I_DN + 2 * I_OAB + I_O + I_WCP;
    for (int it = worker; it < NITEMS; it += nworkers) {
        int r = it;
        if (r < 2 * I_GU) { const int up = r / I_GU; r %= I_GU; const int kb = r / 88, nb = r % 88, n0 = nb * 32;
            tr_item((up ? a.in[I_WU] : a.in[I_WG]) + (size_t)D * FF, FF, FF, kb * 64, n0, WSB(WS_WGU) + (size_t)5632 * D, D, (n0 >> 7) * 256 + up * 128 + (n0 & 127), scr, lane); continue; } r -= 2 * I_GU;
        if (r < I_DN) { const int kb = r / 32, nb = r % 32; tr_item(a.in[I_WD] + (size_t)FF * D, D, D, kb * 64, nb * 32, WSB(WS_WDN) + (size_t)D * FF, FF, nb * 32, scr, lane); continue; } r -= I_DN;
        if (r < 2 * I_OAB) { const int w = r / I_OAB; r %= I_OAB; const int kb = r / 32, nb = r % 32;
            tr_item(w ? a.in[I_WOB] : a.in[I_WOA], D, D, kb * 64, nb * 32, WSB(WS_WOAB), 512, w * 1024 + nb * 32, scr, lane); continue; } r -= 2 * I_OAB;
        if (r < I_O) { const int kb = r / 32, nb = r % 32; tr_item(a.in[I_WOO], D, D, kb * 64, nb * 32, WSB(WS_WO), D, nb * 32, scr, lane); continue; } r -= I_O;
        {
            f32x4 cv[16];
#pragma unroll
            for (int i = 0; i < 16; ++i) { const int f = r * 1024 + i * 64 + lane; const int b = f / 32512, i4 = f % 32512; cv[i] = *(const f32x4*)(a.in[I_SKW] + (size_t)b * 131072 + 1024 + (size_t)i4 * 4); }
#pragma unroll
            for (int i = 0; i < 16; ++i) { const int f = r * 1024 + i * 64 + lane; const int b = f / 32512, i4 = f % 32512; *(f32x4*)(a.out + O_KVW_S + (size_t)b * 131072 + (size_t)i4 * 4) = cv[i]; } }
    }
}
DI void ph_u1(const Args& a, int lane, int wave, int G, int bx) {
    const int gw = wave * G + bx, NGW = G * NWAVES; const float* MOD = WSF(WS_MOD); bf16* U = WSB(WS_U);
    for (int row = gw; row < MA; row += NGW) {
        const float* xr = row < MP ? a.in[I_XP] + (size_t)row * D : a.in[I_XS] + (size_t)(row - MP) * D;
        const float* ms = MOD + (size_t)(bb_of_row(row) * 9) * D;
#pragma unroll
        for (int j = 0; j < 4; ++j) { const int col = lane * 4 + 256 * j;
            f32x4 u = {0.f, 0.f, 0.f, 0.f};
            if (row < MR) { const f32x4 x = *(const f32x4*)(xr + col); u = x * (1.0f + *(const f32x4*)(ms + D + col)) + *(const f32x4*)(ms + col); }
            v2u o; o.x = pk2(u[0], u[1]); o.y = pk2(u[2], u[3]); *(v2u*)(U + (size_t)row * D + col) = o; }
    }
}
constexpr int CS_ROW = 144, CS_BUF = 128 * CS_ROW;
DI void ph_compress_sample(const Args& a, LAS unsigned char* lds, int tid, int lane, int wave, int G, int bx) {
    const int r = lane & 31, hh = lane >> 5;
    if (wave >= 4) {
        const int lw = wave - 4, sg = (lane & 31) >> 4, sd = (lane & 15) * 4;
        for (int u = bx; u < NBS * 16 * 2; u += G) {
            const int kv = u & 1, b = u >> 5, c0 = ((u >> 1) & 15) * 64;
            const float* src[8];
#pragma unroll
            for (int q = 0; q < 8; ++q) { const int cq = c0 + lw * 16 + 2 * q + (lane >> 5); const int page = ((const int*)a.in[I_PT])[b * 128 + (cq >> 3)];
                src[q] = a.in[I_CKC] + ((size_t)page * 128 + (cq & 7) * 16) * 256 + kv * 128 + (lane & 31) * 4; }
            f32x4 ar[3][8];
#pragma unroll
            for (int p = 0; p < 3; ++p)
#pragma unroll
                for (int q = 0; q < 8; ++q) ar[p][q] = *(const f32x4*)(src[q] + (size_t)p * 256);
            __syncthreads();
#pragma unroll 3
            for (int j = 0; j < 16; ++j) {
                LAS unsigned char* buf = lds + (j & 1) * CS_BUF; const int p = j % 3;
#pragma unroll
                for (int q = 0; q < 8; ++q) { const int cl = lw * 16 + 2 * q + (lane >> 5); v2u o; o.x = pk2(ar[p][q][0], ar[p][q][1]); o.y = pk2(ar[p][q][2], ar[p][q][3]);
                    *(LAS v2u*)(buf + (cl * 2 + sg) * CS_ROW + sd * 2) = o; }
                if (j + 3 < 16) {
#pragma unroll
                    for (int q = 0; q < 8; ++q) ar[p][q] = *(const f32x4*)(src[q] + (size_t)(j + 3) * 256); }
                __syncthreads();
            }
        }
    } else {
        const int wn = wave;
        for (int u = bx; u < NBS * 16 * 2; u += G) {
            const int kv = u & 1, b = u >> 5, c0 = ((u >> 1) & 15) * 64;
            const bf16* W1 = WSB(WS_WC1) + (size_t)(kv * 256 + wn * 64 + r) * 1024 + 8 * hh;
            f32x16 acc[4][2];
#pragma unroll
            for (int m = 0; m < 4; ++m) { acc[m][0] = zero16(); acc[m][1] = zero16(); }
            bf16x8 bnx[2][4];
#pragma unroll
            for (int n = 0; n < 2; ++n)
#pragma unroll
                for (int s = 0; s < 4; ++s) bnx[n][s] = *(const bf16x8*)(W1 + (size_t)n * 32 * 1024 + 16 * s);
            __syncthreads();
            for (int j = 0; j < 16; ++j) {
                const LAS unsigned char* buf = lds + (j & 1) * CS_BUF;
                __syncthreads();
                bf16x8 bfr[2][4];
#pragma unroll
                for (int n = 0; n < 2; ++n)
#pragma unroll
                    for (int s = 0; s < 4; ++s) { bfr[n][s] = bnx[n][s]; if (j + 1 < 16) bnx[n][s] = *(const bf16x8*)(W1 + (size_t)n * 32 * 1024 + (j + 1) * 64 + 16 * s); }
                const LAS unsigned char* ab = buf + r * CS_ROW + 16 * hh;
#pragma unroll
                for (int s = 0; s < 4; ++s) {
#pragma unroll
                    for (int m = 0; m < 4; ++m) { const bf16x8 af = *(const LAS bf16x8*)(ab + m * 32 * CS_ROW + 32 * s);
                        acc[m][0] = MFMA32(af, bfr[0][s], acc[m][0]); acc[m][1] = MFMA32(af, bfr[1][s], acc[m][1]); }
                    __builtin_amdgcn_sched_barrier(0); }
            }
            float* hc = WSF(WS_HC) + ((size_t)kv * CROWS + (size_t)(b * NCH_S + c0) * 2) * 256 + wn * 64 + r;
#pragma unroll
            for (int m = 0; m < 4; ++m) {
#pragma unroll
                for (int i = 0; i < 16; ++i) { float* hp = hc + (size_t)(32 * m + crow(i, hh)) * 256; hp[0] = acc[m][0][i]; hp[32] = acc[m][1][i]; }
                asm volatile("" ::: "memory"); }
        }
    }
}
template <int WHICH> DI void ph_ln(const Args& a, int lane, int wave, int G, int bx) {
    const int gw = wave * G + bx, NGW = G * NWAVES; const float* MOD = WSF(WS_MOD); const float* Z = WSF(WS_Z); bf16* U = WSB(WS_U);
    float* XN = WHICH == 0 ? WSF(WS_X1) : (WHICH == 1 ? WSF(WS_X2) : a.out);
    const float* lg = a.in[I_LNG] + WHICH * D; const float* lb = a.in[I_LNB] + WHICH * D;
    constexpr int NKS = WHICH == 1 ? 4 : 11; constexpr int RSLOT = WHICH == 0 ? 2 : (WHICH == 1 ? 5 : 8); constexpr float COEF = WHICH == 1 ? 1.0f : 0.5f;
    const float* xres = WHICH == 0 ? a.in[I_XS] : (WHICH == 1 ? WSF(WS_X1) + (size_t)MP * D : WSF(WS_X2) + (size_t)MP * D);
    for (int row = gw; row < MR; row += NGW) {
        f32x4 v[4]; float s = 0.f;
        if (row < MP) {
#pragma unroll
            for (int j = 0; j < 4; ++j) v[j] = *(const f32x4*)(Z + (size_t)row * D + lane * 4 + 256 * j);
        } else {
            const float* mr = MOD + (size_t)(bb_of_row(row) * 9 + RSLOT) * D;
#pragma unroll
            for (int j = 0; j < 4; ++j) { const int col = lane * 4 + 256 * j; f32x4 acc = {0.f, 0.f, 0.f, 0.f};
#pragma unroll
                for (int ks = 0; ks < NKS; ++ks) acc = acc + *(const f32x4*)(WSF(WS_ZP) + ((size_t)ks * MS + (row - MP)) * D + col);
                v[j] = ALPHA * *(const f32x4*)(xres + (size_t)(row - MP) * D + col) + COEF * (1.0f + *(const f32x4*)(mr + col)) * acc; }
        }
#pragma unroll
        for (int j = 0; j < 4; ++j) s += (v[j][0] + v[j][1]) + (v[j][2] + v[j][3]);
        const float mean = wave_sum(s) * (1.0f / D); float s2 = 0.f;
#pragma unroll
        for (int j = 0; j < 4; ++j) { v[j] = v[j] - mean; s2 += (v[j][0] * v[j][0] + v[j][1] * v[j][1]) + (v[j][2] * v[j][2] + v[j][3] * v[j][3]); }
        const float rstd = 1.0f / sqrtf(wave_sum(s2) * (1.0f / D) + LN_EPS);
        const float* ms = MOD + (size_t)(bb_of_row(row) * 9 + 3 * WHICH + 3) * D;
#pragma unroll
        for (int j = 0; j < 4; ++j) { const int col = lane * 4 + 256 * j;
            const f32x4 x = v[j] * rstd * *(const f32x4*)(lg + col) + *(const f32x4*)(lb + col);
            *(f32x4*)(XN + (size_t)row * D + col) = x;
            if (WHICH < 2) { const f32x4 u = x * (1.0f + *(const f32x4*)(ms + D + col)) + *(const f32x4*)(ms + col);
                v2u o; o.x = pk2(u[0], u[1]); o.y = pk2(u[2], u[3]); *(v2u*)(U + (size_t)row * D + col) = o; } }
    }
}
#ifndef PROBE_SUB
#define PROBE_SUB 0
#endif

DI float proj_prev(const Args& a, const float* PROJ, int row, int col) {
    if (row < MP) return (row & (T - 1)) ? PROJ[(size_t)(row - 1) * NINP + col] : 0.f;
    const int s = row - MP; return (s & 3) ? PROJ[(size_t)(row - 1) * NINP + col] : a.in[I_SSH][(size_t)(s >> 2) * C_Q + col];
}
DI void ph_dist_rwprep(const Args& a, LAS unsigned char* lds, int tid, int lane, int wave, int G, int bx) {
    const float* PROJ = WSF(WS_PROJ);
    LAS float* vt = (LAS float*)lds;
    LAS bf16* LA = (LAS bf16*)(lds + 36864);
    for (int it = bx; it < MP / 32 + MS / 8; it += G) {
        const int r0 = it < MP / 32 ? it * 32 : MP + (it - MP / 32) * 8, nrows = it < MP / 32 ? 32 : 8, nq = it < MP / 32 ? 4 : 1;
        __syncthreads();
        {
            const int rr = tid >> 4, seg = tid & 15, row = r0 + rr;
            if (rr < nrows) { const float* ps = PROJ + (size_t)row * NINP;
                if (row < MP) { if ((row & (T - 1)) == T - 1) {
#pragma unroll 4
                    for (int i = 0; i < 28; ++i) *(f32x4*)(a.out + O_SH_P + (size_t)(row >> 12) * C_Q + 4 * (seg + 16 * i)) = *(const f32x4*)(ps + 4 * (seg + 16 * i)); } }
                else if (((row - MP) & 3) == 3) {
#pragma unroll 4
                    for (int i = 0; i < 28; ++i) *(f32x4*)(a.out + O_SH_S + (size_t)((row - MP) >> 2) * C_Q + 4 * (seg + 16 * i)) = *(const f32x4*)(ps + 4 * (seg + 16 * i)); } }
        }
#pragma unroll 4
        for (int i = 0; i < 16; ++i) { const int e = tid + 512 * i, tt = e >> 8, k = e & 255, row = r0 + tt, col = 1536 + k;
            const float p = PROJ[(size_t)row * NINP + col], pp = proj_prev(a, PROJ, row, col); const float xs = p + (pp - p) * a.in[I_MU][col];
            LA[tt * 264 + k] = (bf16)f2bf(k < 64 ? ftanh(xs) : (k < 128 ? xs : fsig(xs))); }
        __syncthreads();
        for (int prep = 0; prep < ((PROBE_SUB & 64) ? 2 : 1); ++prep) {
            int lane_l = lane; asm volatile("" : "+v"(lane_l));
            const int hh = lane_l >> 5, cl = lane_l & 31;
            f32x16 aw[2], aa[2], ag[2];
#pragma unroll
            for (int cb = 0; cb < 2; ++cb) { aw[cb] = zero16(); aa[cb] = zero16(); ag[cb] = zero16(); }
            const bf16* W2T = WSB(WS_LORA); const bf16* A2T = W2T + 512 * 64; const bf16* G2T = A2T + 512 * 64;
#define LORA_STEP(acc_, WT_, KW_, s_, koff_) { const bf16x8 af = *(const LAS bf16x8*)(LA + cl * 264 + (koff_) + 16 * (s_) + 8 * hh); \
                _Pragma("unroll") for (int cb = 0; cb < 2; ++cb) { const bf16x8 bf_ = *(const bf16x8*)((WT_) + (wave * 64 + cb * 32 + cl) * (KW_) + 16 * (s_) + 8 * hh); acc_[cb] = MFMA32(af, bf_, acc_[cb]); } \
                asm volatile("" ::: "memory"); }
#pragma unroll
            for (int s2 = 0; s2 < 4; ++s2) LORA_STEP(aw, W2T, 64, s2, 0)
#pragma unroll
            for (int s2 = 0; s2 < 4; ++s2) LORA_STEP(aa, A2T, 64, s2, 64)
#pragma unroll
            for (int s2 = 0; s2 < 8; ++s2) LORA_STEP(ag, G2T, 128, s2, 128)
#undef LORA_STEP
            float* RW = WSF(WS_RW);
#pragma unroll
            for (int half = 0; half < 4; ++half) { if (half >= nq) break;
                float mu_r[2], mu_k[2], mu_v[2], w0[2], a0[2], kkc[2], kac[2], rkc[2];
#pragma unroll
                for (int cb = 0; cb < 2; ++cb) { const int c = wave * 64 + cb * 32 + cl;
                mu_r[cb] = a.in[I_MU][c]; mu_k[cb] = a.in[I_MU][512 + c]; mu_v[cb] = a.in[I_MU][1024 + c];
                w0[cb] = a.in[I_W0][c]; a0[cb] = a.in[I_A0][c]; kkc[cb] = a.in[I_KK][c]; kac[cb] = a.in[I_KA][c]; rkc[cb] = a.in[I_RK][c]; }
                float tk[2][4], ta[2][4], tp[2][4], tv[2][4];
                float ld[4][2][6];
#pragma unroll
                for (int i8 = 0; i8 < 4; ++i8) { const int i = half * 4 + i8, row = r0 + crow(i, hh); const float* pr = PROJ + (size_t)row * NINP;
#pragma unroll
                    for (int cb = 0; cb < 2; ++cb) { const int c = wave * 64 + cb * 32 + cl;
                        ld[i8][cb][0] = pr[c]; ld[i8][cb][1] = pr[512 + c]; ld[i8][cb][2] = pr[1024 + c];
                        ld[i8][cb][3] = proj_prev(a, PROJ, row, c); ld[i8][cb][4] = proj_prev(a, PROJ, row, 512 + c); ld[i8][cb][5] = proj_prev(a, PROJ, row, 1024 + c); } }
                asm volatile("" ::: "memory");
#pragma unroll
                for (int i8 = 0; i8 < 4; ++i8) { const int i = half * 4 + i8, row = r0 + crow(i, hh);
#pragma unroll
                    for (int cb = 0; cb < 2; ++cb) { const int c = wave * 64 + cb * 32 + cl;
                        const float pr_ = ld[i8][cb][0], pk_ = ld[i8][cb][1], pv_ = ld[i8][cb][2];
                        const float r = pr_ + (ld[i8][cb][3] - pr_) * mu_r[cb], k = pk_ + (ld[i8][cb][4] - pk_) * mu_k[cb], v = pv_ + (ld[i8][cb][5] - pv_) * mu_v[cb];
                        const float z = -(w0[cb] + aw[cb][i]);
                        const float sp = fmaxf(z, 0.f) + __logf(1.0f + __expf(-fabsf(z)));
                        const float decay = __expf(-__expf(-sp - 0.5f));
                        const float av = fsig(a0[cb] + aa[cb][i]);
                        const float kk = k * kkc[cb], k2 = k * (1.0f + (av - 1.0f) * kac[cb]);
                        const size_t o = (size_t)row * RWW + c;
                        RW[o] = r; RW[RW_STRIDE + o] = decay; RW[2 * RW_STRIDE + o] = k2; RW[3 * RW_STRIDE + o] = v; WSF(WS_G)[o] = ag[cb][i];
                        tk[cb][i8] = kk; ta[cb][i8] = av; tp[cb][i8] = r * k2 * rkc[cb]; tv[cb][i8] = v; } }
#pragma unroll
                for (int i8 = 0; i8 < 4; ++i8) { const int i = half * 4 + i8, row = r0 + crow(i, hh);
                    float ss = tk[0][i8] * tk[0][i8] + tk[1][i8] * tk[1][i8], rk = tp[0][i8] + tp[1][i8];
                    ss = row16_sum(ss); rk = row16_sum(rk); ss += __shfl_xor(ss, 16); rk += __shfl_xor(rk, 16);
                    const float rn = __builtin_amdgcn_rsqf(fmaxf(ss, 1e-24f));
#pragma unroll
                    for (int cb = 0; cb < 2; ++cb) { const int c = wave * 64 + cb * 32 + cl; const size_t o = (size_t)row * RWW + c;
                        const float kkn = tk[cb][i8] * rn; RW[4 * RW_STRIDE + o] = kkn; RW[5 * RW_STRIDE + o] = kkn * ta[cb][i8]; WSF(WS_BON)[o] = rk * tv[cb][i8]; }
                }
            }
        }
    }
}

struct StepD { f32x4 r, w, k, kk, b; float v; };
DI void scan_run(const float* RW, float* Y, int rowbase, int nsteps, int h, int i, int lane, const float* s_in, float* s_out) {
    const int j0 = (lane & 15) * 4; const size_t cofs = (size_t)h * 64 + j0, vofs = (size_t)h * 64 + i;
    f32x4 S = s_in ? *(const f32x4*)(s_in + i * 64 + j0) : (f32x4){0.f, 0.f, 0.f, 0.f};
#define SC_LD(sd, t) { const size_t o_ = (size_t)(rowbase + (t)) * RWW; sd.r = *(const f32x4*)(RW + o_ + cofs); sd.w = *(const f32x4*)(RW + RW_STRIDE + o_ + cofs); sd.k = *(const f32x4*)(RW + 2 * RW_STRIDE + o_ + cofs); \
        sd.v = RW[3 * RW_STRIDE + o_ + vofs]; sd.kk = *(const f32x4*)(RW + 4 * RW_STRIDE + o_ + cofs); sd.b = *(const f32x4*)(RW + 5 * RW_STRIDE + o_ + cofs); }
#define SC_DO(sd, t) { float d_ = (S[0] * sd.kk[0] + S[1] * sd.kk[1]) + (S[2] * sd.kk[2] + S[3] * sd.kk[3]); d_ = row16_sum(d_); const float sa_ = -d_; \
        S = S * sd.w + (sa_ * sd.b + sd.v * sd.k); float y_ = (S[0] * sd.r[0] + S[1] * sd.r[1]) + (S[2] * sd.r[2] + S[3] * sd.r[3]); y_ = row16_sum(y_); \
        if ((lane & 15) == 0) Y[(size_t)(rowbase + (t)) * RWW + vofs] = y_; }
    StepD c0, c1, c2, c3, n0, n1, n2, n3;
    SC_LD(c0, 0) SC_LD(c1, 1) SC_LD(c2, 2) SC_LD(c3, 3)
    for (int t = 0; t < nsteps; t += 4) {
        const int tn = (t + 4 < nsteps) ? t + 4 : t;
        SC_LD(n0, tn) SC_LD(n1, tn + 1) SC_LD(n2, tn + 2) SC_LD(n3, tn + 3)
        SC_DO(c0, t) SC_DO(c1, t + 1) SC_DO(c2, t + 2) SC_DO(c3, t + 3)
        c0 = n0; c1 = n1; c2 = n2; c3 = n3;
    }
#undef SC_LD
#undef SC_DO
    *(f32x4*)(s_out + i * 64 + j0) = S;
}
constexpr int CF_NIT = (NBS * NCMP_S + NBP * NCMP_P) * 2;
#define CFINAL_ITEM(kv_, j_) { const float* HC_ = WSF(WS_HC) + (size_t)(kv_) * CROWS * 256; \
    const int g_ = (j_) & 1; int q_ = (j_) >> 1; int b_, n_, rowlo_; const bool smp_ = q_ < NBS * NCMP_S; \
    if (smp_) { b_ = q_ / NCMP_S; n_ = q_ % NCMP_S; rowlo_ = (b_ * NCH_S + n_) * 2 + g_; } else { q_ -= NBS * NCMP_S; b_ = q_ / NCMP_P; n_ = q_ % NCMP_P; rowlo_ = CROWS_S + (b_ * NCH_P + n_) * 2 + g_; } \
    float s0_, s1_; \
    if (smp_) { const float* lo_ = HC_ + (size_t)rowlo_ * 256; const float* hi_ = lo_ + 2 * 256 + 128; s0_ = lo_[lane] + hi_[lane]; s1_ = lo_[64 + lane] + hi_[64 + lane]; } \
    else { s0_ = 0.f; s1_ = 0.f; _Pragma("unroll") for (int ks_ = 0; ks_ < 4; ++ks_) { const float* lo_ = WSF(WS_HCP) + ((size_t)(ks_ * 2 + (kv_)) * 2048 + (rowlo_ - CROWS_S)) * 256; const float* hi_ = lo_ + 2 * 256 + 128; \
        s0_ += lo_[lane] + hi_[lane]; s1_ += lo_[64 + lane] + hi_[64 + lane]; } } \
    const float h0_ = gelu_tanh(s0_ + pe0), h1_ = gelu_tanh(s1_ + pe1); \
    float acc_ = 0.f; \
    _Pragma("unroll") for (int e = 0; e < 64; ++e) acc_ += __builtin_bit_cast(float, __builtin_amdgcn_readlane(__builtin_bit_cast(int, h0_), e)) * w2c[e]; \
    _Pragma("unroll") for (int e = 0; e < 64; ++e) acc_ += __builtin_bit_cast(float, __builtin_amdgcn_readlane(__builtin_bit_cast(int, h1_), e)) * w2c[64 + e]; \
    if (smp_) WSF(WS_KCS)[(size_t)(kv_) * KCS_STRIDE + ((size_t)(b_ * NCMP_S + n_) * 2 + g_) * 64 + lane] = acc_; \
    else if ((kv_) == 0) WSB(WS_KCP)[((size_t)(b_ * 2 + g_) * 256 + n_) * 64 + lane] = (bf16)f2bf(acc_); \
    else WSB(WS_VCTP)[((size_t)(b_ * 2 + g_) * 64 + lane) * 256 + n_] = (bf16)f2bf(acc_); }
constexpr int SCH = 32, SCHF = SCH * 384;
DI void ph_scan_prompt(const Args& a, LAS unsigned char* lds, int tid, int lane, int wave, int G, int bx) {
    const float* RW = WSF(WS_RW); float* Y = WSF(WS_YS);
    LAS float* buf = (LAS float*)lds;
    constexpr int NCH = T / SCH;
    if (wave >= 2) {
      const bool sidew = (wave & 2) != 0; const int sidx = (wave & 1) + ((wave >> 2) << 1); const int lid = sidx * G + bx, nl = 4 * G, ckv = lid & 1;
      if (sidew) for (int si = lid; si < 4096; si += nl) { const int bh2 = si >> 4, rg2 = si & 15, b2 = bh2 >> 3, h2 = bh2 & 7, i2 = rg2 * 4 + (lane >> 4);
          scan_run(RW, Y, MP + b2 * 4, 4, h2, i2, lane, a.in[I_SWKV] + (size_t)bh2 * 4096, a.out + O_WKV_S + (size_t)bh2 * 4096); }
      asm volatile("" ::: "memory");
      float w2c[128];
#pragma unroll
      for (int e = 0; e < 128; ++e) w2c[e] = a.in[I_PW2][(size_t)(ckv * 128 + e) * 64 + lane];
      const float pe0 = WSF(WS_PET)[ckv * 128 + lane], pe1 = WSF(WS_PET)[ckv * 128 + 64 + lane];
      for (int it = bx; it < 256; it += G) {
        const int bh = it >> 3, b = bh >> 3, h = bh & 7, rowbase = b * T, sidebase = ((it - bx) / G) * NCH;
        __syncthreads();
        {
#define DMA_CHUNK(c) { _Pragma("unroll") for (int q = 0; q < 8; ++q) { const int R0 = ((wave - 2) * 8 + q) * 4, R = R0 + (lane >> 4), t_ = R / 6, aa = R - 6 * t_; \
                __builtin_amdgcn_global_load_lds((const unsigned*)(RW + (size_t)aa * RW_STRIDE + (size_t)(rowbase + (c) * SCH + t_) * RWW + h * 64 + (lane & 15) * 4), \
                    (LAS unsigned*)(buf + ((c) & 1) * SCHF + R0 * 64), 16, 0, 0); } }
            DMA_CHUNK(0)
            asm volatile("s_waitcnt vmcnt(0)" ::: "memory");
            __syncthreads();
            for (int c = 0; c < NCH; ++c) {
                if (c + 1 < NCH) DMA_CHUNK(c + 1)
                if (sidew) { const int j = (sidebase + c) * (nl >> 1) + (lid >> 1); if (j < CF_NIT) CFINAL_ITEM(ckv, j)
                             const int j2 = (NCH + sidebase + c) * (nl >> 1) + (lid >> 1); if (j2 < CF_NIT) CFINAL_ITEM(ckv, j2) }
                asm volatile("s_waitcnt vmcnt(0)" ::: "memory");
                __syncthreads();
            }
#undef DMA_CHUNK
        }
      }
    } else {
      for (int it = bx; it < 256; it += G) {
        const int bh = it >> 3, b = bh >> 3, h = bh & 7, rowbase = b * T;
        __syncthreads();
        {
            const int rg = (it & 7) * 2 + wave, i = rg * 4 + (lane >> 4), j0 = (lane & 15) * 4, k16 = lane & 15; const size_t vofs = (size_t)h * 64 + i;
            typedef float f2 __attribute__((ext_vector_type(2)));
#define RED2(x_, y_) x_ += dpp_f<0x128>(x_); y_ += dpp_f<0x128>(y_); x_ += dpp_f<0x124>(x_); y_ += dpp_f<0x124>(y_); x_ += dpp_f<0x122>(x_); y_ += dpp_f<0x122>(y_); x_ += dpp_f<0x121>(x_); y_ += dpp_f<0x121>(y_);
            f2 Sa = {0.f, 0.f}, Sb = {0.f, 0.f}, ra = {0.f, 0.f}, rb = {0.f, 0.f}; float ysel = 0.f;
            __syncthreads();
            for (int c = 0; c < NCH; ++c) {
                const LAS float* cb = buf + (c & 1) * SCHF; const int tb = c * SCH;
                StepD q0, q1, q2;
#define L_LD(sd, t) { const LAS float* p_ = cb + (t) * 384; sd.r = *(const LAS f32x4*)(p_ + j0); sd.w = *(const LAS f32x4*)(p_ + 64 + j0); sd.k = *(const LAS f32x4*)(p_ + 128 + j0); sd.v = p_[192 + i]; \
                sd.kk = *(const LAS f32x4*)(p_ + 256 + j0); sd.b = *(const LAS f32x4*)(p_ + 320 + j0); }
                L_LD(q0, 0) L_LD(q1, 1)
#pragma unroll
                for (int t = 0; t < SCH; ++t) {
                    if (t + 2 < SCH) L_LD(q2, t + 2)
                    __builtin_amdgcn_sched_barrier(0);
                    f2 td = Sa * (f2){q0.kk[0], q0.kk[1]}; td = Sb * (f2){q0.kk[2], q0.kk[3]} + td;
                    f2 ty = Sa * ra; ty = Sb * rb + ty;
                    float pd = td[0] + td[1], py = ty[0] + ty[1];
                    const f2 vv = {q0.v, q0.v};
                    f2 ua = Sa * (f2){q0.w[0], q0.w[1]}; f2 ub = Sb * (f2){q0.w[2], q0.w[3]};
                    pd += dpp_f<0x128>(pd); py += dpp_f<0x128>(py); ua = vv * (f2){q0.k[0], q0.k[1]} + ua;
                    pd += dpp_f<0x124>(pd); py += dpp_f<0x124>(py); ub = vv * (f2){q0.k[2], q0.k[3]} + ub;
                    pd += dpp_f<0x122>(pd); py += dpp_f<0x122>(py);
                    pd += dpp_f<0x121>(pd); py += dpp_f<0x121>(py);
                    ysel = (k16 == ((t + 15) & 15)) ? py : ysel;
                    if ((t & 15) == 0 && (t > 0 || c > 0)) Y[(size_t)(rowbase + tb + t - 16 + k16) * RWW + vofs] = ysel;
                    const f2 npd = {-pd, -pd};
                    Sa = npd * (f2){q0.b[0], q0.b[1]} + ua; Sb = npd * (f2){q0.b[2], q0.b[3]} + ub;
                    ra = (f2){q0.r[0], q0.r[1]}; rb = (f2){q0.r[2], q0.r[3]};
                    q0 = q1; q1 = q2;
                    __builtin_amdgcn_sched_barrier(0);
                }
#undef L_LD
                __syncthreads();
            }
            { f2 ty = Sa * ra; ty = Sb * rb + ty; float pd = 0.f, py = ty[0] + ty[1]; RED2(pd, py) ysel = (k16 == 15) ? py : ysel; Y[(size_t)(rowbase + T - 16 + k16) * RWW + vofs] = ysel; }
#undef RED2
            const f32x4 S = {Sa[0], Sa[1], Sb[0], Sb[1]};
            *(f32x4*)(a.out + O_WKV_P + (size_t)bh * 4096 + i * 64 + j0) = S;
        }
      }
    }
}

#ifndef PROBE_SUB
#define PROBE_SUB 0
#endif
DI bf16x8 pack8(const f32x4& x0, const f32x4& x1) { v4u p; p.x = pk2(x0[0], x0[1]); p.y = pk2(x0[2], x0[3]); p.z = pk2(x1[0], x1[1]); p.w = pk2(x1[2], x1[3]); return __builtin_bit_cast(bf16x8, p); }
DI f32x16 qk_tile(const bf16* Kp, const bf16x8 (&qf)[4], int lane) {
    const bf16* kr = Kp + (size_t)(lane & 31) * 64 + 8 * (lane >> 5);
    f32x16 p = zero16();
#pragma unroll
    for (int s = 0; s < 4; ++s) { const bf16x8 kf = *(const bf16x8*)(kr + 16 * s); p = MFMA32(kf, qf[s], p); }
    return p;
}
DI void pack_p(const f32x16& P, bf16x8 (&pf)[2]) {
#pragma unroll
    for (int s = 0; s < 2; ++s) { v4u w; w.x = pk2(P[8 * s], P[8 * s + 1]); w.y = pk2(P[8 * s + 2], P[8 * s + 3]); w.z = pk2(P[8 * s + 4], P[8 * s + 5]); w.w = pk2(P[8 * s + 6], P[8 * s + 7]); pf[s] = __builtin_bit_cast(bf16x8, w); }
}
DI void pv_tile(f32x16 (&o)[2], const bf16* Vt, int ldv, const bf16x8 (&pf)[2], int lane) {
    const int hh = lane >> 5;
#pragma unroll
    for (int s = 0; s < 2; ++s)
#pragma unroll
        for (int db = 0; db < 2; ++db) { const bf16* vr = Vt + (size_t)((lane & 31) + 32 * db) * ldv + 16 * s + 4 * hh;
            const s16x4 lo = *(const s16x4*)vr, hi = *(const s16x4*)(vr + 8);
            const bf16x8 vf = __builtin_shufflevector(lo, hi, 0, 1, 2, 3, 4, 5, 6, 7);
            o[db] = MFMA32(vf, pf[s], o[db]); }
}
DI void osm_step(f32x16& p, unsigned okm, float& m, float& l, f32x16 (&o)[2]) {
    float mx = NEGF;
#pragma unroll
    for (int i = 0; i < 16; ++i) mx = ((okm >> i) & 1u) ? fmaxf(mx, p[i]) : mx;
    mx = fmaxf(mx, __shfl_xor(mx, 32));
    const float mn = fmaxf(m, mx), al = __builtin_amdgcn_exp2f(m - mn);
    l *= al; o[0] = o[0] * al; o[1] = o[1] * al;
#pragma unroll
    for (int i = 0; i < 16; ++i) { const float e = ((okm >> i) & 1u) ? __builtin_amdgcn_exp2f(p[i] - mn) : 0.f; p[i] = e; l += e; }
    m = mn;
}
constexpr int IMP_LD = 65;
constexpr int SMASK_OFF = 2 * 4 * 32 * IMP_LD * 4;
DI void swap32_pair(float& a_, float& b_) { asm volatile("s_nop 1\n\tv_permlane32_swap_b32 %0, %1\n\ts_nop 1" : "+v"(a_), "+v"(b_)); }
DI float swap32_max(float x) { float a_ = x, b_ = x; swap32_pair(a_, b_); return fmaxf(a_, b_); }
DI float swap32_sum(float x) { float a_ = x, b_ = x; swap32_pair(a_, b_); return a_ + b_; }
template <int MODE, int BR> DI void osm64(f32x16& p0, f32x16& p1, bool rowok, int kq, float& m, float& l, f32x16 (&o)[2]) {
    float mx = NEGF;
    if (MODE == 2) {
#pragma unroll
        for (int i = 0; i < 16; ++i) { const int c0 = (i & 3) + 8 * (i >> 2), c1 = c0 + 32; const bool a0 = rowok && c0 <= kq && (BR == 1 || c0 > kq - 512), a1 = rowok && c1 <= kq && (BR == 1 || c1 > kq - 512);
            mx = a0 ? fmaxf(mx, p0[i]) : mx; mx = a1 ? fmaxf(mx, p1[i]) : mx; }
    } else {
#pragma unroll
        for (int i = 0; i < 16; i += 2) mx = fmaxf(mx, fmaxf(fmaxf(p0[i], p0[i + 1]), fmaxf(p1[i], p1[i + 1])));
        if (MODE == 1) mx = rowok ? mx : NEGF;
    }
    mx = swap32_max(mx);
    if (__ballot(mx > m) != 0ull) { const float mn = fmaxf(m, mx), al = __builtin_amdgcn_exp2f(m - mn); l *= al; o[0] = o[0] * al; o[1] = o[1] * al; m = mn; }
    const float sub = (MODE == 1 && !rowok) ? 1e30f : m;
    float ls = 0.f;
#pragma unroll
    for (int i = 0; i < 16; ++i) {
        float e0 = __builtin_amdgcn_exp2f(p0[i] - sub), e1 = __builtin_amdgcn_exp2f(p1[i] - sub);
        if (MODE == 2) { const int c0 = (i & 3) + 8 * (i >> 2), c1 = c0 + 32; e0 = (rowok && c0 <= kq && (BR == 1 || c0 > kq - 512)) ? e0 : 0.f; e1 = (rowok && c1 <= kq && (BR == 1 || c1 > kq - 512)) ? e1 : 0.f; }
        p0[i] = e0; p1[i] = e1; ls += e0 + e1; }
    l += ls;
}
constexpr int CMPK_OFF = 69632, CMPV_OFF = CMPK_OFF + 256 * 144, CVROW = 528;
constexpr int ARING_OFF = 69632, ABUF = 18432, AROW = 144, QPARK_OFF = 106496;
template <int BR> DI void attend_blocks(LAS unsigned char* lds, const bf16* Kg, const bf16* Vtg, unsigned long long blkmask, unsigned long long smask,
                                        const LAS bf16x8* qpark, int q0, int t, int tid, int lane, float& m, float& l, f32x16 (&o)[2]) {
    int tid_l = tid; asm volatile("" : "+v"(tid_l));
    const int hh = lane >> 5, r = lane & 31, srow = tid_l >> 3, sch = tid_l & 7;
    const int nb = __popcll(blkmask);
    if (nb == 0) return;
    unsigned long long rem = blkmask;
    int jb = __ffsll((long long)rem) - 1; rem &= rem - 1;
    v4u kreg = *(const v4u*)(Kg + (size_t)(jb * 64 + srow) * 64 + sch * 8);
    v4u vreg = *(const v4u*)(Vtg + (size_t)srow * T + jb * 64 + sch * 8);
    for (int it = 0; it < nb; ++it) {
        LAS unsigned char* kb = lds + ARING_OFF + (it & 1) * ABUF; LAS unsigned char* vb = kb + 64 * AROW;
        *(LAS v4u*)(kb + srow * AROW + sch * 16) = kreg; *(LAS v4u*)(vb + srow * AROW + sch * 16) = vreg;
        const int jcur = jb;
        __syncthreads();
        if (rem) { jb = __ffsll((long long)rem) - 1; rem &= rem - 1;
            kreg = *(const v4u*)(Kg + (size_t)(jb * 64 + srow) * 64 + sch * 8); vreg = *(const v4u*)(Vtg + (size_t)srow * T + jb * 64 + sch * 8); }
        const int k0 = jcur * 64;
        const bool bit = (BR == 1) ? (((*(const LAS unsigned long long*)(lds + SMASK_OFF + ((int)smask) * 8) >> jcur) & 1ull) != 0ull) : true;
        const unsigned long long bal = (BR == 1) ? __ballot(bit) : ~0ull;
        if (bal == 0ull || k0 > q0 + 31 || (BR == 2 && k0 + 63 <= q0 - 512)) continue;
        f32x16 p0 = zero16(), p1 = zero16();
#pragma unroll
        for (int s = 0; s < 4; ++s) { const bf16x8 kf0 = *(const LAS bf16x8*)(kb + r * AROW + 32 * s + 16 * hh), kf1 = *(const LAS bf16x8*)(kb + (32 + r) * AROW + 32 * s + 16 * hh), qs_ = qpark[s * 64];
            p0 = MFMA32(kf0, qs_, p0); p1 = MFMA32(kf1, qs_, p1); }
        const bool interior = (k0 + 63 <= q0) && (BR == 1 || k0 > q0 + 31 - 512);
        if (interior) { if (BR == 2 || bal == ~0ull) osm64<0, BR>(p0, p1, true, 0, m, l, o); else osm64<1, BR>(p0, p1, bit, 0, m, l, o); }
        else osm64<2, BR>(p0, p1, bit, t - k0 - 4 * hh, m, l, o);
        bf16x8 pf0[2], pf1[2]; pack_p(p0, pf0); pack_p(p1, pf1);
#pragma unroll
        for (int s2 = 0; s2 < 2; ++s2)
#pragma unroll
            for (int db = 0; db < 2; ++db) { const LAS unsigned char* vr = vb + (r + 32 * db) * AROW + 32 * s2 + 8 * hh;
                const s16x4 lo0 = *(const LAS s16x4*)vr, hi0 = *(const LAS s16x4*)(vr + 16), lo1 = *(const LAS s16x4*)(vr + 64), hi1 = *(const LAS s16x4*)(vr + 80);
                o[db] = MFMA32(__builtin_shufflevector(lo0, hi0, 0, 1, 2, 3, 4, 5, 6, 7), pf0[s2], o[db]);
                o[db] = MFMA32(__builtin_shufflevector(lo1, hi1, 0, 1, 2, 3, 4, 5, 6, 7), pf1[s2], o[db]); }
    }
    __syncthreads();
}
constexpr int SATT_OFF = 69632;
DI void attn_prompt_unit(const Args& a, LAS unsigned char* lds, int tid, int lane, int wave, int b, int g, int tile) {
    const float* PROJ = WSF(WS_PROJ);
    const int hl = wave & 3, qh = wave >> 2, head = g * 4 + hl, q0 = tile * 64 + qh * 32, r = lane & 31, hh = lane >> 5, t = q0 + r, bg = b * 2 + g;
    const float* prow = PROJ + (size_t)(b * T + t) * NINP;
    {
        const bf16* Kc = WSB(WS_KCP) + (size_t)bg * 256 * 64; const bf16* Vct = WSB(WS_VCTP) + (size_t)bg * 64 * 256;
        LAS unsigned char* ck = lds + CMPK_OFF; LAS unsigned char* cv = lds + CMPV_OFF;
        { const int tmu = tile * 64 + 63, nvu = tmu >= 31 ? (tmu - 31) / 16 + 1 : 0, ntu = (nvu + 31) >> 5;
#pragma unroll
          for (int q = 0; q < 4; ++q) { int tl_ = tid; asm volatile("" : "+v"(tl_)); const int e = tl_ + 512 * q, krow = e >> 3, kch = e & 7, vrow = e >> 5, vch = e & 31;
              if (krow < ntu * 32) *(LAS v4u*)(ck + krow * AROW + kch * 16) = *(const v4u*)(Kc + (size_t)krow * 64 + kch * 8);
              if (vch < ntu * 4) *(LAS v4u*)(cv + vrow * CVROW + vch * 16) = *(const v4u*)(Vct + (size_t)vrow * 256 + vch * 8); } }
    }
    bf16x8 qf[4];
    { const float qs = 0.125f * LOG2E;
#pragma unroll
      for (int s = 0; s < 4; ++s) { const float* qp = prow + C_Q + head * 64 + 16 * s + 8 * hh; qf[s] = pack8(*(const f32x4*)qp * qs, *(const f32x4*)(qp + 4) * qs); } }
    f32x16 of[2]; of[0] = zero16(); of[1] = zero16();
    LAS float* sImp = (LAS float*)lds; LAS unsigned long long* sMask = (LAS unsigned long long*)(lds + SMASK_OFF);
    {
        const bf16* Kc = WSB(WS_KCP) + (size_t)bg * 256 * 64; const bf16* Vct = WSB(WS_VCTP) + (size_t)bg * 64 * 256;
        LAS unsigned char* ck = lds + CMPK_OFF; LAS unsigned char* cv = lds + CMPV_OFF;
        __syncthreads();
        const int tmax = q0 + 31, nvis = tmax >= 31 ? (tmax - 31) / 16 + 1 : 0, ntile = (nvis + 31) >> 5;
#define CMP_QK(p_, kt_) { p_ = zero16(); _Pragma("unroll") for (int s = 0; s < 4; ++s) { const bf16x8 kf = *(const LAS bf16x8*)(ck + ((kt_) * 32 + r) * AROW + 32 * s + 16 * hh); p_ = MFMA32(kf, qf[s], p_); } }
        float m = NEGF, l = 0.f;
        for (int kt = 0; kt < ntile; ++kt) {
            f32x16 p; CMP_QK(p, kt)
            float mx = NEGF;
#pragma unroll
            for (int i = 0; i < 16; ++i) { const int n = kt * 32 + crow(i, hh); mx = (16 * n + 31 <= t) ? fmaxf(mx, p[i]) : mx; }
            mx = swap32_max(mx);
            const float mn = fmaxf(m, mx); l *= __builtin_amdgcn_exp2f(m - mn);
#pragma unroll
            for (int i = 0; i < 16; ++i) { const int n = kt * 32 + crow(i, hh); l += (16 * n + 31 <= t) ? __builtin_amdgcn_exp2f(p[i] - mn) : 0.f; }
            m = mn;
        }
        l = swap32_sum(l);
        const float inv = l > 0.f ? 1.0f / l : 0.f;
        for (int kt = 0; kt < ntile; ++kt) {
            f32x16 p; CMP_QK(p, kt)
#pragma unroll
            for (int i = 0; i < 16; ++i) { const int n = kt * 32 + crow(i, hh); p[i] = (16 * n + 31 <= t) ? __builtin_amdgcn_exp2f(p[i] - m) * inv : 0.f; }
            bf16x8 pf[2]; pack_p(p, pf);
#pragma unroll
            for (int s2 = 0; s2 < 2; ++s2)
#pragma unroll
                for (int db = 0; db < 2; ++db) { const LAS unsigned char* vr = cv + (r + 32 * db) * CVROW + kt * 64 + 32 * s2 + 8 * hh;
                    const s16x4 lo = *(const LAS s16x4*)vr, hi = *(const LAS s16x4*)(vr + 16);
                    of[db] = MFMA32(__builtin_shufflevector(lo, hi, 0, 1, 2, 3, 4, 5, 6, 7), pf[s2], of[db]); }
        }
        { const float g0 = sigmoidf_(WSF(WS_PROJ)[(size_t)(b * T + t) * NINP + C_GATE + head * 3]); of[0] = of[0] * g0; of[1] = of[1] * g0; }
        LAS float* slab = sImp + (size_t)((qh * 4 + hl) * 32 + r) * IMP_LD;
#pragma unroll
        for (int blk = 0; blk < 2; ++blk) {
            f32x16 im = zero16();
            const int kt0 = blk == 0 ? 0 : 3, kt1 = blk == 0 ? (ntile < 4 ? ntile : 4) : ntile;
            for (int kt = kt0; kt < kt1; ++kt) {
                f32x16 p; CMP_QK(p, kt)
#pragma unroll
                for (int i = 0; i < 16; ++i) { const int n = kt * 32 + crow(i, hh); p[i] = (16 * n + 31 <= t) ? __builtin_amdgcn_exp2f(p[i] - m) * inv : 0.f; }
                bf16x8 pf[2]; pack_p(p, pf);
                const int jb = r + 32 * blk;
#pragma unroll
                for (int s = 0; s < 2; ++s) { bf16x8 af;
#pragma unroll
                    for (int j = 0; j < 8; ++j) { const int n = kt * 32 + 16 * s + 8 * (j >> 2) + 4 * hh + (j & 3); af[j] = (n >= 4 * jb - 1 && n <= 4 * jb + 3) ? (short)0x3F80 : (short)0; }
                    im = MFMA32(af, pf[s], im); }
            }
#pragma unroll
            for (int i = 0; i < 16; ++i) slab[32 * blk + crow(i, hh)] = im[i];
        }
#undef CMP_QK
    }
    __syncthreads();
    for (int e = 0; e < 8; ++e) {
        const int qq = wave * 8 + e, qh2 = qq >> 5, rq = qq & 31, tq = tile * 64 + qq, cur = tq >> 6;
        float s = 0.f;
#pragma unroll
        for (int h2 = 0; h2 < 4; ++h2) s += sImp[(size_t)((qh2 * 4 + h2) * 32 + rq) * IMP_LD + lane];
        const float v = lane > cur ? -1e9f : ((lane == 0 || lane == cur || lane == cur - 1) ? 1e9f : s);
        int rank = 0;
#pragma unroll 16
        for (int j = 0; j < 64; ++j) { const float vj = __builtin_bit_cast(float, __builtin_amdgcn_readlane(__builtin_bit_cast(int, v), j)); rank += (vj > v || (vj == v && j < lane)) ? 1 : 0; }
        const unsigned long long mask = __ballot(rank < 16 && lane <= cur);
        if (lane == 0) sMask[qq] = mask;
    }
    __syncthreads();
    const unsigned long long smask = (unsigned long long)(qh * 32 + r);
    __syncthreads();
    LAS float* park = (LAS float*)lds + wave * 2048 + lane;
    LAS bf16x8* qpark = (LAS bf16x8*)(lds + QPARK_OFF) + wave * 256 + lane;
#pragma unroll
    for (int s = 0; s < 4; ++s) qpark[s * 64] = qf[s];
#pragma unroll
    for (int db = 0; db < 2; ++db)
#pragma unroll
        for (int i = 0; i < 16; ++i) park[(db * 16 + i) * 64] = of[db][i];
    {
        float m = NEGF, l = 0.f; f32x16 o[2]; o[0] = zero16(); o[1] = zero16();
        const unsigned long long blk = (tile >= 63) ? ~0ull : ((1ull << (tile + 1)) - 1ull);
        attend_blocks<1>(lds, WSB(WS_KSEL) + (size_t)bg * T * 64, WSB(WS_VTSEL) + (size_t)bg * 64 * T, blk, smask, qpark, q0, t, tid, lane, m, l, o);
        if (PROBE_SUB & 8) attend_blocks<1>(lds, WSB(WS_KSEL) + (size_t)bg * T * 64, WSB(WS_VTSEL) + (size_t)bg * 64 * T, blk, smask, qpark, q0, t, tid, lane, m, l, o);
        l = swap32_sum(l); const float g1 = sigmoidf_(WSF(WS_PROJ)[(size_t)(b * T + t) * NINP + C_GATE + head * 3 + 1]); const float sc = l > 0.f ? g1 / l : 0.f;
#pragma unroll
        for (int db = 0; db < 2; ++db)
#pragma unroll
            for (int i = 0; i < 16; ++i) park[(db * 16 + i) * 64] += o[db][i] * sc;
    }
    {
        float m = NEGF, l = 0.f; f32x16 o[2]; o[0] = zero16(); o[1] = zero16();
        const unsigned long long hi_ = (tile >= 63) ? ~0ull : ((1ull << (tile + 1)) - 1ull), lo_ = (tile >= 8) ? ((1ull << (tile - 8)) - 1ull) : 0ull;
        attend_blocks<2>(lds, WSB(WS_KWIN) + (size_t)bg * T * 64, WSB(WS_VTWIN) + (size_t)bg * 64 * T, hi_ & ~lo_, 0ull, qpark, q0, t, tid, lane, m, l, o);
        if (PROBE_SUB & 16) attend_blocks<2>(lds, WSB(WS_KWIN) + (size_t)bg * T * 64, WSB(WS_VTWIN) + (size_t)bg * 64 * T, hi_ & ~lo_, 0ull, qpark, q0, t, tid, lane, m, l, o);
        l = swap32_sum(l); const float g2 = sigmoidf_(WSF(WS_PROJ)[(size_t)(b * T + t) * NINP + C_GATE + head * 3 + 2]); const float sc = l > 0.f ? g2 / l : 0.f;
#pragma unroll
        for (int db = 0; db < 2; ++db)
#pragma unroll
            for (int i = 0; i < 16; ++i) of[db][i] = park[(db * 16 + i) * 64] + o[db][i] * sc;
    }
    bf16* yb = WSB(WS_AST) + (size_t)(MA + b * T + t) * RWW + head * 64;
#pragma unroll
    for (int db = 0; db < 2; ++db)
#pragma unroll
        for (int gq = 0; gq < 4; ++gq) { v2u w; w.x = pk2(of[db][4 * gq], of[db][4 * gq + 1]); w.y = pk2(of[db][4 * gq + 2], of[db][4 * gq + 3]); *(v2u*)(yb + 32 * db + 8 * gq + 4 * hh) = w; }
}

constexpr int SA_SC = 0, SA_VP = 16384, SA_QV = 24576, SA_RED = 25600, SA_PACC = 26112, SA_IV = 34304, SA_LST = 35392, SA_CNT = 35456, SA_OUT = 35520;
template <int BR> DI void sa_branch_wg(const Args& a, LAS unsigned char* lds, int tid, int lane, int wave, int b, int g, int qpos, int nk, const float* pnew, float g_h0, float g_h1, float g_h2, float g_h3, float (&inv)[4]) {
    LAS float* sc = (LAS float*)(lds + SA_SC); LAS unsigned long long* vptr = (LAS unsigned long long*)(lds + SA_VP); const LAS float* qv = (const LAS float*)(lds + SA_QV);
    LAS float* red = (LAS float*)(lds + SA_RED); LAS float* pacc = (LAS float*)(lds + SA_PACC); const LAS int* lst = (const LAS int*)(lds + SA_LST); LAS float* outb = (LAS float*)(lds + SA_OUT);
    for (int idx = tid; idx < nk; idx += 512) {
        const float* kr; bool ok = true;
        if (BR == 0) kr = WSF(WS_KCS) + ((size_t)(b * NCMP_S + idx) * 2 + g) * 64;
        else if (BR == 1) { if (idx < 960) { const int blk = lst[idx >> 6]; const int page = ((const int*)a.in[I_PT])[b * 128 + (blk >> 1)]; kr = a.in[I_CKS] + ((size_t)page * 128 + (blk & 1) * 64 + (idx & 63)) * 256 + g * 64; }
                            else { kr = pnew + (size_t)(idx - 960) * NINP + 256 + g * 64; ok = (16384 + idx - 960) <= qpos; } }
        else { if (idx < 512) { kr = a.in[I_SKW] + ((size_t)b * 512 + idx) * 256 + g * 64; ok = (15872 + idx) >= qpos - 511; }
               else { kr = pnew + (size_t)(idx - 512) * NINP + 512 + g * 64; ok = (16384 + idx - 512) <= qpos; } }
        vptr[idx] = (unsigned long long)(BR == 0 ? kr + KCS_STRIDE : kr + 128);
        float s0 = 0.f, s1 = 0.f, s2 = 0.f, s3 = 0.f;
#pragma unroll 8
        for (int d4 = 0; d4 < 16; ++d4) { const f32x4 kv = *(const f32x4*)(kr + 4 * d4);
            const f32x4 q0 = *(const LAS f32x4*)(qv + 4 * d4), q1 = *(const LAS f32x4*)(qv + 64 + 4 * d4), q2 = *(const LAS f32x4*)(qv + 128 + 4 * d4), q3 = *(const LAS f32x4*)(qv + 192 + 4 * d4);
            s0 += (kv[0] * q0[0] + kv[1] * q0[1]) + (kv[2] * q0[2] + kv[3] * q0[3]); s1 += (kv[0] * q1[0] + kv[1] * q1[1]) + (kv[2] * q1[2] + kv[3] * q1[3]);
            s2 += (kv[0] * q2[0] + kv[1] * q2[1]) + (kv[2] * q2[2] + kv[3] * q2[3]); s3 += (kv[0] * q3[0] + kv[1] * q3[1]) + (kv[2] * q3[2] + kv[3] * q3[3]); }
        *(LAS f32x4*)(sc + (size_t)idx * 4) = ok ? (f32x4){s0, s1, s2, s3} : (f32x4){NEGF, NEGF, NEGF, NEGF};
    }
    __syncthreads();
    float mx[4] = {NEGF, NEGF, NEGF, NEGF};
    for (int idx = lane; idx < nk; idx += 64) { const f32x4 v = *(const LAS f32x4*)(sc + (size_t)idx * 4);
#pragma unroll
        for (int h = 0; h < 4; ++h) mx[h] = fmaxf(mx[h], v[h]); }
#pragma unroll
    for (int h = 0; h < 4; ++h) mx[h] = wave_max(mx[h]);
    __syncthreads();
    float sm[4] = {0.f, 0.f, 0.f, 0.f};
    for (int idx = tid; idx < nk; idx += 512) { const f32x4 v = *(const LAS f32x4*)(sc + (size_t)idx * 4); f32x4 e;
#pragma unroll
        for (int h = 0; h < 4; ++h) { e[h] = v[h] > -1e29f ? __expf(v[h] - mx[h]) : 0.f; sm[h] += e[h]; }
        *(LAS f32x4*)(sc + (size_t)idx * 4) = e; }
#pragma unroll
    for (int h = 0; h < 4; ++h) { sm[h] = wave_sum(sm[h]); if (lane == 0) red[wave * 4 + h] = sm[h]; }
    __syncthreads();
#pragma unroll
    for (int h = 0; h < 4; ++h) { float t_ = 0.f;
#pragma unroll
        for (int w = 0; w < 8; ++w) t_ += red[w * 4 + h];
        inv[h] = 1.0f / fmaxf(t_, 1e-30f); }
    const int kpw = (nk + 7) >> 3, kbeg = wave * kpw, kend = (kbeg + kpw < nk) ? kbeg + kpw : nk, ks = lane >> 4, d4 = (lane & 15) * 4;
    f32x4 ac0 = {0.f, 0.f, 0.f, 0.f}, ac1 = ac0, ac2 = ac0, ac3 = ac0;
#pragma unroll 8
    for (int idx = kbeg + ks; idx < kend; idx += 4) { const float* vr = (const float*)vptr[idx]; const f32x4 vv = *(const f32x4*)(vr + d4); const f32x4 pp = *(const LAS f32x4*)(sc + (size_t)idx * 4);
        ac0 = ac0 + pp[0] * vv; ac1 = ac1 + pp[1] * vv; ac2 = ac2 + pp[2] * vv; ac3 = ac3 + pp[3] * vv; }
#pragma unroll
    for (int e = 0; e < 4; ++e) { float a0 = ac0[e], a1 = ac1[e], a2 = ac2[e], a3 = ac3[e];
        a0 += __shfl_xor(a0, 16); a0 += __shfl_xor(a0, 32); a1 += __shfl_xor(a1, 16); a1 += __shfl_xor(a1, 32);
        a2 += __shfl_xor(a2, 16); a2 += __shfl_xor(a2, 32); a3 += __shfl_xor(a3, 16); a3 += __shfl_xor(a3, 32);
        if (lane < 16) { pacc[(wave * 4 + 0) * 64 + d4 + e] = a0; pacc[(wave * 4 + 1) * 64 + d4 + e] = a1; pacc[(wave * 4 + 2) * 64 + d4 + e] = a2; pacc[(wave * 4 + 3) * 64 + d4 + e] = a3; } }
    __syncthreads();
    if (tid < 256) { const int h = tid >> 6; float o = 0.f;
#pragma unroll
        for (int w = 0; w < 8; ++w) o += pacc[(w * 4 + h) * 64 + lane];
        const float gsel = h == 0 ? g_h0 : (h == 1 ? g_h1 : (h == 2 ? g_h2 : g_h3));
        outb[tid] = (BR == 0 ? 0.f : outb[tid]) + gsel * o * inv[h]; }
}
DI void attn_sample_wg(const Args& a, LAS unsigned char* lds, int tid, int lane, int wave, int item) {
    const float* PROJ = WSF(WS_PROJ);
    const int b = item >> 3, g = (item >> 2) & 1, q = item & 3, row = MP + b * 4 + q, qpos = 16384 + q;
    const float* prow = PROJ + (size_t)row * NINP; const float* pnew = PROJ + (size_t)(MP + b * 4) * NINP + C_KV;
    LAS float* sc = (LAS float*)(lds + SA_SC); LAS float* qv = (LAS float*)(lds + SA_QV); LAS float* iv = (LAS float*)(lds + SA_IV); LAS int* lst = (LAS int*)(lds + SA_LST); LAS int* cntw = (LAS int*)(lds + SA_CNT);
    const LAS float* outb = (const LAS float*)(lds + SA_OUT);
    __syncthreads();
    if (tid < 256) qv[tid] = prow[C_Q + g * 256 + tid] * 0.125f;
    float gt[4][3];
#pragma unroll
    for (int h = 0; h < 4; ++h)
#pragma unroll
        for (int br = 0; br < 3; ++br) gt[h][br] = sigmoidf_(prow[C_GATE + (g * 4 + h) * 3 + br]);
    __syncthreads();
    float inv[4];
    sa_branch_wg<0>(a, lds, tid, lane, wave, b, g, qpos, NCMP_S, pnew, gt[0][0], gt[1][0], gt[2][0], gt[3][0], inv);
    float val = 0.f; bool cand = tid <= 256;
    if (cand) { float s = 0.f;
        for (int n = 4 * tid - 1; n <= 4 * tid + 3; ++n) if (n >= 0 && n < NCMP_S) { const f32x4 p = *(const LAS f32x4*)(sc + (size_t)n * 4); s += (p[0] * inv[0] + p[1] * inv[1]) + (p[2] * inv[2] + p[3] * inv[3]); }
        val = (tid == 0 || tid == 255 || tid == 256) ? 1e9f : s; iv[tid] = val; }
    __syncthreads();
    int rank = 0;
    if (cand) for (int y = 0; y <= 256; ++y) { const float vy = iv[y]; rank += (vy > val || (vy == val && y < tid)) ? 1 : 0; }
    const bool sel = cand && rank < 16; const unsigned long long bal = __ballot(sel);
    if (lane == 0) cntw[wave] = __popcll(bal);
    __syncthreads();
    { int pos = __popcll(bal & ((1ull << lane) - 1ull)); for (int w = 0; w < wave; ++w) pos += cntw[w]; if (sel) lst[pos] = tid; }
    __syncthreads();
    sa_branch_wg<1>(a, lds, tid, lane, wave, b, g, qpos, 964, pnew, gt[0][1], gt[1][1], gt[2][1], gt[3][1], inv);
    __syncthreads();
    sa_branch_wg<2>(a, lds, tid, lane, wave, b, g, qpos, 516, pnew, gt[0][2], gt[1][2], gt[2][2], gt[3][2], inv);
    __syncthreads();
    if (tid < 256) WSB(WS_AST)[(size_t)(MA + row) * RWW + g * 256 + tid] = (bf16)f2bf(outb[tid]);
}
DI void rwpost_items(const Args& a, int lane, int wave, int G, int bx) {
    const int gw = wave * G + bx, NGW = G * NWAVES, sub = lane >> 4, c4 = (lane & 15) * 4;
    for (int tk = gw; tk < MR * 2; tk += 2 * NGW) {
        f32x4 y[2], bo[2], gg[2]; size_t o[2]; int cc[2]; bool ok[2];
#pragma unroll
        for (int u = 0; u < 2; ++u) { const int t2 = tk + u * NGW; ok[u] = t2 < MR * 2; const int id = (ok[u] ? t2 : tk) * 4 + sub; cc[u] = (id & 7) * 64 + c4; o[u] = (size_t)(id >> 3) * RWW + cc[u];
            y[u] = *(const f32x4*)(WSF(WS_YS) + o[u]); bo[u] = *(const f32x4*)(WSF(WS_BON) + o[u]); gg[u] = *(const f32x4*)(WSF(WS_G) + o[u]); }
#pragma unroll
        for (int u = 0; u < 2; ++u) { const f32x4 lw = *(const f32x4*)(a.in[I_LNW] + cc[u]), lb = *(const f32x4*)(a.in[I_LNBB] + cc[u]);
            const float mean = row16_sum((y[u][0] + y[u][1]) + (y[u][2] + y[u][3])) * (1.0f / 64.0f); const f32x4 dl = y[u] - mean;
            const float var = row16_sum((dl[0] * dl[0] + dl[1] * dl[1]) + (dl[2] * dl[2] + dl[3] * dl[3])) * (1.0f / 64.0f);
            const f32x4 ov = (dl * __builtin_amdgcn_rsqf(var + GN_EPS) * lw + lb + bo[u]) * gg[u];
            if (ok[u]) { v2u w; w.x = pk2(ov[0], ov[1]); w.y = pk2(ov[2], ov[3]); *(v2u*)(WSB(WS_AST) + o[u]) = w; } }
    }
}
#ifndef PROBE_SUB
#define PROBE_SUB 0
#endif
DI void ph_attention(const Args& a, LAS unsigned char* lds, int tid, int lane, int wave, int G, int bx) {
    for (int rep = 0; rep < ((PROBE_SUB & 1) ? 2 : 1); ++rep)
    for (int i = 0; i < 4; ++i) {
        const int vbx = (G % 8 == 0) ? (bx % 8) * (G / 8) + bx / 8 : bx;
        const int base = (i >> 1) * G, u0 = base + vbx; if (u0 >= 256) break;
        const int u = (i & 1) ? 511 - u0 : u0;
        __syncthreads();
        attn_prompt_unit(a, lds, tid, lane, wave, u >> 7, (u >> 6) & 1, u & 63);
    }
    for (int rep = 0; rep < ((PROBE_SUB & 2) ? 2 : 1); ++rep)
    for (int it = bx; it < 256; it += G) attn_sample_wg(a, lds, tid, lane, wave, it);
    for (int rep = 0; rep < ((PROBE_SUB & 4) ? 2 : 1); ++rep)
    rwpost_items(a, lane, wave, G, bx);
}

DI void cfinal_range(const Args& a, int lane, int worker, int nworkers, int j0, int j1) {
    const int ckv = worker & 1;
    float w2c[128];
#pragma unroll
    for (int e = 0; e < 128; ++e) w2c[e] = a.in[I_PW2][(size_t)(ckv * 128 + e) * 64 + lane];
    const float pe0 = WSF(WS_PET)[ckv * 128 + lane], pe1 = WSF(WS_PET)[ckv * 128 + 64 + lane];
    for (int j = j0 + (worker >> 1); j < j1; j += nworkers >> 1) CFINAL_ITEM(ckv, j)
}
DI void cfinal_sample_mfma(const Args& a, int lane, int worker, int nworkers) {
    const int r = lane & 31, hh = lane >> 5;
    for (int task = worker; task < 2 * NBS * 64; task += nworkers) {
        const int kv = task & 1, b = (task >> 1) >> 6, tt = (task >> 1) & 63;
        const int loc = 32 * tt + r, locc = loc < 2 * NCMP_S ? loc : 2 * NCMP_S - 1;
        const float* lo = WSF(WS_HC) + ((size_t)kv * CROWS + (size_t)b * 2048 + locc) * 256 + 8 * hh; const float* hi = lo + 2 * 256 + 128;
        const float* pe = WSF(WS_PET) + kv * 128 + 8 * hh; const bf16* w2t = WSB(WS_W2T) + (size_t)kv * 64 * 128 + (size_t)r * 128 + 8 * hh;
        f32x16 acc0 = zero16(), acc1 = zero16();
#pragma unroll 2
        for (int s = 0; s < 8; ++s) {
            const f32x4 l0 = *(const f32x4*)(lo + 16 * s), l1 = *(const f32x4*)(lo + 16 * s + 4), h0 = *(const f32x4*)(hi + 16 * s), h1 = *(const f32x4*)(hi + 16 * s + 4);
            const f32x4 p0 = *(const f32x4*)(pe + 16 * s), p1 = *(const f32x4*)(pe + 16 * s + 4);
            const bf16x8 b0 = *(const bf16x8*)(w2t + 16 * s), b1 = *(const bf16x8*)(w2t + 32 * 128 + 16 * s);
            f32x4 x0 = l0 + h0 + p0, x1 = l1 + h1 + p1;
#pragma unroll
            for (int e = 0; e < 4; ++e) { x0[e] = gelu_tanh(x0[e]); x1[e] = gelu_tanh(x1[e]); }
            const bf16x8 af = pack8(x0, x1);
            acc0 = MFMA32(af, b0, acc0); acc1 = MFMA32(af, b1, acc1);
        }
        float* out = WSF(WS_KCS) + (size_t)kv * KCS_STRIDE + ((size_t)b * 2 * NCMP_S + 32 * tt) * 64 + r;
#pragma unroll
        for (int i = 0; i < 16; ++i) { const int it = crow(i, hh); if (32 * tt + it < 2 * NCMP_S) { out[(size_t)it * 64] = acc0[i]; out[(size_t)it * 64 + 32] = acc1[i]; } }
    }
}
constexpr int CF_SAMPLE_ITEMS = NBS * NCMP_S * 2;
DI void ph_cfinal_prompt(const Args& a, int lane, int wave, int G, int bx) { cfinal_range(a, lane, wave * G + bx, NWAVES * G, CF_SAMPLE_ITEMS, CF_NIT); }

constexpr int NSCANWG = 64;
struct StepE { f32x4 r0, r1, w0, w1, k0, k1, kk0, kk1, b0, b1; float v; };
DI void scan8(const Args& a, LAS unsigned char* lds, int lane, int wave, int sw) {
    const float* RW = WSF(WS_RW); float* Y = WSF(WS_YS);
    LAS float* buf = (LAS float*)lds;
    constexpr int NCH = T / SCH;
    const int bh = sw >> 1, b = bh >> 3, h = bh & 7, rowbase = b * T;
    const bool scanner = wave < 4;
    const int i = (sw & 1) * 32 + (wave & 3) * 8 + (lane >> 3), j0 = (lane & 7) * 8, k8 = lane & 7; const size_t vofs = (size_t)h * 64 + i;
    typedef float f2 __attribute__((ext_vector_type(2)));
#define DMA_CHUNK8(c) { _Pragma("unroll") for (int q = 0; q < 6; ++q) { const int R0 = (wave * 6 + q) * 4, R = R0 + (lane >> 4), t_ = R / 6, aa = R - 6 * t_; \
        __builtin_amdgcn_global_load_lds((const unsigned*)(RW + (size_t)aa * RW_STRIDE + (size_t)(rowbase + (c) * SCH + t_) * RWW + h * 64 + (lane & 15) * 4), \
            (LAS unsigned*)(buf + ((c) & 1) * SCHF + R0 * 64), 16, 0, 0); } }
#define RED8(x_, y_) x_ += dpp_f<0x141>(x_); y_ += dpp_f<0x141>(y_); x_ += dpp_f<0xB1>(x_); y_ += dpp_f<0xB1>(y_); x_ += dpp_f<0x4E>(x_); y_ += dpp_f<0x4E>(y_);
    f2 S0 = {0.f, 0.f}, S1 = S0, S2 = S0, S3 = S0, p0 = S0, p1 = S0, p2 = S0, p3 = S0; float ysel = 0.f;
    __syncthreads();
    DMA_CHUNK8(0)
    asm volatile("s_waitcnt vmcnt(0)" ::: "memory");
    __syncthreads();
    for (int c = 0; c < NCH; ++c) {
        if (c + 1 < NCH) DMA_CHUNK8(c + 1)
        if (scanner) {
            const LAS float* cb = buf + (c & 1) * SCHF; const int tb = c * SCH;
            StepE q0, q1, q2;
#define L_LD8(sd, t) { const LAS float* p_ = cb + (t) * 384 + j0; sd.r0 = *(const LAS f32x4*)(p_); sd.r1 = *(const LAS f32x4*)(p_ + 4); sd.w0 = *(const LAS f32x4*)(p_ + 64); sd.w1 = *(const LAS f32x4*)(p_ + 68); \
            sd.k0 = *(const LAS f32x4*)(p_ + 128); sd.k1 = *(const LAS f32x4*)(p_ + 132); sd.v = cb[(t) * 384 + 192 + i]; sd.kk0 = *(const LAS f32x4*)(p_ + 256); sd.kk1 = *(const LAS f32x4*)(p_ + 260); \
            sd.b0 = *(const LAS f32x4*)(p_ + 320); sd.b1 = *(const LAS f32x4*)(p_ + 324); }
            L_LD8(q0, 0) L_LD8(q1, 1)
#pragma unroll
            for (int t = 0; t < SCH; ++t) {
                if (t + 2 < SCH) L_LD8(q2, t + 2)
                __builtin_amdgcn_sched_barrier(0);
                f2 ta = S0 * (f2){q0.kk0[0], q0.kk0[1]}, tb2 = S1 * (f2){q0.kk0[2], q0.kk0[3]}; ta = S2 * (f2){q0.kk1[0], q0.kk1[1]} + ta; tb2 = S3 * (f2){q0.kk1[2], q0.kk1[3]} + tb2; ta = ta + tb2;
                f2 ya = S0 * p0, yb = S1 * p1; ya = S2 * p2 + ya; yb = S3 * p3 + yb; ya = ya + yb;
                float pd = ta[0] + ta[1], py = ya[0] + ya[1];
                const f2 vv = {q0.v, q0.v};
                f2 u0 = S0 * (f2){q0.w0[0], q0.w0[1]}, u1 = S1 * (f2){q0.w0[2], q0.w0[3]}, u2 = S2 * (f2){q0.w1[0], q0.w1[1]}, u3 = S3 * (f2){q0.w1[2], q0.w1[3]};
                pd += dpp_f<0x141>(pd); py += dpp_f<0x141>(py); u0 = vv * (f2){q0.k0[0], q0.k0[1]} + u0; u1 = vv * (f2){q0.k0[2], q0.k0[3]} + u1;
                pd += dpp_f<0xB1>(pd); py += dpp_f<0xB1>(py); u2 = vv * (f2){q0.k1[0], q0.k1[1]} + u2; u3 = vv * (f2){q0.k1[2], q0.k1[3]} + u3;
                pd += dpp_f<0x4E>(pd); py += dpp_f<0x4E>(py);
                ysel = (k8 == ((t + 7) & 7)) ? py : ysel;
                if ((t & 7) == 0 && (t > 0 || c > 0)) Y[(size_t)(rowbase + tb + t - 8 + k8) * RWW + vofs] = ysel;
                const f2 npd = {-pd, -pd};
                S0 = npd * (f2){q0.b0[0], q0.b0[1]} + u0; S1 = npd * (f2){q0.b0[2], q0.b0[3]} + u1; S2 = npd * (f2){q0.b1[0], q0.b1[1]} + u2; S3 = npd * (f2){q0.b1[2], q0.b1[3]} + u3;
                p0 = (f2){q0.r0[0], q0.r0[1]}; p1 = (f2){q0.r0[2], q0.r0[3]}; p2 = (f2){q0.r1[0], q0.r1[1]}; p3 = (f2){q0.r1[2], q0.r1[3]};
                q0 = q1; q1 = q2;
                __builtin_amdgcn_sched_barrier(0);
            }
#undef L_LD8
        }
        asm volatile("s_waitcnt vmcnt(0)" ::: "memory");
        __syncthreads();
    }
#undef DMA_CHUNK8
    if (scanner) {
        f2 ya = S0 * p0, yb = S1 * p1; ya = S2 * p2 + ya; yb = S3 * p3 + yb; ya = ya + yb; float py = ya[0] + ya[1], dm = 0.f;
        RED8(dm, py)
        ysel = (k8 == 7) ? py : ysel; Y[(size_t)(rowbase + T - 8 + k8) * RWW + vofs] = ysel;
        float* so = a.out + O_WKV_P + (size_t)bh * 4096 + i * 64 + j0;
        *(f32x4*)so = (f32x4){S0[0], S0[1], S1[0], S1[1]}; *(f32x4*)(so + 4) = (f32x4){S2[0], S2[1], S3[0], S3[1]};
    }
#undef RED8
}
constexpr int CW_CFDONE = 512;
DI void ph_mixers(const Args& a, LAS unsigned char* lds, int tid, int lane, int wave, int G, int bx) {
    if (bx < NSCANWG) { scan8(a, lds, lane, wave, bx); if (PROBE_SUB & 128) scan8(a, lds, lane, wave, bx); return; }
    const int j = bx - NSCANWG, NA = G - NSCANWG;
    unsigned* ctl = (unsigned*)(a.ws + WS_CTL);
    { const float* RW = WSF(WS_RW); float* Y = WSF(WS_YS); const int worker = wave * NA + j, nworkers = NWAVES * NA;
      for (int si = worker; si < 4096; si += nworkers) { const int bh2 = si >> 4, rg2 = si & 15, b2 = bh2 >> 3, h2 = bh2 & 7, i2 = rg2 * 4 + (lane >> 4);
          scan_run(RW, Y, MP + b2 * 4, 4, h2, i2, lane, a.in[I_SWKV] + (size_t)bh2 * 4096, a.out + O_WKV_S + (size_t)bh2 * 4096); }
      asm volatile("" ::: "memory");
      cfinal_sample_mfma(a, lane, worker, nworkers);
      asm volatile("" ::: "memory");
      prologue_late(a, lds, lane, wave, worker, nworkers); }
    asm volatile("s_waitcnt vmcnt(0)" ::: "memory");
    __syncthreads();
    if (tid == 0) { __builtin_amdgcn_fence(__ATOMIC_RELEASE, "agent"); asm volatile("s_waitcnt vmcnt(0)" ::: "memory"); __hip_atomic_fetch_add(ctl + CW_CFDONE, 1u, __ATOMIC_RELAXED, __HIP_MEMORY_SCOPE_AGENT); }
    for (int rnd = 0; ; ++rnd) {
        const int k = rnd * NA + ((rnd & 1) ? NA - 1 - j : j); if (k >= 512) break;
        const int tile = 63 - (k >> 3), bg = k & 7;
        __syncthreads();
        attn_prompt_unit(a, lds, tid, lane, wave, bg >> 1, bg & 1, tile);
    }
    __syncthreads();
    if (tid == 0) { unsigned sp = 0;
        while (__hip_atomic_load(ctl + CW_CFDONE, __ATOMIC_RELAXED, __HIP_MEMORY_SCOPE_AGENT) < (unsigned)NA) { __builtin_amdgcn_s_sleep(2); if (++sp > (1u << 22)) break; }
        __builtin_amdgcn_fence(__ATOMIC_ACQUIRE, "agent"); asm volatile("s_waitcnt vmcnt(0)" ::: "memory"); }
    __syncthreads();
    for (int it = NA - 1 - j; it < 256; it += NA) attn_sample_wg(a, lds, tid, lane, wave, it);
}
DI void ph_rwpost(const Args& a, int lane, int wave, int G, int bx) { rwpost_items(a, lane, wave, G, bx); }

constexpr int N_PHASES = 16;
#ifndef PROBE_MASK
#define PROBE_MASK 0
#endif
#ifndef ONLY_PHASE
#define ONLY_PHASE (-1)
#endif
#ifndef MK_PER_PHASE
#define MK_PER_PHASE 0
#endif
__global__ void __launch_bounds__(NWAVES * 64, 2) fwd_kernel(Args a) {
    extern __shared__ __attribute__((aligned(16))) unsigned char lds_raw[];
    LAS unsigned char* lds = (LAS unsigned char*)lds_raw;
    const int tid = threadIdx.x, lane = tid & 63, wave = __builtin_amdgcn_readfirstlane(tid >> 6), G = gridDim.x, bx = blockIdx.x;
    for (int u = tid; u < (LDS_BYTES - LDSCTL_OFF) / 4; u += NWAVES * 64) ((LAS unsigned*)(lds + LDSCTL_OFF))[u] = 0u;
    __syncthreads();
    volatile LAS unsigned* MISC = (volatile LAS unsigned*)(lds + MISC_OFF);
    unsigned* ctl = (unsigned*)(a.ws + WS_CTL);
    XcdBarrier bar; bar.bar = ctl + CW_BAR; bar.x = 0; bar.st = nullptr;
    if (!MK_PER_PHASE) bar = xcd_barrier_post(ctl + CW_BAR, MISC + 8);
    const int lo = a.ph_lo, hi = a.ph_hi;
#define IN(k) (lo <= (k) && (k) < hi)
#define SEAM(k) do { if (IN(k) && IN((k) + 1)) xcd_barrier(bar); } while (0)
#define RUN(k, ...) do { if (IN(k) && (ONLY_PHASE < 0 || ONLY_PHASE == (k))) { __VA_ARGS__ if ((PROBE_MASK >> (k)) & 1) { xcd_barrier(bar); __VA_ARGS__ } } } while (0)
    LAS unsigned char* ring = lds + RING_OFF;
    RUN(0, ph_prologue(a, lds, tid, lane, wave, G, bx););
    SEAM(0);
    RUN(1, ph_u1(a, lane, wave, G, bx); ph_compress_sample(a, lds, tid, lane, wave, G, bx););
    SEAM(1);
    RUN(2, { pg8::Gemm g{WSB(WS_U), WSB(WS_WGU), MA, 5632, D}; pg8::StaticOrder S; S.init(MA, 5632, G, bx); pg8::EpiSwiglu E{WSB(WS_H)}; pg8::gemm_phase<pg8::EpiSwiglu, pg8::StaticOrder, true, true>(ring, g, S, E); });
    SEAM(2);
    RUN(3, { pg8::Gemm g{WSB(WS_H), WSB(WS_WDN), MA, D, FF}; pg8::PromptPlusSplit S; S.init(D, 11, 4, G, bx); pg8::EpiResid E{a.in[I_XP], a.in[I_XS], WSF(WS_MOD), 2, 0.5f, WSF(WS_Z)}; pg8::gemm_phase<pg8::EpiResid, pg8::PromptPlusSplit, true, true>(ring, g, S, E); });
    SEAM(3);
    RUN(4, ph_ln<0>(a, lane, wave, G, bx););
    SEAM(4);
    RUN(5, { pg8::Gemm g{WSB(WS_U), WSB(WS_WIN), MA, NINP, D}; pg8::StaticOrder S; S.init(MA, NINP, G, bx); pg8::EpiProj E{a.in[I_BIN], WSF(WS_PROJ), a.out, a.ws}; pg8::gemm_phase<pg8::EpiProj, pg8::StaticOrder, true, true>(ring, g, S, E); });
    SEAM(5);
    RUN(6, ph_dist_rwprep(a, lds, tid, lane, wave, G, bx); __syncthreads(); { pg8::Gemm g{WSB(WS_ACMP), WSB(WS_WC1), 2 * CROWS, 512, 1024}; pg8::PromptCmpOrder S{G, (bx + G - 16) % G}; pg8::EpiF32 E{WSF(WS_HCP), 256, 0}; pg8::gemm_phase<pg8::EpiF32, pg8::PromptCmpOrder, true, true>(ring, g, S, E); });
    SEAM(6);
    RUN(7, ph_cfinal_prompt(a, lane, wave, G, bx););
    SEAM(7);
    RUN(8, ph_mixers(a, lds, tid, lane, wave, G, bx););
    SEAM(8);
    RUN(9, ph_rwpost(a, lane, wave, G, bx););
    SEAM(9);
    RUN(10, { pg8::Gemm g{WSB(WS_AST), WSB(WS_WOAB), 2 * MA, 2048, 512}; pg8::PairOrder S{MA / 256, 4, G, bx}; pg8::EpiOutAB E{WSF(WS_PROJ), WSF(WS_M1), WSB(WS_MIN), MA / 256}; pg8::gemm_phase<pg8::EpiOutAB, pg8::PairOrder, true, true>(ring, g, S, E); });
    SEAM(10);
    RUN(11, { pg8::Gemm g{WSB(WS_MIN), WSB(WS_WO), MA, D, D}; pg8::PromptPlusSplit S; S.init(D, 4, 4, G, bx); pg8::EpiResid E{WSF(WS_X1), WSF(WS_X1) + (size_t)MP * D, WSF(WS_MOD), 5, 1.0f, WSF(WS_Z)}; pg8::gemm_phase<pg8::EpiResid, pg8::PromptPlusSplit, true, true>(ring, g, S, E); });
    SEAM(11);
    RUN(12, ph_ln<1>(a, lane, wave, G, bx););
    SEAM(12);
    RUN(13, { pg8::Gemm g{WSB(WS_U), WSB(WS_WGU) + (size_t)5632 * D, MA, 5632, D}; pg8::StaticOrder S; S.init(MA, 5632, G, bx); pg8::EpiSwiglu E{WSB(WS_H)}; pg8::gemm_phase<pg8::EpiSwiglu, pg8::StaticOrder, true, true>(ring, g, S, E); });
    SEAM(13);
    RUN(14, { pg8::Gemm g{WSB(WS_H), WSB(WS_WDN) + (size_t)D * FF, MA, D, FF}; pg8::PromptPlusSplit S; S.init(D, 11, 4, G, bx); pg8::EpiResid E{WSF(WS_X2), WSF(WS_X2) + (size_t)MP * D, WSF(WS_MOD), 8, 0.5f, WSF(WS_Z)}; pg8::gemm_phase<pg8::EpiResid, pg8::PromptPlusSplit, true, true>(ring, g, S, E); });
    SEAM(14);
    RUN(15, ph_ln<2>(a, lane, wave, G, bx););
#undef IN
#undef SEAM
}

extern "C" void kernel_launch(void* const* d_in, const int* in_sizes, int n_in, void* d_out, int out_size, void* d_ws, size_t ws_size, hipStream_t stream) {
    static int grid = 0;
    if (grid == 0) {
        if (n_in != N_IN || (size_t)out_size != O_END || ws_size < WS_END) { fprintf(stderr, "kernel_launch: unexpected shapes: n_in %d out %d ws %zu (need %zu)\n", n_in, out_size, ws_size, (size_t)WS_END); grid = -1; return; }
        int dev = 0, cus = 0, per_cu = 0;
        if (hipGetDevice(&dev) != hipSuccess || hipDeviceGetAttribute(&cus, hipDeviceAttributeMultiprocessorCount, dev) != hipSuccess) { grid = -1; return; }
        if (hipFuncSetAttribute((const void*)fwd_kernel, hipFuncAttributeMaxDynamicSharedMemorySize, LDS_BYTES) != hipSuccess) { fprintf(stderr, "kernel_launch: hipFuncSetAttribute failed\n"); grid = -1; return; }
        if (hipOccupancyMaxActiveBlocksPerMultiprocessor(&per_cu, (const void*)fwd_kernel, NWAVES * 64, LDS_BYTES) != hipSuccess || per_cu < 1)
            fprintf(stderr, "kernel_launch: note: occupancy query reports %d workgroups per CU\n", per_cu);
        (void)hipGetLastError();
        grid = cus;
    }
    if (grid < 0) return;
    if (hipMemsetAsync((char*)d_ws + WS_CTL, 0, CTL_ZERO_BYTES, stream) != hipSuccess) return;
    Args a{};
    for (int i = 0; i < N_IN; ++i) a.in[i] = (const float*)d_in[i];
    a.out = (float*)d_out; a.ws = (unsigned char*)d_ws;
#if MK_PER_PHASE
    for (int p = 0; p < N_PHASES; ++p) { a.ph_lo = p; a.ph_hi = p + 1; hipLaunchKernelGGL(fwd_kernel, dim3(grid), dim3(NWAVES * 64), LDS_BYTES, stream, a); }
#else
    a.ph_lo = 0; a.ph_hi = N_PHASES;
    hipLaunchKernelGGL(fwd_kernel, dim3(grid), dim3(NWAVES * 64), LDS_BYTES, stream, a);
#endif
    const hipError_t le = hipPeekAtLastError();
    if (le != hipSuccess) fprintf(stderr, "kernel_launch: launch failed: %s\n", hipGetErrorName(le));
}
```
